# Optimizing an MI355X kernel written in HIP

```python
import jax, jax.numpy as jnp
from jax import lax
import numpy as np

D_MODEL = 1024
BATCH = 8
SEQ = 2048
DEPTH = 4

GRID_W = 64
N_MEM = 256
HEAD_DIM = 64
N_MIX_HEADS = D_MODEL // HEAD_DIM
ML_HEADS = (3 * N_MIX_HEADS) // 8
NA_HEADS = (N_MIX_HEADS - ML_HEADS) // 2
GLA_HEADS = N_MIX_HEADS - ML_HEADS - NA_HEADS
ML_DIM = ML_HEADS * HEAD_DIM
NA_DIM = NA_HEADS * HEAD_DIM
GLA_DK = HEAD_DIM // 2
GLA_KDIM = GLA_HEADS * GLA_DK
GLA_VDIM = GLA_HEADS * HEAD_DIM
D_MIX = ML_DIM + NA_DIM + GLA_VDIM
GLA_RANK = 16
GLA_TAU = 16.0
NA_KH_MAX = 8
NA_KW = 16
ML_CHUNK = 128
GLA_CHUNK = 64
X_HEADS = 4
X_HEAD_DIM = D_MODEL // X_HEADS
D_FF = ((8 * D_MODEL // 3 + 127) // 128) * 128
EPS = 1e-6
IN_SIZES = (ML_DIM, ML_DIM, ML_DIM, ML_DIM, 4 * ML_HEADS,
            NA_DIM, NA_DIM, NA_DIM,
            GLA_KDIM, GLA_KDIM, GLA_VDIM, GLA_VDIM, 2 * GLA_RANK)
IN_COLS = sum(IN_SIZES)

kernel_name = 'hybrid_mlstm_natten_gla_encoder'


def rms_norm(x, g):
    xf = x.astype(jnp.float32)
    y = xf * lax.rsqrt(jnp.mean(xf * xf, axis=-1, keepdims=True) + EPS)
    return (y * g.astype(jnp.float32)).astype(x.dtype)


def head_rms_norm(h, g, n_heads):
    B, T, C = h.shape
    hh = h.reshape(B, T, n_heads, C // n_heads)
    hh = hh * lax.rsqrt(jnp.mean(hh * hh, axis=-1, keepdims=True) + EPS)
    return hh.reshape(B, T, C) * g.astype(jnp.float32)


def dwconv_centred(x, w, b):
    xp = jnp.pad(x, ((0, 0), (1, 1), (0, 0)))
    return xp[:, :-2] * w[0] + xp[:, 1:-1] * w[1] + xp[:, 2:] * w[2] + b


def to_chunks(a, L):
    B, H, T = a.shape[:3]
    return jnp.moveaxis(a.reshape((B, H, T // L, L) + a.shape[3:]), 2, 0)


def from_chunks(a):
    a = jnp.moveaxis(a, 0, 2)
    return a.reshape(a.shape[:2] + (-1,) + a.shape[4:])


def mlstm_chunkwise(q, k, v, i_pre, f_pre):
    B, H, T, d = q.shape
    L = ML_CHUNK
    logf = jax.nn.log_sigmoid(f_pre)
    xs = tuple(to_chunks(a, L) for a in (q, k, v, i_pre, logf))
    causal = jnp.tril(jnp.ones((L, L), dtype=bool))

    def step(carry, inp):
        C, n, m = carry
        qb, kb, vb, ib, fb = inp
        b = jnp.cumsum(fb, axis=-1)
        g = b[..., -1]
        D = b[..., :, None] - b[..., None, :] + ib[..., None, :]
        D = jnp.where(causal, D, -jnp.inf)
        inter = b + m[..., None]
        m_row = jnp.maximum(inter, jnp.max(D, axis=-1))
        w_inter = jnp.exp(inter - m_row)
        s = jnp.einsum('bhid,bhjd->bhij', qb, kb) * jnp.exp(D - m_row[..., None])
        num = jnp.einsum('bhij,bhje->bhie', s, vb) + w_inter[..., None] * jnp.einsum('bhid,bhde->bhie', qb, C)
        den = jnp.sum(s, axis=-1) + w_inter * jnp.einsum('bhid,bhd->bhi', qb, n)
        h = num / jnp.maximum(jnp.abs(den), jnp.exp(-m_row))[..., None]
        tail = g[..., None] - b + ib
        m_new = jnp.maximum(g + m, jnp.max(tail, axis=-1))
        wk = jnp.exp(tail - m_new[..., None])
        decay = jnp.exp(g + m - m_new)
        C_new = decay[..., None, None] * C + jnp.einsum('bhj,bhjd,bhje->bhde', wk, kb, vb)
        n_new = decay[..., None] * n + jnp.einsum('bhj,bhjd->bhd', wk, kb)
        return (C_new, n_new, m_new), h

    init = (jnp.zeros((B, H, d, d), jnp.float32), jnp.zeros((B, H, d), jnp.float32), jnp.zeros((B, H), jnp.float32))
    _, hs = lax.scan(step, init, xs)
    return from_chunks(hs)


def gla_chunked(q, k, v, log_a):
    B, H, T, dk = q.shape
    dv = v.shape[-1]
    L = GLA_CHUNK
    xs = tuple(to_chunks(a, L) for a in (q, k, v, log_a))
    causal = jnp.tril(jnp.ones((L, L), dtype=bool))

    def step(S, inp):
        qb, kb, vb, ab = inp
        Bc = jnp.cumsum(ab, axis=2)
        Btot = Bc[:, :, -1]
        q_dec = qb * jnp.exp(Bc)
        A = jnp.einsum('bhid,bhjd->bhij', q_dec, kb * jnp.exp(-Bc))
        A = jnp.where(causal, A, 0.0)
        o = jnp.einsum('bhij,bhje->bhie', A, vb) + jnp.einsum('bhid,bhde->bhie', q_dec, S)
        k_tail = kb * jnp.exp(Btot[:, :, None, :] - Bc)
        S_new = jnp.exp(Btot)[..., None] * S + jnp.einsum('bhjd,bhje->bhde', k_tail, vb)
        return S_new, o

    _, os_ = lax.scan(step, jnp.zeros((B, H, dk, dv), jnp.float32), xs)
    return from_chunks(os_)


def neighbourhood_attention(q, k, v, rpb):
    B, T, H, d = q.shape
    rows = T // GRID_W
    kh = min(NA_KH_MAX, rows)
    qg = q.reshape(B, rows, GRID_W, H, d)
    kg = k.reshape(B, rows, GRID_W, H, d)
    vg = v.reshape(B, rows, GRID_W, H, d)
    r = jnp.arange(rows)
    row_start = jnp.clip(r - kh // 2, 0, rows - kh)
    key_rows = row_start[:, None] + jnp.arange(kh)[None, :]
    k_band = jnp.take(kg, key_rows, axis=1)
    v_band = jnp.take(vg, key_rows, axis=1)
    c = jnp.arange(GRID_W)
    col_start = jnp.clip(c - NA_KW // 2, 0, GRID_W - NA_KW)
    in_win = (c[None, :] >= col_start[:, None]) & (c[None, :] < col_start[:, None] + NA_KW)
    dr = key_rows - r[:, None] + (NA_KH_MAX - 1)
    dc = jnp.clip(c[None, :] - c[:, None], -(NA_KW - 1), NA_KW - 1) + (NA_KW - 1)
    bias = rpb.astype(jnp.float32)[:, dr[:, None, :, None], dc[None, :, None, :]]
    s = jnp.einsum('brqhd,brkwhd->bhrqkw', qg, k_band).astype(jnp.float32) * (d ** -0.5) + bias
    s = jnp.where(in_win[:, None, :], s, -jnp.inf)
    p = jax.nn.softmax(s.reshape(B, H, rows, GRID_W, kh * GRID_W), axis=-1).reshape(s.shape)
    o = jnp.einsum('bhrqkw,brkwhd->brqhd', p.astype(v.dtype), v_band)
    return o.reshape(B, T, H * d)


def hybrid_mixer(h, w_in, ml_conv_w, ml_conv_b, ml_gate_b, ml_norm_g, na_rpb,
                 gla_a_w2, gla_a_b, gla_norm_g, w_out):
    B, T, _ = h.shape
    f32 = jnp.float32
    proj = h @ w_in
    pts = []
    acc = 0
    for s_ in IN_SIZES[:-1]:
        acc += s_
        pts.append(acc)
    (ml_q, ml_k, ml_v, ml_o, ml_g, na_q, na_k, na_v,
     g_q, g_k, g_v, g_g, g_a) = jnp.split(proj, pts, axis=-1)

    def heads(a, n):
        return a.reshape(B, T, n, -1).transpose(0, 2, 1, 3).astype(f32)

    def flip(a):
        return jnp.flip(a, axis=2)

    qk = jax.nn.silu(dwconv_centred(jnp.concatenate([ml_q, ml_k], axis=-1), ml_conv_w, ml_conv_b))
    mq = heads(qk[..., :ML_DIM], ML_HEADS)
    mk = heads(qk[..., ML_DIM:], ML_HEADS) * (HEAD_DIM ** -0.5)
    mv = heads(ml_v, ML_HEADS)
    gates = ml_g.reshape(B, T, 4, ML_HEADS).astype(f32) + ml_gate_b.astype(f32)
    gates = gates.transpose(2, 0, 3, 1)
    h_f = mlstm_chunkwise(mq, mk, mv, gates[0], gates[1])
    h_b = flip(mlstm_chunkwise(flip(mq), flip(mk), flip(mv), flip(gates[2]), flip(gates[3])))
    ml_h = (h_f + h_b).transpose(0, 2, 1, 3).reshape(B, T, ML_DIM)
    ml_out = head_rms_norm(ml_h, ml_norm_g, ML_HEADS) * jax.nn.sigmoid(ml_o.astype(f32))

    na_out = neighbourhood_attention(na_q.reshape(B, T, NA_HEADS, HEAD_DIM),
                                     na_k.reshape(B, T, NA_HEADS, HEAD_DIM),
                                     na_v.reshape(B, T, NA_HEADS, HEAD_DIM), na_rpb).astype(f32)

    gq = heads(g_q, GLA_HEADS) * (GLA_DK ** -0.5)
    gk = heads(g_k, GLA_HEADS)
    gv = heads(g_v, GLA_HEADS)
    z = jnp.einsum('btzr,zrk->zbtk', g_a.reshape(B, T, 2, GLA_RANK).astype(f32), gla_a_w2.astype(f32))
    z = z + gla_a_b.astype(f32)[:, None, None, :]
    log_a = jax.nn.log_sigmoid(z) / GLA_TAU
    log_a = log_a.reshape(2, B, T, GLA_HEADS, GLA_DK).transpose(0, 1, 3, 2, 4)
    o_f = gla_chunked(gq, gk, gv, log_a[0])
    o_b = flip(gla_chunked(flip(gq), flip(gk), flip(gv), flip(log_a[1])))
    gla_h = (o_f + o_b).transpose(0, 2, 1, 3).reshape(B, T, GLA_VDIM)
    gla_out = head_rms_norm(gla_h, gla_norm_g, GLA_HEADS) * jax.nn.silu(g_g.astype(f32))

    mixed = jnp.concatenate([ml_out, na_out, gla_out], axis=-1).astype(h.dtype)
    return mixed @ w_out


def memory_cross_attention(h, mem_n, wq, wk, wv, wo):
    B, T, _ = h.shape
    M = mem_n.shape[1]
    q = (h @ wq).reshape(B, T, X_HEADS, X_HEAD_DIM)
    k = (mem_n @ wk).reshape(B, M, X_HEADS, X_HEAD_DIM)
    v = (mem_n @ wv).reshape(B, M, X_HEADS, X_HEAD_DIM)
    s = jnp.einsum('bthd,bmhd->bhtm', q, k).astype(jnp.float32) * (X_HEAD_DIM ** -0.5)
    p = jax.nn.softmax(s, axis=-1).astype(v.dtype)
    o = jnp.einsum('bhtm,bmhd->bthd', p, v).reshape(B, T, D_MODEL)
    return o @ wo


def conv_ffn(h, w_up, conv_w, conv_b, w_down):
    u = h @ w_up
    a, g = u[..., :D_FF], u[..., D_FF:]
    a = dwconv_centred(a, conv_w, conv_b)
    return (jax.nn.gelu(a) * g) @ w_down


def setup_inputs(seed: int = 0) -> dict:
    key = jax.random.key(seed)
    ks = jax.random.split(key, 26)
    f32 = jnp.float32

    def nrm(k, shape, scale):
        return jax.random.normal(k, shape, f32) * scale

    def gain(k, shape):
        return 1.0 + nrm(k, shape, 0.02)

    f_bias = jnp.linspace(3.0, 6.0, ML_HEADS, dtype=f32)
    zeros_h = jnp.zeros((ML_HEADS,), f32)
    gate_base = jnp.stack([zeros_h, f_bias, zeros_h, f_bias])
    return {
        'x': nrm(ks[0], (BATCH, SEQ, D_MODEL), 1.0),
        'mem': nrm(ks[1], (BATCH, N_MEM, D_MODEL), 1.0),
        'mix_norm_g': gain(ks[2], (DEPTH, D_MODEL)),
        'w_in': nrm(ks[3], (DEPTH, D_MODEL, IN_COLS), D_MODEL ** -0.5),
        'ml_conv_w': nrm(ks[4], (DEPTH, 3, 2 * ML_DIM), 3 ** -0.5),
        'ml_conv_b': nrm(ks[5], (DEPTH, 2 * ML_DIM), 0.02),
        'ml_gate_b': gate_base[None] + nrm(ks[6], (DEPTH, 4, ML_HEADS), 0.1),
        'ml_norm_g': gain(ks[7], (DEPTH, ML_DIM)),
        'na_rpb': nrm(ks[8], (DEPTH, NA_HEADS, 2 * NA_KH_MAX - 1, 2 * NA_KW - 1), 0.1),
        'gla_a_w2': nrm(ks[9], (DEPTH, 2, GLA_RANK, GLA_KDIM), GLA_RANK ** -0.5),
        'gla_a_b': nrm(ks[10], (DEPTH, 2, GLA_KDIM), 0.1),
        'gla_norm_g': gain(ks[11], (DEPTH, GLA_VDIM)),
        'w_out': nrm(ks[12], (DEPTH, D_MIX, D_MODEL), D_MIX ** -0.5),
        'xattn_norm_g': gain(ks[13], (DEPTH, D_MODEL)),
        'mem_norm_g': gain(ks[14], (DEPTH, D_MODEL)),
        'w_xq': nrm(ks[15], (DEPTH, D_MODEL, D_MODEL), D_MODEL ** -0.5),
        'w_xk': nrm(ks[16], (DEPTH, D_MODEL, D_MODEL), D_MODEL ** -0.5),
        'w_xv': nrm(ks[17], (DEPTH, D_MODEL, D_MODEL), D_MODEL ** -0.5),
        'w_xo': nrm(ks[18], (DEPTH, D_MODEL, D_MODEL), D_MODEL ** -0.5),
        'ffn_norm_g': gain(ks[19], (DEPTH, D_MODEL)),
        'w_up': nrm(ks[20], (DEPTH, D_MODEL, 2 * D_FF), D_MODEL ** -0.5),
        'ffn_conv_w': nrm(ks[21], (DEPTH, 3, D_FF), 3 ** -0.5),
        'ffn_conv_b': nrm(ks[22], (DEPTH, D_FF), 0.02),
        'w_down': nrm(ks[23], (DEPTH, D_FF, D_MODEL), D_FF ** -0.5),
        'final_norm_g': gain(ks[24], (D_MODEL,)),
    }


def reference(x, mem, mix_norm_g, w_in, ml_conv_w, ml_conv_b, ml_gate_b, ml_norm_g, na_rpb,
              gla_a_w2, gla_a_b, gla_norm_g, w_out, xattn_norm_g, mem_norm_g,
              w_xq, w_xk, w_xv, w_xo, ffn_norm_g, w_up, ffn_conv_w, ffn_conv_b, w_down,
              final_norm_g):
    h = x
    for l in range(DEPTH):
        h = h + hybrid_mixer(rms_norm(h, mix_norm_g[l]), w_in[l], ml_conv_w[l], ml_conv_b[l],
                             ml_gate_b[l], ml_norm_g[l], na_rpb[l], gla_a_w2[l], gla_a_b[l],
                             gla_norm_g[l], w_out[l])
        h = h + memory_cross_attention(rms_norm(h, xattn_norm_g[l]), rms_norm(mem, mem_norm_g[l]),
                                       w_xq[l], w_xk[l], w_xv[l], w_xo[l])
        h = h + conv_ffn(rms_norm(h, ffn_norm_g[l]), w_up[l], ffn_conv_w[l], ffn_conv_b[l], w_down[l])
    return rms_norm(h, final_norm_g)
```

```cpp
#include <hip/hip_runtime.h>
#include <cstdio>
namespace gold {
constexpr int T = 2048, D = 1024, NB = 8, DEPTH = 4, NMEM = 256, IN_COLS = 3512, DFF = 2816;
constexpr int C_MLQ = 0, C_MLK = 384, C_MLV = 768, C_MLO = 1152, C_MLG = 1536, C_NAQ = 1560, C_NAK = 1880, C_NAV = 2200,
              C_GQ = 2520, C_GK = 2680, C_GV = 2840, C_GG = 3160, C_GA = 3480;
constexpr float EPS = 1e-6f;

__global__ __launch_bounds__(256) void g_rmsnorm(const float* x, const float* g, float* y, int rows) {
    const int row = blockIdx.x * 4 + (threadIdx.x >> 6), lane = threadIdx.x & 63;
    if (row >= rows) return;
    const float* xr = x + (size_t)row * D; float v[16]; float s = 0.f;
#pragma unroll
    for (int j = 0; j < 16; ++j) { v[j] = xr[lane + 64 * j]; s += v[j] * v[j]; }
#pragma unroll
    for (int o = 32; o; o >>= 1) s += __shfl_xor(s, o);
    const float r = 1.0f / sqrtf(s * (1.0f / D) + EPS);
#pragma unroll
    for (int j = 0; j < 16; ++j) y[(size_t)row * D + lane + 64 * j] = v[j] * r * g[lane + 64 * j];
}

template <bool TB>
__global__ __launch_bounds__(256) void g_gemm(const float* A, int lda, const float* B, int ldb, float* C, int ldc, const float* R, int M, int N, int K) {
    __shared__ float As[16][65], Bs[16][65];
    const int tx = threadIdx.x & 15, ty = threadIdx.x >> 4;
    const int m0 = blockIdx.y * 64, n0 = blockIdx.x * 64;
    float acc[4][4];
#pragma unroll
    for (int i = 0; i < 4; ++i)
#pragma unroll
        for (int j = 0; j < 4; ++j) acc[i][j] = 0.f;
    for (int k0 = 0; k0 < K; k0 += 16) {
        for (int i = threadIdx.x; i < 1024; i += 256) { const int m = i >> 4, k = i & 15; As[k][m] = A[(size_t)(m0 + m) * lda + k0 + k]; }
        for (int i = threadIdx.x; i < 1024; i += 256) {
            if (TB) { const int n = i >> 4, k = i & 15; Bs[k][n] = (n0 + n < N) ? B[(size_t)(n0 + n) * ldb + k0 + k] : 0.f; }
            else { const int k = i >> 6, n = i & 63; Bs[k][n] = (n0 + n < N) ? B[(size_t)(k0 + k) * ldb + n0 + n] : 0.f; }
        }
        __syncthreads();
#pragma unroll
        for (int k = 0; k < 16; ++k) {
            float a[4], b[4];
#pragma unroll
            for (int i = 0; i < 4; ++i) a[i] = As[k][ty * 4 + i];
#pragma unroll
            for (int j = 0; j < 4; ++j) b[j] = Bs[k][tx * 4 + j];
#pragma unroll
            for (int i = 0; i < 4; ++i)
#pragma unroll
                for (int j = 0; j < 4; ++j) acc[i][j] += a[i] * b[j];
        }
        __syncthreads();
    }
#pragma unroll
    for (int i = 0; i < 4; ++i)
#pragma unroll
        for (int j = 0; j < 4; ++j) { const int m = m0 + ty * 4 + i, n = n0 + tx * 4 + j;
            if (n < N) { float v = acc[i][j]; if (R) v += R[(size_t)m * ldc + n]; C[(size_t)m * ldc + n] = v; } }
}

__global__ void g_mlconv(const float* proj, const float* cw, const float* cb, float* qk) {
    const int idx = blockIdx.x * 256 + threadIdx.x; if (idx >= T * 768) return;
    const int t = idx / 768, c = idx % 768;
    const float xm = t > 0 ? proj[(size_t)(t - 1) * IN_COLS + c] : 0.f, x0 = proj[(size_t)t * IN_COLS + c], xp = t < T - 1 ? proj[(size_t)(t + 1) * IN_COLS + c] : 0.f;
    float y = xm * cw[c] + x0 * cw[768 + c] + xp * cw[1536 + c] + cb[c];
    y = y / (1.f + expf(-y));
    if (c >= 384) y *= 0.125f;
    qk[(size_t)t * 768 + c] = y;
}

__global__ __launch_bounds__(256) void g_mlstm(const float* qk, const float* proj, const float* gate_b, float* hout) {
    const int h = blockIdx.x % 6, dir = blockIdx.x / 6;
    const int e = threadIdx.x & 63, dg = threadIdx.x >> 6;
    __shared__ float rnum[2][4][64]; __shared__ float rden[2][4];
    float C[16], n[16];
#pragma unroll
    for (int j = 0; j < 16; ++j) { C[j] = 0.f; n[j] = 0.f; }
    const float bi = gate_b[(2 * dir) * 6 + h], bf = gate_b[(2 * dir + 1) * 6 + h];
    for (int s = 0; s < T; ++s) {
        const int t = dir ? T - 1 - s : s;
        const float* qr = qk + (size_t)t * 768 + h * 64; const float* kr = qr + 384;
        const float* pr = proj + (size_t)t * IN_COLS;
        const float ip = pr[C_MLG + (2 * dir) * 6 + h] + bi, fp = pr[C_MLG + (2 * dir + 1) * 6 + h] + bf;
        const float f = 1.f / (1.f + expf(-fp)), ig = expf(ip);
        const float v = pr[C_MLV + h * 64 + e];
        float pn = 0.f, pd = 0.f;
#pragma unroll
        for (int j = 0; j < 16; ++j) { const float kd = kr[dg * 16 + j], qd = qr[dg * 16 + j];
            C[j] = f * C[j] + ig * kd * v; n[j] = f * n[j] + ig * kd; pn += C[j] * qd; pd += n[j] * qd; }
        const int p = s & 1;
        rnum[p][dg][e] = pn; if (e == 0) rden[p][dg] = pd;
        __syncthreads();
        if (dg == 0) { const float num = (rnum[p][0][e] + rnum[p][1][e]) + (rnum[p][2][e] + rnum[p][3][e]);
            const float den = (rden[p][0] + rden[p][1]) + (rden[p][2] + rden[p][3]);
            hout[((size_t)dir * T + t) * 384 + h * 64 + e] = num / fmaxf(fabsf(den), 1.f); }
    }
}

__global__ void g_mlcombine(const float* hout, const float* proj, const float* ng, float* mixed) {
    const int idx = blockIdx.x * 256 + threadIdx.x; if (idx >= T * 6) return;
    const int t = idx / 6, h = idx % 6;
    const float* a = hout + (size_t)t * 384 + h * 64; const float* b = a + (size_t)T * 384;
    float ss = 0.f; for (int e = 0; e < 64; ++e) { const float v = a[e] + b[e]; ss += v * v; }
    const float r = 1.0f / sqrtf(ss * (1.0f / 64) + EPS);
    for (int e = 0; e < 64; ++e) { const float v = (a[e] + b[e]) * r * ng[h * 64 + e]; const float o = proj[(size_t)t * IN_COLS + C_MLO + h * 64 + e];
        mixed[(size_t)t * D + h * 64 + e] = v / (1.f + expf(-o)); }
}

__global__ __launch_bounds__(256) void g_na(const float* proj, const float* rpb, float* mixed) {
    const int r = blockIdx.x % 32, h = blockIdx.x / 32;
    const int c = threadIdx.x >> 2, s = threadIdx.x & 3;
    __shared__ float sc[64][129];
    const int rs = min(max(r - 4, 0), 24), cs = min(max(c - 8, 0), 48);
    const float* qp = proj + (size_t)(r * 64 + c) * IN_COLS + C_NAQ + h * 64;
    float q[64];
#pragma unroll
    for (int e = 0; e < 64; ++e) q[e] = qp[e];
    for (int kk = 0; kk < 32; ++kk) { const int key = s * 32 + kk, tr = rs + (key >> 4), tc = cs + (key & 15);
        const float* kp = proj + (size_t)(tr * 64 + tc) * IN_COLS + C_NAK + h * 64; float d = 0.f;
#pragma unroll
        for (int e = 0; e < 64; ++e) d += q[e] * kp[e];
        const int dr = tr - r + 7, dc = min(max(tc - c, -15), 15) + 15;
        sc[c][key] = d * 0.125f + rpb[(h * 15 + dr) * 31 + dc]; }
    __syncthreads();
    float mx = -3.0e38f; for (int k = 0; k < 128; ++k) mx = fmaxf(mx, sc[c][k]);
    float sum = 0.f; for (int k = 0; k < 128; ++k) sum += expf(sc[c][k] - mx);
    __syncthreads();
    for (int kk = 0; kk < 32; ++kk) { const int key = s * 32 + kk; sc[c][key] = expf(sc[c][key] - mx) / sum; }
    __syncthreads();
    float o[16];
#pragma unroll
    for (int j = 0; j < 16; ++j) o[j] = 0.f;
    for (int key = 0; key < 128; ++key) { const int tr = rs + (key >> 4), tc = cs + (key & 15);
        const float* vp = proj + (size_t)(tr * 64 + tc) * IN_COLS + C_NAV + h * 64 + s * 16; const float p = sc[c][key];
#pragma unroll
        for (int j = 0; j < 16; ++j) o[j] += p * vp[j]; }
#pragma unroll
    for (int j = 0; j < 16; ++j) mixed[(size_t)(r * 64 + c) * D + 384 + h * 64 + s * 16 + j] = o[j];
}

__global__ void g_gla_loga(const float* proj, const float* w2, const float* ab, float* loga) {
    const int idx = blockIdx.x * 256 + threadIdx.x; if (idx >= 2 * T * 160) return;
    const int dir = idx / (T * 160), t = (idx / 160) % T, k = idx % 160;
    float z = ab[dir * 160 + k];
    for (int r = 0; r < 16; ++r) z += proj[(size_t)t * IN_COLS + C_GA + dir * 16 + r] * w2[(dir * 16 + r) * 160 + k];
    loga[idx] = (fminf(z, 0.f) - log1pf(expf(-fabsf(z)))) * (1.0f / 16.0f);
}

__global__ __launch_bounds__(256) void g_gla(const float* proj, const float* loga, float* oout) {
    const int h = blockIdx.x % 5, dir = blockIdx.x / 5;
    const int e = threadIdx.x & 63, kg = threadIdx.x >> 6;
    __shared__ float rnum[2][4][64];
    float S[8];
#pragma unroll
    for (int j = 0; j < 8; ++j) S[j] = 0.f;
    for (int s = 0; s < T; ++s) {
        const int t = dir ? T - 1 - s : s;
        const float* pr = proj + (size_t)t * IN_COLS;
        const float* qr = pr + C_GQ + h * 32; const float* kr = pr + C_GK + h * 32; const float v = pr[C_GV + h * 64 + e];
        const float* la = loga + ((size_t)dir * T + t) * 160 + h * 32;
        float pn = 0.f;
#pragma unroll
        for (int j = 0; j < 8; ++j) { const int d = kg * 8 + j; const float a = expf(la[d]); S[j] = a * S[j] + kr[d] * v; pn += S[j] * qr[d]; }
        const int p = s & 1;
        rnum[p][kg][e] = pn * 0.17677669529663687f;
        __syncthreads();
        if (kg == 0) oout[((size_t)dir * T + t) * 320 + h * 64 + e] = (rnum[p][0][e] + rnum[p][1][e]) + (rnum[p][2][e] + rnum[p][3][e]);
    }
}

__global__ void g_glacombine(const float* oout, const float* proj, const float* ng, float* mixed) {
    const int idx = blockIdx.x * 256 + threadIdx.x; if (idx >= T * 5) return;
    const int t = idx / 5, h = idx % 5;
    const float* a = oout + (size_t)t * 320 + h * 64; const float* b = a + (size_t)T * 320;
    float ss = 0.f; for (int e = 0; e < 64; ++e) { const float v = a[e] + b[e]; ss += v * v; }
    const float r = 1.0f / sqrtf(ss * (1.0f / 64) + EPS);
    for (int e = 0; e < 64; ++e) { const float v = (a[e] + b[e]) * r * ng[h * 64 + e]; const float g = proj[(size_t)t * IN_COLS + C_GG + h * 64 + e];
        mixed[(size_t)t * D + 704 + h * 64 + e] = v * (g / (1.f + expf(-g))); }
}

__global__ __launch_bounds__(256) void g_softmax256(float* S, int rows, float scale) {
    const int row = blockIdx.x * 4 + (threadIdx.x >> 6), lane = threadIdx.x & 63; if (row >= rows) return;
    float* p = S + (size_t)row * 256; float v[4]; float mx = -3.0e38f;
#pragma unroll
    for (int j = 0; j < 4; ++j) { v[j] = p[lane + 64 * j] * scale; mx = fmaxf(mx, v[j]); }
#pragma unroll
    for (int o = 32; o; o >>= 1) mx = fmaxf(mx, __shfl_xor(mx, o));
    float sum = 0.f;
#pragma unroll
    for (int j = 0; j < 4; ++j) { v[j] = expf(v[j] - mx); sum += v[j]; }
#pragma unroll
    for (int o = 32; o; o >>= 1) sum += __shfl_xor(sum, o);
#pragma unroll
    for (int j = 0; j < 4; ++j) p[lane + 64 * j] = v[j] / sum;
}

__global__ void g_ffnact(const float* u, const float* cw, const float* cb, float* act) {
    const int idx = blockIdx.x * 256 + threadIdx.x; if (idx >= T * DFF) return;
    const int t = idx / DFF, c = idx % DFF;
    const float xm = t > 0 ? u[(size_t)(t - 1) * 2 * DFF + c] : 0.f, x0 = u[(size_t)t * 2 * DFF + c], xp = t < T - 1 ? u[(size_t)(t + 1) * 2 * DFF + c] : 0.f;
    const float a = xm * cw[c] + x0 * cw[DFF + c] + xp * cw[2 * DFF + c] + cb[c];
    const float ge = 0.5f * a * (1.f + tanhf(0.7978845608028654f * (a + 0.044715f * a * a * a)));
    act[(size_t)t * DFF + c] = ge * u[(size_t)t * 2 * DFF + DFF + c];
}

__global__ void g_copy(const float* a, float* b, size_t n) { for (size_t i = (size_t)blockIdx.x * 256 + threadIdx.x; i < n; i += (size_t)gridDim.x * 256) b[i] = a[i]; }

template <bool TB> static void gemm(hipStream_t st, const float* A, int lda, const float* B, int ldb, float* C, int ldc, const float* R, int M, int N, int K) {
    hipLaunchKernelGGL((g_gemm<TB>), dim3((N + 63) / 64, M / 64), dim3(256), 0, st, A, lda, B, ldb, C, ldc, R, M, N, K);
}

static void forward(void* const* d_in, float* out, float* ws, hipStream_t st) {
    const float* x = (const float*)d_in[0]; const float* mem = (const float*)d_in[1];
    auto P = [&](int i) { return (const float*)d_in[i]; };
    float* hn = ws;
    float* proj = hn + (size_t)T * D;
    float* qk = proj + (size_t)T * IN_COLS;
    float* hfb = qk + (size_t)T * 768;
    float* loga = hfb + (size_t)2 * T * 384;
    float* gout = loga + (size_t)2 * T * 160;
    float* mixed = gout + (size_t)2 * T * 320;
    float* memn = mixed + (size_t)T * D;
    float* mk = memn + (size_t)NMEM * D;
    float* mv = mk + (size_t)NMEM * D;
    float* q = mv + (size_t)NMEM * D;
    float* S = q + (size_t)T * D;
    float* o = S + (size_t)4 * T * 256;
    float* u = o + (size_t)T * D;
    float* act = u + (size_t)T * 2 * DFF;
    hipLaunchKernelGGL(g_copy, dim3(4096), dim3(256), 0, st, x, out, (size_t)NB * T * D);
    for (int b = 0; b < NB; ++b) {
        float* h = out + (size_t)b * T * D;
        for (int l = 0; l < DEPTH; ++l) {
            hipLaunchKernelGGL(g_rmsnorm, dim3(T / 4), dim3(256), 0, st, h, P(2) + l * D, hn, T);
            gemm<false>(st, hn, D, P(3) + (size_t)l * D * IN_COLS, IN_COLS, proj, IN_COLS, nullptr, T, IN_COLS, D);
            hipLaunchKernelGGL(g_mlconv, dim3(T * 768 / 256), dim3(256), 0, st, proj, P(4) + l * 3 * 768, P(5) + l * 768, qk);
            hipLaunchKernelGGL(g_mlstm, dim3(12), dim3(256), 0, st, qk, proj, P(6) + l * 24, hfb);
            hipLaunchKernelGGL(g_mlcombine, dim3((T * 6 + 255) / 256), dim3(256), 0, st, hfb, proj, P(7) + l * 384, mixed);
            hipLaunchKernelGGL(g_na, dim3(32 * 5), dim3(256), 0, st, proj, P(8) + l * 5 * 15 * 31, mixed);
            hipLaunchKernelGGL(g_gla_loga, dim3((2 * T * 160 + 255) / 256), dim3(256), 0, st, proj, P(9) + l * 2 * 16 * 160, P(10) + l * 2 * 160, loga);
            hipLaunchKernelGGL(g_gla, dim3(10), dim3(256), 0, st, proj, loga, gout);
            hipLaunchKernelGGL(g_glacombine, dim3((T * 5 + 255) / 256), dim3(256), 0, st, gout, proj, P(11) + l * 320, mixed);
            gemm<false>(st, mixed, D, P(12) + (size_t)l * D * D, D, h, D, h, T, D, D);
            hipLaunchKernelGGL(g_rmsnorm, dim3(T / 4), dim3(256), 0, st, h, P(13) + l * D, hn, T);
            hipLaunchKernelGGL(g_rmsnorm, dim3(NMEM / 4), dim3(256), 0, st, mem + (size_t)b * NMEM * D, P(14) + l * D, memn, NMEM);
            gemm<false>(st, hn, D, P(15) + (size_t)l * D * D, D, q, D, nullptr, T, D, D);
            gemm<false>(st, memn, D, P(16) + (size_t)l * D * D, D, mk, D, nullptr, NMEM, D, D);
            gemm<false>(st, memn, D, P(17) + (size_t)l * D * D, D, mv, D, nullptr, NMEM, D, D);
            for (int hh = 0; hh < 4; ++hh) gemm<true>(st, q + hh * 256, D, mk + hh * 256, D, S + (size_t)hh * T * 256, 256, nullptr, T, 256, 256);
            hipLaunchKernelGGL(g_softmax256, dim3(4 * T / 4), dim3(256), 0, st, S, 4 * T, 0.0625f);
            for (int hh = 0; hh < 4; ++hh) gemm<false>(st, S + (size_t)hh * T * 256, 256, mv + hh * 256, D, o + hh * 256, D, nullptr, T, 256, 256);
            gemm<false>(st, o, D, P(18) + (size_t)l * D * D, D, h, D, h, T, D, D);
            hipLaunchKernelGGL(g_rmsnorm, dim3(T / 4), dim3(256), 0, st, h, P(19) + l * D, hn, T);
            gemm<false>(st, hn, D, P(20) + (size_t)l * D * 2 * DFF, 2 * DFF, u, 2 * DFF, nullptr, T, 2 * DFF, D);
            hipLaunchKernelGGL(g_ffnact, dim3((T * DFF + 255) / 256), dim3(256), 0, st, u, P(21) + l * 3 * DFF, P(22) + l * DFF, act);
            gemm<false>(st, act, DFF, P(23) + (size_t)l * DFF * D, D, h, D, h, T, D, DFF);
        }
    }
    hipLaunchKernelGGL(g_rmsnorm, dim3(NB * T / 4), dim3(256), 0, st, out, P(24), out, NB * T);
}
constexpr size_t WS_FLOATS = (size_t)T * D * 5 + (size_t)T * IN_COLS + (size_t)T * 768 + 2 * (size_t)T * 384 + 2 * (size_t)T * 160 + 2 * (size_t)T * 320 + 3 * (size_t)NMEM * D + 4 * (size_t)T * 256 + (size_t)T * 3 * DFF;
}
extern "C" void kernel_launch(void* const* d_in, const int* in_sizes, int n_in,
                              void* d_out, int out_size, void* d_ws, size_t ws_size,
                              hipStream_t stream) {
    if (n_in != 25 || out_size != gold::NB * gold::T * gold::D || ws_size < gold::WS_FLOATS * sizeof(float)) {
        fprintf(stderr, "kernel_launch: unexpected shapes / workspace (n_in %d out %d ws %zu)\n", n_in, out_size, ws_size); return; }
    gold::forward(d_in, (float*)d_out, (float*)d_ws, stream);
}
```

```cpp
#include <hip/hip_runtime.h>
#include <hip/hip_cooperative_groups.h>
#include <cstdio>
#include <cstdint>
namespace cg = cooperative_groups;
#define MK_PER_PHASE 1
namespace pg8 {
#define PG8_LAS __attribute__((address_space(3)))
typedef unsigned short bf16_t;
typedef short bf16x8 __attribute__((ext_vector_type(8)));
typedef float f32x4 __attribute__((ext_vector_type(4)));
typedef unsigned u32x4 __attribute__((ext_vector_type(4)));
constexpr int BM = 256, BK = 64, HALF = 128, HTB = HALF * BK * 2  , STAGE_BYTES = 8 * HTB, NXCD = 8, WGM = 8;

__host__ __device__ __forceinline__ int lds_byte(int r, int c) { const int st = (r >> 4) * 2 + (c >> 5), rr = r & 15, cc = c & 31, ob = rr * 64 + cc * 2; return st * 1024 + (ob ^ (((ob >> 9) & 1) << 5)); }
__host__ __device__ __forceinline__ void stage_rc(int b, int& R, int& C) { const int st = b / 1024, sb = b % 1024, swz = sb ^ (((sb >> 9) & 1) << 5); R = (st >> 1) * 16 + swz / 64; C = (st & 1) * 32 + (swz % 64) / 2; }
__host__ __device__ __forceinline__ int perm32(int rho) { const int n = rho >> 4, i = rho & 15; return 8 * (i >> 2) + 4 * n + (i & 3); }

struct Unit { int pm, pn; };
struct Gemm { const bf16_t* A; const bf16_t* Bt; int M, N, K; };

struct StaticOrder {
    int nM, nN, nwg, G, c;
    __host__ __device__ void init(int M, int N, int G_, int c_) { nM = M / BM; nN = N / BM; nwg = nM * nN; G = G_; c = c_; }
    __host__ __device__ bool next(int i, Unit& u) const {
        const long L = (long)i * G + c; if (L >= nwg) return false;
        int wgid = (int)L; { const int q = nwg / NXCD, r = nwg % NXCD, xcd = wgid % NXCD, off = wgid / NXCD; wgid = (xcd < r ? xcd * (q + 1) : r * (q + 1) + (xcd - r) * q) + off; }
        const int nig = WGM * nN, gid = wgid / nig, fm = gid * WGM, gsz = (nM - fm) < WGM ? (nM - fm) : WGM;
        u.pm = fm + ((wgid % nig) % gsz); u.pn = (wgid % nig) / gsz; return true;
    }
    __device__ __forceinline__ void a_ready(const Unit&) const {}
    __device__ __forceinline__ void done(const Unit&) const {}
};

template <class Epi, class Sched, bool ALIGN_EPI = false, bool SP2 = false>
__device__ __forceinline__ void gemm_phase(PG8_LAS unsigned char* lds, const Gemm g, const Sched& S, const Epi& E) {
    int tid_l = threadIdx.x; asm volatile("" : "+v"(tid_l));
    const int tid = tid_l, wid = __builtin_amdgcn_readfirstlane(tid >> 6), lane = tid & 63, wr = wid >> 2, wc = wid & 3, fr = lane & 15, fq = lane >> 4;
    const int K = g.K, nt = K / BK;
    unsigned voffA[2], voffB[2];
#pragma unroll
    for (int i = 0; i < 2; ++i) { int R, C; stage_rc(tid * 16 + i * 8192, R, C); const int Rb = Epi::PERM ? ((R & ~31) + perm32(R & 31)) : R;
        voffA[i] = (unsigned)(R * K + C) * 2u; voffB[i] = (unsigned)(Rb * K + C) * 2u; }
    const size_t kstep = (size_t)(BK * 2);
    const size_t hstep = (size_t)HALF * K * 2;
    const size_t tstep = 2 * hstep;
    const unsigned ldsw = (unsigned)wid * 1024u;
    const int aoff = lds_byte(wr * 64 + fr, fq * 8), boff = lds_byte(wc * 32 + fr, fq * 8);
#define PG8_SA(b, h) (((b) * 2 + (h)) * HTB)
#define PG8_SB(b, h) ((4 + (b) * 2 + (h)) * HTB)
#define PG8_STAGE(bufoff, gbase, voff) do { _Pragma("unroll") for (int _i = 0; _i < 2; ++_i) \
        __builtin_amdgcn_global_load_lds((const unsigned*)((const char*)(gbase) + (voff)[_i]), (PG8_LAS unsigned*)(lds + (bufoff) + ldsw + _i * 8192), 16, 0, 0); } while (0)
#define PG8_LDA(dst, b, h) do { _Pragma("unroll") for (int m = 0; m < 4; ++m) _Pragma("unroll") for (int k = 0; k < 2; ++k) dst[m][k] = *(const PG8_LAS bf16x8*)(lds + PG8_SA(b, h) + aoff + m * 2048 + k * 1024); } while (0)
#define PG8_LDB(dst, b, h) do { _Pragma("unroll") for (int n = 0; n < 2; ++n) _Pragma("unroll") for (int k = 0; k < 2; ++k) dst[n][k] = *(const PG8_LAS bf16x8*)(lds + PG8_SB(b, h) + boff + n * 2048 + k * 1024); } while (0)
#define PG8_MMA(ai, bj, At, Bt) do { __builtin_amdgcn_s_setprio(1); _Pragma("unroll") for (int m = 0; m < 4; ++m) _Pragma("unroll") for (int n = 0; n < 2; ++n) _Pragma("unroll") for (int k = 0; k < 2; ++k) \
        acc[ai][bj][m][n] = __builtin_amdgcn_mfma_f32_16x16x32_bf16(Bt[n][k], At[m][k], acc[ai][bj][m][n], 0, 0, 0); __builtin_amdgcn_s_setprio(0); } while (0)
#define PG8_WAIT_V(n) asm volatile("s_waitcnt vmcnt(" #n ")" ::: "memory")
#define PG8_WAIT_L(n) asm volatile("s_waitcnt lgkmcnt(" #n ")" ::: "memory")
#define PG8_BAR __builtin_amdgcn_s_barrier()
#define PG8_SCHED __builtin_amdgcn_sched_barrier(0)
    Unit cur, nxt; int ui = 0;
    if (!S.next(0, cur)) return;
    f32x4 acc[2][2][4][2];
#pragma unroll
    for (int a = 0; a < 2; ++a)
#pragma unroll
        for (int b = 0; b < 2; ++b)
#pragma unroll
            for (int m = 0; m < 4; ++m)
#pragma unroll
                for (int n = 0; n < 2; ++n) acc[a][b][m][n] = (f32x4){0.f, 0.f, 0.f, 0.f};
    bf16x8 At[4][2], B0[2][2], B1[2][2];
    const char* cA = (const char*)g.A + (size_t)cur.pm * tstep; const char* cB = (const char*)g.Bt + (size_t)cur.pn * tstep;
    S.a_ready(cur);
    if constexpr (SP2) {
        PG8_STAGE(PG8_SB(0, 0), cB, voffB); PG8_STAGE(PG8_SB(0, 1), cB + hstep, voffB); PG8_STAGE(PG8_SA(0, 0), cA, voffA); PG8_STAGE(PG8_SA(0, 1), cA + hstep, voffA);
        if (wr == 1) PG8_BAR;
        PG8_WAIT_V(2); PG8_BAR;
        PG8_STAGE(PG8_SB(1, 0), cB + kstep, voffB); PG8_STAGE(PG8_SA(1, 0), cA + kstep, voffA); PG8_STAGE(PG8_SB(1, 1), cB + hstep + kstep, voffB);
        PG8_WAIT_V(6); PG8_BAR;
    } else {
        PG8_STAGE(PG8_SB(0, 0), cB, voffB); PG8_STAGE(PG8_SA(0, 0), cA, voffA); PG8_STAGE(PG8_SB(0, 1), cB + hstep, voffB); PG8_STAGE(PG8_SA(0, 1), cA + hstep, voffA);
        if (wr == 1) PG8_BAR;
        PG8_WAIT_V(4); PG8_BAR;
        PG8_STAGE(PG8_SB(1, 0), cB + kstep, voffB); PG8_STAGE(PG8_SA(1, 0), cA + kstep, voffA); PG8_STAGE(PG8_SB(1, 1), cB + hstep + kstep, voffB);
        PG8_WAIT_V(6); PG8_BAR;
    }
    for (;;) {
        const bool has_next = S.next(ui + 1, nxt);
        const char* nA = has_next ? (const char*)g.A + (size_t)nxt.pm * tstep : cA; const char* nB = has_next ? (const char*)g.Bt + (size_t)nxt.pn * tstep : cB;
        for (int t = 0; t < nt; t += 2) {
            const bool last = (t == nt - 2);
            const char* a1 = cA + (size_t)(t + 1) * kstep;
            const char* a2 = last ? nA : cA + (size_t)(t + 2) * kstep; const char* b2 = last ? nB : cB + (size_t)(t + 2) * kstep;
            const char* a3 = a2 + kstep; const char* b3 = b2 + kstep;
            if (last && has_next) S.a_ready(nxt);
            if constexpr (SP2) {
            PG8_LDB(B0, 0, 0); PG8_LDB(B1, 0, 1); PG8_SCHED; PG8_LDA(At, 0, 0); PG8_STAGE(PG8_SA(1, 1), a1 + hstep, voffA);
            PG8_WAIT_V(8); PG8_WAIT_L(0); PG8_BAR; PG8_MMA(0, 0, At, B0); PG8_MMA(0, 1, At, B1); PG8_BAR; PG8_SCHED;
            PG8_LDA(At, 0, 1); PG8_STAGE(PG8_SB(0, 0), b2, voffB); PG8_STAGE(PG8_SB(0, 1), b2 + hstep, voffB); PG8_STAGE(PG8_SA(0, 0), a2, voffA);
            PG8_WAIT_V(8); PG8_WAIT_L(0); PG8_BAR; PG8_MMA(1, 0, At, B0); PG8_MMA(1, 1, At, B1); PG8_BAR; PG8_SCHED;
            PG8_LDB(B0, 1, 0); PG8_LDB(B1, 1, 1); PG8_SCHED; PG8_LDA(At, 1, 0); PG8_STAGE(PG8_SA(0, 1), a2 + hstep, voffA);
            PG8_WAIT_V(8); PG8_WAIT_L(0); PG8_BAR; PG8_MMA(0, 0, At, B0); PG8_MMA(0, 1, At, B1); PG8_BAR; PG8_SCHED;
            PG8_LDA(At, 1, 1); PG8_STAGE(PG8_SB(1, 0), b3, voffB); PG8_STAGE(PG8_SB(1, 1), b3 + hstep, voffB); PG8_STAGE(PG8_SA(1, 0), a3, voffA);
            PG8_WAIT_V(8); PG8_WAIT_L(0); PG8_BAR; PG8_MMA(1, 0, At, B0); PG8_MMA(1, 1, At, B1); PG8_BAR; PG8_SCHED;
            } else {
            PG8_LDB(B0, 0, 0); PG8_SCHED; PG8_LDA(At, 0, 0); PG8_STAGE(PG8_SA(1, 1), a1 + hstep, voffA);
            PG8_WAIT_L(8); PG8_BAR; PG8_WAIT_L(0); PG8_MMA(0, 0, At, B0); PG8_BAR; PG8_SCHED;
            PG8_LDB(B1, 0, 1); PG8_STAGE(PG8_SB(0, 0), b2, voffB);
            PG8_BAR; PG8_WAIT_L(0); PG8_MMA(0, 1, At, B1); PG8_BAR;
            PG8_LDA(At, 0, 1); PG8_STAGE(PG8_SA(0, 0), a2, voffA);
            PG8_BAR; PG8_WAIT_L(0); PG8_MMA(1, 0, At, B0); PG8_BAR; PG8_SCHED;
            PG8_STAGE(PG8_SB(0, 1), b2 + hstep, voffB);
            PG8_WAIT_V(6); PG8_BAR; PG8_MMA(1, 1, At, B1); PG8_BAR;
            PG8_LDB(B0, 1, 0); PG8_SCHED; PG8_LDA(At, 1, 0); PG8_STAGE(PG8_SA(0, 1), a2 + hstep, voffA);
            PG8_WAIT_L(8); PG8_BAR; PG8_WAIT_L(0); PG8_MMA(0, 0, At, B0); PG8_BAR; PG8_SCHED;
            PG8_LDB(B1, 1, 1); PG8_STAGE(PG8_SB(1, 0), b3, voffB);
            PG8_BAR; PG8_WAIT_L(0); PG8_MMA(0, 1, At, B1); PG8_BAR;
            PG8_LDA(At, 1, 1); PG8_STAGE(PG8_SA(1, 0), a3, voffA);
            PG8_BAR; PG8_WAIT_L(0); PG8_MMA(1, 0, At, B0); PG8_BAR; PG8_SCHED;
            PG8_STAGE(PG8_SB(1, 1), b3 + hstep, voffB);
            PG8_WAIT_V(6); PG8_BAR; PG8_MMA(1, 1, At, B1); PG8_BAR;
            }
        }
        if constexpr (ALIGN_EPI) { if (wr == 0) PG8_BAR; }
        if constexpr (!Epi::AFTER_DRAIN) { E(acc, cur, wr, wc, fr, fq); S.done(cur); }
        if (!has_next) break;
#pragma unroll
        for (int a = 0; a < 2; ++a)
#pragma unroll
            for (int b = 0; b < 2; ++b)
#pragma unroll
                for (int m = 0; m < 4; ++m)
#pragma unroll
                    for (int n = 0; n < 2; ++n) acc[a][b][m][n] = (f32x4){0.f, 0.f, 0.f, 0.f};
        cur = nxt; cA = nA; cB = nB; ++ui;
        if constexpr (ALIGN_EPI) { if (wr == 1) PG8_BAR; }
    }
    PG8_WAIT_V(0);
    if constexpr (!ALIGN_EPI) { if (wr == 0) PG8_BAR; }
    PG8_BAR;
    if constexpr (Epi::AFTER_DRAIN) { E.fused(acc, cur, wr, wc, fr, fq, lds, wid, lane); S.done(cur); }
#undef PG8_SA
#undef PG8_SB
#undef PG8_STAGE
#undef PG8_LDA
#undef PG8_LDB
#undef PG8_MMA
#undef PG8_WAIT_V
#undef PG8_WAIT_L
#undef PG8_BAR
#undef PG8_SCHED
}
}
namespace mk {
using pg8::bf16_t; using pg8::f32x4; using pg8::u32x4; using pg8::bf16x8;
#define LAS __attribute__((address_space(3)))
constexpr int NB = 8, T = 2048, M = NB * T, D = 1024, DEPTH = 4, NMEM = 256, MM = NB * NMEM;
constexpr int NPROJ = 3584, IN_COLS = 3512, DFF = 2816, NUP = 2 * DFF;
constexpr float EPS = 1e-6f;
constexpr int P_MLQ = 0, P_MLK = 384, P_MLV = 768, P_MLO = 1152, P_NAQ = 1536, P_NAK = 1856, P_NAV = 2176, P_GQ = 2496, P_GK = 2656, P_GV = 2816, P_GG = 3136, P_MLG = 3456, P_GA = 3480;
constexpr int NTHREADS = 512, NWAVES = 8;
constexpr int LDS_BYTES = 160 * 1024;
constexpr size_t MiB = (size_t)1 << 20;
constexpr size_t WS_RS0 = 0, WS_RS1 = 1 * MiB, WS_RS2 = 2 * MiB, WS_RSM = 3 * MiB;
constexpr size_t WS_GATES = 4 * MiB;
constexpr size_t WS_MEMB = 8 * MiB;
constexpr size_t WS_MEMKV = 12 * MiB;
constexpr size_t WS_WIN = 20 * MiB, WS_WOUT = 27 * MiB, WS_WQ = 29 * MiB, WS_WO = 31 * MiB, WS_WUP = 33 * MiB, WS_WDN = 44 * MiB, WS_WKV = 50 * MiB;
constexpr size_t WS_HB = 54 * MiB;
constexpr size_t WS_BIG = 86 * MiB;
constexpr size_t WS_HSML = WS_BIG + 112 * MiB, WS_HSGL = WS_HSML + 24 * MiB;
constexpr size_t WS_ACT = 262 * MiB;
constexpr size_t WS_MIXED = WS_ACT, WS_Q = WS_ACT + 32 * MiB;
constexpr size_t WS_END = 350 * MiB;

__device__ __forceinline__ float bf2f(unsigned v) { return __uint_as_float(v << 16); }
__device__ __forceinline__ unsigned f2bf(float f) { const unsigned u = __float_as_uint(f); return (u + 0x7fffu + ((u >> 16) & 1u)) >> 16; }
__device__ __forceinline__ unsigned pk2(float lo, float hi) { return f2bf(lo) | (f2bf(hi) << 16); }
__device__ __forceinline__ unsigned cvt_pk_bf16(float lo, float hi) { unsigned r; asm volatile("v_cvt_pk_bf16_f32 %0, %1, %2" : "=v"(r) : "v"(lo), "v"(hi)); return r; }
__device__ __forceinline__ void unpack8(const u32x4 w, float (&o)[8]) {
    o[0] = bf2f(w.x & 0xffffu); o[1] = bf2f(w.x >> 16); o[2] = bf2f(w.y & 0xffffu); o[3] = bf2f(w.y >> 16);
    o[4] = bf2f(w.z & 0xffffu); o[5] = bf2f(w.z >> 16); o[6] = bf2f(w.w & 0xffffu); o[7] = bf2f(w.w >> 16);
}
__device__ __forceinline__ float wave_sum(float v) {
#pragma unroll
    for (int o = 1; o < 64; o <<= 1) v += __shfl_xor(v, o);
    return v;
}
__device__ __forceinline__ float sigmoidf_(float x) { return 1.f / (1.f + __expf(-x)); }

typedef const float* cfptr;
struct Ctx {
    float* out; unsigned char* ws;
    int G, bid, tid, lane, wave;
    __device__ __forceinline__ const float* in(int i) const {
        asm volatile("" : "+s"(i));
        const __attribute__((address_space(4))) cfptr* tbl = (const __attribute__((address_space(4))) cfptr*)__builtin_amdgcn_kernarg_segment_ptr();
        return tbl[i];
    }
    template <class Tp> __device__ __forceinline__ Tp* wsp(size_t off) const { unsigned o = (unsigned)off; asm volatile("" : "+s"(o)); return (Tp*)(ws + o); }
    __device__ __forceinline__ float* rs0() const { return wsp<float>(WS_RS0); }
    __device__ __forceinline__ float* rs1() const { return wsp<float>(WS_RS1); }
    __device__ __forceinline__ float* rs2() const { return wsp<float>(WS_RS2); }
    __device__ __forceinline__ float* rsm() const { return wsp<float>(WS_RSM); }
    __device__ __forceinline__ float* gates() const { return wsp<float>(WS_GATES); }
    __device__ __forceinline__ float* hsml() const { return wsp<float>(WS_HSML); }
    __device__ __forceinline__ float* hsgl() const { return wsp<float>(WS_HSGL); }
    __device__ __forceinline__ bf16_t* memb() const { return wsp<bf16_t>(WS_MEMB); }
    __device__ __forceinline__ bf16_t* memkv() const { return wsp<bf16_t>(WS_MEMKV); }
    __device__ __forceinline__ bf16_t* w_in() const { return wsp<bf16_t>(WS_WIN); }
    __device__ __forceinline__ bf16_t* w_out() const { return wsp<bf16_t>(WS_WOUT); }
    __device__ __forceinline__ bf16_t* wq() const { return wsp<bf16_t>(WS_WQ); }
    __device__ __forceinline__ bf16_t* wo() const { return wsp<bf16_t>(WS_WO); }
    __device__ __forceinline__ bf16_t* w_up() const { return wsp<bf16_t>(WS_WUP); }
    __device__ __forceinline__ bf16_t* w_dn() const { return wsp<bf16_t>(WS_WDN); }
    __device__ __forceinline__ bf16_t* wkv() const { return wsp<bf16_t>(WS_WKV); }
    __device__ __forceinline__ bf16_t* hb() const { return wsp<bf16_t>(WS_HB); }
    __device__ __forceinline__ bf16_t* proj() const { return wsp<bf16_t>(WS_BIG); }
    __device__ __forceinline__ bf16_t* u() const { return wsp<bf16_t>(WS_BIG); }
    __device__ __forceinline__ bf16_t* act() const { return wsp<bf16_t>(WS_ACT); }
    __device__ __forceinline__ bf16_t* mixed() const { return wsp<bf16_t>(WS_MIXED); }
    __device__ __forceinline__ bf16_t* q() const { return wsp<bf16_t>(WS_Q); }
};

struct EpiScale {
    static constexpr bool PERM = true, AFTER_DRAIN = false;
    bf16_t* O; int ldc; const float* rowss; float* gates; int gate_pn;
    __device__ __forceinline__ void operator()(const f32x4 (&acc)[2][2][4][2], const pg8::Unit& u, int wr, int wc, int fr, int fq) const {
        const int row0 = u.pm * 256 + wr * 64 + fr, col0 = u.pn * 256 + wc * 32 + 8 * fq;
        const bool gt = (u.pn == gate_pn) && (wc < 2);
#pragma unroll
        for (int ai = 0; ai < 2; ++ai)
#pragma unroll
            for (int m = 0; m < 4; ++m) {
                const int row = row0 + ai * 128 + m * 16;
                float rs = 1.0f;
                if (rowss) { const f32x4* rp = (const f32x4*)(rowss + (size_t)row * 16); const f32x4 p0 = rp[0], p1 = rp[1], p2 = rp[2], p3 = rp[3];
                    const float ssum = (((p0[0] + p0[1]) + (p0[2] + p0[3])) + ((p1[0] + p1[1]) + (p1[2] + p1[3]))) + (((p2[0] + p2[1]) + (p2[2] + p2[3])) + ((p3[0] + p3[1]) + (p3[2] + p3[3])));
                    rs = 1.0f / sqrtf(ssum * (1.0f / D) + EPS); }
                bf16_t* rowp = O + (size_t)row * ldc + col0;
#pragma unroll
                for (int bj = 0; bj < 2; ++bj) {
                    const f32x4 v0 = acc[ai][bj][m][0] * rs, v1 = acc[ai][bj][m][1] * rs;
                    u32x4 w; w.x = cvt_pk_bf16(v0[0], v0[1]); w.y = cvt_pk_bf16(v0[2], v0[3]); w.z = cvt_pk_bf16(v1[0], v1[1]); w.w = cvt_pk_bf16(v1[2], v1[3]);
                    *(u32x4*)(rowp + bj * 128) = w;
                    if (bj == 1 && gt) { float* gp = gates + (size_t)row * 64 + wc * 32 + 8 * fq; *(f32x4*)gp = v0; *(f32x4*)(gp + 4) = v1; }
                }
            }
    }
};
struct EpiResid {
    static constexpr bool PERM = true, AFTER_DRAIN = false;
    const float* base; float* out; bf16_t* hb; float* rowss_out;
    __device__ __forceinline__ void operator()(const f32x4 (&acc)[2][2][4][2], const pg8::Unit& u, int wr, int wc, int fr, int fq) const {
        const int row0 = u.pm * 256 + wr * 64 + fr, col0 = u.pn * 256 + wc * 32 + 8 * fq;
#pragma unroll
        for (int ai = 0; ai < 2; ++ai)
#pragma unroll
            for (int m = 0; m < 4; ++m) {
                const int row = row0 + ai * 128 + m * 16; const size_t off = (size_t)row * D + col0; float ss = 0.f;
#pragma unroll
                for (int bj = 0; bj < 2; ++bj) {
                    const f32x4 v0 = acc[ai][bj][m][0] + *(const f32x4*)(base + off + bj * 128), v1 = acc[ai][bj][m][1] + *(const f32x4*)(base + off + bj * 128 + 4);
                    *(f32x4*)(out + off + bj * 128) = v0; *(f32x4*)(out + off + bj * 128 + 4) = v1;
                    u32x4 w; w.x = cvt_pk_bf16(v0[0], v0[1]); w.y = cvt_pk_bf16(v0[2], v0[3]); w.z = cvt_pk_bf16(v1[0], v1[1]); w.w = cvt_pk_bf16(v1[2], v1[3]);
                    *(u32x4*)(hb + off + bj * 128) = w;
                    ss += (v0[0] * v0[0] + v0[1] * v0[1]) + (v0[2] * v0[2] + v0[3] * v0[3]) + (v1[0] * v1[0] + v1[1] * v1[1]) + (v1[2] * v1[2] + v1[3] * v1[3]);
                }
                ss += __shfl_xor(ss, 16); ss += __shfl_xor(ss, 32);
                if (fq == 0) rowss_out[(size_t)row * 16 + u.pn * 4 + wc] = ss;
                asm volatile("" ::: "memory");
            }
    }
};

template <class Map>
__device__ __forceinline__ void cvt_item(const float* W, int K, int N, const float* gain, bf16_t* WT, LAS float* scr, int item, int lane, Map map) {
    const int nblk = (N + 31) / 32, kb = item / nblk, nb = item % nblk, k0 = 64 * kb, n0 = 32 * nb;
    const int nn = n0 + (lane & 31);
#pragma unroll 8
    for (int i = 0; i < 32; ++i) { const int kk = 2 * i + (lane >> 5); float w = (nn < N) ? W[(size_t)(k0 + kk) * N + nn] : 0.f; if (gain) w *= gain[k0 + kk]; scr[kk * 33 + (lane & 31)] = w; }
    asm volatile("s_waitcnt lgkmcnt(0)" ::: "memory");
    const int c = lane & 7;
#pragma unroll
    for (int j = 0; j < 4; ++j) { const int n = (lane >> 3) + 8 * j; const LAS float* s = scr + (8 * c) * 33 + n;
        u32x4 o; o.x = pk2(s[0 * 33], s[1 * 33]); o.y = pk2(s[2 * 33], s[3 * 33]); o.z = pk2(s[4 * 33], s[5 * 33]); o.w = pk2(s[6 * 33], s[7 * 33]);
        if (n0 + n < N) *(u32x4*)(WT + (size_t)map(n0 + n) * K + k0 + 8 * c) = o; }
    asm volatile("s_waitcnt lgkmcnt(0)" ::: "memory");
}
struct MapId { int off; __device__ __forceinline__ int operator()(int n) const { return n + off; } };
struct MapIn { __device__ __forceinline__ int operator()(int n) const { return n < 1536 ? n : (n < 1560 ? n + (P_MLG - 1536) : (n < 3480 ? n - 24 : n)); } };

__device__ __forceinline__ void convert_layer(const Ctx& c, int l, LAS unsigned char* lds) {
    LAS float* scr = (LAS float*)(lds + c.wave * 16384);
    const int gw = c.bid * NWAVES + c.wave, NGW = c.G * NWAVES;
    constexpr int I_IN = 16 * 110, I_SQ = 16 * 32, I_UP = 16 * 176, I_DN = 44 * 32;
    constexpr int NITEMS = I_IN + 5 * I_SQ + I_UP + I_DN;
    for (int it = gw; it < NITEMS; it += NGW) {
        int r = it;
        if (r < I_IN) { cvt_item(c.in(3) + (size_t)l * D * IN_COLS, D, IN_COLS, c.in(2) + l * D, c.w_in(), scr, r, c.lane, MapIn{}); continue; } r -= I_IN;
        if (r < I_SQ) { cvt_item(c.in(12) + (size_t)l * D * D, D, D, nullptr, c.w_out(), scr, r, c.lane, MapId{0}); continue; } r -= I_SQ;
        if (r < I_SQ) { cvt_item(c.in(15) + (size_t)l * D * D, D, D, c.in(13) + l * D, c.wq(), scr, r, c.lane, MapId{0}); continue; } r -= I_SQ;
        if (r < I_SQ) { cvt_item(c.in(16) + (size_t)l * D * D, D, D, c.in(14) + l * D, c.wkv(), scr, r, c.lane, MapId{0}); continue; } r -= I_SQ;
        if (r < I_SQ) { cvt_item(c.in(17) + (size_t)l * D * D, D, D, c.in(14) + l * D, c.wkv(), scr, r, c.lane, MapId{D}); continue; } r -= I_SQ;
        if (r < I_SQ) { cvt_item(c.in(18) + (size_t)l * D * D, D, D, nullptr, c.wo(), scr, r, c.lane, MapId{0}); continue; } r -= I_SQ;
        if (r < I_UP) { cvt_item(c.in(20) + (size_t)l * D * NUP, D, NUP, c.in(19) + l * D, c.w_up(), scr, r, c.lane, MapId{0}); continue; } r -= I_UP;
        cvt_item(c.in(23) + (size_t)l * DFF * D, DFF, D, nullptr, c.w_dn(), scr, r, c.lane, MapId{0});
    }
    const int gt = c.bid * NTHREADS + c.tid;
    for (int i = gt; i < (NPROJ - IN_COLS) * D / 8; i += c.G * NTHREADS) *(u32x4*)(c.w_in() + (size_t)IN_COLS * D + (size_t)i * 8) = (u32x4){0u, 0u, 0u, 0u};
}
__device__ __forceinline__ void rows_to_bf16(const Ctx& c, const float* X, bf16_t* Y, float* rss, int rows) {
    const int gw = c.bid * NWAVES + c.wave, NGW = c.G * NWAVES;
    for (int m = gw; m < rows; m += NGW) {
        const f32x4* xr = (const f32x4*)(X + (size_t)m * D) + c.lane; float s = 0.f;
        unsigned long long* o8 = (unsigned long long*)(Y + (size_t)m * D) + c.lane;
#pragma unroll
        for (int j = 0; j < 4; ++j) { const f32x4 v = xr[64 * j]; s += (v[0] * v[0] + v[1] * v[1]) + (v[2] * v[2] + v[3] * v[3]);
            o8[64 * j] = (unsigned long long)pk2(v[0], v[1]) | ((unsigned long long)pk2(v[2], v[3]) << 32); }
        s = wave_sum(s); if (c.lane < 16) rss[(size_t)m * 16 + c.lane] = (c.lane == 0) ? s : 0.f;
    }
}
__device__ __forceinline__ void final_norm(const Ctx& c) {
    const int gw = c.bid * NWAVES + c.wave, NGW = c.G * NWAVES; const float* g = c.in(24);
    for (int m = gw; m < M; m += NGW) {
        f32x4* xr = (f32x4*)(c.out + (size_t)m * D) + c.lane; f32x4 v[4]; float s = 0.f;
#pragma unroll
        for (int j = 0; j < 4; ++j) { v[j] = xr[64 * j]; s += (v[j][0] * v[j][0] + v[j][1] * v[j][1]) + (v[j][2] * v[j][2] + v[j][3] * v[j][3]); }
        const float r = 1.0f / sqrtf(wave_sum(s) * (1.0f / D) + EPS);
#pragma unroll
        for (int j = 0; j < 4; ++j) xr[64 * j] = v[j] * r * ((const f32x4*)g)[c.lane + 64 * j];
    }
}
__device__ __forceinline__ void ml_load_row(const bf16_t* projb, int t, int coff, float (&dst)[2][8]) {
    if (t < 0 || t >= T) {
#pragma unroll
        for (int j = 0; j < 8; ++j) { dst[0][j] = 0.f; dst[1][j] = 0.f; }
    } else {
        const u32x4 a = *(const u32x4*)(projb + (size_t)t * NPROJ + P_MLQ + coff), b = *(const u32x4*)(projb + (size_t)t * NPROJ + P_MLK + coff);
        unpack8(a, dst[0]); unpack8(b, dst[1]);
    }
}
__device__ __forceinline__ void ml_item(const Ctx& c, int l, int item, LAS unsigned char* lds) {
    const int b = item / 6, h = item % 6, e = c.tid & 63, dg = c.tid >> 6;
    LAS float* rnum = (LAS float*)lds;
    LAS float* rden = (LAS float*)lds + 1024;
    const bf16_t* projb = c.proj() + (size_t)b * T * NPROJ;
    const float* gatesb = c.gates() + (size_t)b * T * 64;
    float* hs = c.hsml() + (size_t)b * T * 384 + h * 64;
    const float* cwp = c.in(4) + (size_t)l * 3 * 768; const float* cbp = c.in(5) + (size_t)l * 768;
    const float* gb = c.in(6) + l * 24; const float* ng = c.in(7) + l * 384;
    const int coff = h * 64 + dg * 8;
    float cw[2][8][4];
#pragma unroll
    for (int qk = 0; qk < 2; ++qk)
#pragma unroll
        for (int j = 0; j < 8; ++j) { const int ch = qk * 384 + coff + j; cw[qk][j][0] = cwp[ch]; cw[qk][j][1] = cwp[768 + ch]; cw[qk][j][2] = cwp[1536 + ch]; cw[qk][j][3] = cbp[ch]; }
    for (int dir = 0; dir < 2; ++dir) {
        float C[8], n[8];
#pragma unroll
        for (int j = 0; j < 8; ++j) { C[j] = 0.f; n[j] = 0.f; }
        const float bi = gb[(2 * dir) * 6 + h], bff = gb[(2 * dir + 1) * 6 + h];
        float lo[2][8], mid[2][8], hi[2][8];
        const int t0 = dir ? T - 1 : 0;
        ml_load_row(projb, t0 - 1, coff, lo); ml_load_row(projb, t0, coff, mid); ml_load_row(projb, t0 + 1, coff, hi);
        for (int s = 0; s < T; ++s) {
            const int t = dir ? T - 1 - s : s;
            const float ip = gatesb[(size_t)t * 64 + (2 * dir) * 6 + h] + bi, fp = gatesb[(size_t)t * 64 + (2 * dir + 1) * 6 + h] + bff;
            const float f = sigmoidf_(fp), ig = __expf(ip);
            const float v = bf2f(projb[(size_t)t * NPROJ + P_MLV + h * 64 + e]);
            float pn = 0.f, pd = 0.f;
#pragma unroll
            for (int j = 0; j < 8; ++j) {
                float yq = lo[0][j] * cw[0][j][0] + mid[0][j] * cw[0][j][1] + hi[0][j] * cw[0][j][2] + cw[0][j][3];
                float yk = lo[1][j] * cw[1][j][0] + mid[1][j] * cw[1][j][1] + hi[1][j] * cw[1][j][2] + cw[1][j][3];
                const float qd = yq * sigmoidf_(yq), kd = yk * sigmoidf_(yk) * 0.125f;
                C[j] = f * C[j] + ig * kd * v; n[j] = f * n[j] + ig * kd; pn += C[j] * qd; pd += n[j] * qd;
            }
            const int p = s & 1;
            rnum[(p * 8 + dg) * 64 + e] = pn; if (e == 0) rden[p * 8 + dg] = pd;
            __syncthreads();
            if (dg == 0) {
                float num = 0.f, den = 0.f;
#pragma unroll
                for (int g = 0; g < 8; ++g) { num += rnum[(p * 8 + g) * 64 + e]; den += rden[p * 8 + g]; }
                const float hv = num / fmaxf(fabsf(den), 1.f);
                if (dir == 0) hs[(size_t)t * 384 + e] = hv;
                else { const float tot = hs[(size_t)t * 384 + e] + hv; const float ss = wave_sum(tot * tot);
                    const float r = 1.0f / sqrtf(ss * (1.0f / 64) + EPS); const float og = bf2f(projb[(size_t)t * NPROJ + P_MLO + h * 64 + e]);
                    c.mixed()[((size_t)b * T + t) * D + h * 64 + e] = (bf16_t)f2bf(tot * r * ng[h * 64 + e] * sigmoidf_(og)); }
            }
            if (dir == 0) {
#pragma unroll
                for (int j = 0; j < 8; ++j) { lo[0][j] = mid[0][j]; lo[1][j] = mid[1][j]; mid[0][j] = hi[0][j]; mid[1][j] = hi[1][j]; }
                ml_load_row(projb, t + 2, coff, hi);
            } else {
#pragma unroll
                for (int j = 0; j < 8; ++j) { hi[0][j] = mid[0][j]; hi[1][j] = mid[1][j]; mid[0][j] = lo[0][j]; mid[1][j] = lo[1][j]; }
                ml_load_row(projb, t - 2, coff, lo);
            }
        }
        __syncthreads();
    }
}
__device__ __forceinline__ void gla_item(const Ctx& c, int l, int item, LAS unsigned char* lds) {
    const int b = item / 5, h = item % 5, e = c.tid & 63, kg = c.tid >> 6;
    LAS float* rnum = (LAS float*)lds;
    const bf16_t* projb = c.proj() + (size_t)b * T * NPROJ;
    const float* gatesb = c.gates() + (size_t)b * T * 64;
    float* gs = c.hsgl() + (size_t)b * T * 320 + h * 64;
    const float* ng = c.in(11) + l * 320;
    const int doff = h * 32 + kg * 4;
    for (int dir = 0; dir < 2; ++dir) {
        const float* w2 = c.in(9) + ((size_t)l * 2 + dir) * 16 * 160; const float* ab = c.in(10) + ((size_t)l * 2 + dir) * 160;
        float w2r[16][4], abv[4], S[4];
#pragma unroll
        for (int j = 0; j < 4; ++j) { abv[j] = ab[doff + j]; S[j] = 0.f;
#pragma unroll
            for (int r = 0; r < 16; ++r) w2r[r][j] = w2[r * 160 + doff + j]; }
        for (int s = 0; s < T; ++s) {
            const int t = dir ? T - 1 - s : s;
            const float* gp = gatesb + (size_t)t * 64 + 24 + dir * 16;
            float ga[16];
#pragma unroll
            for (int r4 = 0; r4 < 4; ++r4) { const f32x4 x = *(const f32x4*)(gp + 4 * r4); ga[4 * r4] = x[0]; ga[4 * r4 + 1] = x[1]; ga[4 * r4 + 2] = x[2]; ga[4 * r4 + 3] = x[3]; }
            const unsigned long long qw = *(const unsigned long long*)(projb + (size_t)t * NPROJ + P_GQ + doff), kw = *(const unsigned long long*)(projb + (size_t)t * NPROJ + P_GK + doff);
            const float v = bf2f(projb[(size_t)t * NPROJ + P_GV + h * 64 + e]);
            float pn = 0.f;
#pragma unroll
            for (int j = 0; j < 4; ++j) {
                float z = abv[j];
#pragma unroll
                for (int r = 0; r < 16; ++r) z += ga[r] * w2r[r][j];
                const float la = (fminf(z, 0.f) - log1pf(__expf(-fabsf(z)))) * (1.0f / 16.0f);
                const float a = __expf(la);
                const float qd = bf2f((unsigned)(qw >> (16 * j)) & 0xffffu), kd = bf2f((unsigned)(kw >> (16 * j)) & 0xffffu);
                S[j] = a * S[j] + kd * v; pn += S[j] * qd;
            }
            const int p = s & 1;
            rnum[(p * 8 + kg) * 64 + e] = pn * 0.17677669529663687f;
            __syncthreads();
            if (kg == 0) {
                float o = 0.f;
#pragma unroll
                for (int g = 0; g < 8; ++g) o += rnum[(p * 8 + g) * 64 + e];
                if (dir == 0) gs[(size_t)t * 320 + e] = o;
                else { const float tot = gs[(size_t)t * 320 + e] + o; const float ss = wave_sum(tot * tot);
                    const float r = 1.0f / sqrtf(ss * (1.0f / 64) + EPS); const float gg = bf2f(projb[(size_t)t * NPROJ + P_GG + h * 64 + e]);
                    c.mixed()[((size_t)b * T + t) * D + 704 + h * 64 + e] = (bf16_t)f2bf(tot * r * ng[h * 64 + e] * gg * sigmoidf_(gg)); }
            }
        }
        __syncthreads();
    }
}
__device__ __forceinline__ void na_item(const Ctx& c, int l, int item, LAS unsigned char* lds) {
    const int b = item / 160, h = (item % 160) / 32, r = item % 32;
    const int q = c.tid >> 3, s = c.tid & 7;
    LAS float* sc = (LAS float*)lds;
    const bf16_t* projb = c.proj() + (size_t)b * T * NPROJ;
    const float* rpb = c.in(8) + ((size_t)l * 5 + h) * 15 * 31;
    const int rs = min(max(r - 4, 0), 24), cs = min(max(q - 8, 0), 48);
    float qv[64];
    { const bf16_t* qp = projb + (size_t)(r * 64 + q) * NPROJ + P_NAQ + h * 64;
#pragma unroll
      for (int i = 0; i < 8; ++i) { float t8[8]; unpack8(*(const u32x4*)(qp + 8 * i), t8);
#pragma unroll
          for (int j = 0; j < 8; ++j) qv[8 * i + j] = t8[j]; } }
    const int tr = rs + s;
    for (int kk = 0; kk < 16; ++kk) { const int tc = cs + kk;
        const bf16_t* kp = projb + (size_t)(tr * 64 + tc) * NPROJ + P_NAK + h * 64; float d = 0.f;
#pragma unroll
        for (int i = 0; i < 8; ++i) { float t8[8]; unpack8(*(const u32x4*)(kp + 8 * i), t8);
#pragma unroll
            for (int j = 0; j < 8; ++j) d += qv[8 * i + j] * t8[j]; }
        const int dr = tr - r + 7, dc = min(max(tc - q, -15), 15) + 15;
        sc[q * 129 + s * 16 + kk] = d * 0.125f + rpb[dr * 31 + dc]; }
    __syncthreads();
    float mx = -3.0e38f; for (int k = 0; k < 128; ++k) mx = fmaxf(mx, sc[q * 129 + k]);
    float sum = 0.f; for (int k = 0; k < 128; ++k) sum += __expf(sc[q * 129 + k] - mx);
    __syncthreads();
    const float inv = 1.0f / sum;
    for (int kk = 0; kk < 16; ++kk) sc[q * 129 + s * 16 + kk] = __expf(sc[q * 129 + s * 16 + kk] - mx) * inv;
    __syncthreads();
    float o[8];
#pragma unroll
    for (int j = 0; j < 8; ++j) o[j] = 0.f;
    for (int key = 0; key < 128; ++key) { const int trr = rs + (key >> 4), tcc = cs + (key & 15);
        float t8[8]; unpack8(*(const u32x4*)(projb + (size_t)(trr * 64 + tcc) * NPROJ + P_NAV + h * 64 + s * 8), t8); const float p = sc[q * 129 + key];
#pragma unroll
        for (int j = 0; j < 8; ++j) o[j] += p * t8[j]; }
    u32x4 w; w.x = pk2(o[0], o[1]); w.y = pk2(o[2], o[3]); w.z = pk2(o[4], o[5]); w.w = pk2(o[6], o[7]);
    *(u32x4*)(c.mixed() + ((size_t)b * T + r * 64 + q) * D + 384 + h * 64 + s * 8) = w;
    __syncthreads();
}
__device__ __forceinline__ void xattn_item(const Ctx& c, int item, LAS unsigned char* lds) {
    const int b = item / 256, hd = (item / 64) % 4, qt = item % 64; const int row0 = b * T + qt * 32;
    LAS float* qs = (LAS float*)lds;
    LAS float* ps = (LAS float*)lds + 8192;
    const int qi = c.tid >> 4, sub = c.tid & 15;
    { const bf16_t* qp = c.q() + (size_t)(row0 + qi) * D + hd * 256 + sub * 16; float t8[8];
      unpack8(*(const u32x4*)qp, t8);
#pragma unroll
      for (int j = 0; j < 8; ++j) qs[qi * 256 + sub * 16 + j] = t8[j];
      unpack8(*(const u32x4*)(qp + 8), t8);
#pragma unroll
      for (int j = 0; j < 8; ++j) qs[qi * 256 + sub * 16 + 8 + j] = t8[j]; }
    __syncthreads();
    const bf16_t* kvb = c.memkv() + (size_t)b * NMEM * 2048 + hd * 256;
    float acc[16];
#pragma unroll
    for (int j = 0; j < 16; ++j) acc[j] = 0.f;
    for (int dc = 0; dc < 32; ++dc) {
        float qr[8];
#pragma unroll
        for (int i = 0; i < 8; ++i) qr[i] = qs[qi * 256 + dc * 8 + i];
#pragma unroll
        for (int j = 0; j < 16; ++j) { float t8[8]; unpack8(*(const u32x4*)(kvb + (size_t)(sub + 16 * j) * 2048 + dc * 8), t8);
#pragma unroll
            for (int i = 0; i < 8; ++i) acc[j] += qr[i] * t8[i]; }
    }
    float mx = -3.0e38f;
#pragma unroll
    for (int j = 0; j < 16; ++j) { acc[j] *= 0.0625f; mx = fmaxf(mx, acc[j]); }
#pragma unroll
    for (int o = 1; o < 16; o <<= 1) mx = fmaxf(mx, __shfl_xor(mx, o));
    float sum = 0.f;
#pragma unroll
    for (int j = 0; j < 16; ++j) { acc[j] = __expf(acc[j] - mx); sum += acc[j]; }
#pragma unroll
    for (int o = 1; o < 16; o <<= 1) sum += __shfl_xor(sum, o);
    const float inv = 1.0f / sum;
#pragma unroll
    for (int j = 0; j < 16; ++j) ps[qi * 256 + sub + 16 * j] = acc[j] * inv;
    __syncthreads();
    float o[16];
#pragma unroll
    for (int j = 0; j < 16; ++j) o[j] = 0.f;
    for (int key = 0; key < 256; ++key) { const float p = ps[qi * 256 + key]; const bf16_t* vp = kvb + (size_t)key * 2048 + 1024 + sub * 16; float t8[8];
        unpack8(*(const u32x4*)vp, t8);
#pragma unroll
        for (int j = 0; j < 8; ++j) o[j] += p * t8[j];
        unpack8(*(const u32x4*)(vp + 8), t8);
#pragma unroll
        for (int j = 0; j < 8; ++j) o[8 + j] += p * t8[j]; }
    bf16_t* op = c.mixed() + (size_t)(row0 + qi) * D + hd * 256 + sub * 16;
    u32x4 w; w.x = pk2(o[0], o[1]); w.y = pk2(o[2], o[3]); w.z = pk2(o[4], o[5]); w.w = pk2(o[6], o[7]); *(u32x4*)op = w;
    w.x = pk2(o[8], o[9]); w.y = pk2(o[10], o[11]); w.z = pk2(o[12], o[13]); w.w = pk2(o[14], o[15]); *(u32x4*)(op + 8) = w;
    __syncthreads();
}
__device__ __forceinline__ void act_pass(const Ctx& c, int l) {
    const float* cw = c.in(21) + (size_t)l * 3 * DFF; const float* cb = c.in(22) + (size_t)l * DFF;
    constexpr int CH = DFF / 8;
    for (int idx = c.bid * NTHREADS + c.tid; idx < M * CH; idx += c.G * NTHREADS) {
        const int row = idx / CH, c8 = (idx % CH) * 8, t = row % T;
        const bf16_t* up = c.u() + (size_t)row * NUP + c8;
        float a0[8], am[8], ap[8], g[8];
        unpack8(*(const u32x4*)up, a0); unpack8(*(const u32x4*)(up + DFF), g);
        if (t > 0) unpack8(*(const u32x4*)(up - NUP), am); else {
#pragma unroll
            for (int j = 0; j < 8; ++j) am[j] = 0.f; }
        if (t < T - 1) unpack8(*(const u32x4*)(up + NUP), ap); else {
#pragma unroll
            for (int j = 0; j < 8; ++j) ap[j] = 0.f; }
        float o[8];
#pragma unroll
        for (int j = 0; j < 8; ++j) { const float a = am[j] * cw[c8 + j] + a0[j] * cw[DFF + c8 + j] + ap[j] * cw[2 * DFF + c8 + j] + cb[c8 + j];
            const float uu = 0.7978845608028654f * (a + 0.044715f * a * a * a);
            o[j] = a / (1.f + __expf(-2.f * uu)) * g[j]; }
        u32x4 w; w.x = pk2(o[0], o[1]); w.y = pk2(o[2], o[3]); w.z = pk2(o[4], o[5]); w.w = pk2(o[6], o[7]);
        *(u32x4*)(c.act() + (size_t)row * DFF + c8) = w;
    }
}
#ifndef MK_PER_PHASE
#define MK_PER_PHASE 0
#endif
constexpr int PH_PER_LAYER = 10, NP = 2 + DEPTH * PH_PER_LAYER;
struct Args { const float* in[25]; float* out; unsigned char* ws; int ph_lo, ph_hi; };

__global__ void __launch_bounds__(NTHREADS, 2) mega(Args a) {
    extern __shared__ __attribute__((aligned(16))) unsigned char lds_raw[];
    LAS unsigned char* lds = (LAS unsigned char*)lds_raw;
    Ctx c;
    c.out = a.out; c.ws = a.ws;
    cg::grid_group grid = cg::this_grid();

    for (int p = a.ph_lo; p < a.ph_hi; ++p) {
        { int t_ = threadIdx.x, b_ = blockIdx.x, g_ = gridDim.x;
          asm volatile("" : "+v"(t_)); asm volatile("" : "+s"(b_)); asm volatile("" : "+s"(g_));
          c.tid = t_; c.lane = t_ & 63; c.wave = __builtin_amdgcn_readfirstlane(t_ >> 6); c.bid = b_; c.G = g_; }
        if (p == 0) {
            convert_layer(c, 0, lds);
            rows_to_bf16(c, c.in(0), c.hb(), c.rs0(), M);
            rows_to_bf16(c, c.in(1), c.memb(), c.rsm(), MM);
        } else if (p == NP - 1) {
            final_norm(c);
        } else {
            const int l = (p - 1) / PH_PER_LAYER, st = (p - 1) % PH_PER_LAYER;
            if (st == 0) {
                { pg8::Gemm g{c.hb(), c.w_in(), M, NPROJ, D}; pg8::StaticOrder S; S.init(M, NPROJ, c.G, c.bid);
                  EpiScale E{c.proj(), NPROJ, c.rs0(), c.gates(), 13};
                  pg8::gemm_phase<EpiScale, pg8::StaticOrder, true, true>(lds, g, S, E); }
                { pg8::Gemm g{c.memb(), c.wkv(), MM, 2 * D, D}; pg8::StaticOrder S; S.init(MM, 2 * D, c.G, c.bid);
                  EpiScale E{c.memkv(), 2 * D, c.rsm(), nullptr, -1};
                  pg8::gemm_phase<EpiScale, pg8::StaticOrder, true, true>(lds, g, S, E); }
            } else if (st == 1) {
                if (c.bid < 48) ml_item(c, l, c.bid, lds);
                else if (c.bid < 88) gla_item(c, l, c.bid - 48, lds);
                else for (int i = c.bid - 88; i < NB * 5 * 32; i += c.G - 88) na_item(c, l, i, lds);
            } else if (st == 2) {
                pg8::Gemm g{c.mixed(), c.w_out(), M, D, D}; pg8::StaticOrder S; S.init(M, D, c.G, c.bid);
                EpiResid E{l == 0 ? c.in(0) : c.out, c.out, c.hb(), c.rs1()};
                pg8::gemm_phase<EpiResid, pg8::StaticOrder, true, true>(lds, g, S, E);
            } else if (st == 3) {
                pg8::Gemm g{c.hb(), c.wq(), M, D, D}; pg8::StaticOrder S; S.init(M, D, c.G, c.bid);
                EpiScale E{c.q(), D, c.rs1(), nullptr, -1};
                pg8::gemm_phase<EpiScale, pg8::StaticOrder, true, true>(lds, g, S, E);
            } else if (st == 4) {
                for (int i = c.bid; i < NB * 4 * 64; i += c.G) xattn_item(c, i, lds);
            } else if (st == 5) {
                pg8::Gemm g{c.mixed(), c.wo(), M, D, D}; pg8::StaticOrder S; S.init(M, D, c.G, c.bid);
                EpiResid E{c.out, c.out, c.hb(), c.rs2()};
                pg8::gemm_phase<EpiResid, pg8::StaticOrder, true, true>(lds, g, S, E);
            } else if (st == 6) {
                pg8::Gemm g{c.hb(), c.w_up(), M, NUP, D}; pg8::StaticOrder S; S.init(M, NUP, c.G, c.bid);
                EpiScale E{c.u(), NUP, c.rs2(), nullptr, -1};
                pg8::gemm_phase<EpiScale, pg8::StaticOrder, true, true>(lds, g, S, E);
            } else if (st == 7) {
                act_pass(c, l);
            } else if (st == 8) {
                pg8::Gemm g{c.act(), c.w_dn(), M, D, DFF}; pg8::StaticOrder S; S.init(M, D, c.G, c.bid);
                EpiResid E{c.out, c.out, c.hb(), c.rs0()};
                pg8::gemm_phase<EpiResid, pg8::StaticOrder, true, true>(lds, g, S, E);
            } else {
                if (l + 1 < DEPTH) convert_layer(c, l + 1, lds);
            }
        }
        if (p + 1 < a.ph_hi) grid.sync();
    }
}
}

extern "C" void kernel_launch(void* const* d_in, const int* in_sizes, int n_in, void* d_out, int out_size, void* d_ws, size_t ws_size, hipStream_t stream) {
    static int grid = 0;
    if (grid == 0) {
        if (n_in != 25 || out_size != mk::M * mk::D || ws_size < mk::WS_END) { fprintf(stderr, "kernel_launch: unexpected shapes / workspace (n_in %d out %d ws %zu need %zu)\n", n_in, out_size, ws_size, (size_t)mk::WS_END); grid = -1; return; }
        int dev = 0, cus = 0, per_cu = 0;
        (void)hipGetDevice(&dev); (void)hipDeviceGetAttribute(&cus, hipDeviceAttributeMultiprocessorCount, dev);
        if (hipFuncSetAttribute((const void*)mk::mega, hipFuncAttributeMaxDynamicSharedMemorySize, mk::LDS_BYTES) != hipSuccess) { fprintf(stderr, "kernel_launch: hipFuncSetAttribute failed\n"); grid = -1; return; }
        (void)hipOccupancyMaxActiveBlocksPerMultiprocessor(&per_cu, (const void*)mk::mega, mk::NTHREADS, mk::LDS_BYTES);
        if (per_cu < 1) { fprintf(stderr, "kernel_launch: occupancy query says %d blocks per CU\n", per_cu); grid = -1; return; }
        grid = cus;
        if (grid < 96) { fprintf(stderr, "kernel_launch: needs >= 96 CUs\n"); grid = -1; return; }
    }
    if (grid < 0) return;
    mk::Args a{};
    for (int i = 0; i < 25; ++i) a.in[i] = (const float*)d_in[i];
    a.out = (float*)d_out; a.ws = (unsigned char*)d_ws;
#if MK_PER_PHASE
    for (int p = 0; p < mk::NP; ++p) { a.ph_lo = p; a.ph_hi = p + 1; hipLaunchKernelGGL(mk::mega, dim3(grid), dim3(mk::NTHREADS), mk::LDS_BYTES, stream, a); }
#else
    a.ph_lo = 0; a.ph_hi = mk::NP;
    void* args[] = {&a};
    hipError_t e = hipLaunchCooperativeKernel((const void*)mk::mega, dim3(grid), dim3(mk::NTHREADS), args, mk::LDS_BYTES, stream);
    if (e != hipSuccess) fprintf(stderr, "cooperative launch failed: %s (grid %d)\n", hipGetErrorString(e), grid);
#endif
}
```

```cpp
#include <hip/hip_runtime.h>
#include <hip/hip_cooperative_groups.h>
#include <cstdio>
#include <cstdint>
namespace cg = cooperative_groups;
#define MK_PER_PHASE 0
namespace pg8 {
#define PG8_LAS __attribute__((address_space(3)))
typedef unsigned short bf16_t;
typedef short bf16x8 __attribute__((ext_vector_type(8)));
typedef float f32x4 __attribute__((ext_vector_type(4)));
typedef unsigned u32x4 __attribute__((ext_vector_type(4)));
constexpr int BM = 256, BK = 64, HALF = 128, HTB = HALF * BK * 2  , STAGE_BYTES = 8 * HTB, NXCD = 8, WGM = 8;

__host__ __device__ __forceinline__ int lds_byte(int r, int c) { const int st = (r >> 4) * 2 + (c >> 5), rr = r & 15, cc = c & 31, ob = rr * 64 + cc * 2; return st * 1024 + (ob ^ (((ob >> 9) & 1) << 5)); }
__host__ __device__ __forceinline__ void stage_rc(int b, int& R, int& C) { const int st = b / 1024, sb = b % 1024, swz = sb ^ (((sb >> 9) & 1) << 5); R = (st >> 1) * 16 + swz / 64; C = (st & 1) * 32 + (swz % 64) / 2; }
__host__ __device__ __forceinline__ int perm32(int rho) { const int n = rho >> 4, i = rho & 15; return 8 * (i >> 2) + 4 * n + (i & 3); }

struct Unit { int pm, pn; };
struct Gemm { const bf16_t* A; const bf16_t* Bt; int M, N, K; };

struct StaticOrder {
    int nM, nN, nwg, G, c;
    __host__ __device__ void init(int M, int N, int G_, int c_) { nM = M / BM; nN = N / BM; nwg = nM * nN; G = G_; c = c_; }
    __host__ __device__ bool next(int i, Unit& u) const {
        const long L = (long)i * G + c; if (L >= nwg) return false;
        int wgid = (int)L; { const int q = nwg / NXCD, r = nwg % NXCD, xcd = wgid % NXCD, off = wgid / NXCD; wgid = (xcd < r ? xcd * (q + 1) : r * (q + 1) + (xcd - r) * q) + off; }
        const int nig = WGM * nN, gid = wgid / nig, fm = gid * WGM, gsz = (nM - fm) < WGM ? (nM - fm) : WGM;
        u.pm = fm + ((wgid % nig) % gsz); u.pn = (wgid % nig) / gsz; return true;
    }
    __device__ __forceinline__ void a_ready(const Unit&) const {}
    __device__ __forceinline__ void done(const Unit&) const {}
};

template <class Epi, class Sched, bool ALIGN_EPI = false, bool SP2 = false>
__device__ __forceinline__ void gemm_phase(PG8_LAS unsigned char* lds, const Gemm g, const Sched& S, const Epi& E) {
    int tid_l = threadIdx.x; asm volatile("" : "+v"(tid_l));
    const int tid = tid_l, wid = __builtin_amdgcn_readfirstlane(tid >> 6), lane = tid & 63, wr = wid >> 2, wc = wid & 3, fr = lane & 15, fq = lane >> 4;
    const int K = g.K, nt = K / BK;
    unsigned voffA[2], voffB[2];
#pragma unroll
    for (int i = 0; i < 2; ++i) { int R, C; stage_rc(tid * 16 + i * 8192, R, C); const int Rb = Epi::PERM ? ((R & ~31) + perm32(R & 31)) : R;
        voffA[i] = (unsigned)(R * K + C) * 2u; voffB[i] = (unsigned)(Rb * K + C) * 2u; }
    const size_t kstep = (size_t)(BK * 2);
    const size_t hstep = (size_t)HALF * K * 2;
    const size_t tstep = 2 * hstep;
    const unsigned ldsw = (unsigned)wid * 1024u;
    const int aoff = lds_byte(wr * 64 + fr, fq * 8), boff = lds_byte(wc * 32 + fr, fq * 8);
#define PG8_SA(b, h) (((b) * 2 + (h)) * HTB)
#define PG8_SB(b, h) ((4 + (b) * 2 + (h)) * HTB)
#define PG8_STAGE(bufoff, gbase, voff) do { _Pragma("unroll") for (int _i = 0; _i < 2; ++_i) \
        __builtin_amdgcn_global_load_lds((const unsigned*)((const char*)(gbase) + (voff)[_i]), (PG8_LAS unsigned*)(lds + (bufoff) + ldsw + _i * 8192), 16, 0, 0); } while (0)
#define PG8_LDA(dst, b, h) do { _Pragma("unroll") for (int m = 0; m < 4; ++m) _Pragma("unroll") for (int k = 0; k < 2; ++k) dst[m][k] = *(const PG8_LAS bf16x8*)(lds + PG8_SA(b, h) + aoff + m * 2048 + k * 1024); } while (0)
#define PG8_LDB(dst, b, h) do { _Pragma("unroll") for (int n = 0; n < 2; ++n) _Pragma("unroll") for (int k = 0; k < 2; ++k) dst[n][k] = *(const PG8_LAS bf16x8*)(lds + PG8_SB(b, h) + boff + n * 2048 + k * 1024); } while (0)
#define PG8_MMA(ai, bj, At, Bt) do { __builtin_amdgcn_s_setprio(1); _Pragma("unroll") for (int m = 0; m < 4; ++m) _Pragma("unroll") for (int n = 0; n < 2; ++n) _Pragma("unroll") for (int k = 0; k < 2; ++k) \
        acc[ai][bj][m][n] = __builtin_amdgcn_mfma_f32_16x16x32_bf16(Bt[n][k], At[m][k], acc[ai][bj][m][n], 0, 0, 0); __builtin_amdgcn_s_setprio(0); } while (0)
#define PG8_WAIT_V(n) asm volatile("s_waitcnt vmcnt(" #n ")" ::: "memory")
#define PG8_WAIT_L(n) asm volatile("s_waitcnt lgkmcnt(" #n ")" ::: "memory")
#define PG8_BAR __builtin_amdgcn_s_barrier()
#define PG8_SCHED __builtin_amdgcn_sched_barrier(0)
    Unit cur, nxt; int ui = 0;
    if (!S.next(0, cur)) return;
    f32x4 acc[2][2][4][2];
#pragma unroll
    for (int a = 0; a < 2; ++a)
#pragma unroll
        for (int b = 0; b < 2; ++b)
#pragma unroll
            for (int m = 0; m < 4; ++m)
#pragma unroll
                for (int n = 0; n < 2; ++n) acc[a][b][m][n] = (f32x4){0.f, 0.f, 0.f, 0.f};
    bf16x8 At[4][2], B0[2][2], B1[2][2];
    const char* cA = (const char*)g.A + (size_t)cur.pm * tstep; const char* cB = (const char*)g.Bt + (size_t)cur.pn * tstep;
    S.a_ready(cur);
    if constexpr (SP2) {
        PG8_STAGE(PG8_SB(0, 0), cB, voffB); PG8_STAGE(PG8_SB(0, 1), cB + hstep, voffB); PG8_STAGE(PG8_SA(0, 0), cA, voffA); PG8_STAGE(PG8_SA(0, 1), cA + hstep, voffA);
        if (wr == 1) PG8_BAR;
        PG8_WAIT_V(2); PG8_BAR;
        PG8_STAGE(PG8_SB(1, 0), cB + kstep, voffB); PG8_STAGE(PG8_SA(1, 0), cA + kstep, voffA); PG8_STAGE(PG8_SB(1, 1), cB + hstep + kstep, voffB);
        PG8_WAIT_V(6); PG8_BAR;
    } else {
        PG8_STAGE(PG8_SB(0, 0), cB, voffB); PG8_STAGE(PG8_SA(0, 0), cA, voffA); PG8_STAGE(PG8_SB(0, 1), cB + hstep, voffB); PG8_STAGE(PG8_SA(0, 1), cA + hstep, voffA);
        if (wr == 1) PG8_BAR;
        PG8_WAIT_V(4); PG8_BAR;
        PG8_STAGE(PG8_SB(1, 0), cB + kstep, voffB); PG8_STAGE(PG8_SA(1, 0), cA + kstep, voffA); PG8_STAGE(PG8_SB(1, 1), cB + hstep + kstep, voffB);
        PG8_WAIT_V(6); PG8_BAR;
    }
    for (;;) {
        const bool has_next = S.next(ui + 1, nxt);
        const char* nA = has_next ? (const char*)g.A + (size_t)nxt.pm * tstep : cA; const char* nB = has_next ? (const char*)g.Bt + (size_t)nxt.pn * tstep : cB;
        for (int t = 0; t < nt; t += 2) {
            const bool last = (t == nt - 2);
            const char* a1 = cA + (size_t)(t + 1) * kstep;
            const char* a2 = last ? nA : cA + (size_t)(t + 2) * kstep; const char* b2 = last ? nB : cB + (size_t)(t + 2) * kstep;
            const char* a3 = a2 + kstep; const char* b3 = b2 + kstep;
            if (last && has_next) S.a_ready(nxt);
            if constexpr (SP2) {
            PG8_LDB(B0, 0, 0); PG8_LDB(B1, 0, 1); PG8_SCHED; PG8_LDA(At, 0, 0); PG8_STAGE(PG8_SA(1, 1), a1 + hstep, voffA);
            PG8_WAIT_V(8); PG8_WAIT_L(0); PG8_BAR; PG8_MMA(0, 0, At, B0); PG8_MMA(0, 1, At, B1); PG8_BAR; PG8_SCHED;
            PG8_LDA(At, 0, 1); PG8_STAGE(PG8_SB(0, 0), b2, voffB); PG8_STAGE(PG8_SB(0, 1), b2 + hstep, voffB); PG8_STAGE(PG8_SA(0, 0), a2, voffA);
            PG8_WAIT_V(8); PG8_WAIT_L(0); PG8_BAR; PG8_MMA(1, 0, At, B0); PG8_MMA(1, 1, At, B1); PG8_BAR; PG8_SCHED;
            PG8_LDB(B0, 1, 0); PG8_LDB(B1, 1, 1); PG8_SCHED; PG8_LDA(At, 1, 0); PG8_STAGE(PG8_SA(0, 1), a2 + hstep, voffA);
            PG8_WAIT_V(8); PG8_WAIT_L(0); PG8_BAR; PG8_MMA(0, 0, At, B0); PG8_MMA(0, 1, At, B1); PG8_BAR; PG8_SCHED;
            PG8_LDA(At, 1, 1); PG8_STAGE(PG8_SB(1, 0), b3, voffB); PG8_STAGE(PG8_SB(1, 1), b3 + hstep, voffB); PG8_STAGE(PG8_SA(1, 0), a3, voffA);
            PG8_WAIT_V(8); PG8_WAIT_L(0); PG8_BAR; PG8_MMA(1, 0, At, B0); PG8_MMA(1, 1, At, B1); PG8_BAR; PG8_SCHED;
            } else {
            PG8_LDB(B0, 0, 0); PG8_SCHED; PG8_LDA(At, 0, 0); PG8_STAGE(PG8_SA(1, 1), a1 + hstep, voffA);
            PG8_WAIT_L(8); PG8_BAR; PG8_WAIT_L(0); PG8_MMA(0, 0, At, B0); PG8_BAR; PG8_SCHED;
            PG8_LDB(B1, 0, 1); PG8_STAGE(PG8_SB(0, 0), b2, voffB);
            PG8_BAR; PG8_WAIT_L(0); PG8_MMA(0, 1, At, B1); PG8_BAR;
            PG8_LDA(At, 0, 1); PG8_STAGE(PG8_SA(0, 0), a2, voffA);
            PG8_BAR; PG8_WAIT_L(0); PG8_MMA(1, 0, At, B0); PG8_BAR; PG8_SCHED;
            PG8_STAGE(PG8_SB(0, 1), b2 + hstep, voffB);
            PG8_WAIT_V(6); PG8_BAR; PG8_MMA(1, 1, At, B1); PG8_BAR;
            PG8_LDB(B0, 1, 0); PG8_SCHED; PG8_LDA(At, 1, 0); PG8_STAGE(PG8_SA(0, 1), a2 + hstep, voffA);
            PG8_WAIT_L(8); PG8_BAR; PG8_WAIT_L(0); PG8_MMA(0, 0, At, B0); PG8_BAR; PG8_SCHED;
            PG8_LDB(B1, 1, 1); PG8_STAGE(PG8_SB(1, 0), b3, voffB);
            PG8_BAR; PG8_WAIT_L(0); PG8_MMA(0, 1, At, B1); PG8_BAR;
            PG8_LDA(At, 1, 1); PG8_STAGE(PG8_SA(1, 0), a3, voffA);
            PG8_BAR; PG8_WAIT_L(0); PG8_MMA(1, 0, At, B0); PG8_BAR; PG8_SCHED;
            PG8_STAGE(PG8_SB(1, 1), b3 + hstep, voffB);
            PG8_WAIT_V(6); PG8_BAR; PG8_MMA(1, 1, At, B1); PG8_BAR;
            }
        }
        if constexpr (ALIGN_EPI) { if (wr == 0) PG8_BAR; }
        if constexpr (!Epi::AFTER_DRAIN) { E(acc, cur, wr, wc, fr, fq); S.done(cur); }
        if (!has_next) break;
#pragma unroll
        for (int a = 0; a < 2; ++a)
#pragma unroll
            for (int b = 0; b < 2; ++b)
#pragma unroll
                for (int m = 0; m < 4; ++m)
#pragma unroll
                    for (int n = 0; n < 2; ++n) acc[a][b][m][n] = (f32x4){0.f, 0.f, 0.f, 0.f};
        cur = nxt; cA = nA; cB = nB; ++ui;
        if constexpr (ALIGN_EPI) { if (wr == 1) PG8_BAR; }
    }
    PG8_WAIT_V(0);
    if constexpr (!ALIGN_EPI) { if (wr == 0) PG8_BAR; }
    PG8_BAR;
    if constexpr (Epi::AFTER_DRAIN) { E.fused(acc, cur, wr, wc, fr, fq, lds, wid, lane); S.done(cur); }
#undef PG8_SA
#undef PG8_SB
#undef PG8_STAGE
#undef PG8_LDA
#undef PG8_LDB
#undef PG8_MMA
#undef PG8_WAIT_V
#undef PG8_WAIT_L
#undef PG8_BAR
#undef PG8_SCHED
}
}
namespace mk {
using pg8::bf16_t; using pg8::f32x4; using pg8::u32x4; using pg8::bf16x8;
#define LAS __attribute__((address_space(3)))
constexpr int NB = 8, T = 2048, M = NB * T, D = 1024, DEPTH = 4, NMEM = 256, MM = NB * NMEM;
constexpr int NPROJ = 3584, IN_COLS = 3512, DFF = 2816, NUP = 2 * DFF;
constexpr float EPS = 1e-6f;
constexpr int P_MLQ = 0, P_MLK = 384, P_MLV = 768, P_MLO = 1152, P_NAQ = 1536, P_NAK = 1856, P_NAV = 2176, P_GQ = 2496, P_GK = 2656, P_GV = 2816, P_GG = 3136, P_MLG = 3456, P_GA = 3480;
constexpr int NTHREADS = 512, NWAVES = 8;
constexpr int LDS_BYTES = 160 * 1024;
constexpr size_t MiB = (size_t)1 << 20;
constexpr size_t WS_RS0 = 0, WS_RS1 = 1 * MiB, WS_RS2 = 2 * MiB, WS_RSM = 3 * MiB;
constexpr size_t WS_GATES = 4 * MiB;
constexpr size_t WS_MEMB = 8 * MiB;
constexpr size_t WS_MEMKV = 12 * MiB;
constexpr size_t WS_WIN = 20 * MiB, WS_WOUT = 27 * MiB, WS_WQ = 29 * MiB, WS_WO = 31 * MiB, WS_WUP = 33 * MiB, WS_WDN = 44 * MiB, WS_WKV = 50 * MiB;
constexpr size_t WS_HB = 54 * MiB;
constexpr size_t WS_BIG = 86 * MiB;
constexpr size_t WS_HSML = WS_BIG + 112 * MiB, WS_HSGL = WS_HSML + 24 * MiB;
constexpr size_t WS_ACT = 262 * MiB;
constexpr size_t WS_MIXED = WS_ACT, WS_Q = WS_ACT + 32 * MiB;
constexpr size_t WS_END = 350 * MiB;

__device__ __forceinline__ float bf2f(unsigned v) { return __uint_as_float(v << 16); }
__device__ __forceinline__ unsigned f2bf(float f) { const unsigned u = __float_as_uint(f); return (u + 0x7fffu + ((u >> 16) & 1u)) >> 16; }
__device__ __forceinline__ unsigned pk2(float lo, float hi) { return f2bf(lo) | (f2bf(hi) << 16); }
__device__ __forceinline__ unsigned cvt_pk_bf16(float lo, float hi) { unsigned r; asm volatile("v_cvt_pk_bf16_f32 %0, %1, %2" : "=v"(r) : "v"(lo), "v"(hi)); return r; }
__device__ __forceinline__ void unpack8(const u32x4 w, float (&o)[8]) {
    o[0] = bf2f(w.x & 0xffffu); o[1] = bf2f(w.x >> 16); o[2] = bf2f(w.y & 0xffffu); o[3] = bf2f(w.y >> 16);
    o[4] = bf2f(w.z & 0xffffu); o[5] = bf2f(w.z >> 16); o[6] = bf2f(w.w & 0xffffu); o[7] = bf2f(w.w >> 16);
}
__device__ __forceinline__ float wave_sum(float v) {
#pragma unroll
    for (int o = 1; o < 64; o <<= 1) v += __shfl_xor(v, o);
    return v;
}
__device__ __forceinline__ float sigmoidf_(float x) { return 1.f / (1.f + __expf(-x)); }

typedef const float* cfptr;
struct Ctx {
    float* out; unsigned char* ws;
    int G, bid, tid, lane, wave;
    __device__ __forceinline__ const float* in(int i) const {
        asm volatile("" : "+s"(i));
        const __attribute__((address_space(4))) cfptr* tbl = (const __attribute__((address_space(4))) cfptr*)__builtin_amdgcn_kernarg_segment_ptr();
        return tbl[i];
    }
    template <class Tp> __device__ __forceinline__ Tp* wsp(size_t off) const { unsigned o = (unsigned)off; asm volatile("" : "+s"(o)); return (Tp*)(ws + o); }
    __device__ __forceinline__ float* rs0() const { return wsp<float>(WS_RS0); }
    __device__ __forceinline__ float* rs1() const { return wsp<float>(WS_RS1); }
    __device__ __forceinline__ float* rs2() const { return wsp<float>(WS_RS2); }
    __device__ __forceinline__ float* rsm() const { return wsp<float>(WS_RSM); }
    __device__ __forceinline__ float* gates() const { return wsp<float>(WS_GATES); }
    __device__ __forceinline__ float* hsml() const { return wsp<float>(WS_HSML); }
    __device__ __forceinline__ float* hsgl() const { return wsp<float>(WS_HSGL); }
    __device__ __forceinline__ bf16_t* memb() const { return wsp<bf16_t>(WS_MEMB); }
    __device__ __forceinline__ bf16_t* memkv() const { return wsp<bf16_t>(WS_MEMKV); }
    __device__ __forceinline__ bf16_t* w_in() const { return wsp<bf16_t>(WS_WIN); }
    __device__ __forceinline__ bf16_t* w_out() const { return wsp<bf16_t>(WS_WOUT); }
    __device__ __forceinline__ bf16_t* wq() const { return wsp<bf16_t>(WS_WQ); }
    __device__ __forceinline__ bf16_t* wo() const { return wsp<bf16_t>(WS_WO); }
    __device__ __forceinline__ bf16_t* w_up() const { return wsp<bf16_t>(WS_WUP); }
    __device__ __forceinline__ bf16_t* w_dn() const { return wsp<bf16_t>(WS_WDN); }
    __device__ __forceinline__ bf16_t* wkv() const { return wsp<bf16_t>(WS_WKV); }
    __device__ __forceinline__ bf16_t* hb() const { return wsp<bf16_t>(WS_HB); }
    __device__ __forceinline__ bf16_t* proj() const { return wsp<bf16_t>(WS_BIG); }
    __device__ __forceinline__ bf16_t* u() const { return wsp<bf16_t>(WS_BIG); }
    __device__ __forceinline__ bf16_t* act() const { return wsp<bf16_t>(WS_ACT); }
    __device__ __forceinline__ bf16_t* mixed() const { return wsp<bf16_t>(WS_MIXED); }
    __device__ __forceinline__ bf16_t* q() const { return wsp<bf16_t>(WS_Q); }
};

struct EpiScale {
    static constexpr bool PERM = true, AFTER_DRAIN = false;
    bf16_t* O; int ldc; const float* rowss; float* gates; int gate_pn;
    __device__ __forceinline__ void operator()(const f32x4 (&acc)[2][2][4][2], const pg8::Unit& u, int wr, int wc, int fr, int fq) const {
        const int row0 = u.pm * 256 + wr * 64 + fr, col0 = u.pn * 256 + wc * 32 + 8 * fq;
        const bool gt = (u.pn == gate_pn) && (wc < 2);
#pragma unroll
        for (int ai = 0; ai < 2; ++ai)
#pragma unroll
            for (int m = 0; m < 4; ++m) {
                const int row = row0 + ai * 128 + m * 16;
                float rs = 1.0f;
                if (rowss) { const f32x4* rp = (const f32x4*)(rowss + (size_t)row * 16); const f32x4 p0 = rp[0], p1 = rp[1], p2 = rp[2], p3 = rp[3];
                    const float ssum = (((p0[0] + p0[1]) + (p0[2] + p0[3])) + ((p1[0] + p1[1]) + (p1[2] + p1[3]))) + (((p2[0] + p2[1]) + (p2[2] + p2[3])) + ((p3[0] + p3[1]) + (p3[2] + p3[3])));
                    rs = 1.0f / sqrtf(ssum * (1.0f / D) + EPS); }
                bf16_t* rowp = O + (size_t)row * ldc + col0;
#pragma unroll
                for (int bj = 0; bj < 2; ++bj) {
                    const f32x4 v0 = acc[ai][bj][m][0] * rs, v1 = acc[ai][bj][m][1] * rs;
                    u32x4 w; w.x = cvt_pk_bf16(v0[0], v0[1]); w.y = cvt_pk_bf16(v0[2], v0[3]); w.z = cvt_pk_bf16(v1[0], v1[1]); w.w = cvt_pk_bf16(v1[2], v1[3]);
                    *(u32x4*)(rowp + bj * 128) = w;
                    if (bj == 1 && gt) { float* gp = gates + (size_t)row * 64 + wc * 32 + 8 * fq; *(f32x4*)gp = v0; *(f32x4*)(gp + 4) = v1; }
                }
            }
    }
};
struct EpiResid {
    static constexpr bool PERM = true, AFTER_DRAIN = false;
    const float* base; float* out; bf16_t* hb; float* rowss_out;
    __device__ __forceinline__ void operator()(const f32x4 (&acc)[2][2][4][2], const pg8::Unit& u, int wr, int wc, int fr, int fq) const {
        const int row0 = u.pm * 256 + wr * 64 + fr, col0 = u.pn * 256 + wc * 32 + 8 * fq;
#pragma unroll
        for (int ai = 0; ai < 2; ++ai)
#pragma unroll
            for (int m = 0; m < 4; ++m) {
                const int row = row0 + ai * 128 + m * 16; const size_t off = (size_t)row * D + col0; float ss = 0.f;
#pragma unroll
                for (int bj = 0; bj < 2; ++bj) {
                    const f32x4 v0 = acc[ai][bj][m][0] + *(const f32x4*)(base + off + bj * 128), v1 = acc[ai][bj][m][1] + *(const f32x4*)(base + off + bj * 128 + 4);
                    *(f32x4*)(out + off + bj * 128) = v0; *(f32x4*)(out + off + bj * 128 + 4) = v1;
                    u32x4 w; w.x = cvt_pk_bf16(v0[0], v0[1]); w.y = cvt_pk_bf16(v0[2], v0[3]); w.z = cvt_pk_bf16(v1[0], v1[1]); w.w = cvt_pk_bf16(v1[2], v1[3]);
                    *(u32x4*)(hb + off + bj * 128) = w;
                    ss += (v0[0] * v0[0] + v0[1] * v0[1]) + (v0[2] * v0[2] + v0[3] * v0[3]) + (v1[0] * v1[0] + v1[1] * v1[1]) + (v1[2] * v1[2] + v1[3] * v1[3]);
                }
                ss += __shfl_xor(ss, 16); ss += __shfl_xor(ss, 32);
                if (fq == 0) rowss_out[(size_t)row * 16 + u.pn * 4 + wc] = ss;
                asm volatile("" ::: "memory");
            }
    }
};

template <class Map>
__device__ __forceinline__ void cvt_item(const float* W, int K, int N, const float* gain, bf16_t* WT, LAS float* scr, int item, int lane, Map map) {
    const int nblk = (N + 31) / 32, kb = item / nblk, nb = item % nblk, k0 = 64 * kb, n0 = 32 * nb;
    const int nn = n0 + (lane & 31);
#pragma unroll 8
    for (int i = 0; i < 32; ++i) { const int kk = 2 * i + (lane >> 5); float w = (nn < N) ? W[(size_t)(k0 + kk) * N + nn] : 0.f; if (gain) w *= gain[k0 + kk]; scr[kk * 33 + (lane & 31)] = w; }
    asm volatile("s_waitcnt lgkmcnt(0)" ::: "memory");
    const int c = lane & 7;
#pragma unroll
    for (int j = 0; j < 4; ++j) { const int n = (lane >> 3) + 8 * j; const LAS float* s = scr + (8 * c) * 33 + n;
        u32x4 o; o.x = pk2(s[0 * 33], s[1 * 33]); o.y = pk2(s[2 * 33], s[3 * 33]); o.z = pk2(s[4 * 33], s[5 * 33]); o.w = pk2(s[6 * 33], s[7 * 33]);
        if (n0 + n < N) *(u32x4*)(WT + (size_t)map(n0 + n) * K + k0 + 8 * c) = o; }
    asm volatile("s_waitcnt lgkmcnt(0)" ::: "memory");
}
struct MapId { int off; __device__ __forceinline__ int operator()(int n) const { return n + off; } };
struct MapIn { __device__ __forceinline__ int operator()(int n) const { return n < 1536 ? n : (n < 1560 ? n + (P_MLG - 1536) : (n < 3480 ? n - 24 : n)); } };

__device__ __forceinline__ void convert_layer(const Ctx& c, int l, LAS unsigned char* lds) {
    LAS float* scr = (LAS float*)(lds + c.wave * 16384);
    const int gw = c.bid * NWAVES + c.wave, NGW = c.G * NWAVES;
    constexpr int I_IN = 16 * 110, I_SQ = 16 * 32, I_UP = 16 * 176, I_DN = 44 * 32;
    constexpr int NITEMS = I_IN + 5 * I_SQ + I_UP + I_DN;
    for (int it = gw; it < NITEMS; it += NGW) {
        int r = it;
        if (r < I_IN) { cvt_item(c.in(3) + (size_t)l * D * IN_COLS, D, IN_COLS, c.in(2) + l * D, c.w_in(), scr, r, c.lane, MapIn{}); continue; } r -= I_IN;
        if (r < I_SQ) { cvt_item(c.in(12) + (size_t)l * D * D, D, D, nullptr, c.w_out(), scr, r, c.lane, MapId{0}); continue; } r -= I_SQ;
        if (r < I_SQ) { cvt_item(c.in(15) + (size_t)l * D * D, D, D, c.in(13) + l * D, c.wq(), scr, r, c.lane, MapId{0}); continue; } r -= I_SQ;
        if (r < I_SQ) { cvt_item(c.in(16) + (size_t)l * D * D, D, D, c.in(14) + l * D, c.wkv(), scr, r, c.lane, MapId{0}); continue; } r -= I_SQ;
        if (r < I_SQ) { cvt_item(c.in(17) + (size_t)l * D * D, D, D, c.in(14) + l * D, c.wkv(), scr, r, c.lane, MapId{D}); continue; } r -= I_SQ;
        if (r < I_SQ) { cvt_item(c.in(18) + (size_t)l * D * D, D, D, nullptr, c.wo(), scr, r, c.lane, MapId{0}); continue; } r -= I_SQ;
        if (r < I_UP) { cvt_item(c.in(20) + (size_t)l * D * NUP, D, NUP, c.in(19) + l * D, c.w_up(), scr, r, c.lane, MapId{0}); continue; } r -= I_UP;
        cvt_item(c.in(23) + (size_t)l * DFF * D, DFF, D, nullptr, c.w_dn(), scr, r, c.lane, MapId{0});
    }
    const int gt = c.bid * NTHREADS + c.tid;
    for (int i = gt; i < (NPROJ - IN_COLS) * D / 8; i += c.G * NTHREADS) *(u32x4*)(c.w_in() + (size_t)IN_COLS * D + (size_t)i * 8) = (u32x4){0u, 0u, 0u, 0u};
}
__device__ __forceinline__ void rows_to_bf16(const Ctx& c, const float* X, bf16_t* Y, float* rss, int rows) {
    const int gw = c.bid * NWAVES + c.wave, NGW = c.G * NWAVES;
    for (int m = gw; m < rows; m += NGW) {
        const f32x4* xr = (const f32x4*)(X + (size_t)m * D) + c.lane; float s = 0.f;
        unsigned long long* o8 = (unsigned long long*)(Y + (size_t)m * D) + c.lane;
#pragma unroll
        for (int j = 0; j < 4; ++j) { const f32x4 v = xr[64 * j]; s += (v[0] * v[0] + v[1] * v[1]) + (v[2] * v[2] + v[3] * v[3]);
            o8[64 * j] = (unsigned long long)pk2(v[0], v[1]) | ((unsigned long long)pk2(v[2], v[3]) << 32); }
        s = wave_sum(s); if (c.lane < 16) rss[(size_t)m * 16 + c.lane] = (c.lane == 0) ? s : 0.f;
    }
}
__device__ __forceinline__ void final_norm(const Ctx& c) {
    const int gw = c.bid * NWAVES + c.wave, NGW = c.G * NWAVES; const float* g = c.in(24);
    for (int m = gw; m < M; m += NGW) {
        f32x4* xr = (f32x4*)(c.out + (size_t)m * D) + c.lane; f32x4 v[4]; float s = 0.f;
#pragma unroll
        for (int j = 0; j < 4; ++j) { v[j] = xr[64 * j]; s += (v[j][0] * v[j][0] + v[j][1] * v[j][1]) + (v[j][2] * v[j][2] + v[j][3] * v[j][3]); }
        const float r = 1.0f / sqrtf(wave_sum(s) * (1.0f / D) + EPS);
#pragma unroll
        for (int j = 0; j < 4; ++j) xr[64 * j] = v[j] * r * ((const f32x4*)g)[c.lane + 64 * j];
    }
}
__device__ __forceinline__ void ml_load_row(const bf16_t* projb, int t, int coff, float (&dst)[2][8]) {
    if (t < 0 || t >= T) {
#pragma unroll
        for (int j = 0; j < 8; ++j) { dst[0][j] = 0.f; dst[1][j] = 0.f; }
    } else {
        const u32x4 a = *(const u32x4*)(projb + (size_t)t * NPROJ + P_MLQ + coff), b = *(const u32x4*)(projb + (size_t)t * NPROJ + P_MLK + coff);
        unpack8(a, dst[0]); unpack8(b, dst[1]);
    }
}
__device__ __forceinline__ void ml_item(const Ctx& c, int l, int item, LAS unsigned char* lds) {
    const int b = item / 6, h = item % 6, e = c.tid & 63, dg = c.tid >> 6;
    LAS float* rnum = (LAS float*)lds;
    LAS float* rden = (LAS float*)lds + 1024;
    const bf16_t* projb = c.proj() + (size_t)b * T * NPROJ;
    const float* gatesb = c.gates() + (size_t)b * T * 64;
    float* hs = c.hsml() + (size_t)b * T * 384 + h * 64;
    const float* cwp = c.in(4) + (size_t)l * 3 * 768; const float* cbp = c.in(5) + (size_t)l * 768;
    const float* gb = c.in(6) + l * 24; const float* ng = c.in(7) + l * 384;
    const int coff = h * 64 + dg * 8;
    float cw[2][8][4];
#pragma unroll
    for (int qk = 0; qk < 2; ++qk)
#pragma unroll
        for (int j = 0; j < 8; ++j) { const int ch = qk * 384 + coff + j; cw[qk][j][0] = cwp[ch]; cw[qk][j][1] = cwp[768 + ch]; cw[qk][j][2] = cwp[1536 + ch]; cw[qk][j][3] = cbp[ch]; }
    for (int dir = 0; dir < 2; ++dir) {
        float C[8], n[8];
#pragma unroll
        for (int j = 0; j < 8; ++j) { C[j] = 0.f; n[j] = 0.f; }
        const float bi = gb[(2 * dir) * 6 + h], bff = gb[(2 * dir + 1) * 6 + h];
        float lo[2][8], mid[2][8], hi[2][8];
        const int t0 = dir ? T - 1 : 0;
        ml_load_row(projb, t0 - 1, coff, lo); ml_load_row(projb, t0, coff, mid); ml_load_row(projb, t0 + 1, coff, hi);
        for (int s = 0; s < T; ++s) {
            const int t = dir ? T - 1 - s : s;
            const float ip = gatesb[(size_t)t * 64 + (2 * dir) * 6 + h] + bi, fp = gatesb[(size_t)t * 64 + (2 * dir + 1) * 6 + h] + bff;
            const float f = sigmoidf_(fp), ig = __expf(ip);
            const float v = bf2f(projb[(size_t)t * NPROJ + P_MLV + h * 64 + e]);
            float pn = 0.f, pd = 0.f;
#pragma unroll
            for (int j = 0; j < 8; ++j) {
                float yq = lo[0][j] * cw[0][j][0] + mid[0][j] * cw[0][j][1] + hi[0][j] * cw[0][j][2] + cw[0][j][3];
                float yk = lo[1][j] * cw[1][j][0] + mid[1][j] * cw[1][j][1] + hi[1][j] * cw[1][j][2] + cw[1][j][3];
                const float qd = yq * sigmoidf_(yq), kd = yk * sigmoidf_(yk) * 0.125f;
                C[j] = f * C[j] + ig * kd * v; n[j] = f * n[j] + ig * kd; pn += C[j] * qd; pd += n[j] * qd;
            }
            const int p = s & 1;
            rnum[(p * 8 + dg) * 64 + e] = pn; if (e == 0) rden[p * 8 + dg] = pd;
            __syncthreads();
            if (dg == 0) {
                float num = 0.f, den = 0.f;
#pragma unroll
                for (int g = 0; g < 8; ++g) { num += rnum[(p * 8 + g) * 64 + e]; den += rden[p * 8 + g]; }
                const float hv = num / fmaxf(fabsf(den), 1.f);
                if (dir == 0) hs[(size_t)t * 384 + e] = hv;
                else { const float tot = hs[(size_t)t * 384 + e] + hv; const float ss = wave_sum(tot * tot);
                    const float r = 1.0f / sqrtf(ss * (1.0f / 64) + EPS); const float og = bf2f(projb[(size_t)t * NPROJ + P_MLO + h * 64 + e]);
                    c.mixed()[((size_t)b * T + t) * D + h * 64 + e] = (bf16_t)f2bf(tot * r * ng[h * 64 + e] * sigmoidf_(og)); }
            }
            if (dir == 0) {
#pragma unroll
                for (int j = 0; j < 8; ++j) { lo[0][j] = mid[0][j]; lo[1][j] = mid[1][j]; mid[0][j] = hi[0][j]; mid[1][j] = hi[1][j]; }
                ml_load_row(projb, t + 2, coff, hi);
            } else {
#pragma unroll
                for (int j = 0; j < 8; ++j) { hi[0][j] = mid[0][j]; hi[1][j] = mid[1][j]; mid[0][j] = lo[0][j]; mid[1][j] = lo[1][j]; }
                ml_load_row(projb, t - 2, coff, lo);
            }
        }
        __syncthreads();
    }
}
__device__ __forceinline__ void gla_item(const Ctx& c, int l, int item, LAS unsigned char* lds) {
    const int b = item / 5, h = item % 5, e = c.tid & 63, kg = c.tid >> 6;
    LAS float* rnum = (LAS float*)lds;
    const bf16_t* projb = c.proj() + (size_t)b * T * NPROJ;
    const float* gatesb = c.gates() + (size_t)b * T * 64;
    float* gs = c.hsgl() + (size_t)b * T * 320 + h * 64;
    const float* ng = c.in(11) + l * 320;
    const int doff = h * 32 + kg * 4;
    for (int dir = 0; dir < 2; ++dir) {
        const float* w2 = c.in(9) + ((size_t)l * 2 + dir) * 16 * 160; const float* ab = c.in(10) + ((size_t)l * 2 + dir) * 160;
        float w2r[16][4], abv[4], S[4];
#pragma unroll
        for (int j = 0; j < 4; ++j) { abv[j] = ab[doff + j]; S[j] = 0.f;
#pragma unroll
            for (int r = 0; r < 16; ++r) w2r[r][j] = w2[r * 160 + doff + j]; }
        for (int s = 0; s < T; ++s) {
            const int t = dir ? T - 1 - s : s;
            const float* gp = gatesb + (size_t)t * 64 + 24 + dir * 16;
            float ga[16];
#pragma unroll
            for (int r4 = 0; r4 < 4; ++r4) { const f32x4 x = *(const f32x4*)(gp + 4 * r4); ga[4 * r4] = x[0]; ga[4 * r4 + 1] = x[1]; ga[4 * r4 + 2] = x[2]; ga[4 * r4 + 3] = x[3]; }
            const unsigned long long qw = *(const unsigned long long*)(projb + (size_t)t * NPROJ + P_GQ + doff), kw = *(const unsigned long long*)(projb + (size_t)t * NPROJ + P_GK + doff);
            const float v = bf2f(projb[(size_t)t * NPROJ + P_GV + h * 64 + e]);
            float pn = 0.f;
#pragma unroll
            for (int j = 0; j < 4; ++j) {
                float z = abv[j];
#pragma unroll
                for (int r = 0; r < 16; ++r) z += ga[r] * w2r[r][j];
                const float la = (fminf(z, 0.f) - log1pf(__expf(-fabsf(z)))) * (1.0f / 16.0f);
                const float a = __expf(la);
                const float qd = bf2f((unsigned)(qw >> (16 * j)) & 0xffffu), kd = bf2f((unsigned)(kw >> (16 * j)) & 0xffffu);
                S[j] = a * S[j] + kd * v; pn += S[j] * qd;
            }
            const int p = s & 1;
            rnum[(p * 8 + kg) * 64 + e] = pn * 0.17677669529663687f;
            __syncthreads();
            if (kg == 0) {
                float o = 0.f;
#pragma unroll
                for (int g = 0; g < 8; ++g) o += rnum[(p * 8 + g) * 64 + e];
                if (dir == 0) gs[(size_t)t * 320 + e] = o;
                else { const float tot = gs[(size_t)t * 320 + e] + o; const float ss = wave_sum(tot * tot);
                    const float r = 1.0f / sqrtf(ss * (1.0f / 64) + EPS); const float gg = bf2f(projb[(size_t)t * NPROJ + P_GG + h * 64 + e]);
                    c.mixed()[((size_t)b * T + t) * D + 704 + h * 64 + e] = (bf16_t)f2bf(tot * r * ng[h * 64 + e] * gg * sigmoidf_(gg)); }
            }
        }
        __syncthreads();
    }
}
__device__ __forceinline__ void na_item(const Ctx& c, int l, int item, LAS unsigned char* lds) {
    const int b = item / 160, h = (item % 160) / 32, r = item % 32;
    const int q = c.tid >> 3, s = c.tid & 7;
    LAS float* sc = (LAS float*)lds;
    const bf16_t* projb = c.proj() + (size_t)b * T * NPROJ;
    const float* rpb = c.in(8) + ((size_t)l * 5 + h) * 15 * 31;
    const int rs = min(max(r - 4, 0), 24), cs = min(max(q - 8, 0), 48);
    float qv[64];
    { const bf16_t* qp = projb + (size_t)(r * 64 + q) * NPROJ + P_NAQ + h * 64;
#pragma unroll
      for (int i = 0; i < 8; ++i) { float t8[8]; unpack8(*(const u32x4*)(qp + 8 * i), t8);
#pragma unroll
          for (int j = 0; j < 8; ++j) qv[8 * i + j] = t8[j]; } }
    const int tr = rs + s;
    for (int kk = 0; kk < 16; ++kk) { const int tc = cs + kk;
        const bf16_t* kp = projb + (size_t)(tr * 64 + tc) * NPROJ + P_NAK + h * 64; float d = 0.f;
#pragma unroll
        for (int i = 0; i < 8; ++i) { float t8[8]; unpack8(*(const u32x4*)(kp + 8 * i), t8);
#pragma unroll
            for (int j = 0; j < 8; ++j) d += qv[8 * i + j] * t8[j]; }
        const int dr = tr - r + 7, dc = min(max(tc - q, -15), 15) + 15;
        sc[q * 129 + s * 16 + kk] = d * 0.125f + rpb[dr * 31 + dc]; }
    __syncthreads();
    float mx = -3.0e38f; for (int k = 0; k < 128; ++k) mx = fmaxf(mx, sc[q * 129 + k]);
    float sum = 0.f; for (int k = 0; k < 128; ++k) sum += __expf(sc[q * 129 + k] - mx);
    __syncthreads();
    const float inv = 1.0f / sum;
    for (int kk = 0; kk < 16; ++kk) sc[q * 129 + s * 16 + kk] = __expf(sc[q * 129 + s * 16 + kk] - mx) * inv;
    __syncthreads();
    float o[8];
#pragma unroll
    for (int j = 0; j < 8; ++j) o[j] = 0.f;
    for (int key = 0; key < 128; ++key) { const int trr = rs + (key >> 4), tcc = cs + (key & 15);
        float t8[8]; unpack8(*(const u32x4*)(projb + (size_t)(trr * 64 + tcc) * NPROJ + P_NAV + h * 64 + s * 8), t8); const float p = sc[q * 129 + key];
#pragma unroll
        for (int j = 0; j < 8; ++j) o[j] += p * t8[j]; }
    u32x4 w; w.x = pk2(o[0], o[1]); w.y = pk2(o[2], o[3]); w.z = pk2(o[4], o[5]); w.w = pk2(o[6], o[7]);
    *(u32x4*)(c.mixed() + ((size_t)b * T + r * 64 + q) * D + 384 + h * 64 + s * 8) = w;
    __syncthreads();
}
__device__ __forceinline__ void xattn_item(const Ctx& c, int item, LAS unsigned char* lds) {
    const int b = item / 256, hd = (item / 64) % 4, qt = item % 64; const int row0 = b * T + qt * 32;
    LAS float* qs = (LAS float*)lds;
    LAS float* ps = (LAS float*)lds + 8192;
    const int qi = c.tid >> 4, sub = c.tid & 15;
    { const bf16_t* qp = c.q() + (size_t)(row0 + qi) * D + hd * 256 + sub * 16; float t8[8];
      unpack8(*(const u32x4*)qp, t8);
#pragma unroll
      for (int j = 0; j < 8; ++j) qs[qi * 256 + sub * 16 + j] = t8[j];
      unpack8(*(const u32x4*)(qp + 8), t8);
#pragma unroll
      for (int j = 0; j < 8; ++j) qs[qi * 256 + sub * 16 + 8 + j] = t8[j]; }
    __syncthreads();
    const bf16_t* kvb = c.memkv() + (size_t)b * NMEM * 2048 + hd * 256;
    float acc[16];
#pragma unroll
    for (int j = 0; j < 16; ++j) acc[j] = 0.f;
    for (int dc = 0; dc < 32; ++dc) {
        float qr[8];
#pragma unroll
        for (int i = 0; i < 8; ++i) qr[i] = qs[qi * 256 + dc * 8 + i];
#pragma unroll
        for (int j = 0; j < 16; ++j) { float t8[8]; unpack8(*(const u32x4*)(kvb + (size_t)(sub + 16 * j) * 2048 + dc * 8), t8);
#pragma unroll
            for (int i = 0; i < 8; ++i) acc[j] += qr[i] * t8[i]; }
    }
    float mx = -3.0e38f;
#pragma unroll
    for (int j = 0; j < 16; ++j) { acc[j] *= 0.0625f; mx = fmaxf(mx, acc[j]); }
#pragma unroll
    for (int o = 1; o < 16; o <<= 1) mx = fmaxf(mx, __shfl_xor(mx, o));
    float sum = 0.f;
#pragma unroll
    for (int j = 0; j < 16; ++j) { acc[j] = __expf(acc[j] - mx); sum += acc[j]; }
#pragma unroll
    for (int o = 1; o < 16; o <<= 1) sum += __shfl_xor(sum, o);
    const float inv = 1.0f / sum;
#pragma unroll
    for (int j = 0; j < 16; ++j) ps[qi * 256 + sub + 16 * j] = acc[j] * inv;
    __syncthreads();
    float o[16];
#pragma unroll
    for (int j = 0; j < 16; ++j) o[j] = 0.f;
    for (int key = 0; key < 256; ++key) { const float p = ps[qi * 256 + key]; const bf16_t* vp = kvb + (size_t)key * 2048 + 1024 + sub * 16; float t8[8];
        unpack8(*(const u32x4*)vp, t8);
#pragma unroll
        for (int j = 0; j < 8; ++j) o[j] += p * t8[j];
        unpack8(*(const u32x4*)(vp + 8), t8);
#pragma unroll
        for (int j = 0; j < 8; ++j) o[8 + j] += p * t8[j]; }
    bf16_t* op = c.mixed() + (size_t)(row0 + qi) * D + hd * 256 + sub * 16;
    u32x4 w; w.x = pk2(o[0], o[1]); w.y = pk2(o[2], o[3]); w.z = pk2(o[4], o[5]); w.w = pk2(o[6], o[7]); *(u32x4*)op = w;
    w.x = pk2(o[8], o[9]); w.y = pk2(o[10], o[11]); w.z = pk2(o[12], o[13]); w.w = pk2(o[14], o[15]); *(u32x4*)(op + 8) = w;
    __syncthreads();
}
__device__ __forceinline__ void act_pass(const Ctx& c, int l) {
    const float* cw = c.in(21) + (size_t)l * 3 * DFF; const float* cb = c.in(22) + (size_t)l * DFF;
    constexpr int CH = DFF / 8;
    for (int idx = c.bid * NTHREADS + c.tid; idx < M * CH; idx += c.G * NTHREADS) {
        const int row = idx / CH, c8 = (idx % CH) * 8, t = row % T;
        const bf16_t* up = c.u() + (size_t)row * NUP + c8;
        float a0[8], am[8], ap[8], g[8];
        unpack8(*(const u32x4*)up, a0); unpack8(*(const u32x4*)(up + DFF), g);
        if (t > 0) unpack8(*(const u32x4*)(up - NUP), am); else {
#pragma unroll
            for (int j = 0; j < 8; ++j) am[j] = 0.f; }
        if (t < T - 1) unpack8(*(const u32x4*)(up + NUP), ap); else {
#pragma unroll
            for (int j = 0; j < 8; ++j) ap[j] = 0.f; }
        float o[8];
#pragma unroll
        for (int j = 0; j < 8; ++j) { const float a = am[j] * cw[c8 + j] + a0[j] * cw[DFF + c8 + j] + ap[j] * cw[2 * DFF + c8 + j] + cb[c8 + j];
            const float uu = 0.7978845608028654f * (a + 0.044715f * a * a * a);
            o[j] = a / (1.f + __expf(-2.f * uu)) * g[j]; }
        u32x4 w; w.x = pk2(o[0], o[1]); w.y = pk2(o[2], o[3]); w.z = pk2(o[4], o[5]); w.w = pk2(o[6], o[7]);
        *(u32x4*)(c.act() + (size_t)row * DFF + c8) = w;
    }
}
#ifndef MK_PER_PHASE
#define MK_PER_PHASE 0
#endif
constexpr int PH_PER_LAYER = 10, NP = 2 + DEPTH * PH_PER_LAYER;
struct Args { const float* in[25]; float* out; unsigned char* ws; int ph_lo, ph_hi; };

__global__ void __launch_bounds__(NTHREADS, 2) mega(Args a) {
    extern __shared__ __attribute__((aligned(16))) unsigned char lds_raw[];
    LAS unsigned char* lds = (LAS unsigned char*)lds_raw;
    Ctx c;
    c.out = a.out; c.ws = a.ws;
    cg::grid_group grid = cg::this_grid();

    for (int p = a.ph_lo; p < a.ph_hi; ++p) {
        { int t_ = threadIdx.x, b_ = blockIdx.x, g_ = gridDim.x;
          asm volatile("" : "+v"(t_)); asm volatile("" : "+s"(b_)); asm volatile("" : "+s"(g_));
          c.tid = t_; c.lane = t_ & 63; c.wave = __builtin_amdgcn_readfirstlane(t_ >> 6); c.bid = b_; c.G = g_; }
        if (p == 0) {
            convert_layer(c, 0, lds);
            rows_to_bf16(c, c.in(0), c.hb(), c.rs0(), M);
            rows_to_bf16(c, c.in(1), c.memb(), c.rsm(), MM);
        } else if (p == NP - 1) {
            final_norm(c);
        } else {
            const int l = (p - 1) / PH_PER_LAYER, st = (p - 1) % PH_PER_LAYER;
            if (st == 0) {
                { pg8::Gemm g{c.hb(), c.w_in(), M, NPROJ, D}; pg8::StaticOrder S; S.init(M, NPROJ, c.G, c.bid);
                  EpiScale E{c.proj(), NPROJ, c.rs0(), c.gates(), 13};
                  pg8::gemm_phase<EpiScale, pg8::StaticOrder, true, true>(lds, g, S, E); }
                { pg8::Gemm g{c.memb(), c.wkv(), MM, 2 * D, D}; pg8::StaticOrder S; S.init(MM, 2 * D, c.G, c.bid);
                  EpiScale E{c.memkv(), 2 * D, c.rsm(), nullptr, -1};
                  pg8::gemm_phase<EpiScale, pg8::StaticOrder, true, true>(lds, g, S, E); }
            } else if (st == 1) {
                if (c.bid < 48) ml_item(c, l, c.bid, lds);
                else if (c.bid < 88) gla_item(c, l, c.bid - 48, lds);
                else for (int i = c.bid - 88; i < NB * 5 * 32; i += c.G - 88) na_item(c, l, i, lds);
            } else if (st == 2) {
                pg8::Gemm g{c.mixed(), c.w_out(), M, D, D}; pg8::StaticOrder S; S.init(M, D, c.G, c.bid);
                EpiResid E{l == 0 ? c.in(0) : c.out, c.out, c.hb(), c.rs1()};
                pg8::gemm_phase<EpiResid, pg8::StaticOrder, true, true>(lds, g, S, E);
            } else if (st == 3) {
                pg8::Gemm g{c.hb(), c.wq(), M, D, D}; pg8::StaticOrder S; S.init(M, D, c.G, c.bid);
                EpiScale E{c.q(), D, c.rs1(), nullptr, -1};
                pg8::gemm_phase<EpiScale, pg8::StaticOrder, true, true>(lds, g, S, E);
            } else if (st == 4) {
                for (int i = c.bid; i < NB * 4 * 64; i += c.G) xattn_item(c, i, lds);
            } else if (st == 5) {
                pg8::Gemm g{c.mixed(), c.wo(), M, D, D}; pg8::StaticOrder S; S.init(M, D, c.G, c.bid);
                EpiResid E{c.out, c.out, c.hb(), c.rs2()};
                pg8::gemm_phase<EpiResid, pg8::StaticOrder, true, true>(lds, g, S, E);
            } else if (st == 6) {
                pg8::Gemm g{c.hb(), c.w_up(), M, NUP, D}; pg8::StaticOrder S; S.init(M, NUP, c.G, c.bid);
                EpiScale E{c.u(), NUP, c.rs2(), nullptr, -1};
                pg8::gemm_phase<EpiScale, pg8::StaticOrder, true, true>(lds, g, S, E);
            } else if (st == 7) {
                act_pass(c, l);
            } else if (st == 8) {
                pg8::Gemm g{c.act(), c.w_dn(), M, D, DFF}; pg8::StaticOrder S; S.init(M, D, c.G, c.bid);
                EpiResid E{c.out, c.out, c.hb(), c.rs0()};
                pg8::gemm_phase<EpiResid, pg8::StaticOrder, true, true>(lds, g, S, E);
            } else {
                if (l + 1 < DEPTH) convert_layer(c, l + 1, lds);
            }
        }
        if (p + 1 < a.ph_hi) grid.sync();
    }
}
}

extern "C" void kernel_launch(void* const* d_in, const int* in_sizes, int n_in, void* d_out, int out_size, void* d_ws, size_t ws_size, hipStream_t stream) {
    static int grid = 0;
    if (grid == 0) {
        if (n_in != 25 || out_size != mk::M * mk::D || ws_size < mk::WS_END) { fprintf(stderr, "kernel_launch: unexpected shapes / workspace (n_in %d out %d ws %zu need %zu)\n", n_in, out_size, ws_size, (size_t)mk::WS_END); grid = -1; return; }
        int dev = 0, cus = 0, per_cu = 0;
        (void)hipGetDevice(&dev); (void)hipDeviceGetAttribute(&cus, hipDeviceAttributeMultiprocessorCount, dev);
        if (hipFuncSetAttribute((const void*)mk::mega, hipFuncAttributeMaxDynamicSharedMemorySize, mk::LDS_BYTES) != hipSuccess) { fprintf(stderr, "kernel_launch: hipFuncSetAttribute failed\n"); grid = -1; return; }
        (void)hipOccupancyMaxActiveBlocksPerMultiprocessor(&per_cu, (const void*)mk::mega, mk::NTHREADS, mk::LDS_BYTES);
        if (per_cu < 1) { fprintf(stderr, "kernel_launch: occupancy query says %d blocks per CU\n", per_cu); grid = -1; return; }
        grid = cus;
        if (grid < 96) { fprintf(stderr, "kernel_launch: needs >= 96 CUs\n"); grid = -1; return; }
    }
    if (grid < 0) return;
    mk::Args a{};
    for (int i = 0; i < 25; ++i) a.in[i] = (const float*)d_in[i];
    a.out = (float*)d_out; a.ws = (unsigned char*)d_ws;
#if MK_PER_PHASE
    for (int p = 0; p < mk::NP; ++p) { a.ph_lo = p; a.ph_hi = p + 1; hipLaunchKernelGGL(mk::mega, dim3(grid), dim3(mk::NTHREADS), mk::LDS_BYTES, stream, a); }
#else
    a.ph_lo = 0; a.ph_hi = mk::NP;
    void* args[] = {&a};
    hipError_t e = hipLaunchCooperativeKernel((const void*)mk::mega, dim3(grid), dim3(mk::NTHREADS), args, mk::LDS_BYTES, stream);
    if (e != hipSuccess) fprintf(stderr, "cooperative launch failed: %s (grid %d)\n", hipGetErrorString(e), grid);
#endif
}
```

```cpp
#include <hip/hip_runtime.h>
#include <hip/hip_cooperative_groups.h>
#include <cstdio>
#include <cstdint>
namespace cg = cooperative_groups;
#define MK_PER_PHASE 0
namespace pg8 {
#define PG8_LAS __attribute__((address_space(3)))
typedef unsigned short bf16_t;
typedef short bf16x8 __attribute__((ext_vector_type(8)));
typedef float f32x4 __attribute__((ext_vector_type(4)));
typedef unsigned u32x4 __attribute__((ext_vector_type(4)));
constexpr int BM = 256, BK = 64, HALF = 128, HTB = HALF * BK * 2  , STAGE_BYTES = 8 * HTB, NXCD = 8, WGM = 8;

__host__ __device__ __forceinline__ int lds_byte(int r, int c) { const int st = (r >> 4) * 2 + (c >> 5), rr = r & 15, cc = c & 31, ob = rr * 64 + cc * 2; return st * 1024 + (ob ^ (((ob >> 9) & 1) << 5)); }
__host__ __device__ __forceinline__ void stage_rc(int b, int& R, int& C) { const int st = b / 1024, sb = b % 1024, swz = sb ^ (((sb >> 9) & 1) << 5); R = (st >> 1) * 16 + swz / 64; C = (st & 1) * 32 + (swz % 64) / 2; }
__host__ __device__ __forceinline__ int perm32(int rho) { const int n = rho >> 4, i = rho & 15; return 8 * (i >> 2) + 4 * n + (i & 3); }

struct Unit { int pm, pn; };
struct Gemm { const bf16_t* A; const bf16_t* Bt; int M, N, K; };

struct StaticOrder {
    int nM, nN, nwg, G, c;
    __host__ __device__ void init(int M, int N, int G_, int c_) { nM = M / BM; nN = N / BM; nwg = nM * nN; G = G_; c = c_; }
    __host__ __device__ bool next(int i, Unit& u) const {
        const long L = (long)i * G + c; if (L >= nwg) return false;
        int wgid = (int)L; { const int q = nwg / NXCD, r = nwg % NXCD, xcd = wgid % NXCD, off = wgid / NXCD; wgid = (xcd < r ? xcd * (q + 1) : r * (q + 1) + (xcd - r) * q) + off; }
        const int nig = WGM * nN, gid = wgid / nig, fm = gid * WGM, gsz = (nM - fm) < WGM ? (nM - fm) : WGM;
        u.pm = fm + ((wgid % nig) % gsz); u.pn = (wgid % nig) / gsz; return true;
    }
    __device__ __forceinline__ void a_ready(const Unit&) const {}
    __device__ __forceinline__ void done(const Unit&) const {}
};

template <class Epi, class Sched, bool ALIGN_EPI = false, bool SP2 = false>
__device__ __forceinline__ void gemm_phase(PG8_LAS unsigned char* lds, const Gemm g, const Sched& S, const Epi& E) {
    int tid_l = threadIdx.x; asm volatile("" : "+v"(tid_l));
    const int tid = tid_l, wid = __builtin_amdgcn_readfirstlane(tid >> 6), lane = tid & 63, wr = wid >> 2, wc = wid & 3, fr = lane & 15, fq = lane >> 4;
    const int K = g.K, nt = K / BK;
    unsigned voffA[2], voffB[2];
#pragma unroll
    for (int i = 0; i < 2; ++i) { int R, C; stage_rc(tid * 16 + i * 8192, R, C); const int Rb = Epi::PERM ? ((R & ~31) + perm32(R & 31)) : R;
        voffA[i] = (unsigned)(R * K + C) * 2u; voffB[i] = (unsigned)(Rb * K + C) * 2u; }
    const size_t kstep = (size_t)(BK * 2);
    const size_t hstep = (size_t)HALF * K * 2;
    const size_t tstep = 2 * hstep;
    const unsigned ldsw = (unsigned)wid * 1024u;
    const int aoff = lds_byte(wr * 64 + fr, fq * 8), boff = lds_byte(wc * 32 + fr, fq * 8);
#define PG8_SA(b, h) (((b) * 2 + (h)) * HTB)
#define PG8_SB(b, h) ((4 + (b) * 2 + (h)) * HTB)
#define PG8_STAGE(bufoff, gbase, voff) do { _Pragma("unroll") for (int _i = 0; _i < 2; ++_i) \
        __builtin_amdgcn_global_load_lds((const unsigned*)((const char*)(gbase) + (voff)[_i]), (PG8_LAS unsigned*)(lds + (bufoff) + ldsw + _i * 8192), 16, 0, 0); } while (0)
#define PG8_LDA(dst, b, h) do { _Pragma("unroll") for (int m = 0; m < 4; ++m) _Pragma("unroll") for (int k = 0; k < 2; ++k) dst[m][k] = *(const PG8_LAS bf16x8*)(lds + PG8_SA(b, h) + aoff + m * 2048 + k * 1024); } while (0)
#define PG8_LDB(dst, b, h) do { _Pragma("unroll") for (int n = 0; n < 2; ++n) _Pragma("unroll") for (int k = 0; k < 2; ++k) dst[n][k] = *(const PG8_LAS bf16x8*)(lds + PG8_SB(b, h) + boff + n * 2048 + k * 1024); } while (0)
#define PG8_MMA(ai, bj, At, Bt) do { __builtin_amdgcn_s_setprio(1); _Pragma("unroll") for (int m = 0; m < 4; ++m) _Pragma("unroll") for (int n = 0; n < 2; ++n) _Pragma("unroll") for (int k = 0; k < 2; ++k) \
        acc[ai][bj][m][n] = __builtin_amdgcn_mfma_f32_16x16x32_bf16(Bt[n][k], At[m][k], acc[ai][bj][m][n], 0, 0, 0); __builtin_amdgcn_s_setprio(0); } while (0)
#define PG8_WAIT_V(n) asm volatile("s_waitcnt vmcnt(" #n ")" ::: "memory")
#define PG8_WAIT_L(n) asm volatile("s_waitcnt lgkmcnt(" #n ")" ::: "memory")
#define PG8_BAR __builtin_amdgcn_s_barrier()
#define PG8_SCHED __builtin_amdgcn_sched_barrier(0)
    Unit cur, nxt; int ui = 0;
    if (!S.next(0, cur)) return;
    f32x4 acc[2][2][4][2];
#pragma unroll
    for (int a = 0; a < 2; ++a)
#pragma unroll
        for (int b = 0; b < 2; ++b)
#pragma unroll
            for (int m = 0; m < 4; ++m)
#pragma unroll
                for (int n = 0; n < 2; ++n) acc[a][b][m][n] = (f32x4){0.f, 0.f, 0.f, 0.f};
    bf16x8 At[4][2], B0[2][2], B1[2][2];
    const char* cA = (const char*)g.A + (size_t)cur.pm * tstep; const char* cB = (const char*)g.Bt + (size_t)cur.pn * tstep;
    S.a_ready(cur);
    if constexpr (SP2) {
        PG8_STAGE(PG8_SB(0, 0), cB, voffB); PG8_STAGE(PG8_SB(0, 1), cB + hstep, voffB); PG8_STAGE(PG8_SA(0, 0), cA, voffA); PG8_STAGE(PG8_SA(0, 1), cA + hstep, voffA);
        if (wr == 1) PG8_BAR;
        PG8_WAIT_V(2); PG8_BAR;
        PG8_STAGE(PG8_SB(1, 0), cB + kstep, voffB); PG8_STAGE(PG8_SA(1, 0), cA + kstep, voffA); PG8_STAGE(PG8_SB(1, 1), cB + hstep + kstep, voffB);
        PG8_WAIT_V(6); PG8_BAR;
    } else {
        PG8_STAGE(PG8_SB(0, 0), cB, voffB); PG8_STAGE(PG8_SA(0, 0), cA, voffA); PG8_STAGE(PG8_SB(0, 1), cB + hstep, voffB); PG8_STAGE(PG8_SA(0, 1), cA + hstep, voffA);
        if (wr == 1) PG8_BAR;
        PG8_WAIT_V(4); PG8_BAR;
        PG8_STAGE(PG8_SB(1, 0), cB + kstep, voffB); PG8_STAGE(PG8_SA(1, 0), cA + kstep, voffA); PG8_STAGE(PG8_SB(1, 1), cB + hstep + kstep, voffB);
        PG8_WAIT_V(6); PG8_BAR;
    }
    for (;;) {
        const bool has_next = S.next(ui + 1, nxt);
        const char* nA = has_next ? (const char*)g.A + (size_t)nxt.pm * tstep : cA; const char* nB = has_next ? (const char*)g.Bt + (size_t)nxt.pn * tstep : cB;
        for (int t = 0; t < nt; t += 2) {
            const bool last = (t == nt - 2);
            const char* a1 = cA + (size_t)(t + 1) * kstep;
            const char* a2 = last ? nA : cA + (size_t)(t + 2) * kstep; const char* b2 = last ? nB : cB + (size_t)(t + 2) * kstep;
            const char* a3 = a2 + kstep; const char* b3 = b2 + kstep;
            if (last && has_next) S.a_ready(nxt);
            if constexpr (SP2) {
            PG8_LDB(B0, 0, 0); PG8_LDB(B1, 0, 1); PG8_SCHED; PG8_LDA(At, 0, 0); PG8_STAGE(PG8_SA(1, 1), a1 + hstep, voffA);
            PG8_WAIT_V(8); PG8_WAIT_L(0); PG8_BAR; PG8_MMA(0, 0, At, B0); PG8_MMA(0, 1, At, B1); PG8_BAR; PG8_SCHED;
            PG8_LDA(At, 0, 1); PG8_STAGE(PG8_SB(0, 0), b2, voffB); PG8_STAGE(PG8_SB(0, 1), b2 + hstep, voffB); PG8_STAGE(PG8_SA(0, 0), a2, voffA);
            PG8_WAIT_V(8); PG8_WAIT_L(0); PG8_BAR; PG8_MMA(1, 0, At, B0); PG8_MMA(1, 1, At, B1); PG8_BAR; PG8_SCHED;
            PG8_LDB(B0, 1, 0); PG8_LDB(B1, 1, 1); PG8_SCHED; PG8_LDA(At, 1, 0); PG8_STAGE(PG8_SA(0, 1), a2 + hstep, voffA);
            PG8_WAIT_V(8); PG8_WAIT_L(0); PG8_BAR; PG8_MMA(0, 0, At, B0); PG8_MMA(0, 1, At, B1); PG8_BAR; PG8_SCHED;
            PG8_LDA(At, 1, 1); PG8_STAGE(PG8_SB(1, 0), b3, voffB); PG8_STAGE(PG8_SB(1, 1), b3 + hstep, voffB); PG8_STAGE(PG8_SA(1, 0), a3, voffA);
            PG8_WAIT_V(8); PG8_WAIT_L(0); PG8_BAR; PG8_MMA(1, 0, At, B0); PG8_MMA(1, 1, At, B1); PG8_BAR; PG8_SCHED;
            } else {
            PG8_LDB(B0, 0, 0); PG8_SCHED; PG8_LDA(At, 0, 0); PG8_STAGE(PG8_SA(1, 1), a1 + hstep, voffA);
            PG8_WAIT_L(8); PG8_BAR; PG8_WAIT_L(0); PG8_MMA(0, 0, At, B0); PG8_BAR; PG8_SCHED;
            PG8_LDB(B1, 0, 1); PG8_STAGE(PG8_SB(0, 0), b2, voffB);
            PG8_BAR; PG8_WAIT_L(0); PG8_MMA(0, 1, At, B1); PG8_BAR;
            PG8_LDA(At, 0, 1); PG8_STAGE(PG8_SA(0, 0), a2, voffA);
            PG8_BAR; PG8_WAIT_L(0); PG8_MMA(1, 0, At, B0); PG8_BAR; PG8_SCHED;
            PG8_STAGE(PG8_SB(0, 1), b2 + hstep, voffB);
            PG8_WAIT_V(6); PG8_BAR; PG8_MMA(1, 1, At, B1); PG8_BAR;
            PG8_LDB(B0, 1, 0); PG8_SCHED; PG8_LDA(At, 1, 0); PG8_STAGE(PG8_SA(0, 1), a2 + hstep, voffA);
            PG8_WAIT_L(8); PG8_BAR; PG8_WAIT_L(0); PG8_MMA(0, 0, At, B0); PG8_BAR; PG8_SCHED;
            PG8_LDB(B1, 1, 1); PG8_STAGE(PG8_SB(1, 0), b3, voffB);
            PG8_BAR; PG8_WAIT_L(0); PG8_MMA(0, 1, At, B1); PG8_BAR;
            PG8_LDA(At, 1, 1); PG8_STAGE(PG8_SA(1, 0), a3, voffA);
            PG8_BAR; PG8_WAIT_L(0); PG8_MMA(1, 0, At, B0); PG8_BAR; PG8_SCHED;
            PG8_STAGE(PG8_SB(1, 1), b3 + hstep, voffB);
            PG8_WAIT_V(6); PG8_BAR; PG8_MMA(1, 1, At, B1); PG8_BAR;
            }
        }
        if constexpr (ALIGN_EPI) { if (wr == 0) PG8_BAR; }
        if constexpr (!Epi::AFTER_DRAIN) { E(acc, cur, wr, wc, fr, fq); S.done(cur); }
        if (!has_next) break;
#pragma unroll
        for (int a = 0; a < 2; ++a)
#pragma unroll
            for (int b = 0; b < 2; ++b)
#pragma unroll
                for (int m = 0; m < 4; ++m)
#pragma unroll
                    for (int n = 0; n < 2; ++n) acc[a][b][m][n] = (f32x4){0.f, 0.f, 0.f, 0.f};
        cur = nxt; cA = nA; cB = nB; ++ui;
        if constexpr (ALIGN_EPI) { if (wr == 1) PG8_BAR; }
    }
    PG8_WAIT_V(0);
    if constexpr (!ALIGN_EPI) { if (wr == 0) PG8_BAR; }
    PG8_BAR;
    if constexpr (Epi::AFTER_DRAIN) { E.fused(acc, cur, wr, wc, fr, fq, lds, wid, lane); S.done(cur); }
#undef PG8_SA
#undef PG8_SB
#undef PG8_STAGE
#undef PG8_LDA
#undef PG8_LDB
#undef PG8_MMA
#undef PG8_WAIT_V
#undef PG8_WAIT_L
#undef PG8_BAR
#undef PG8_SCHED
}
}
namespace mk {
using pg8::bf16_t; using pg8::f32x4; using pg8::u32x4; using pg8::bf16x8;
#define LAS __attribute__((address_space(3)))
constexpr int NB = 8, T = 2048, M = NB * T, D = 1024, DEPTH = 4, NMEM = 256, MM = NB * NMEM;
constexpr int NPROJ = 3584, IN_COLS = 3512, DFF = 2816, NUP = 2 * DFF;
constexpr float EPS = 1e-6f;
constexpr int P_MLQ = 0, P_MLK = 384, P_MLV = 768, P_MLO = 1152, P_NAQ = 1536, P_NAK = 1856, P_NAV = 2176, P_GQ = 2496, P_GK = 2656, P_GV = 2816, P_GG = 3136, P_MLG = 3456, P_GA = 3480;
constexpr int NTHREADS = 512, NWAVES = 8;
constexpr int LDS_BYTES = 160 * 1024;
constexpr size_t MiB = (size_t)1 << 20;
constexpr size_t WS_RS0 = 0, WS_RS1 = 1 * MiB, WS_RS2 = 2 * MiB, WS_RSM = 3 * MiB;
constexpr size_t WS_GATES = 4 * MiB;
constexpr size_t WS_MEMB = 8 * MiB;
constexpr size_t WS_MEMKV = 12 * MiB;
constexpr size_t WS_WIN = 20 * MiB, WS_WOUT = 27 * MiB, WS_WQ = 29 * MiB, WS_WO = 31 * MiB, WS_WUP = 33 * MiB, WS_WDN = 44 * MiB, WS_WKV = 50 * MiB;
constexpr size_t WS_HB = 54 * MiB;
constexpr size_t WS_BIG = 86 * MiB;
constexpr size_t WS_HSML = WS_BIG + 112 * MiB, WS_HSGL = WS_HSML + 24 * MiB;
constexpr size_t WS_ACT = 262 * MiB;
constexpr size_t WS_MIXED = WS_ACT, WS_Q = WS_ACT + 32 * MiB;
constexpr size_t WS_END = 350 * MiB;

__device__ __forceinline__ float bf2f(unsigned v) { return __uint_as_float(v << 16); }
__device__ __forceinline__ unsigned f2bf(float f) { const unsigned u = __float_as_uint(f); return (u + 0x7fffu + ((u >> 16) & 1u)) >> 16; }
__device__ __forceinline__ unsigned pk2(float lo, float hi) { return f2bf(lo) | (f2bf(hi) << 16); }
__device__ __forceinline__ unsigned cvt_pk_bf16(float lo, float hi) { unsigned r; asm volatile("v_cvt_pk_bf16_f32 %0, %1, %2" : "=v"(r) : "v"(lo), "v"(hi)); return r; }
__device__ __forceinline__ void unpack8(const u32x4 w, float (&o)[8]) {
    o[0] = bf2f(w.x & 0xffffu); o[1] = bf2f(w.x >> 16); o[2] = bf2f(w.y & 0xffffu); o[3] = bf2f(w.y >> 16);
    o[4] = bf2f(w.z & 0xffffu); o[5] = bf2f(w.z >> 16); o[6] = bf2f(w.w & 0xffffu); o[7] = bf2f(w.w >> 16);
}
__device__ __forceinline__ float wave_sum(float v) {
#pragma unroll
    for (int o = 1; o < 64; o <<= 1) v += __shfl_xor(v, o);
    return v;
}
__device__ __forceinline__ float sigmoidf_(float x) { return 1.f / (1.f + __expf(-x)); }

typedef const float* cfptr;
struct Ctx {
    float* out; unsigned char* ws;
    int G, bid, tid, lane, wave;
    __device__ __forceinline__ const float* in(int i) const {
        asm volatile("" : "+s"(i));
        const __attribute__((address_space(4))) cfptr* tbl = (const __attribute__((address_space(4))) cfptr*)__builtin_amdgcn_kernarg_segment_ptr();
        return tbl[i];
    }
    template <class Tp> __device__ __forceinline__ Tp* wsp(size_t off) const { unsigned o = (unsigned)off; asm volatile("" : "+s"(o)); return (Tp*)(ws + o); }
    __device__ __forceinline__ float* rs0() const { return wsp<float>(WS_RS0); }
    __device__ __forceinline__ float* rs1() const { return wsp<float>(WS_RS1); }
    __device__ __forceinline__ float* rs2() const { return wsp<float>(WS_RS2); }
    __device__ __forceinline__ float* rsm() const { return wsp<float>(WS_RSM); }
    __device__ __forceinline__ float* gates() const { return wsp<float>(WS_GATES); }
    __device__ __forceinline__ float* hsml() const { return wsp<float>(WS_HSML); }
    __device__ __forceinline__ float* hsgl() const { return wsp<float>(WS_HSGL); }
    __device__ __forceinline__ bf16_t* memb() const { return wsp<bf16_t>(WS_MEMB); }
    __device__ __forceinline__ bf16_t* memkv() const { return wsp<bf16_t>(WS_MEMKV); }
    __device__ __forceinline__ bf16_t* w_in() const { return wsp<bf16_t>(WS_WIN); }
    __device__ __forceinline__ bf16_t* w_out() const { return wsp<bf16_t>(WS_WOUT); }
    __device__ __forceinline__ bf16_t* wq() const { return wsp<bf16_t>(WS_WQ); }
    __device__ __forceinline__ bf16_t* wo() const { return wsp<bf16_t>(WS_WO); }
    __device__ __forceinline__ bf16_t* w_up() const { return wsp<bf16_t>(WS_WUP); }
    __device__ __forceinline__ bf16_t* w_dn() const { return wsp<bf16_t>(WS_WDN); }
    __device__ __forceinline__ bf16_t* wkv() const { return wsp<bf16_t>(WS_WKV); }
    __device__ __forceinline__ bf16_t* hb() const { return wsp<bf16_t>(WS_HB); }
    __device__ __forceinline__ bf16_t* proj() const { return wsp<bf16_t>(WS_BIG); }
    __device__ __forceinline__ bf16_t* u() const { return wsp<bf16_t>(WS_BIG); }
    __device__ __forceinline__ bf16_t* act() const { return wsp<bf16_t>(WS_ACT); }
    __device__ __forceinline__ bf16_t* mixed() const { return wsp<bf16_t>(WS_MIXED); }
    __device__ __forceinline__ bf16_t* q() const { return wsp<bf16_t>(WS_Q); }
};

#define LAUNDER_CTX(c0, c) Ctx c = (c0); { int t_ = c.tid; asm volatile("" : "+v"(t_)); c.tid = t_; c.lane = t_ & 63; c.wave = __builtin_amdgcn_readfirstlane(t_ >> 6); }

struct EpiScale {
    static constexpr bool PERM = true, AFTER_DRAIN = false;
    bf16_t* O; int ldc; const float* rowss; float* gates; int gate_pn;
    __device__ __forceinline__ void operator()(const f32x4 (&acc)[2][2][4][2], const pg8::Unit& u, int wr, int wc, int fr, int fq) const {
        const int row0 = u.pm * 256 + wr * 64 + fr, col0 = u.pn * 256 + wc * 32 + 8 * fq;
        const bool gt = (u.pn == gate_pn) && (wc < 2);
#pragma unroll
        for (int ai = 0; ai < 2; ++ai)
#pragma unroll
            for (int m = 0; m < 4; ++m) {
                const int row = row0 + ai * 128 + m * 16;
                float rs = 1.0f;
                if (rowss) { const f32x4* rp = (const f32x4*)(rowss + (size_t)row * 16); const f32x4 p0 = rp[0], p1 = rp[1], p2 = rp[2], p3 = rp[3];
                    const float ssum = (((p0[0] + p0[1]) + (p0[2] + p0[3])) + ((p1[0] + p1[1]) + (p1[2] + p1[3]))) + (((p2[0] + p2[1]) + (p2[2] + p2[3])) + ((p3[0] + p3[1]) + (p3[2] + p3[3])));
                    rs = 1.0f / sqrtf(ssum * (1.0f / D) + EPS); }
                bf16_t* rowp = O + (size_t)row * ldc + col0;
#pragma unroll
                for (int bj = 0; bj < 2; ++bj) {
                    const f32x4 v0 = acc[ai][bj][m][0] * rs, v1 = acc[ai][bj][m][1] * rs;
                    u32x4 w; w.x = cvt_pk_bf16(v0[0], v0[1]); w.y = cvt_pk_bf16(v0[2], v0[3]); w.z = cvt_pk_bf16(v1[0], v1[1]); w.w = cvt_pk_bf16(v1[2], v1[3]);
                    *(u32x4*)(rowp + bj * 128) = w;
                    if (bj == 1 && gt) { float* gp = gates + (size_t)row * 64 + wc * 32 + 8 * fq; *(f32x4*)gp = v0; *(f32x4*)(gp + 4) = v1; }
                }
            }
    }
};
struct EpiResid {
    static constexpr bool PERM = true, AFTER_DRAIN = false;
    const float* base; float* out; bf16_t* hb; float* rowss_out;
    __device__ __forceinline__ void operator()(const f32x4 (&acc)[2][2][4][2], const pg8::Unit& u, int wr, int wc, int fr, int fq) const {
        const int row0 = u.pm * 256 + wr * 64 + fr, col0 = u.pn * 256 + wc * 32 + 8 * fq;
#pragma unroll
        for (int ai = 0; ai < 2; ++ai)
#pragma unroll
            for (int m = 0; m < 4; ++m) {
                const int row = row0 + ai * 128 + m * 16; const size_t off = (size_t)row * D + col0; float ss = 0.f;
#pragma unroll
                for (int bj = 0; bj < 2; ++bj) {
                    const f32x4 v0 = acc[ai][bj][m][0] + *(const f32x4*)(base + off + bj * 128), v1 = acc[ai][bj][m][1] + *(const f32x4*)(base + off + bj * 128 + 4);
                    *(f32x4*)(out + off + bj * 128) = v0; *(f32x4*)(out + off + bj * 128 + 4) = v1;
                    u32x4 w; w.x = cvt_pk_bf16(v0[0], v0[1]); w.y = cvt_pk_bf16(v0[2], v0[3]); w.z = cvt_pk_bf16(v1[0], v1[1]); w.w = cvt_pk_bf16(v1[2], v1[3]);
                    *(u32x4*)(hb + off + bj * 128) = w;
                    ss += (v0[0] * v0[0] + v0[1] * v0[1]) + (v0[2] * v0[2] + v0[3] * v0[3]) + (v1[0] * v1[0] + v1[1] * v1[1]) + (v1[2] * v1[2] + v1[3] * v1[3]);
                }
                ss += __shfl_xor(ss, 16); ss += __shfl_xor(ss, 32);
                if (fq == 0) rowss_out[(size_t)row * 16 + u.pn * 4 + wc] = ss;
                asm volatile("" ::: "memory");
            }
    }
};

template <class Map>
__device__ __forceinline__ void cvt_item(const float* W, int K, int N, const float* gain, bf16_t* WT, LAS float* scr, int item, int lane, Map map) {
    const int nblk = (N + 31) / 32, kb = item / nblk, nb = item % nblk, k0 = 64 * kb, n0 = 32 * nb;
    const int nn = n0 + (lane & 31);
#pragma unroll 8
    for (int i = 0; i < 32; ++i) { const int kk = 2 * i + (lane >> 5); float w = (nn < N) ? W[(size_t)(k0 + kk) * N + nn] : 0.f; if (gain) w *= gain[k0 + kk]; scr[kk * 33 + (lane & 31)] = w; }
    asm volatile("s_waitcnt lgkmcnt(0)" ::: "memory");
    const int c = lane & 7;
#pragma unroll
    for (int j = 0; j < 4; ++j) { const int n = (lane >> 3) + 8 * j; const LAS float* s = scr + (8 * c) * 33 + n;
        u32x4 o; o.x = pk2(s[0 * 33], s[1 * 33]); o.y = pk2(s[2 * 33], s[3 * 33]); o.z = pk2(s[4 * 33], s[5 * 33]); o.w = pk2(s[6 * 33], s[7 * 33]);
        if (n0 + n < N) *(u32x4*)(WT + (size_t)map(n0 + n) * K + k0 + 8 * c) = o; }
    asm volatile("s_waitcnt lgkmcnt(0)" ::: "memory");
}
struct MapId { int off; __device__ __forceinline__ int operator()(int n) const { return n + off; } };
struct MapIn { __device__ __forceinline__ int operator()(int n) const { return n < 1536 ? n : (n < 1560 ? n + (P_MLG - 1536) : (n < 3480 ? n - 24 : n)); } };

__device__ __forceinline__ void convert_layer(const Ctx& c, int l, LAS unsigned char* lds) {
    LAS float* scr = (LAS float*)(lds + c.wave * 16384);
    const int gw = c.bid * NWAVES + c.wave, NGW = c.G * NWAVES;
    constexpr int I_IN = 16 * 110, I_SQ = 16 * 32, I_UP = 16 * 176, I_DN = 44 * 32;
    constexpr int NITEMS = I_IN + 5 * I_SQ + I_UP + I_DN;
    for (int it = gw; it < NITEMS; it += NGW) {
        int r = it;
        if (r < I_IN) { cvt_item(c.in(3) + (size_t)l * D * IN_COLS, D, IN_COLS, c.in(2) + l * D, c.w_in(), scr, r, c.lane, MapIn{}); continue; } r -= I_IN;
        if (r < I_SQ) { cvt_item(c.in(12) + (size_t)l * D * D, D, D, nullptr, c.w_out(), scr, r, c.lane, MapId{0}); continue; } r -= I_SQ;
        if (r < I_SQ) { cvt_item(c.in(15) + (size_t)l * D * D, D, D, c.in(13) + l * D, c.wq(), scr, r, c.lane, MapId{0}); continue; } r -= I_SQ;
        if (r < I_SQ) { cvt_item(c.in(16) + (size_t)l * D * D, D, D, c.in(14) + l * D, c.wkv(), scr, r, c.lane, MapId{0}); continue; } r -= I_SQ;
        if (r < I_SQ) { cvt_item(c.in(17) + (size_t)l * D * D, D, D, c.in(14) + l * D, c.wkv(), scr, r, c.lane, MapId{D}); continue; } r -= I_SQ;
        if (r < I_SQ) { cvt_item(c.in(18) + (size_t)l * D * D, D, D, nullptr, c.wo(), scr, r, c.lane, MapId{0}); continue; } r -= I_SQ;
        if (r < I_UP) { cvt_item(c.in(20) + (size_t)l * D * NUP, D, NUP, c.in(19) + l * D, c.w_up(), scr, r, c.lane, MapId{0}); continue; } r -= I_UP;
        cvt_item(c.in(23) + (size_t)l * DFF * D, DFF, D, nullptr, c.w_dn(), scr, r, c.lane, MapId{0});
    }
    const int gt = c.bid * NTHREADS + c.tid;
    for (int i = gt; i < (NPROJ - IN_COLS) * D / 8; i += c.G * NTHREADS) *(u32x4*)(c.w_in() + (size_t)IN_COLS * D + (size_t)i * 8) = (u32x4){0u, 0u, 0u, 0u};
}
__device__ __forceinline__ void rows_to_bf16(const Ctx& c, const float* X, bf16_t* Y, float* rss, int rows) {
    const int gw = c.bid * NWAVES + c.wave, NGW = c.G * NWAVES;
    for (int m = gw; m < rows; m += NGW) {
        const f32x4* xr = (const f32x4*)(X + (size_t)m * D) + c.lane; float s = 0.f;
        unsigned long long* o8 = (unsigned long long*)(Y + (size_t)m * D) + c.lane;
#pragma unroll
        for (int j = 0; j < 4; ++j) { const f32x4 v = xr[64 * j]; s += (v[0] * v[0] + v[1] * v[1]) + (v[2] * v[2] + v[3] * v[3]);
            o8[64 * j] = (unsigned long long)pk2(v[0], v[1]) | ((unsigned long long)pk2(v[2], v[3]) << 32); }
        s = wave_sum(s); if (c.lane < 16) rss[(size_t)m * 16 + c.lane] = (c.lane == 0) ? s : 0.f;
    }
}
__device__ __forceinline__ void final_norm(const Ctx& c) {
    const int gw = c.bid * NWAVES + c.wave, NGW = c.G * NWAVES; const float* g = c.in(24);
    for (int m = gw; m < M; m += NGW) {
        f32x4* xr = (f32x4*)(c.out + (size_t)m * D) + c.lane; f32x4 v[4]; float s = 0.f;
#pragma unroll
        for (int j = 0; j < 4; ++j) { v[j] = xr[64 * j]; s += (v[j][0] * v[j][0] + v[j][1] * v[j][1]) + (v[j][2] * v[j][2] + v[j][3] * v[j][3]); }
        const float r = 1.0f / sqrtf(wave_sum(s) * (1.0f / D) + EPS);
#pragma unroll
        for (int j = 0; j < 4; ++j) xr[64 * j] = v[j] * r * ((const f32x4*)g)[c.lane + 64 * j];
    }
}
__device__ __forceinline__ void ml_load_row(const bf16_t* projb, int t, int coff, float (&dst)[2][8]) {
    if (t < 0 || t >= T) {
#pragma unroll
        for (int j = 0; j < 8; ++j) { dst[0][j] = 0.f; dst[1][j] = 0.f; }
    } else {
        const u32x4 a = *(const u32x4*)(projb + (size_t)t * NPROJ + P_MLQ + coff), b = *(const u32x4*)(projb + (size_t)t * NPROJ + P_MLK + coff);
        unpack8(a, dst[0]); unpack8(b, dst[1]);
    }
}
__device__ __forceinline__ void ml_item(const Ctx& c0, int l, int item, LAS unsigned char* lds) {
    LAUNDER_CTX(c0, c);
    const int b = item / 6, h = item % 6, e = c.tid & 63, dg = c.tid >> 6;
    LAS float* rnum = (LAS float*)lds;
    LAS float* rden = (LAS float*)lds + 1024;
    const bf16_t* projb = c.proj() + (size_t)b * T * NPROJ;
    const float* gatesb = c.gates() + (size_t)b * T * 64;
    float* hs = c.hsml() + (size_t)b * T * 384 + h * 64;
    const float* cwp = c.in(4) + (size_t)l * 3 * 768; const float* cbp = c.in(5) + (size_t)l * 768;
    const float* gb = c.in(6) + l * 24; const float* ng = c.in(7) + l * 384;
    const int coff = h * 64 + dg * 8;
    float cw[2][8][4];
#pragma unroll
    for (int qk = 0; qk < 2; ++qk)
#pragma unroll
        for (int j = 0; j < 8; ++j) { const int ch = qk * 384 + coff + j; cw[qk][j][0] = cwp[ch]; cw[qk][j][1] = cwp[768 + ch]; cw[qk][j][2] = cwp[1536 + ch]; cw[qk][j][3] = cbp[ch]; }
    for (int dir = 0; dir < 2; ++dir) {
        float C[8], n[8];
#pragma unroll
        for (int j = 0; j < 8; ++j) { C[j] = 0.f; n[j] = 0.f; }
        const float bi = gb[(2 * dir) * 6 + h], bff = gb[(2 * dir + 1) * 6 + h];
        float lo[2][8], mid[2][8], hi[2][8];
        const int t0 = dir ? T - 1 : 0;
        ml_load_row(projb, t0 - 1, coff, lo); ml_load_row(projb, t0, coff, mid); ml_load_row(projb, t0 + 1, coff, hi);
        for (int s = 0; s < T; ++s) {
            const int t = dir ? T - 1 - s : s;
            const float ip = gatesb[(size_t)t * 64 + (2 * dir) * 6 + h] + bi, fp = gatesb[(size_t)t * 64 + (2 * dir + 1) * 6 + h] + bff;
            const float f = sigmoidf_(fp), ig = __expf(ip);
            const float v = bf2f(projb[(size_t)t * NPROJ + P_MLV + h * 64 + e]);
            float pn = 0.f, pd = 0.f;
#pragma unroll
            for (int j = 0; j < 8; ++j) {
                float yq = lo[0][j] * cw[0][j][0] + mid[0][j] * cw[0][j][1] + hi[0][j] * cw[0][j][2] + cw[0][j][3];
                float yk = lo[1][j] * cw[1][j][0] + mid[1][j] * cw[1][j][1] + hi[1][j] * cw[1][j][2] + cw[1][j][3];
                const float qd = yq * sigmoidf_(yq), kd = yk * sigmoidf_(yk) * 0.125f;
                C[j] = f * C[j] + ig * kd * v; n[j] = f * n[j] + ig * kd; pn += C[j] * qd; pd += n[j] * qd;
            }
            const int p = s & 1;
            rnum[(p * 8 + dg) * 64 + e] = pn; if (e == 0) rden[p * 8 + dg] = pd;
            __syncthreads();
            if (dg == 0) {
                float num = 0.f, den = 0.f;
#pragma unroll
                for (int g = 0; g < 8; ++g) { num += rnum[(p * 8 + g) * 64 + e]; den += rden[p * 8 + g]; }
                const float hv = num / fmaxf(fabsf(den), 1.f);
                if (dir == 0) hs[(size_t)t * 384 + e] = hv;
                else { const float tot = hs[(size_t)t * 384 + e] + hv; const float ss = wave_sum(tot * tot);
                    const float r = 1.0f / sqrtf(ss * (1.0f / 64) + EPS); const float og = bf2f(projb[(size_t)t * NPROJ + P_MLO + h * 64 + e]);
                    c.mixed()[((size_t)b * T + t) * D + h * 64 + e] = (bf16_t)f2bf(tot * r * ng[h * 64 + e] * sigmoidf_(og)); }
            }
            if (dir == 0) {
#pragma unroll
                for (int j = 0; j < 8; ++j) { lo[0][j] = mid[0][j]; lo[1][j] = mid[1][j]; mid[0][j] = hi[0][j]; mid[1][j] = hi[1][j]; }
                ml_load_row(projb, t + 2, coff, hi);
            } else {
#pragma unroll
                for (int j = 0; j < 8; ++j) { hi[0][j] = mid[0][j]; hi[1][j] = mid[1][j]; mid[0][j] = lo[0][j]; mid[1][j] = lo[1][j]; }
                ml_load_row(projb, t - 2, coff, lo);
            }
        }
        __syncthreads();
    }
}
__device__ __forceinline__ void gla_item(const Ctx& c0, int l, int item, LAS unsigned char* lds) {
    LAUNDER_CTX(c0, c);
    const int b = item / 5, h = item % 5, e = c.tid & 63, kg = c.tid >> 6;
    LAS float* rnum = (LAS float*)lds;
    const bf16_t* projb = c.proj() + (size_t)b * T * NPROJ;
    const float* gatesb = c.gates() + (size_t)b * T * 64;
    float* gs = c.hsgl() + (size_t)b * T * 320 + h * 64;
    const float* ng = c.in(11) + l * 320;
    const int doff = h * 32 + kg * 4;
    for (int dir = 0; dir < 2; ++dir) {
        const float* w2 = c.in(9) + ((size_t)l * 2 + dir) * 16 * 160; const float* ab = c.in(10) + ((size_t)l * 2 + dir) * 160;
        float w2r[16][4], abv[4], S[4];
#pragma unroll
        for (int j = 0; j < 4; ++j) { abv[j] = ab[doff + j]; S[j] = 0.f;
#pragma unroll
            for (int r = 0; r < 16; ++r) w2r[r][j] = w2[r * 160 + doff + j]; }
        for (int s = 0; s < T; ++s) {
            const int t = dir ? T - 1 - s : s;
            const float* gp = gatesb + (size_t)t * 64 + 24 + dir * 16;
            float ga[16];
#pragma unroll
            for (int r4 = 0; r4 < 4; ++r4) { const f32x4 x = *(const f32x4*)(gp + 4 * r4); ga[4 * r4] = x[0]; ga[4 * r4 + 1] = x[1]; ga[4 * r4 + 2] = x[2]; ga[4 * r4 + 3] = x[3]; }
            const unsigned long long qw = *(const unsigned long long*)(projb + (size_t)t * NPROJ + P_GQ + doff), kw = *(const unsigned long long*)(projb + (size_t)t * NPROJ + P_GK + doff);
            const float v = bf2f(projb[(size_t)t * NPROJ + P_GV + h * 64 + e]);
            float pn = 0.f;
#pragma unroll
            for (int j = 0; j < 4; ++j) {
                float z = abv[j];
#pragma unroll
                for (int r = 0; r < 16; ++r) z += ga[r] * w2r[r][j];
                const float la = (fminf(z, 0.f) - log1pf(__expf(-fabsf(z)))) * (1.0f / 16.0f);
                const float a = __expf(la);
                const float qd = bf2f((unsigned)(qw >> (16 * j)) & 0xffffu), kd = bf2f((unsigned)(kw >> (16 * j)) & 0xffffu);
                S[j] = a * S[j] + kd * v; pn += S[j] * qd;
            }
            const int p = s & 1;
            rnum[(p * 8 + kg) * 64 + e] = pn * 0.17677669529663687f;
            __syncthreads();
            if (kg == 0) {
                float o = 0.f;
#pragma unroll
                for (int g = 0; g < 8; ++g) o += rnum[(p * 8 + g) * 64 + e];
                if (dir == 0) gs[(size_t)t * 320 + e] = o;
                else { const float tot = gs[(size_t)t * 320 + e] + o; const float ss = wave_sum(tot * tot);
                    const float r = 1.0f / sqrtf(ss * (1.0f / 64) + EPS); const float gg = bf2f(projb[(size_t)t * NPROJ + P_GG + h * 64 + e]);
                    c.mixed()[((size_t)b * T + t) * D + 704 + h * 64 + e] = (bf16_t)f2bf(tot * r * ng[h * 64 + e] * gg * sigmoidf_(gg)); }
            }
        }
        __syncthreads();
    }
}
__device__ __forceinline__ void na_item(const Ctx& c0, int l, int item, LAS unsigned char* lds) {
    LAUNDER_CTX(c0, c);
    const int b = item / 160, h = (item % 160) / 32, r = item % 32;
    const int q = c.tid >> 3, s = c.tid & 7;
    LAS float* sc = (LAS float*)lds;
    const bf16_t* projb = c.proj() + (size_t)b * T * NPROJ;
    const float* rpb = c.in(8) + ((size_t)l * 5 + h) * 15 * 31;
    const int rs = min(max(r - 4, 0), 24), cs = min(max(q - 8, 0), 48);
    float qv[64];
    { const bf16_t* qp = projb + (size_t)(r * 64 + q) * NPROJ + P_NAQ + h * 64;
#pragma unroll
      for (int i = 0; i < 8; ++i) { float t8[8]; unpack8(*(const u32x4*)(qp + 8 * i), t8);
#pragma unroll
          for (int j = 0; j < 8; ++j) qv[8 * i + j] = t8[j]; } }
    const int tr = rs + s;
    for (int kk = 0; kk < 16; ++kk) { const int tc = cs + kk;
        const bf16_t* kp = projb + (size_t)(tr * 64 + tc) * NPROJ + P_NAK + h * 64; float d = 0.f;
#pragma unroll
        for (int i = 0; i < 8; ++i) { float t8[8]; unpack8(*(const u32x4*)(kp + 8 * i), t8);
#pragma unroll
            for (int j = 0; j < 8; ++j) d += qv[8 * i + j] * t8[j]; }
        const int dr = tr - r + 7, dc = min(max(tc - q, -15), 15) + 15;
        sc[q * 129 + s * 16 + kk] = d * 0.125f + rpb[dr * 31 + dc]; }
    __syncthreads();
    float mx = -3.0e38f; for (int k = 0; k < 128; ++k) mx = fmaxf(mx, sc[q * 129 + k]);
    float sum = 0.f; for (int k = 0; k < 128; ++k) sum += __expf(sc[q * 129 + k] - mx);
    __syncthreads();
    const float inv = 1.0f / sum;
    for (int kk = 0; kk < 16; ++kk) sc[q * 129 + s * 16 + kk] = __expf(sc[q * 129 + s * 16 + kk] - mx) * inv;
    __syncthreads();
    float o[8];
#pragma unroll
    for (int j = 0; j < 8; ++j) o[j] = 0.f;
    for (int key = 0; key < 128; ++key) { const int trr = rs + (key >> 4), tcc = cs + (key & 15);
        float t8[8]; unpack8(*(const u32x4*)(projb + (size_t)(trr * 64 + tcc) * NPROJ + P_NAV + h * 64 + s * 8), t8); const float p = sc[q * 129 + key];
#pragma unroll
        for (int j = 0; j < 8; ++j) o[j] += p * t8[j]; }
    u32x4 w; w.x = pk2(o[0], o[1]); w.y = pk2(o[2], o[3]); w.z = pk2(o[4], o[5]); w.w = pk2(o[6], o[7]);
    *(u32x4*)(c.mixed() + ((size_t)b * T + r * 64 + q) * D + 384 + h * 64 + s * 8) = w;
    __syncthreads();
}
__device__ __forceinline__ void xattn_item(const Ctx& c0, int item, LAS unsigned char* lds) {
    LAUNDER_CTX(c0, c);
    const int b = item / 256, hd = (item / 64) % 4, qt = item % 64; const int row0 = b * T + qt * 32;
    LAS float* qs = (LAS float*)lds;
    LAS float* ps = (LAS float*)lds + 8192;
    const int qi = c.tid >> 4, sub = c.tid & 15;
    { const bf16_t* qp = c.q() + (size_t)(row0 + qi) * D + hd * 256 + sub * 16; float t8[8];
      unpack8(*(const u32x4*)qp, t8);
#pragma unroll
      for (int j = 0; j < 8; ++j) qs[qi * 256 + sub * 16 + j] = t8[j];
      unpack8(*(const u32x4*)(qp + 8), t8);
#pragma unroll
      for (int j = 0; j < 8; ++j) qs[qi * 256 + sub * 16 + 8 + j] = t8[j]; }
    __syncthreads();
    const bf16_t* kvb = c.memkv() + (size_t)b * NMEM * 2048 + hd * 256;
    float acc[16];
#pragma unroll
    for (int j = 0; j < 16; ++j) acc[j] = 0.f;
    for (int dc = 0; dc < 32; ++dc) {
        float qr[8];
#pragma unroll
        for (int i = 0; i < 8; ++i) qr[i] = qs[qi * 256 + dc * 8 + i];
#pragma unroll
        for (int j = 0; j < 16; ++j) { float t8[8]; unpack8(*(const u32x4*)(kvb + (size_t)(sub + 16 * j) * 2048 + dc * 8), t8);
#pragma unroll
            for (int i = 0; i < 8; ++i) acc[j] += qr[i] * t8[i]; }
    }
    float mx = -3.0e38f;
#pragma unroll
    for (int j = 0; j < 16; ++j) { acc[j] *= 0.0625f; mx = fmaxf(mx, acc[j]); }
#pragma unroll
    for (int o = 1; o < 16; o <<= 1) mx = fmaxf(mx, __shfl_xor(mx, o));
    float sum = 0.f;
#pragma unroll
    for (int j = 0; j < 16; ++j) { acc[j] = __expf(acc[j] - mx); sum += acc[j]; }
#pragma unroll
    for (int o = 1; o < 16; o <<= 1) sum += __shfl_xor(sum, o);
    const float inv = 1.0f / sum;
#pragma unroll
    for (int j = 0; j < 16; ++j) ps[qi * 256 + sub + 16 * j] = acc[j] * inv;
    __syncthreads();
    float o[16];
#pragma unroll
    for (int j = 0; j < 16; ++j) o[j] = 0.f;
    for (int key = 0; key < 256; ++key) { const float p = ps[qi * 256 + key]; const bf16_t* vp = kvb + (size_t)key * 2048 + 1024 + sub * 16; float t8[8];
        unpack8(*(const u32x4*)vp, t8);
#pragma unroll
        for (int j = 0; j < 8; ++j) o[j] += p * t8[j];
        unpack8(*(const u32x4*)(vp + 8), t8);
#pragma unroll
        for (int j = 0; j < 8; ++j) o[8 + j] += p * t8[j]; }
    bf16_t* op = c.mixed() + (size_t)(row0 + qi) * D + hd * 256 + sub * 16;
    u32x4 w; w.x = pk2(o[0], o[1]); w.y = pk2(o[2], o[3]); w.z = pk2(o[4], o[5]); w.w = pk2(o[6], o[7]); *(u32x4*)op = w;
    w.x = pk2(o[8], o[9]); w.y = pk2(o[10], o[11]); w.z = pk2(o[12], o[13]); w.w = pk2(o[14], o[15]); *(u32x4*)(op + 8) = w;
    __syncthreads();
}
__device__ __forceinline__ void act_pass(const Ctx& c, int l) {
    const float* cw = c.in(21) + (size_t)l * 3 * DFF; const float* cb = c.in(22) + (size_t)l * DFF;
    constexpr int CH = DFF / 8;
    for (int idx = c.bid * NTHREADS + c.tid; idx < M * CH; idx += c.G * NTHREADS) {
        const int row = idx / CH, c8 = (idx % CH) * 8, t = row % T;
        const bf16_t* up = c.u() + (size_t)row * NUP + c8;
        float a0[8], am[8], ap[8], g[8];
        unpack8(*(const u32x4*)up, a0); unpack8(*(const u32x4*)(up + DFF), g);
        if (t > 0) unpack8(*(const u32x4*)(up - NUP), am); else {
#pragma unroll
            for (int j = 0; j < 8; ++j) am[j] = 0.f; }
        if (t < T - 1) unpack8(*(const u32x4*)(up + NUP), ap); else {
#pragma unroll
            for (int j = 0; j < 8; ++j) ap[j] = 0.f; }
        float o[8];
#pragma unroll
        for (int j = 0; j < 8; ++j) { const float a = am[j] * cw[c8 + j] + a0[j] * cw[DFF + c8 + j] + ap[j] * cw[2 * DFF + c8 + j] + cb[c8 + j];
            const float uu = 0.7978845608028654f * (a + 0.044715f * a * a * a);
            o[j] = a / (1.f + __expf(-2.f * uu)) * g[j]; }
        u32x4 w; w.x = pk2(o[0], o[1]); w.y = pk2(o[2], o[3]); w.z = pk2(o[4], o[5]); w.w = pk2(o[6], o[7]);
        *(u32x4*)(c.act() + (size_t)row * DFF + c8) = w;
    }
}
typedef short s16x4 __attribute__((ext_vector_type(4)));
#define MFMA16(a, b, c) __builtin_amdgcn_mfma_f32_16x16x32_bf16((a), (b), (c), 0, 0, 0)
__device__ __forceinline__ bf16x8 frag_nt(LAS const unsigned char* tile, int pitch, int row, int kbyte) {
    return *(const LAS bf16x8*)(tile + row * pitch + kbyte);
}
__device__ __forceinline__ bf16x8 frag_tr(LAS const unsigned char* tile, int pitch, int r0, int r1, int n0, int lane) {
    const int q4 = (lane & 15) >> 2, p4 = lane & 3;
    const unsigned a0 = (unsigned)(size_t)tile + (unsigned)((r0 + q4) * pitch + (n0 + 4 * p4) * 2), a1 = (unsigned)(size_t)tile + (unsigned)((r1 + q4) * pitch + (n0 + 4 * p4) * 2);
    s16x4 x, y;
    asm volatile("ds_read_b64_tr_b16 %0, %2\n\tds_read_b64_tr_b16 %1, %3\n\ts_waitcnt lgkmcnt(0)" : "=&v"(x), "=&v"(y) : "v"(a0), "v"(a1) : "memory");
    return (bf16x8){x[0], x[1], x[2], x[3], y[0], y[1], y[2], y[3]};
}
__device__ __forceinline__ bf16x8 pack_frag(const f32x4 lo, const f32x4 hi) {
    u32x4 w; w.x = cvt_pk_bf16(lo[0], lo[1]); w.y = cvt_pk_bf16(lo[2], lo[3]); w.z = cvt_pk_bf16(hi[0], hi[1]); w.w = cvt_pk_bf16(hi[2], hi[3]);
    return __builtin_bit_cast(bf16x8, w);
}
__device__ __forceinline__ float logsigmoidf_(float x) { return fminf(x, 0.f) - log1pf(__expf(-fabsf(x))); }
__device__ __forceinline__ float wave_incl_scan(float v, int lane) {
#pragma unroll
    for (int o = 1; o < 64; o <<= 1) { const float t = __shfl_up(v, o); if (lane >= o) v += t; }
    return v;
}
constexpr int P64 = 144;

__device__ __forceinline__ bf16_t* mlc_ptr(const Ctx& c, int b, int h, int dir, int ch) { return c.wsp<bf16_t>(WS_HSML) + (size_t)((((b * 6 + h) * 2 + dir) * 16) + ch) * 80 * 64; }

template <bool ROWW>
__device__ __forceinline__ void ml_stage_conv(const Ctx& c, const bf16_t* projb, int t0, int pcol, const float* cwp, const float* cbp, int cch, float scale, const LAS float* roww, LAS unsigned char* tile) {
    const int j = c.tid >> 2, cb = (c.tid & 3) * 16, t = t0 + j;
    float lo[16], mid[16], hi[16];
    { const bf16_t* p = projb + (size_t)t * NPROJ + pcol + cb; float t8[8];
      unpack8(*(const u32x4*)p, t8);
#pragma unroll
      for (int x = 0; x < 8; ++x) mid[x] = t8[x];
      unpack8(*(const u32x4*)(p + 8), t8);
#pragma unroll
      for (int x = 0; x < 8; ++x) mid[8 + x] = t8[x];
      if (t > 0) { unpack8(*(const u32x4*)(p - NPROJ), t8);
#pragma unroll
          for (int x = 0; x < 8; ++x) lo[x] = t8[x];
          unpack8(*(const u32x4*)(p - NPROJ + 8), t8);
#pragma unroll
          for (int x = 0; x < 8; ++x) lo[8 + x] = t8[x]; }
      else {
#pragma unroll
          for (int x = 0; x < 16; ++x) lo[x] = 0.f; }
      if (t < T - 1) { unpack8(*(const u32x4*)(p + NPROJ), t8);
#pragma unroll
          for (int x = 0; x < 8; ++x) hi[x] = t8[x];
          unpack8(*(const u32x4*)(p + NPROJ + 8), t8);
#pragma unroll
          for (int x = 0; x < 8; ++x) hi[8 + x] = t8[x]; }
      else {
#pragma unroll
          for (int x = 0; x < 16; ++x) hi[x] = 0.f; } }
    const float rw = ROWW ? roww[j] * scale : scale;
    float o[16];
#pragma unroll
    for (int x = 0; x < 16; ++x) { const int ch = cch + cb + x;
        const float y = lo[x] * cwp[ch] + mid[x] * cwp[768 + ch] + hi[x] * cwp[1536 + ch] + cbp[ch];
        o[x] = y * sigmoidf_(y) * rw; }
    u32x4 w0, w1; w0.x = pk2(o[0], o[1]); w0.y = pk2(o[2], o[3]); w0.z = pk2(o[4], o[5]); w0.w = pk2(o[6], o[7]);
    w1.x = pk2(o[8], o[9]); w1.y = pk2(o[10], o[11]); w1.z = pk2(o[12], o[13]); w1.w = pk2(o[14], o[15]);
    *(LAS u32x4*)(tile + j * P64 + cb * 2) = w0; *(LAS u32x4*)(tile + j * P64 + cb * 2 + 16) = w1;
}
__device__ __forceinline__ void ml_stage_plain(const Ctx& c, const bf16_t* projb, int t0, int pcol, LAS unsigned char* tile) {
    const int j = c.tid >> 2, cb = (c.tid & 3) * 16; const bf16_t* p = projb + (size_t)(t0 + j) * NPROJ + pcol + cb;
    *(LAS u32x4*)(tile + j * P64 + cb * 2) = *(const u32x4*)p; *(LAS u32x4*)(tile + j * P64 + cb * 2 + 16) = *(const u32x4*)(p + 8);
}
__device__ __forceinline__ float ml_gate_scan(const float* gatesb, int t0, int dir, int h, float bi, float bf_, LAS float* bcum, LAS float* ii, int lane) {
    const float* g0 = gatesb + (size_t)(t0 + 2 * lane) * 64; const float* g1 = g0 + 64;
    const float i0 = g0[(2 * dir) * 6 + h] + bi, i1 = g1[(2 * dir) * 6 + h] + bi;
    const float f0 = logsigmoidf_(g0[(2 * dir + 1) * 6 + h] + bf_), f1 = logsigmoidf_(g1[(2 * dir + 1) * 6 + h] + bf_);
    const float inc = wave_incl_scan(f0 + f1, lane), tot = __shfl(inc, 63);
    float b0, b1;
    if (dir == 0) { b0 = inc - f1; b1 = inc; } else { b1 = tot - inc + f1; b0 = b1 + f0; }
    bcum[2 * lane] = b0; bcum[2 * lane + 1] = b1; ii[2 * lane] = i0; ii[2 * lane + 1] = i1;
    return tot;
}

__device__ __forceinline__ void ml_state_item(const Ctx& c0, int l, int item, LAS unsigned char* lds) {
    LAUNDER_CTX(c0, c);
    const int b = item / 12, h = (item % 12) >> 1, dir = item & 1;
    const int lane = c.lane, w = c.wave, i = lane & 15, g = lane >> 4;
    LAS unsigned char* Kw = lds;
    LAS unsigned char* Vt = lds + 128 * P64;
    LAS float* wj = (LAS float*)(lds + 2 * 128 * P64);
    LAS float* bcum = wj + 128; LAS float* iiv = wj + 256; LAS float* nst = wj + 384; LAS float* misc = wj + 448;
    const bf16_t* projb = c.proj() + (size_t)b * T * NPROJ; const float* gatesb = c.gates() + (size_t)b * T * 64;
    const float* cwp = c.in(4) + (size_t)l * 3 * 768; const float* cbp = c.in(5) + (size_t)l * 768; const float* gb = c.in(6) + l * 24;
    const float bi = gb[(2 * dir) * 6 + h], bf_ = gb[(2 * dir + 1) * 6 + h];
    const int td = w >> 1, te0 = (w & 1) * 2;
    f32x4 acc[2] = {{0.f, 0.f, 0.f, 0.f}, {0.f, 0.f, 0.f, 0.f}};
    if (c.tid < 64) nst[c.tid] = 0.f;
    __syncthreads();
    for (int cc = 0; cc < 16; ++cc) {
        const int ch = dir ? 15 - cc : cc, t0 = ch * 128;
        bf16_t* st = mlc_ptr(c, b, h, dir, ch);
#pragma unroll
        for (int x = 0; x < 2; ++x) { const int e = 16 * (te0 + x) + i, d = 16 * td + 4 * g;
            *(unsigned long long*)(st + e * 64 + d) = (unsigned long long)cvt_pk_bf16(acc[x][0], acc[x][1]) | ((unsigned long long)cvt_pk_bf16(acc[x][2], acc[x][3]) << 32); }
        if (c.tid < 64) st[64 * 64 + c.tid] = (bf16_t)f2bf(nst[c.tid]);
        for (int x = c.tid; x < 15 * 64 / 8; x += NTHREADS) *(u32x4*)(st + 65 * 64 + x * 8) = (u32x4){0u, 0u, 0u, 0u};
        if (cc == 15) break;
        if (w == 0) { const float tot = ml_gate_scan(gatesb, t0, dir, h, bi, bf_, bcum, iiv, lane);
            wj[2 * lane] = __expf(tot - bcum[2 * lane] + iiv[2 * lane]); wj[2 * lane + 1] = __expf(tot - bcum[2 * lane + 1] + iiv[2 * lane + 1]);
            if (lane == 0) misc[0] = __expf(tot); }
        __syncthreads();
        ml_stage_conv<true>(c, projb, t0, P_MLK + h * 64, cwp, cbp, 384 + h * 64, 0.125f, wj, Kw);
        ml_stage_plain(c, projb, t0, P_MLV + h * 64, Vt);
        __syncthreads();
        const float eg = misc[0];
        acc[0] = acc[0] * eg; acc[1] = acc[1] * eg;
#pragma unroll
        for (int s = 0; s < 4; ++s) { const int r0 = 32 * s + 8 * g, r1 = r0 + 4;
            const bf16x8 a = frag_tr(Kw, P64, r0, r1, 16 * td, lane);
#pragma unroll
            for (int x = 0; x < 2; ++x) { const bf16x8 bb = frag_tr(Vt, P64, r0, r1, 16 * (te0 + x), lane); acc[x] = MFMA16(a, bb, acc[x]); } }
        if (c.tid < 64) { float s = 0.f; for (int j = 0; j < 128; ++j) s += bf2f(*(const LAS unsigned short*)(Kw + j * P64 + c.tid * 2)); nst[c.tid] = eg * nst[c.tid] + s; }
        __syncthreads();
    }
}

__device__ __forceinline__ void ml_out_item(const Ctx& c0, int l, int item, LAS unsigned char* lds) {
    LAUNDER_CTX(c0, c);
    const int b = item / 96, h = (item % 96) / 16, ch = item % 16, t0 = ch * 128;
    const int lane = c.lane, w = c.wave, i = lane & 15, g = lane >> 4;
    LAS unsigned char* Qt = lds; LAS unsigned char* Kt = lds + 128 * P64; LAS unsigned char* Vt = lds + 2 * 128 * P64;
    LAS unsigned char* Cf = lds + 3 * 128 * P64; LAS unsigned char* Cb = Cf + 80 * P64;
    LAS float* bF = (LAS float*)(Cb + 80 * P64); LAS float* iF = bF + 128; LAS float* bB = bF + 256; LAS float* iB = bF + 384;
    const bf16_t* projb = c.proj() + (size_t)b * T * NPROJ; const float* gatesb = c.gates() + (size_t)b * T * 64;
    const float* cwp = c.in(4) + (size_t)l * 3 * 768; const float* cbp = c.in(5) + (size_t)l * 768; const float* gb = c.in(6) + l * 24;
    if (w == 0) (void)ml_gate_scan(gatesb, t0, 0, h, gb[0 * 6 + h], gb[1 * 6 + h], bF, iF, lane);
    if (w == 1) (void)ml_gate_scan(gatesb, t0, 1, h, gb[2 * 6 + h], gb[3 * 6 + h], bB, iB, lane);
    ml_stage_conv<false>(c, projb, t0, P_MLQ + h * 64, cwp, cbp, h * 64, 1.0f, nullptr, Qt);
    ml_stage_conv<false>(c, projb, t0, P_MLK + h * 64, cwp, cbp, 384 + h * 64, 0.125f, nullptr, Kt);
    ml_stage_plain(c, projb, t0, P_MLV + h * 64, Vt);
    { const bf16_t* sf = mlc_ptr(c, b, h, 0, ch); const bf16_t* sb = mlc_ptr(c, b, h, 1, ch);
      for (int x = c.tid; x < 80 * 8; x += NTHREADS) { const int r = x >> 3, k8 = x & 7;
          *(LAS u32x4*)(Cf + r * P64 + k8 * 16) = *(const u32x4*)(sf + r * 64 + k8 * 8); *(LAS u32x4*)(Cb + r * P64 + k8 * 16) = *(const u32x4*)(sb + r * 64 + k8 * 8); } }
    __syncthreads();
    const int ti = w, qi = 16 * ti + i;
    const bf16x8 q0 = frag_nt(Qt, P64, qi, 16 * g), q1 = frag_nt(Qt, P64, qi, 64 + 16 * g);
    const float bFq = bF[qi], bBq = bB[qi];
    f32x4 of[4], ob[4];
#pragma unroll
    for (int x = 0; x < 4; ++x) { of[x] = (f32x4){0.f, 0.f, 0.f, 0.f}; ob[x] = (f32x4){0.f, 0.f, 0.f, 0.f}; }
    float denf = 0.f, denb = 0.f;
#pragma unroll
    for (int s4 = 0; s4 < 4; ++s4) {
        const bool dof = (2 * s4 <= ti), dob = (2 * s4 + 1 >= ti);
        f32x4 pf[2], pb[2];
#pragma unroll
        for (int x = 0; x < 2; ++x) { const int tj = 2 * s4 + x;
            f32x4 s = (f32x4){0.f, 0.f, 0.f, 0.f};
            s = MFMA16(frag_nt(Kt, P64, 16 * tj + i, 16 * g), q0, s); s = MFMA16(frag_nt(Kt, P64, 16 * tj + i, 64 + 16 * g), q1, s);
#pragma unroll
            for (int r = 0; r < 4; ++r) { const int j = 16 * tj + 4 * g + r;
                const float wf = (j <= qi) ? __expf(bFq - bF[j] + iF[j]) : 0.f, wb = (j >= qi) ? __expf(bBq - bB[j] + iB[j]) : 0.f;
                pf[x][r] = s[r] * wf; pb[x][r] = s[r] * wb; denf += pf[x][r]; denb += pb[x][r]; } }
        const int r0 = 32 * s4 + 4 * g, r1 = r0 + 16;
        if (dof) { const bf16x8 p = pack_frag(pf[0], pf[1]);
#pragma unroll
            for (int te = 0; te < 4; ++te) of[te] = MFMA16(frag_tr(Vt, P64, r0, r1, 16 * te, lane), p, of[te]); }
        if (dob) { const bf16x8 p = pack_frag(pb[0], pb[1]);
#pragma unroll
            for (int te = 0; te < 4; ++te) ob[te] = MFMA16(frag_tr(Vt, P64, r0, r1, 16 * te, lane), p, ob[te]); }
    }
    denf += __shfl_xor(denf, 16); denf += __shfl_xor(denf, 32); denb += __shfl_xor(denb, 16); denb += __shfl_xor(denb, 32);
    { const float ef = __expf(bFq), eb = __expf(bBq);
#pragma unroll
      for (int te = 0; te < 5; ++te) {
          f32x4 tf = (f32x4){0.f, 0.f, 0.f, 0.f}, tb = (f32x4){0.f, 0.f, 0.f, 0.f};
          tf = MFMA16(frag_nt(Cf, P64, 16 * te + i, 16 * g), q0, tf); tf = MFMA16(frag_nt(Cf, P64, 16 * te + i, 64 + 16 * g), q1, tf);
          tb = MFMA16(frag_nt(Cb, P64, 16 * te + i, 16 * g), q0, tb); tb = MFMA16(frag_nt(Cb, P64, 16 * te + i, 64 + 16 * g), q1, tb);
          if (te < 4) { of[te] = of[te] + tf * ef; ob[te] = ob[te] + tb * eb; }
          else { denf += ef * __shfl(tf[0], i); denb += eb * __shfl(tb[0], i); } } }
    const float rf = 1.0f / fmaxf(fabsf(denf), 1.f), rb = 1.0f / fmaxf(fabsf(denb), 1.f);
    float ss = 0.f;
#pragma unroll
    for (int te = 0; te < 4; ++te) { of[te] = of[te] * rf + ob[te] * rb; ss += (of[te][0] * of[te][0] + of[te][1] * of[te][1]) + (of[te][2] * of[te][2] + of[te][3] * of[te][3]); }
    ss += __shfl_xor(ss, 16); ss += __shfl_xor(ss, 32);
    const float rn = 1.0f / sqrtf(ss * (1.0f / 64) + EPS);
    const float* ng = c.in(7) + l * 384 + h * 64;
    const size_t row = (size_t)b * T + t0 + qi;
#pragma unroll
    for (int te = 0; te < 4; ++te) { const int e = 16 * te + 4 * g;
        const unsigned long long ow = *(const unsigned long long*)(projb + (size_t)(t0 + qi) * NPROJ + P_MLO + h * 64 + e);
        float o4[4];
#pragma unroll
        for (int r = 0; r < 4; ++r) { const float og = bf2f((unsigned)(ow >> (16 * r)) & 0xffffu); o4[r] = of[te][r] * rn * ng[e + r] * sigmoidf_(og); }
        *(unsigned long long*)(c.mixed() + row * D + h * 64 + e) = (unsigned long long)pk2(o4[0], o4[1]) | ((unsigned long long)pk2(o4[2], o4[3]) << 32); }
    __syncthreads();
}

constexpr int P32 = 80;
constexpr int LAP = 33;
__device__ __forceinline__ bf16_t* glc_ptr(const Ctx& c, int b, int h, int dir, int ch) { return c.wsp<bf16_t>(WS_HSGL) + (size_t)((((b * 5 + h) * 2 + dir) * 32) + ch) * 64 * 32; }
__device__ __forceinline__ void gla_loga(const Ctx& c, const float* gatesb, int t0, int nrows, int dir, const LAS float* w2s  , const LAS float* abs_  , LAS float* la  ) {
    for (int x = c.tid; x < nrows * 8; x += NTHREADS) { const int j = x >> 3, d4 = (x & 7) * 4;
        const float* gp = gatesb + (size_t)(t0 + j) * 64 + 24 + dir * 16; float ga[16];
#pragma unroll
        for (int r4 = 0; r4 < 4; ++r4) { const f32x4 v = *(const f32x4*)(gp + 4 * r4); ga[4 * r4] = v[0]; ga[4 * r4 + 1] = v[1]; ga[4 * r4 + 2] = v[2]; ga[4 * r4 + 3] = v[3]; }
#pragma unroll
        for (int y = 0; y < 4; ++y) { float z = abs_[d4 + y];
#pragma unroll
            for (int r = 0; r < 16; ++r) z += ga[r] * w2s[r * 32 + d4 + y];
            la[j * LAP + d4 + y] = logsigmoidf_(z) * (1.0f / 16.0f); } }
}
__device__ __forceinline__ void gla_scan64(LAS float* la  , int dir, int d, int lane, LAS float* tot) {
    const float v = la[lane * LAP + d]; const float inc = wave_incl_scan(v, lane), t = __shfl(inc, 63);
    la[lane * LAP + d] = dir ? (t - inc + v) : inc;
    if (tot && lane == 0) tot[d] = t;
}

__device__ __forceinline__ void gla_state_item(const Ctx& c0, int l, int item, LAS unsigned char* lds) {
    LAUNDER_CTX(c0, c);
    const int b = item / 10, h = (item % 10) >> 1, dir = item & 1;
    const int lane = c.lane, w = c.wave, i = lane & 15, g = lane >> 4;
    LAS unsigned char* Kt = lds;
    LAS unsigned char* Vt = lds + 64 * P32;
    LAS float* la = (LAS float*)(lds + 64 * P32 + 64 * P64);
    LAS float* btot = la + 64 * LAP; LAS float* w2s = btot + 32; LAS float* abs_ = w2s + 512;
    const bf16_t* projb = c.proj() + (size_t)b * T * NPROJ; const float* gatesb = c.gates() + (size_t)b * T * 64;
    { const float* w2 = c.in(9) + ((size_t)l * 2 + dir) * 16 * 160; const float* ab = c.in(10) + ((size_t)l * 2 + dir) * 160;
      w2s[c.tid] = w2[(c.tid >> 5) * 160 + h * 32 + (c.tid & 31)]; if (c.tid < 32) abs_[c.tid] = ab[h * 32 + c.tid]; }
    const int td = w >> 2, te = w & 3;
    f32x4 acc = {0.f, 0.f, 0.f, 0.f};
    __syncthreads();
    for (int cc = 0; cc < 32; ++cc) {
        const int ch = dir ? 31 - cc : cc, t0 = ch * 64;
        { bf16_t* st = glc_ptr(c, b, h, dir, ch); const int e = 16 * te + i, d = 16 * td + 4 * g;
          *(unsigned long long*)(st + e * 32 + d) = (unsigned long long)cvt_pk_bf16(acc[0], acc[1]) | ((unsigned long long)cvt_pk_bf16(acc[2], acc[3]) << 32); }
        if (cc == 31) break;
        gla_loga(c, gatesb, t0, 64, dir, w2s, abs_, la);
        __syncthreads();
#pragma unroll
        for (int y = 0; y < 4; ++y) gla_scan64(la, dir, w * 4 + y, lane, btot);
        __syncthreads();
        { const int j = c.tid >> 3, d4 = (c.tid & 7) * 4;
          const unsigned long long kw = *(const unsigned long long*)(projb + (size_t)(t0 + j) * NPROJ + P_GK + h * 32 + d4); float o[4];
#pragma unroll
          for (int y = 0; y < 4; ++y) o[y] = bf2f((unsigned)(kw >> (16 * y)) & 0xffffu) * __expf(btot[d4 + y] - la[j * LAP + d4 + y]);
          *(LAS unsigned long long*)(Kt + j * P32 + d4 * 2) = (unsigned long long)pk2(o[0], o[1]) | ((unsigned long long)pk2(o[2], o[3]) << 32);
          const int e8 = (c.tid & 7) * 8; *(LAS u32x4*)(Vt + j * P64 + e8 * 2) = *(const u32x4*)(projb + (size_t)(t0 + j) * NPROJ + P_GV + h * 64 + e8); }
        __syncthreads();
#pragma unroll
        for (int r = 0; r < 4; ++r) acc[r] *= __expf(btot[16 * td + 4 * g + r]);
#pragma unroll
        for (int s = 0; s < 2; ++s) { const int r0 = 32 * s + 8 * g, r1 = r0 + 4;
            acc = MFMA16(frag_tr(Kt, P32, r0, r1, 16 * td, lane), frag_tr(Vt, P64, r0, r1, 16 * te, lane), acc); }
        __syncthreads();
    }
}

__device__ __forceinline__ void gla_out_item(const Ctx& c0, int l, int item, LAS unsigned char* lds) {
    LAUNDER_CTX(c0, c);
    const int b = item / 80, h = (item % 80) / 16, cp = item % 16, t0 = cp * 128;
    const int lane = c.lane, w = c.wave, i = lane & 15, g = lane >> 4;
    LAS unsigned char* Qf = lds; LAS unsigned char* Kf = Qf + 128 * P32; LAS unsigned char* Qb = Kf + 128 * P32; LAS unsigned char* Kb = Qb + 128 * P32;
    LAS unsigned char* Vt = Kb + 128 * P32;
    LAS unsigned char* Sf = Vt + 128 * P64;
    LAS unsigned char* Sb = Sf + 2 * 64 * P32;
    LAS float* laf = (LAS float*)(Sb + 2 * 64 * P32);
    LAS float* lab = laf + 128 * LAP; LAS float* w2s = lab + 128 * LAP; LAS float* abs_ = w2s + 1024;
    const bf16_t* projb = c.proj() + (size_t)b * T * NPROJ; const float* gatesb = c.gates() + (size_t)b * T * 64;
    { const float* w2 = c.in(9) + (size_t)l * 2 * 16 * 160; const float* ab = c.in(10) + (size_t)l * 2 * 160;
      for (int x = c.tid; x < 1024; x += NTHREADS) w2s[x] = w2[(x >> 5) * 160 + h * 32 + (x & 31)];
      if (c.tid < 64) abs_[c.tid] = ab[(c.tid >> 5) * 160 + h * 32 + (c.tid & 31)]; }
    __syncthreads();
    gla_loga(c, gatesb, t0, 128, 0, w2s, abs_, laf);
    gla_loga(c, gatesb, t0, 128, 1, w2s + 512, abs_ + 32, lab);
    __syncthreads();
#pragma unroll 4
    for (int y = 0; y < 16; ++y) { const int sidx = w * 16 + y, dir = sidx >> 6, sub = (sidx >> 5) & 1, d = sidx & 31;
        gla_scan64((dir ? lab : laf) + sub * 64 * LAP, dir, d, lane, nullptr); }
    __syncthreads();
    { const int j = c.tid >> 2, d8 = (c.tid & 3) * 8;
      float q8[8], k8[8];
      unpack8(*(const u32x4*)(projb + (size_t)(t0 + j) * NPROJ + P_GQ + h * 32 + d8), q8); unpack8(*(const u32x4*)(projb + (size_t)(t0 + j) * NPROJ + P_GK + h * 32 + d8), k8);
      float oqf[8], okf[8], oqb[8], okb[8];
#pragma unroll
      for (int y = 0; y < 8; ++y) { const float bf_ = laf[j * LAP + d8 + y], bb_ = lab[j * LAP + d8 + y];
          oqf[y] = q8[y] * 0.17677669529663687f * __expf(bf_); okf[y] = k8[y] * __expf(-bf_); oqb[y] = q8[y] * 0.17677669529663687f * __expf(bb_); okb[y] = k8[y] * __expf(-bb_); }
      u32x4 x;
      x.x = pk2(oqf[0], oqf[1]); x.y = pk2(oqf[2], oqf[3]); x.z = pk2(oqf[4], oqf[5]); x.w = pk2(oqf[6], oqf[7]); *(LAS u32x4*)(Qf + j * P32 + d8 * 2) = x;
      x.x = pk2(okf[0], okf[1]); x.y = pk2(okf[2], okf[3]); x.z = pk2(okf[4], okf[5]); x.w = pk2(okf[6], okf[7]); *(LAS u32x4*)(Kf + j * P32 + d8 * 2) = x;
      x.x = pk2(oqb[0], oqb[1]); x.y = pk2(oqb[2], oqb[3]); x.z = pk2(oqb[4], oqb[5]); x.w = pk2(oqb[6], oqb[7]); *(LAS u32x4*)(Qb + j * P32 + d8 * 2) = x;
      x.x = pk2(okb[0], okb[1]); x.y = pk2(okb[2], okb[3]); x.z = pk2(okb[4], okb[5]); x.w = pk2(okb[6], okb[7]); *(LAS u32x4*)(Kb + j * P32 + d8 * 2) = x; }
    ml_stage_plain(c, projb, t0, P_GV + h * 64, Vt);
    for (int x = c.tid; x < 2 * 2 * 64 * 4; x += NTHREADS) { const int dir = x >> 9, sub = (x >> 8) & 1, r = (x >> 2) & 63, k4 = x & 3;
        const bf16_t* s = glc_ptr(c, b, h, dir, 2 * cp + sub); *(LAS u32x4*)((dir ? Sb : Sf) + (sub * 64 + r) * P32 + k4 * 16) = *(const u32x4*)(s + r * 32 + k4 * 8); }
    __syncthreads();
    const int sub = w >> 2, ti = w & 3, R = 64 * sub, qi = 16 * ti + i;
    const bf16x8 qf = frag_nt(Qf, P32, R + qi, 16 * g), qb = frag_nt(Qb, P32, R + qi, 16 * g);
    f32x4 o[4];
#pragma unroll
    for (int te = 0; te < 4; ++te) o[te] = (f32x4){0.f, 0.f, 0.f, 0.f};
#pragma unroll
    for (int s2 = 0; s2 < 2; ++s2) {
        f32x4 p[2];
#pragma unroll
        for (int x = 0; x < 2; ++x) { const int tj = 2 * s2 + x; const f32x4 z = {0.f, 0.f, 0.f, 0.f};
            const f32x4 sf = MFMA16(frag_nt(Kf, P32, R + 16 * tj + i, 16 * g), qf, z), sb = MFMA16(frag_nt(Kb, P32, R + 16 * tj + i, 16 * g), qb, z);
#pragma unroll
            for (int r = 0; r < 4; ++r) { const int j = 16 * tj + 4 * g + r; p[x][r] = ((j <= qi) ? sf[r] : 0.f) + ((j >= qi) ? sb[r] : 0.f); } }
        const bf16x8 pp = pack_frag(p[0], p[1]); const int r0 = R + 32 * s2 + 4 * g, r1 = r0 + 16;
#pragma unroll
        for (int te = 0; te < 4; ++te) o[te] = MFMA16(frag_tr(Vt, P64, r0, r1, 16 * te, lane), pp, o[te]);
    }
#pragma unroll
    for (int te = 0; te < 4; ++te) { o[te] = MFMA16(frag_nt(Sf, P32, R + 16 * te + i, 16 * g), qf, o[te]); o[te] = MFMA16(frag_nt(Sb, P32, R + 16 * te + i, 16 * g), qb, o[te]); }
    float ss = 0.f;
#pragma unroll
    for (int te = 0; te < 4; ++te) ss += (o[te][0] * o[te][0] + o[te][1] * o[te][1]) + (o[te][2] * o[te][2] + o[te][3] * o[te][3]);
    ss += __shfl_xor(ss, 16); ss += __shfl_xor(ss, 32);
    const float rn = 1.0f / sqrtf(ss * (1.0f / 64) + EPS);
    const float* ng = c.in(11) + l * 320 + h * 64;
    const int tq = t0 + R + qi;
#pragma unroll
    for (int te = 0; te < 4; ++te) { const int e = 16 * te + 4 * g;
        const unsigned long long gw = *(const unsigned long long*)(projb + (size_t)tq * NPROJ + P_GG + h * 64 + e); float o4[4];
#pragma unroll
        for (int r = 0; r < 4; ++r) { const float gg = bf2f((unsigned)(gw >> (16 * r)) & 0xffffu); o4[r] = o[te][r] * rn * ng[e + r] * gg * sigmoidf_(gg); }
        *(unsigned long long*)(c.mixed() + ((size_t)b * T + tq) * D + 704 + h * 64 + e) = (unsigned long long)pk2(o4[0], o4[1]) | ((unsigned long long)pk2(o4[2], o4[3]) << 32); }
    __syncthreads();
}
#ifndef MK_PER_PHASE
#define MK_PER_PHASE 0
#endif
constexpr int PH_PER_LAYER = 11, NP = 2 + DEPTH * PH_PER_LAYER;
struct Args { const float* in[25]; float* out; unsigned char* ws; int ph_lo, ph_hi; };

__global__ void __launch_bounds__(NTHREADS, 2) mega(Args a) {
    extern __shared__ __attribute__((aligned(16))) unsigned char lds_raw[];
    LAS unsigned char* lds = (LAS unsigned char*)lds_raw;
    Ctx c;
    c.out = a.out; c.ws = a.ws;
    cg::grid_group grid = cg::this_grid();

    for (int p = a.ph_lo; p < a.ph_hi; ++p) {
        { int t_ = threadIdx.x, b_ = blockIdx.x, g_ = gridDim.x;
          asm volatile("" : "+v"(t_)); asm volatile("" : "+s"(b_)); asm volatile("" : "+s"(g_));
          c.tid = t_; c.lane = t_ & 63; c.wave = __builtin_amdgcn_readfirstlane(t_ >> 6); c.bid = b_; c.G = g_; }
        if (p == 0) {
            convert_layer(c, 0, lds);
            rows_to_bf16(c, c.in(0), c.hb(), c.rs0(), M);
            rows_to_bf16(c, c.in(1), c.memb(), c.rsm(), MM);
        } else if (p == NP - 1) {
            final_norm(c);
        } else {
            const int l = (p - 1) / PH_PER_LAYER, st = (p - 1) % PH_PER_LAYER;
            if (st == 0) {
                { pg8::Gemm g{c.hb(), c.w_in(), M, NPROJ, D}; pg8::StaticOrder S; S.init(M, NPROJ, c.G, c.bid);
                  EpiScale E{c.proj(), NPROJ, c.rs0(), c.gates(), 13};
                  pg8::gemm_phase<EpiScale, pg8::StaticOrder, true, true>(lds, g, S, E); }
                { pg8::Gemm g{c.memb(), c.wkv(), MM, 2 * D, D}; pg8::StaticOrder S; S.init(MM, 2 * D, c.G, c.bid);
                  EpiScale E{c.memkv(), 2 * D, c.rsm(), nullptr, -1};
                  pg8::gemm_phase<EpiScale, pg8::StaticOrder, true, true>(lds, g, S, E); }
            } else if (st == 1) {
                if (c.bid < 96) ml_state_item(c, l, c.bid, lds);
                else if (c.bid < 176) gla_state_item(c, l, c.bid - 96, lds);
                else for (int i = c.bid - 176; i < NB * 5 * 32; i += c.G - 176) na_item(c, l, i, lds);
            } else if (st == 2) {
                for (int i = c.bid; i < NB * 6 * 16 + NB * 5 * 16; i += c.G) { if (i < NB * 6 * 16) ml_out_item(c, l, i, lds); else gla_out_item(c, l, i - NB * 6 * 16, lds); }
            } else if (st == 3) {
                pg8::Gemm g{c.mixed(), c.w_out(), M, D, D}; pg8::StaticOrder S; S.init(M, D, c.G, c.bid);
                EpiResid E{l == 0 ? c.in(0) : c.out, c.out, c.hb(), c.rs1()};
                pg8::gemm_phase<EpiResid, pg8::StaticOrder, true, true>(lds, g, S, E);
            } else if (st == 4) {
                pg8::Gemm g{c.hb(), c.wq(), M, D, D}; pg8::StaticOrder S; S.init(M, D, c.G, c.bid);
                EpiScale E{c.q(), D, c.rs1(), nullptr, -1};
                pg8::gemm_phase<EpiScale, pg8::StaticOrder, true, true>(lds, g, S, E);
            } else if (st == 5) {
                for (int i = c.bid; i < NB * 4 * 64; i += c.G) xattn_item(c, i, lds);
            } else if (st == 6) {
                pg8::Gemm g{c.mixed(), c.wo(), M, D, D}; pg8::StaticOrder S; S.init(M, D, c.G, c.bid);
                EpiResid E{c.out, c.out, c.hb(), c.rs2()};
                pg8::gemm_phase<EpiResid, pg8::StaticOrder, true, true>(lds, g, S, E);
            } else if (st == 7) {
                pg8::Gemm g{c.hb(), c.w_up(), M, NUP, D}; pg8::StaticOrder S; S.init(M, NUP, c.G, c.bid);
                EpiScale E{c.u(), NUP, c.rs2(), nullptr, -1};
                pg8::gemm_phase<EpiScale, pg8::StaticOrder, true, true>(lds, g, S, E);
            } else if (st == 8) {
                act_pass(c, l);
            } else if (st == 9) {
                pg8::Gemm g{c.act(), c.w_dn(), M, D, DFF}; pg8::StaticOrder S; S.init(M, D, c.G, c.bid);
                EpiResid E{c.out, c.out, c.hb(), c.rs0()};
                pg8::gemm_phase<EpiResid, pg8::StaticOrder, true, true>(lds, g, S, E);
            } else {
                if (l + 1 < DEPTH) convert_layer(c, l + 1, lds);
            }
        }
        if (p + 1 < a.ph_hi) grid.sync();
    }
}
}

extern "C" void kernel_launch(void* const* d_in, const int* in_sizes, int n_in, void* d_out, int out_size, void* d_ws, size_t ws_size, hipStream_t stream) {
    static int grid = 0;
    if (grid == 0) {
        if (n_in != 25 || out_size != mk::M * mk::D || ws_size < mk::WS_END) { fprintf(stderr, "kernel_launch: unexpected shapes / workspace (n_in %d out %d ws %zu need %zu)\n", n_in, out_size, ws_size, (size_t)mk::WS_END); grid = -1; return; }
        int dev = 0, cus = 0, per_cu = 0;
        (void)hipGetDevice(&dev); (void)hipDeviceGetAttribute(&cus, hipDeviceAttributeMultiprocessorCount, dev);
        if (hipFuncSetAttribute((const void*)mk::mega, hipFuncAttributeMaxDynamicSharedMemorySize, mk::LDS_BYTES) != hipSuccess) { fprintf(stderr, "kernel_launch: hipFuncSetAttribute failed\n"); grid = -1; return; }
        (void)hipOccupancyMaxActiveBlocksPerMultiprocessor(&per_cu, (const void*)mk::mega, mk::NTHREADS, mk::LDS_BYTES);
        if (per_cu < 1) { fprintf(stderr, "kernel_launch: occupancy query says %d blocks per CU\n", per_cu); grid = -1; return; }
        grid = cus;
        if (grid < 192) { fprintf(stderr, "kernel_launch: needs >= 192 CUs\n"); grid = -1; return; }
    }
    if (grid < 0) return;
    mk::Args a{};
    for (int i = 0; i < 25; ++i) a.in[i] = (const float*)d_in[i];
    a.out = (float*)d_out; a.ws = (unsigned char*)d_ws;
#if MK_PER_PHASE
    for (int p = 0; p < mk::NP; ++p) { a.ph_lo = p; a.ph_hi = p + 1; hipLaunchKernelGGL(mk::mega, dim3(grid), dim3(mk::NTHREADS), mk::LDS_BYTES, stream, a); }
#else
    a.ph_lo = 0; a.ph_hi = mk::NP;
    void* args[] = {&a};
    hipError_t e = hipLaunchCooperativeKernel((const void*)mk::mega, dim3(grid), dim3(mk::NTHREADS), args, mk::LDS_BYTES, stream);
    if (e != hipSuccess) fprintf(stderr, "cooperative launch failed: %s (grid %d)\n", hipGetErrorString(e), grid);
#endif
}
```

```cpp
#include <hip/hip_runtime.h>
#include <hip/hip_cooperative_groups.h>
#include <cstdio>
#include <cstdint>
namespace cg = cooperative_groups;
#define MK_PER_PHASE 0
namespace pg8 {
#define PG8_LAS __attribute__((address_space(3)))
typedef unsigned short bf16_t;
typedef short bf16x8 __attribute__((ext_vector_type(8)));
typedef float f32x4 __attribute__((ext_vector_type(4)));
typedef unsigned u32x4 __attribute__((ext_vector_type(4)));
constexpr int BM = 256, BK = 64, HALF = 128, HTB = HALF * BK * 2  , STAGE_BYTES = 8 * HTB, NXCD = 8, WGM = 8;

__host__ __device__ __forceinline__ int lds_byte(int r, int c) { const int st = (r >> 4) * 2 + (c >> 5), rr = r & 15, cc = c & 31, ob = rr * 64 + cc * 2; return st * 1024 + (ob ^ (((ob >> 9) & 1) << 5)); }
__host__ __device__ __forceinline__ void stage_rc(int b, int& R, int& C) { const int st = b / 1024, sb = b % 1024, swz = sb ^ (((sb >> 9) & 1) << 5); R = (st >> 1) * 16 + swz / 64; C = (st & 1) * 32 + (swz % 64) / 2; }
__host__ __device__ __forceinline__ int perm32(int rho) { const int n = rho >> 4, i = rho & 15; return 8 * (i >> 2) + 4 * n + (i & 3); }

struct Unit { int pm, pn; };
struct Gemm { const bf16_t* A; const bf16_t* Bt; int M, N, K; };

struct StaticOrder {
    int nM, nN, nwg, G, c;
    __host__ __device__ void init(int M, int N, int G_, int c_) { nM = M / BM; nN = N / BM; nwg = nM * nN; G = G_; c = c_; }
    __host__ __device__ bool next(int i, Unit& u) const {
        const long L = (long)i * G + c; if (L >= nwg) return false;
        int wgid = (int)L; { const int q = nwg / NXCD, r = nwg % NXCD, xcd = wgid % NXCD, off = wgid / NXCD; wgid = (xcd < r ? xcd * (q + 1) : r * (q + 1) + (xcd - r) * q) + off; }
        const int nig = WGM * nN, gid = wgid / nig, fm = gid * WGM, gsz = (nM - fm) < WGM ? (nM - fm) : WGM;
        u.pm = fm + ((wgid % nig) % gsz); u.pn = (wgid % nig) / gsz; return true;
    }
    __device__ __forceinline__ void a_ready(const Unit&) const {}
    __device__ __forceinline__ void done(const Unit&) const {}
};

template <class Epi, class Sched, bool ALIGN_EPI = false, bool SP2 = false>
__device__ __forceinline__ void gemm_phase(PG8_LAS unsigned char* lds, const Gemm g, const Sched& S, const Epi& E) {
    int tid_l = threadIdx.x; asm volatile("" : "+v"(tid_l));
    const int tid = tid_l, wid = __builtin_amdgcn_readfirstlane(tid >> 6), lane = tid & 63, wr = wid >> 2, wc = wid & 3, fr = lane & 15, fq = lane >> 4;
    const int K = g.K, nt = K / BK;
    unsigned voffA[2], voffB[2];
#pragma unroll
    for (int i = 0; i < 2; ++i) { int R, C; stage_rc(tid * 16 + i * 8192, R, C); const int Rb = Epi::PERM ? ((R & ~31) + perm32(R & 31)) : R;
        voffA[i] = (unsigned)(R * K + C) * 2u; voffB[i] = (unsigned)(Rb * K + C) * 2u; }
    const size_t kstep = (size_t)(BK * 2);
    const size_t hstep = (size_t)HALF * K * 2;
    const size_t tstep = 2 * hstep;
    const unsigned ldsw = (unsigned)wid * 1024u;
    const int aoff = lds_byte(wr * 64 + fr, fq * 8), boff = lds_byte(wc * 32 + fr, fq * 8);
#define PG8_SA(b, h) (((b) * 2 + (h)) * HTB)
#define PG8_SB(b, h) ((4 + (b) * 2 + (h)) * HTB)
#define PG8_STAGE(bufoff, gbase, voff) do { _Pragma("unroll") for (int _i = 0; _i < 2; ++_i) \
        __builtin_amdgcn_global_load_lds((const unsigned*)((const char*)(gbase) + (voff)[_i]), (PG8_LAS unsigned*)(lds + (bufoff) + ldsw + _i * 8192), 16, 0, 0); } while (0)
#define PG8_LDA(dst, b, h) do { _Pragma("unroll") for (int m = 0; m < 4; ++m) _Pragma("unroll") for (int k = 0; k < 2; ++k) dst[m][k] = *(const PG8_LAS bf16x8*)(lds + PG8_SA(b, h) + aoff + m * 2048 + k * 1024); } while (0)
#define PG8_LDB(dst, b, h) do { _Pragma("unroll") for (int n = 0; n < 2; ++n) _Pragma("unroll") for (int k = 0; k < 2; ++k) dst[n][k] = *(const PG8_LAS bf16x8*)(lds + PG8_SB(b, h) + boff + n * 2048 + k * 1024); } while (0)
#define PG8_MMA(ai, bj, At, Bt) do { __builtin_amdgcn_s_setprio(1); _Pragma("unroll") for (int m = 0; m < 4; ++m) _Pragma("unroll") for (int n = 0; n < 2; ++n) _Pragma("unroll") for (int k = 0; k < 2; ++k) \
        acc[ai][bj][m][n] = __builtin_amdgcn_mfma_f32_16x16x32_bf16(Bt[n][k], At[m][k], acc[ai][bj][m][n], 0, 0, 0); __builtin_amdgcn_s_setprio(0); } while (0)
#define PG8_WAIT_V(n) asm volatile("s_waitcnt vmcnt(" #n ")" ::: "memory")
#define PG8_WAIT_L(n) asm volatile("s_waitcnt lgkmcnt(" #n ")" ::: "memory")
#define PG8_BAR __builtin_amdgcn_s_barrier()
#define PG8_SCHED __builtin_amdgcn_sched_barrier(0)
    Unit cur, nxt; int ui = 0;
    if (!S.next(0, cur)) return;
    f32x4 acc[2][2][4][2];
#pragma unroll
    for (int a = 0; a < 2; ++a)
#pragma unroll
        for (int b = 0; b < 2; ++b)
#pragma unroll
            for (int m = 0; m < 4; ++m)
#pragma unroll
                for (int n = 0; n < 2; ++n) acc[a][b][m][n] = (f32x4){0.f, 0.f, 0.f, 0.f};
    bf16x8 At[4][2], B0[2][2], B1[2][2];
    const char* cA = (const char*)g.A + (size_t)cur.pm * tstep; const char* cB = (const char*)g.Bt + (size_t)cur.pn * tstep;
    S.a_ready(cur);
    if constexpr (SP2) {
        PG8_STAGE(PG8_SB(0, 0), cB, voffB); PG8_STAGE(PG8_SB(0, 1), cB + hstep, voffB); PG8_STAGE(PG8_SA(0, 0), cA, voffA); PG8_STAGE(PG8_SA(0, 1), cA + hstep, voffA);
        if (wr == 1) PG8_BAR;
        PG8_WAIT_V(2); PG8_BAR;
        PG8_STAGE(PG8_SB(1, 0), cB + kstep, voffB); PG8_STAGE(PG8_SA(1, 0), cA + kstep, voffA); PG8_STAGE(PG8_SB(1, 1), cB + hstep + kstep, voffB);
        PG8_WAIT_V(6); PG8_BAR;
    } else {
        PG8_STAGE(PG8_SB(0, 0), cB, voffB); PG8_STAGE(PG8_SA(0, 0), cA, voffA); PG8_STAGE(PG8_SB(0, 1), cB + hstep, voffB); PG8_STAGE(PG8_SA(0, 1), cA + hstep, voffA);
        if (wr == 1) PG8_BAR;
        PG8_WAIT_V(4); PG8_BAR;
        PG8_STAGE(PG8_SB(1, 0), cB + kstep, voffB); PG8_STAGE(PG8_SA(1, 0), cA + kstep, voffA); PG8_STAGE(PG8_SB(1, 1), cB + hstep + kstep, voffB);
        PG8_WAIT_V(6); PG8_BAR;
    }
    for (;;) {
        const bool has_next = S.next(ui + 1, nxt);
        const char* nA = has_next ? (const char*)g.A + (size_t)nxt.pm * tstep : cA; const char* nB = has_next ? (const char*)g.Bt + (size_t)nxt.pn * tstep : cB;
        for (int t = 0; t < nt; t += 2) {
            const bool last = (t == nt - 2);
            const char* a1 = cA + (size_t)(t + 1) * kstep;
            const char* a2 = last ? nA : cA + (size_t)(t + 2) * kstep; const char* b2 = last ? nB : cB + (size_t)(t + 2) * kstep;
            const char* a3 = a2 + kstep; const char* b3 = b2 + kstep;
            if (last && has_next) S.a_ready(nxt);
            if constexpr (SP2) {
            PG8_LDB(B0, 0, 0); PG8_LDB(B1, 0, 1); PG8_SCHED; PG8_LDA(At, 0, 0); PG8_STAGE(PG8_SA(1, 1), a1 + hstep, voffA);
            PG8_WAIT_V(8); PG8_WAIT_L(0); PG8_BAR; PG8_MMA(0, 0, At, B0); PG8_MMA(0, 1, At, B1); PG8_BAR; PG8_SCHED;
            PG8_LDA(At, 0, 1); PG8_STAGE(PG8_SB(0, 0), b2, voffB); PG8_STAGE(PG8_SB(0, 1), b2 + hstep, voffB); PG8_STAGE(PG8_SA(0, 0), a2, voffA);
            PG8_WAIT_V(8); PG8_WAIT_L(0); PG8_BAR; PG8_MMA(1, 0, At, B0); PG8_MMA(1, 1, At, B1); PG8_BAR; PG8_SCHED;
            PG8_LDB(B0, 1, 0); PG8_LDB(B1, 1, 1); PG8_SCHED; PG8_LDA(At, 1, 0); PG8_STAGE(PG8_SA(0, 1), a2 + hstep, voffA);
            PG8_WAIT_V(8); PG8_WAIT_L(0); PG8_BAR; PG8_MMA(0, 0, At, B0); PG8_MMA(0, 1, At, B1); PG8_BAR; PG8_SCHED;
            PG8_LDA(At, 1, 1); PG8_STAGE(PG8_SB(1, 0), b3, voffB); PG8_STAGE(PG8_SB(1, 1), b3 + hstep, voffB); PG8_STAGE(PG8_SA(1, 0), a3, voffA);
            PG8_WAIT_V(8); PG8_WAIT_L(0); PG8_BAR; PG8_MMA(1, 0, At, B0); PG8_MMA(1, 1, At, B1); PG8_BAR; PG8_SCHED;
            } else {
            PG8_LDB(B0, 0, 0); PG8_SCHED; PG8_LDA(At, 0, 0); PG8_STAGE(PG8_SA(1, 1), a1 + hstep, voffA);
            PG8_WAIT_L(8); PG8_BAR; PG8_WAIT_L(0); PG8_MMA(0, 0, At, B0); PG8_BAR; PG8_SCHED;
            PG8_LDB(B1, 0, 1); PG8_STAGE(PG8_SB(0, 0), b2, voffB);
            PG8_BAR; PG8_WAIT_L(0); PG8_MMA(0, 1, At, B1); PG8_BAR;
            PG8_LDA(At, 0, 1); PG8_STAGE(PG8_SA(0, 0), a2, voffA);
            PG8_BAR; PG8_WAIT_L(0); PG8_MMA(1, 0, At, B0); PG8_BAR; PG8_SCHED;
            PG8_STAGE(PG8_SB(0, 1), b2 + hstep, voffB);
            PG8_WAIT_V(6); PG8_BAR; PG8_MMA(1, 1, At, B1); PG8_BAR;
            PG8_LDB(B0, 1, 0); PG8_SCHED; PG8_LDA(At, 1, 0); PG8_STAGE(PG8_SA(0, 1), a2 + hstep, voffA);
            PG8_WAIT_L(8); PG8_BAR; PG8_WAIT_L(0); PG8_MMA(0, 0, At, B0); PG8_BAR; PG8_SCHED;
            PG8_LDB(B1, 1, 1); PG8_STAGE(PG8_SB(1, 0), b3, voffB);
            PG8_BAR; PG8_WAIT_L(0); PG8_MMA(0, 1, At, B1); PG8_BAR;
            PG8_LDA(At, 1, 1); PG8_STAGE(PG8_SA(1, 0), a3, voffA);
            PG8_BAR; PG8_WAIT_L(0); PG8_MMA(1, 0, At, B0); PG8_BAR; PG8_SCHED;
            PG8_STAGE(PG8_SB(1, 1), b3 + hstep, voffB);
            PG8_WAIT_V(6); PG8_BAR; PG8_MMA(1, 1, At, B1); PG8_BAR;
            }
        }
        if constexpr (ALIGN_EPI) { if (wr == 0) PG8_BAR; }
        if constexpr (!Epi::AFTER_DRAIN) { E(acc, cur, wr, wc, fr, fq); S.done(cur); }
        if (!has_next) break;
#pragma unroll
        for (int a = 0; a < 2; ++a)
#pragma unroll
            for (int b = 0; b < 2; ++b)
#pragma unroll
                for (int m = 0; m < 4; ++m)
#pragma unroll
                    for (int n = 0; n < 2; ++n) acc[a][b][m][n] = (f32x4){0.f, 0.f, 0.f, 0.f};
        cur = nxt; cA = nA; cB = nB; ++ui;
        if constexpr (ALIGN_EPI) { if (wr == 1) PG8_BAR; }
    }
    PG8_WAIT_V(0);
    if constexpr (!ALIGN_EPI) { if (wr == 0) PG8_BAR; }
    PG8_BAR;
    if constexpr (Epi::AFTER_DRAIN) { E.fused(acc, cur, wr, wc, fr, fq, lds, wid, lane); S.done(cur); }
#undef PG8_SA
#undef PG8_SB
#undef PG8_STAGE
#undef PG8_LDA
#undef PG8_LDB
#undef PG8_MMA
#undef PG8_WAIT_V
#undef PG8_WAIT_L
#undef PG8_BAR
#undef PG8_SCHED
}
}
namespace mk {
using pg8::bf16_t; using pg8::f32x4; using pg8::u32x4; using pg8::bf16x8;
#define LAS __attribute__((address_space(3)))
constexpr int NB = 8, T = 2048, M = NB * T, D = 1024, DEPTH = 4, NMEM = 256, MM = NB * NMEM;
constexpr int NPROJ = 3584, IN_COLS = 3512, DFF = 2816, NUP = 2 * DFF;
constexpr float EPS = 1e-6f;
constexpr int P_MLQ = 0, P_MLK = 384, P_MLV = 768, P_MLO = 1152, P_NAQ = 1536, P_NAK = 1856, P_NAV = 2176, P_GQ = 2496, P_GK = 2656, P_GV = 2816, P_GG = 3136, P_MLG = 3456, P_GA = 3480;
constexpr int NTHREADS = 512, NWAVES = 8;
constexpr int LDS_BYTES = 160 * 1024;
constexpr size_t MiB = (size_t)1 << 20;
constexpr size_t WS_RS0 = 0, WS_RS1 = 1 * MiB, WS_RS2 = 2 * MiB, WS_RSM = 3 * MiB;
constexpr size_t WS_GATES = 4 * MiB;
constexpr size_t WS_MEMB = 8 * MiB;
constexpr size_t WS_MEMKV = 12 * MiB;
constexpr size_t WS_WIN = 20 * MiB, WS_WOUT = 27 * MiB, WS_WQ = 29 * MiB, WS_WO = 31 * MiB, WS_WUP = 33 * MiB, WS_WDN = 44 * MiB, WS_WKV = 50 * MiB;
constexpr size_t WS_HB = 54 * MiB;
constexpr size_t WS_BIG = 86 * MiB;
constexpr size_t WS_HSML = WS_BIG + 112 * MiB, WS_HSGL = WS_HSML + 24 * MiB;
constexpr size_t WS_ACT = 262 * MiB;
constexpr size_t WS_MIXED = WS_ACT, WS_Q = WS_ACT + 32 * MiB;
constexpr size_t WS_END = 350 * MiB;

__device__ __forceinline__ float bf2f(unsigned v) { return __uint_as_float(v << 16); }
__device__ __forceinline__ unsigned f2bf(float f) { const unsigned u = __float_as_uint(f); return (u + 0x7fffu + ((u >> 16) & 1u)) >> 16; }
__device__ __forceinline__ unsigned pk2(float lo, float hi) { return f2bf(lo) | (f2bf(hi) << 16); }
__device__ __forceinline__ unsigned cvt_pk_bf16(float lo, float hi) { unsigned r; asm volatile("v_cvt_pk_bf16_f32 %0, %1, %2" : "=v"(r) : "v"(lo), "v"(hi)); return r; }
__device__ __forceinline__ void unpack8(const u32x4 w, float (&o)[8]) {
    o[0] = bf2f(w.x & 0xffffu); o[1] = bf2f(w.x >> 16); o[2] = bf2f(w.y & 0xffffu); o[3] = bf2f(w.y >> 16);
    o[4] = bf2f(w.z & 0xffffu); o[5] = bf2f(w.z >> 16); o[6] = bf2f(w.w & 0xffffu); o[7] = bf2f(w.w >> 16);
}
__device__ __forceinline__ float wave_sum(float v) {
#pragma unroll
    for (int o = 1; o < 64; o <<= 1) v += __shfl_xor(v, o);
    return v;
}
__device__ __forceinline__ float sigmoidf_(float x) { return 1.f / (1.f + __expf(-x)); }

typedef const float* cfptr;
struct Ctx {
    float* out; unsigned char* ws;
    int G, bid, tid, lane, wave;
    __device__ __forceinline__ const float* in(int i) const {
        asm volatile("" : "+s"(i));
        const __attribute__((address_space(4))) cfptr* tbl = (const __attribute__((address_space(4))) cfptr*)__builtin_amdgcn_kernarg_segment_ptr();
        return tbl[i];
    }
    template <class Tp> __device__ __forceinline__ Tp* wsp(size_t off) const { unsigned o = (unsigned)off; asm volatile("" : "+s"(o)); return (Tp*)(ws + o); }
    __device__ __forceinline__ float* rs0() const { return wsp<float>(WS_RS0); }
    __device__ __forceinline__ float* rs1() const { return wsp<float>(WS_RS1); }
    __device__ __forceinline__ float* rs2() const { return wsp<float>(WS_RS2); }
    __device__ __forceinline__ float* rsm() const { return wsp<float>(WS_RSM); }
    __device__ __forceinline__ float* gates() const { return wsp<float>(WS_GATES); }
    __device__ __forceinline__ float* hsml() const { return wsp<float>(WS_HSML); }
    __device__ __forceinline__ float* hsgl() const { return wsp<float>(WS_HSGL); }
    __device__ __forceinline__ bf16_t* memb() const { return wsp<bf16_t>(WS_MEMB); }
    __device__ __forceinline__ bf16_t* memkv() const { return wsp<bf16_t>(WS_MEMKV); }
    __device__ __forceinline__ bf16_t* w_in() const { return wsp<bf16_t>(WS_WIN); }
    __device__ __forceinline__ bf16_t* w_out() const { return wsp<bf16_t>(WS_WOUT); }
    __device__ __forceinline__ bf16_t* wq() const { return wsp<bf16_t>(WS_WQ); }
    __device__ __forceinline__ bf16_t* wo() const { return wsp<bf16_t>(WS_WO); }
    __device__ __forceinline__ bf16_t* w_up() const { return wsp<bf16_t>(WS_WUP); }
    __device__ __forceinline__ bf16_t* w_dn() const { return wsp<bf16_t>(WS_WDN); }
    __device__ __forceinline__ bf16_t* wkv() const { return wsp<bf16_t>(WS_WKV); }
    __device__ __forceinline__ bf16_t* hb() const { return wsp<bf16_t>(WS_HB); }
    __device__ __forceinline__ bf16_t* proj() const { return wsp<bf16_t>(WS_BIG); }
    __device__ __forceinline__ bf16_t* u() const { return wsp<bf16_t>(WS_BIG); }
    __device__ __forceinline__ bf16_t* act() const { return wsp<bf16_t>(WS_ACT); }
    __device__ __forceinline__ bf16_t* mixed() const { return wsp<bf16_t>(WS_MIXED); }
    __device__ __forceinline__ bf16_t* q() const { return wsp<bf16_t>(WS_Q); }
};

#define LAUNDER_CTX(c0, c) Ctx c = (c0); { int t_ = c.tid; asm volatile("" : "+v"(t_)); c.tid = t_; c.lane = t_ & 63; c.wave = __builtin_amdgcn_readfirstlane(t_ >> 6); }

struct EpiScale {
    static constexpr bool PERM = true, AFTER_DRAIN = false;
    bf16_t* O; int ldc; const float* rowss; float* gates; int gate_pn;
    __device__ __forceinline__ void operator()(const f32x4 (&acc)[2][2][4][2], const pg8::Unit& u, int wr, int wc, int fr, int fq) const {
        const int row0 = u.pm * 256 + wr * 64 + fr, col0 = u.pn * 256 + wc * 32 + 8 * fq;
        const bool gt = (u.pn == gate_pn) && (wc < 2);
#pragma unroll
        for (int ai = 0; ai < 2; ++ai)
#pragma unroll
            for (int m = 0; m < 4; ++m) {
                const int row = row0 + ai * 128 + m * 16;
                float rs = 1.0f;
                if (rowss) { const f32x4* rp = (const f32x4*)(rowss + (size_t)row * 16); const f32x4 p0 = rp[0], p1 = rp[1], p2 = rp[2], p3 = rp[3];
                    const float ssum = (((p0[0] + p0[1]) + (p0[2] + p0[3])) + ((p1[0] + p1[1]) + (p1[2] + p1[3]))) + (((p2[0] + p2[1]) + (p2[2] + p2[3])) + ((p3[0] + p3[1]) + (p3[2] + p3[3])));
                    rs = 1.0f / sqrtf(ssum * (1.0f / D) + EPS); }
                bf16_t* rowp = O + (size_t)row * ldc + col0;
#pragma unroll
                for (int bj = 0; bj < 2; ++bj) {
                    const f32x4 v0 = acc[ai][bj][m][0] * rs, v1 = acc[ai][bj][m][1] * rs;
                    u32x4 w; w.x = cvt_pk_bf16(v0[0], v0[1]); w.y = cvt_pk_bf16(v0[2], v0[3]); w.z = cvt_pk_bf16(v1[0], v1[1]); w.w = cvt_pk_bf16(v1[2], v1[3]);
                    *(u32x4*)(rowp + bj * 128) = w;
                    if (bj == 1 && gt) { float* gp = gates + (size_t)row * 64 + wc * 32 + 8 * fq; *(f32x4*)gp = v0; *(f32x4*)(gp + 4) = v1; }
                }
            }
    }
};
struct EpiResid {
    static constexpr bool PERM = true, AFTER_DRAIN = false;
    const float* base; float* out; bf16_t* hb; float* rowss_out;
    __device__ __forceinline__ void operator()(const f32x4 (&acc)[2][2][4][2], const pg8::Unit& u, int wr, int wc, int fr, int fq) const {
        const int row0 = u.pm * 256 + wr * 64 + fr, col0 = u.pn * 256 + wc * 32 + 8 * fq;
#pragma unroll
        for (int ai = 0; ai < 2; ++ai)
#pragma unroll
            for (int m = 0; m < 4; ++m) {
                const int row = row0 + ai * 128 + m * 16; const size_t off = (size_t)row * D + col0; float ss = 0.f;
#pragma unroll
                for (int bj = 0; bj < 2; ++bj) {
                    const f32x4 v0 = acc[ai][bj][m][0] + *(const f32x4*)(base + off + bj * 128), v1 = acc[ai][bj][m][1] + *(const f32x4*)(base + off + bj * 128 + 4);
                    *(f32x4*)(out + off + bj * 128) = v0; *(f32x4*)(out + off + bj * 128 + 4) = v1;
                    u32x4 w; w.x = cvt_pk_bf16(v0[0], v0[1]); w.y = cvt_pk_bf16(v0[2], v0[3]); w.z = cvt_pk_bf16(v1[0], v1[1]); w.w = cvt_pk_bf16(v1[2], v1[3]);
                    *(u32x4*)(hb + off + bj * 128) = w;
                    ss += (v0[0] * v0[0] + v0[1] * v0[1]) + (v0[2] * v0[2] + v0[3] * v0[3]) + (v1[0] * v1[0] + v1[1] * v1[1]) + (v1[2] * v1[2] + v1[3] * v1[3]);
                }
                ss += __shfl_xor(ss, 16); ss += __shfl_xor(ss, 32);
                if (fq == 0) rowss_out[(size_t)row * 16 + u.pn * 4 + wc] = ss;
                asm volatile("" ::: "memory");
            }
    }
};

template <class Map>
__device__ __forceinline__ void cvt_item(const float* W, int K, int N, const float* gain, bf16_t* WT, LAS float* scr, int item, int lane, Map map) {
    const int nblk = (N + 31) / 32, kb = item / nblk, nb = item % nblk, k0 = 64 * kb, n0 = 32 * nb;
    const int nn = n0 + (lane & 31);
#pragma unroll 8
    for (int i = 0; i < 32; ++i) { const int kk = 2 * i + (lane >> 5); float w = (nn < N) ? W[(size_t)(k0 + kk) * N + nn] : 0.f; if (gain) w *= gain[k0 + kk]; scr[kk * 33 + (lane & 31)] = w; }
    asm volatile("s_waitcnt lgkmcnt(0)" ::: "memory");
    const int c = lane & 7;
#pragma unroll
    for (int j = 0; j < 4; ++j) { const int n = (lane >> 3) + 8 * j; const LAS float* s = scr + (8 * c) * 33 + n;
        u32x4 o; o.x = pk2(s[0 * 33], s[1 * 33]); o.y = pk2(s[2 * 33], s[3 * 33]); o.z = pk2(s[4 * 33], s[5 * 33]); o.w = pk2(s[6 * 33], s[7 * 33]);
        if (n0 + n < N) *(u32x4*)(WT + (size_t)map(n0 + n) * K + k0 + 8 * c) = o; }
    asm volatile("s_waitcnt lgkmcnt(0)" ::: "memory");
}
struct MapId { int off; __device__ __forceinline__ int operator()(int n) const { return n + off; } };
struct MapIn { __device__ __forceinline__ int operator()(int n) const { return n < 1536 ? n : (n < 1560 ? n + (P_MLG - 1536) : (n < 3480 ? n - 24 : n)); } };

__device__ __forceinline__ void convert_layer(const Ctx& c, int l, LAS unsigned char* lds) {
    LAS float* scr = (LAS float*)(lds + c.wave * 16384);
    const int gw = c.bid * NWAVES + c.wave, NGW = c.G * NWAVES;
    constexpr int I_IN = 16 * 110, I_SQ = 16 * 32, I_UP = 16 * 176, I_DN = 44 * 32;
    constexpr int NITEMS = I_IN + 5 * I_SQ + I_UP + I_DN;
    for (int it = gw; it < NITEMS; it += NGW) {
        int r = it;
        if (r < I_IN) { cvt_item(c.in(3) + (size_t)l * D * IN_COLS, D, IN_COLS, c.in(2) + l * D, c.w_in(), scr, r, c.lane, MapIn{}); continue; } r -= I_IN;
        if (r < I_SQ) { cvt_item(c.in(12) + (size_t)l * D * D, D, D, nullptr, c.w_out(), scr, r, c.lane, MapId{0}); continue; } r -= I_SQ;
        if (r < I_SQ) { cvt_item(c.in(15) + (size_t)l * D * D, D, D, c.in(13) + l * D, c.wq(), scr, r, c.lane, MapId{0}); continue; } r -= I_SQ;
        if (r < I_SQ) { cvt_item(c.in(16) + (size_t)l * D * D, D, D, c.in(14) + l * D, c.wkv(), scr, r, c.lane, MapId{0}); continue; } r -= I_SQ;
        if (r < I_SQ) { cvt_item(c.in(17) + (size_t)l * D * D, D, D, c.in(14) + l * D, c.wkv(), scr, r, c.lane, MapId{D}); continue; } r -= I_SQ;
        if (r < I_SQ) { cvt_item(c.in(18) + (size_t)l * D * D, D, D, nullptr, c.wo(), scr, r, c.lane, MapId{0}); continue; } r -= I_SQ;
        if (r < I_UP) { cvt_item(c.in(20) + (size_t)l * D * NUP, D, NUP, c.in(19) + l * D, c.w_up(), scr, r, c.lane, MapId{0}); continue; } r -= I_UP;
        cvt_item(c.in(23) + (size_t)l * DFF * D, DFF, D, nullptr, c.w_dn(), scr, r, c.lane, MapId{0});
    }
    const int gt = c.bid * NTHREADS + c.tid;
    for (int i = gt; i < (NPROJ - IN_COLS) * D / 8; i += c.G * NTHREADS) *(u32x4*)(c.w_in() + (size_t)IN_COLS * D + (size_t)i * 8) = (u32x4){0u, 0u, 0u, 0u};
}
__device__ __forceinline__ void rows_to_bf16(const Ctx& c, const float* X, bf16_t* Y, float* rss, int rows) {
    const int gw = c.bid * NWAVES + c.wave, NGW = c.G * NWAVES;
    for (int m = gw; m < rows; m += NGW) {
        const f32x4* xr = (const f32x4*)(X + (size_t)m * D) + c.lane; float s = 0.f;
        unsigned long long* o8 = (unsigned long long*)(Y + (size_t)m * D) + c.lane;
#pragma unroll
        for (int j = 0; j < 4; ++j) { const f32x4 v = xr[64 * j]; s += (v[0] * v[0] + v[1] * v[1]) + (v[2] * v[2] + v[3] * v[3]);
            o8[64 * j] = (unsigned long long)pk2(v[0], v[1]) | ((unsigned long long)pk2(v[2], v[3]) << 32); }
        s = wave_sum(s); if (c.lane < 16) rss[(size_t)m * 16 + c.lane] = (c.lane == 0) ? s : 0.f;
    }
}
__device__ __forceinline__ void final_norm(const Ctx& c) {
    const int gw = c.bid * NWAVES + c.wave, NGW = c.G * NWAVES; const float* g = c.in(24);
    for (int m = gw; m < M; m += NGW) {
        f32x4* xr = (f32x4*)(c.out + (size_t)m * D) + c.lane; f32x4 v[4]; float s = 0.f;
#pragma unroll
        for (int j = 0; j < 4; ++j) { v[j] = xr[64 * j]; s += (v[j][0] * v[j][0] + v[j][1] * v[j][1]) + (v[j][2] * v[j][2] + v[j][3] * v[j][3]); }
        const float r = 1.0f / sqrtf(wave_sum(s) * (1.0f / D) + EPS);
#pragma unroll
        for (int j = 0; j < 4; ++j) xr[64 * j] = v[j] * r * ((const f32x4*)g)[c.lane + 64 * j];
    }
}
__device__ __forceinline__ void ml_load_row(const bf16_t* projb, int t, int coff, float (&dst)[2][8]) {
    if (t < 0 || t >= T) {
#pragma unroll
        for (int j = 0; j < 8; ++j) { dst[0][j] = 0.f; dst[1][j] = 0.f; }
    } else {
        const u32x4 a = *(const u32x4*)(projb + (size_t)t * NPROJ + P_MLQ + coff), b = *(const u32x4*)(projb + (size_t)t * NPROJ + P_MLK + coff);
        unpack8(a, dst[0]); unpack8(b, dst[1]);
    }
}
__device__ __forceinline__ void ml_item(const Ctx& c0, int l, int item, LAS unsigned char* lds) {
    LAUNDER_CTX(c0, c);
    const int b = item / 6, h = item % 6, e = c.tid & 63, dg = c.tid >> 6;
    LAS float* rnum = (LAS float*)lds;
    LAS float* rden = (LAS float*)lds + 1024;
    const bf16_t* projb = c.proj() + (size_t)b * T * NPROJ;
    const float* gatesb = c.gates() + (size_t)b * T * 64;
    float* hs = c.hsml() + (size_t)b * T * 384 + h * 64;
    const float* cwp = c.in(4) + (size_t)l * 3 * 768; const float* cbp = c.in(5) + (size_t)l * 768;
    const float* gb = c.in(6) + l * 24; const float* ng = c.in(7) + l * 384;
    const int coff = h * 64 + dg * 8;
    float cw[2][8][4];
#pragma unroll
    for (int qk = 0; qk < 2; ++qk)
#pragma unroll
        for (int j = 0; j < 8; ++j) { const int ch = qk * 384 + coff + j; cw[qk][j][0] = cwp[ch]; cw[qk][j][1] = cwp[768 + ch]; cw[qk][j][2] = cwp[1536 + ch]; cw[qk][j][3] = cbp[ch]; }
    for (int dir = 0; dir < 2; ++dir) {
        float C[8], n[8];
#pragma unroll
        for (int j = 0; j < 8; ++j) { C[j] = 0.f; n[j] = 0.f; }
        const float bi = gb[(2 * dir) * 6 + h], bff = gb[(2 * dir + 1) * 6 + h];
        float lo[2][8], mid[2][8], hi[2][8];
        const int t0 = dir ? T - 1 : 0;
        ml_load_row(projb, t0 - 1, coff, lo); ml_load_row(projb, t0, coff, mid); ml_load_row(projb, t0 + 1, coff, hi);
        for (int s = 0; s < T; ++s) {
            const int t = dir ? T - 1 - s : s;
            const float ip = gatesb[(size_t)t * 64 + (2 * dir) * 6 + h] + bi, fp = gatesb[(size_t)t * 64 + (2 * dir + 1) * 6 + h] + bff;
            const float f = sigmoidf_(fp), ig = __expf(ip);
            const float v = bf2f(projb[(size_t)t * NPROJ + P_MLV + h * 64 + e]);
            float pn = 0.f, pd = 0.f;
#pragma unroll
            for (int j = 0; j < 8; ++j) {
                float yq = lo[0][j] * cw[0][j][0] + mid[0][j] * cw[0][j][1] + hi[0][j] * cw[0][j][2] + cw[0][j][3];
                float yk = lo[1][j] * cw[1][j][0] + mid[1][j] * cw[1][j][1] + hi[1][j] * cw[1][j][2] + cw[1][j][3];
                const float qd = yq * sigmoidf_(yq), kd = yk * sigmoidf_(yk) * 0.125f;
                C[j] = f * C[j] + ig * kd * v; n[j] = f * n[j] + ig * kd; pn += C[j] * qd; pd += n[j] * qd;
            }
            const int p = s & 1;
            rnum[(p * 8 + dg) * 64 + e] = pn; if (e == 0) rden[p * 8 + dg] = pd;
            __syncthreads();
            if (dg == 0) {
                float num = 0.f, den = 0.f;
#pragma unroll
                for (int g = 0; g < 8; ++g) { num += rnum[(p * 8 + g) * 64 + e]; den += rden[p * 8 + g]; }
                const float hv = num / fmaxf(fabsf(den), 1.f);
                if (dir == 0) hs[(size_t)t * 384 + e] = hv;
                else { const float tot = hs[(size_t)t * 384 + e] + hv; const float ss = wave_sum(tot * tot);
                    const float r = 1.0f / sqrtf(ss * (1.0f / 64) + EPS); const float og = bf2f(projb[(size_t)t * NPROJ + P_MLO + h * 64 + e]);
                    c.mixed()[((size_t)b * T + t) * D + h * 64 + e] = (bf16_t)f2bf(tot * r * ng[h * 64 + e] * sigmoidf_(og)); }
            }
            if (dir == 0) {
#pragma unroll
                for (int j = 0; j < 8; ++j) { lo[0][j] = mid[0][j]; lo[1][j] = mid[1][j]; mid[0][j] = hi[0][j]; mid[1][j] = hi[1][j]; }
                ml_load_row(projb, t + 2, coff, hi);
            } else {
#pragma unroll
                for (int j = 0; j < 8; ++j) { hi[0][j] = mid[0][j]; hi[1][j] = mid[1][j]; mid[0][j] = lo[0][j]; mid[1][j] = lo[1][j]; }
                ml_load_row(projb, t - 2, coff, lo);
            }
        }
        __syncthreads();
    }
}
__device__ __forceinline__ void gla_item(const Ctx& c0, int l, int item, LAS unsigned char* lds) {
    LAUNDER_CTX(c0, c);
    const int b = item / 5, h = item % 5, e = c.tid & 63, kg = c.tid >> 6;
    LAS float* rnum = (LAS float*)lds;
    const bf16_t* projb = c.proj() + (size_t)b * T * NPROJ;
    const float* gatesb = c.gates() + (size_t)b * T * 64;
    float* gs = c.hsgl() + (size_t)b * T * 320 + h * 64;
    const float* ng = c.in(11) + l * 320;
    const int doff = h * 32 + kg * 4;
    for (int dir = 0; dir < 2; ++dir) {
        const float* w2 = c.in(9) + ((size_t)l * 2 + dir) * 16 * 160; const float* ab = c.in(10) + ((size_t)l * 2 + dir) * 160;
        float w2r[16][4], abv[4], S[4];
#pragma unroll
        for (int j = 0; j < 4; ++j) { abv[j] = ab[doff + j]; S[j] = 0.f;
#pragma unroll
            for (int r = 0; r < 16; ++r) w2r[r][j] = w2[r * 160 + doff + j]; }
        for (int s = 0; s < T; ++s) {
            const int t = dir ? T - 1 - s : s;
            const float* gp = gatesb + (size_t)t * 64 + 24 + dir * 16;
            float ga[16];
#pragma unroll
            for (int r4 = 0; r4 < 4; ++r4) { const f32x4 x = *(const f32x4*)(gp + 4 * r4); ga[4 * r4] = x[0]; ga[4 * r4 + 1] = x[1]; ga[4 * r4 + 2] = x[2]; ga[4 * r4 + 3] = x[3]; }
            const unsigned long long qw = *(const unsigned long long*)(projb + (size_t)t * NPROJ + P_GQ + doff), kw = *(const unsigned long long*)(projb + (size_t)t * NPROJ + P_GK + doff);
            const float v = bf2f(projb[(size_t)t * NPROJ + P_GV + h * 64 + e]);
            float pn = 0.f;
#pragma unroll
            for (int j = 0; j < 4; ++j) {
                float z = abv[j];
#pragma unroll
                for (int r = 0; r < 16; ++r) z += ga[r] * w2r[r][j];
                const float la = (fminf(z, 0.f) - log1pf(__expf(-fabsf(z)))) * (1.0f / 16.0f);
                const float a = __expf(la);
                const float qd = bf2f((unsigned)(qw >> (16 * j)) & 0xffffu), kd = bf2f((unsigned)(kw >> (16 * j)) & 0xffffu);
                S[j] = a * S[j] + kd * v; pn += S[j] * qd;
            }
            const int p = s & 1;
            rnum[(p * 8 + kg) * 64 + e] = pn * 0.17677669529663687f;
            __syncthreads();
            if (kg == 0) {
                float o = 0.f;
#pragma unroll
                for (int g = 0; g < 8; ++g) o += rnum[(p * 8 + g) * 64 + e];
                if (dir == 0) gs[(size_t)t * 320 + e] = o;
                else { const float tot = gs[(size_t)t * 320 + e] + o; const float ss = wave_sum(tot * tot);
                    const float r = 1.0f / sqrtf(ss * (1.0f / 64) + EPS); const float gg = bf2f(projb[(size_t)t * NPROJ + P_GG + h * 64 + e]);
                    c.mixed()[((size_t)b * T + t) * D + 704 + h * 64 + e] = (bf16_t)f2bf(tot * r * ng[h * 64 + e] * gg * sigmoidf_(gg)); }
            }
        }
        __syncthreads();
    }
}
__device__ __forceinline__ void na_item(const Ctx& c0, int l, int item, LAS unsigned char* lds) {
    LAUNDER_CTX(c0, c);
    const int b = item / 160, h = (item % 160) / 32, r = item % 32;
    const int q = c.tid >> 3, s = c.tid & 7;
    LAS float* sc = (LAS float*)lds;
    const bf16_t* projb = c.proj() + (size_t)b * T * NPROJ;
    const float* rpb = c.in(8) + ((size_t)l * 5 + h) * 15 * 31;
    const int rs = min(max(r - 4, 0), 24), cs = min(max(q - 8, 0), 48);
    float qv[64];
    { const bf16_t* qp = projb + (size_t)(r * 64 + q) * NPROJ + P_NAQ + h * 64;
#pragma unroll
      for (int i = 0; i < 8; ++i) { float t8[8]; unpack8(*(const u32x4*)(qp + 8 * i), t8);
#pragma unroll
          for (int j = 0; j < 8; ++j) qv[8 * i + j] = t8[j]; } }
    const int tr = rs + s;
    for (int kk = 0; kk < 16; ++kk) { const int tc = cs + kk;
        const bf16_t* kp = projb + (size_t)(tr * 64 + tc) * NPROJ + P_NAK + h * 64; float d = 0.f;
#pragma unroll
        for (int i = 0; i < 8; ++i) { float t8[8]; unpack8(*(const u32x4*)(kp + 8 * i), t8);
#pragma unroll
            for (int j = 0; j < 8; ++j) d += qv[8 * i + j] * t8[j]; }
        const int dr = tr - r + 7, dc = min(max(tc - q, -15), 15) + 15;
        sc[q * 129 + s * 16 + kk] = d * 0.125f + rpb[dr * 31 + dc]; }
    __syncthreads();
    float mx = -3.0e38f; for (int k = 0; k < 128; ++k) mx = fmaxf(mx, sc[q * 129 + k]);
    float sum = 0.f; for (int k = 0; k < 128; ++k) sum += __expf(sc[q * 129 + k] - mx);
    __syncthreads();
    const float inv = 1.0f / sum;
    for (int kk = 0; kk < 16; ++kk) sc[q * 129 + s * 16 + kk] = __expf(sc[q * 129 + s * 16 + kk] - mx) * inv;
    __syncthreads();
    float o[8];
#pragma unroll
    for (int j = 0; j < 8; ++j) o[j] = 0.f;
    for (int key = 0; key < 128; ++key) { const int trr = rs + (key >> 4), tcc = cs + (key & 15);
        float t8[8]; unpack8(*(const u32x4*)(projb + (size_t)(trr * 64 + tcc) * NPROJ + P_NAV + h * 64 + s * 8), t8); const float p = sc[q * 129 + key];
#pragma unroll
        for (int j = 0; j < 8; ++j) o[j] += p * t8[j]; }
    u32x4 w; w.x = pk2(o[0], o[1]); w.y = pk2(o[2], o[3]); w.z = pk2(o[4], o[5]); w.w = pk2(o[6], o[7]);
    *(u32x4*)(c.mixed() + ((size_t)b * T + r * 64 + q) * D + 384 + h * 64 + s * 8) = w;
    __syncthreads();
}
__device__ __forceinline__ void xattn_item(const Ctx& c0, int item, LAS unsigned char* lds) {
    LAUNDER_CTX(c0, c);
    const int b = item / 256, hd = (item / 64) % 4, qt = item % 64; const int row0 = b * T + qt * 32;
    LAS float* qs = (LAS float*)lds;
    LAS float* ps = (LAS float*)lds + 8192;
    const int qi = c.tid >> 4, sub = c.tid & 15;
    { const bf16_t* qp = c.q() + (size_t)(row0 + qi) * D + hd * 256 + sub * 16; float t8[8];
      unpack8(*(const u32x4*)qp, t8);
#pragma unroll
      for (int j = 0; j < 8; ++j) qs[qi * 256 + sub * 16 + j] = t8[j];
      unpack8(*(const u32x4*)(qp + 8), t8);
#pragma unroll
      for (int j = 0; j < 8; ++j) qs[qi * 256 + sub * 16 + 8 + j] = t8[j]; }
    __syncthreads();
    const bf16_t* kvb = c.memkv() + (size_t)b * NMEM * 2048 + hd * 256;
    float acc[16];
#pragma unroll
    for (int j = 0; j < 16; ++j) acc[j] = 0.f;
    for (int dc = 0; dc < 32; ++dc) {
        float qr[8];
#pragma unroll
        for (int i = 0; i < 8; ++i) qr[i] = qs[qi * 256 + dc * 8 + i];
#pragma unroll
        for (int j = 0; j < 16; ++j) { float t8[8]; unpack8(*(const u32x4*)(kvb + (size_t)(sub + 16 * j) * 2048 + dc * 8), t8);
#pragma unroll
            for (int i = 0; i < 8; ++i) acc[j] += qr[i] * t8[i]; }
    }
    float mx = -3.0e38f;
#pragma unroll
    for (int j = 0; j < 16; ++j) { acc[j] *= 0.0625f; mx = fmaxf(mx, acc[j]); }
#pragma unroll
    for (int o = 1; o < 16; o <<= 1) mx = fmaxf(mx, __shfl_xor(mx, o));
    float sum = 0.f;
#pragma unroll
    for (int j = 0; j < 16; ++j) { acc[j] = __expf(acc[j] - mx); sum += acc[j]; }
#pragma unroll
    for (int o = 1; o < 16; o <<= 1) sum += __shfl_xor(sum, o);
    const float inv = 1.0f / sum;
#pragma unroll
    for (int j = 0; j < 16; ++j) ps[qi * 256 + sub + 16 * j] = acc[j] * inv;
    __syncthreads();
    float o[16];
#pragma unroll
    for (int j = 0; j < 16; ++j) o[j] = 0.f;
    for (int key = 0; key < 256; ++key) { const float p = ps[qi * 256 + key]; const bf16_t* vp = kvb + (size_t)key * 2048 + 1024 + sub * 16; float t8[8];
        unpack8(*(const u32x4*)vp, t8);
#pragma unroll
        for (int j = 0; j < 8; ++j) o[j] += p * t8[j];
        unpack8(*(const u32x4*)(vp + 8), t8);
#pragma unroll
        for (int j = 0; j < 8; ++j) o[8 + j] += p * t8[j]; }
    bf16_t* op = c.mixed() + (size_t)(row0 + qi) * D + hd * 256 + sub * 16;
    u32x4 w; w.x = pk2(o[0], o[1]); w.y = pk2(o[2], o[3]); w.z = pk2(o[4], o[5]); w.w = pk2(o[6], o[7]); *(u32x4*)op = w;
    w.x = pk2(o[8], o[9]); w.y = pk2(o[10], o[11]); w.z = pk2(o[12], o[13]); w.w = pk2(o[14], o[15]); *(u32x4*)(op + 8) = w;
    __syncthreads();
}
__device__ __forceinline__ void act_pass(const Ctx& c, int l) {
    const float* cw = c.in(21) + (size_t)l * 3 * DFF; const float* cb = c.in(22) + (size_t)l * DFF;
    constexpr int CH = DFF / 8;
    for (int idx = c.bid * NTHREADS + c.tid; idx < M * CH; idx += c.G * NTHREADS) {
        const int row = idx / CH, c8 = (idx % CH) * 8, t = row % T;
        const bf16_t* up = c.u() + (size_t)row * NUP + c8;
        float a0[8], am[8], ap[8], g[8];
        unpack8(*(const u32x4*)up, a0); unpack8(*(const u32x4*)(up + DFF), g);
        if (t > 0) unpack8(*(const u32x4*)(up - NUP), am); else {
#pragma unroll
            for (int j = 0; j < 8; ++j) am[j] = 0.f; }
        if (t < T - 1) unpack8(*(const u32x4*)(up + NUP), ap); else {
#pragma unroll
            for (int j = 0; j < 8; ++j) ap[j] = 0.f; }
        float o[8];
#pragma unroll
        for (int j = 0; j < 8; ++j) { const float a = am[j] * cw[c8 + j] + a0[j] * cw[DFF + c8 + j] + ap[j] * cw[2 * DFF + c8 + j] + cb[c8 + j];
            const float uu = 0.7978845608028654f * (a + 0.044715f * a * a * a);
            o[j] = a / (1.f + __expf(-2.f * uu)) * g[j]; }
        u32x4 w; w.x = pk2(o[0], o[1]); w.y = pk2(o[2], o[3]); w.z = pk2(o[4], o[5]); w.w = pk2(o[6], o[7]);
        *(u32x4*)(c.act() + (size_t)row * DFF + c8) = w;
    }
}
typedef short s16x4 __attribute__((ext_vector_type(4)));
#define MFMA16(a, b, c) __builtin_amdgcn_mfma_f32_16x16x32_bf16((a), (b), (c), 0, 0, 0)
__device__ __forceinline__ bf16x8 frag_nt(LAS const unsigned char* tile, int pitch, int row, int kbyte) {
    return *(const LAS bf16x8*)(tile + row * pitch + kbyte);
}
__device__ __forceinline__ bf16x8 frag_tr(LAS const unsigned char* tile, int pitch, int r0, int r1, int n0, int lane) {
    const int q4 = (lane & 15) >> 2, p4 = lane & 3;
    const unsigned a0 = (unsigned)(size_t)tile + (unsigned)((r0 + q4) * pitch + (n0 + 4 * p4) * 2), a1 = (unsigned)(size_t)tile + (unsigned)((r1 + q4) * pitch + (n0 + 4 * p4) * 2);
    s16x4 x, y;
    asm volatile("ds_read_b64_tr_b16 %0, %2\n\tds_read_b64_tr_b16 %1, %3\n\ts_waitcnt lgkmcnt(0)" : "=&v"(x), "=&v"(y) : "v"(a0), "v"(a1) : "memory");
    return (bf16x8){x[0], x[1], x[2], x[3], y[0], y[1], y[2], y[3]};
}
__device__ __forceinline__ bf16x8 pack_frag(const f32x4 lo, const f32x4 hi) {
    u32x4 w; w.x = cvt_pk_bf16(lo[0], lo[1]); w.y = cvt_pk_bf16(lo[2], lo[3]); w.z = cvt_pk_bf16(hi[0], hi[1]); w.w = cvt_pk_bf16(hi[2], hi[3]);
    return __builtin_bit_cast(bf16x8, w);
}
__device__ __forceinline__ float logsigmoidf_(float x) { return fminf(x, 0.f) - log1pf(__expf(-fabsf(x))); }
__device__ __forceinline__ float wave_incl_scan(float v, int lane) {
#pragma unroll
    for (int o = 1; o < 64; o <<= 1) { const float t = __shfl_up(v, o); if (lane >= o) v += t; }
    return v;
}
constexpr int P64 = 144;

__device__ __forceinline__ bf16_t* mlc_ptr(const Ctx& c, int b, int h, int dir, int ch) { return c.wsp<bf16_t>(WS_HSML) + (size_t)((((b * 6 + h) * 2 + dir) * 16) + ch) * 80 * 64; }

template <bool ROWW>
__device__ __forceinline__ void ml_stage_conv(const Ctx& c, const bf16_t* projb, int t0, int pcol, const float* cwp, const float* cbp, int cch, float scale, const LAS float* roww, LAS unsigned char* tile) {
    const int j = c.tid >> 2, cb = (c.tid & 3) * 16, t = t0 + j;
    float lo[16], mid[16], hi[16];
    { const bf16_t* p = projb + (size_t)t * NPROJ + pcol + cb; float t8[8];
      unpack8(*(const u32x4*)p, t8);
#pragma unroll
      for (int x = 0; x < 8; ++x) mid[x] = t8[x];
      unpack8(*(const u32x4*)(p + 8), t8);
#pragma unroll
      for (int x = 0; x < 8; ++x) mid[8 + x] = t8[x];
      if (t > 0) { unpack8(*(const u32x4*)(p - NPROJ), t8);
#pragma unroll
          for (int x = 0; x < 8; ++x) lo[x] = t8[x];
          unpack8(*(const u32x4*)(p - NPROJ + 8), t8);
#pragma unroll
          for (int x = 0; x < 8; ++x) lo[8 + x] = t8[x]; }
      else {
#pragma unroll
          for (int x = 0; x < 16; ++x) lo[x] = 0.f; }
      if (t < T - 1) { unpack8(*(const u32x4*)(p + NPROJ), t8);
#pragma unroll
          for (int x = 0; x < 8; ++x) hi[x] = t8[x];
          unpack8(*(const u32x4*)(p + NPROJ + 8), t8);
#pragma unroll
          for (int x = 0; x < 8; ++x) hi[8 + x] = t8[x]; }
      else {
#pragma unroll
          for (int x = 0; x < 16; ++x) hi[x] = 0.f; } }
    const float rw = ROWW ? roww[j] * scale : scale;
    float o[16];
#pragma unroll
    for (int x = 0; x < 16; ++x) { const int ch = cch + cb + x;
        const float y = lo[x] * cwp[ch] + mid[x] * cwp[768 + ch] + hi[x] * cwp[1536 + ch] + cbp[ch];
        o[x] = y * sigmoidf_(y) * rw; }
    u32x4 w0, w1; w0.x = pk2(o[0], o[1]); w0.y = pk2(o[2], o[3]); w0.z = pk2(o[4], o[5]); w0.w = pk2(o[6], o[7]);
    w1.x = pk2(o[8], o[9]); w1.y = pk2(o[10], o[11]); w1.z = pk2(o[12], o[13]); w1.w = pk2(o[14], o[15]);
    *(LAS u32x4*)(tile + j * P64 + cb * 2) = w0; *(LAS u32x4*)(tile + j * P64 + cb * 2 + 16) = w1;
}
__device__ __forceinline__ void ml_stage_plain(const Ctx& c, const bf16_t* projb, int t0, int pcol, LAS unsigned char* tile) {
    const int j = c.tid >> 2, cb = (c.tid & 3) * 16; const bf16_t* p = projb + (size_t)(t0 + j) * NPROJ + pcol + cb;
    *(LAS u32x4*)(tile + j * P64 + cb * 2) = *(const u32x4*)p; *(LAS u32x4*)(tile + j * P64 + cb * 2 + 16) = *(const u32x4*)(p + 8);
}
__device__ __forceinline__ float ml_gate_scan(const float* gatesb, int t0, int dir, int h, float bi, float bf_, LAS float* bcum, LAS float* ii, int lane) {
    const float* g0 = gatesb + (size_t)(t0 + 2 * lane) * 64; const float* g1 = g0 + 64;
    const float i0 = g0[(2 * dir) * 6 + h] + bi, i1 = g1[(2 * dir) * 6 + h] + bi;
    const float f0 = logsigmoidf_(g0[(2 * dir + 1) * 6 + h] + bf_), f1 = logsigmoidf_(g1[(2 * dir + 1) * 6 + h] + bf_);
    const float inc = wave_incl_scan(f0 + f1, lane), tot = __shfl(inc, 63);
    float b0, b1;
    if (dir == 0) { b0 = inc - f1; b1 = inc; } else { b1 = tot - inc + f1; b0 = b1 + f0; }
    bcum[2 * lane] = b0; bcum[2 * lane + 1] = b1; ii[2 * lane] = i0; ii[2 * lane + 1] = i1;
    return tot;
}

__device__ __forceinline__ void ml_state_item(const Ctx& c0, int l, int item, LAS unsigned char* lds) {
    LAUNDER_CTX(c0, c);
    const int b = item / 12, h = (item % 12) >> 1, dir = item & 1;
    const int lane = c.lane, w = c.wave, i = lane & 15, g = lane >> 4;
    LAS unsigned char* Kw = lds;
    LAS unsigned char* Vt = lds + 128 * P64;
    LAS float* wj = (LAS float*)(lds + 2 * 128 * P64);
    LAS float* bcum = wj + 128; LAS float* iiv = wj + 256; LAS float* nst = wj + 384; LAS float* misc = wj + 448;
    const bf16_t* projb = c.proj() + (size_t)b * T * NPROJ; const float* gatesb = c.gates() + (size_t)b * T * 64;
    const float* cwp = c.in(4) + (size_t)l * 3 * 768; const float* cbp = c.in(5) + (size_t)l * 768; const float* gb = c.in(6) + l * 24;
    const float bi = gb[(2 * dir) * 6 + h], bf_ = gb[(2 * dir + 1) * 6 + h];
    const int td = w >> 1, te0 = (w & 1) * 2;
    f32x4 acc[2] = {{0.f, 0.f, 0.f, 0.f}, {0.f, 0.f, 0.f, 0.f}};
    if (c.tid < 64) nst[c.tid] = 0.f;
    __syncthreads();
    for (int cc = 0; cc < 16; ++cc) {
        const int ch = dir ? 15 - cc : cc, t0 = ch * 128;
        bf16_t* st = mlc_ptr(c, b, h, dir, ch);
#pragma unroll
        for (int x = 0; x < 2; ++x) { const int e = 16 * (te0 + x) + i, d = 16 * td + 4 * g;
            *(unsigned long long*)(st + e * 64 + d) = (unsigned long long)cvt_pk_bf16(acc[x][0], acc[x][1]) | ((unsigned long long)cvt_pk_bf16(acc[x][2], acc[x][3]) << 32); }
        if (c.tid < 64) st[64 * 64 + c.tid] = (bf16_t)f2bf(nst[c.tid]);
        for (int x = c.tid; x < 15 * 64 / 8; x += NTHREADS) *(u32x4*)(st + 65 * 64 + x * 8) = (u32x4){0u, 0u, 0u, 0u};
        if (cc == 15) break;
        if (w == 0) { const float tot = ml_gate_scan(gatesb, t0, dir, h, bi, bf_, bcum, iiv, lane);
            wj[2 * lane] = __expf(tot - bcum[2 * lane] + iiv[2 * lane]); wj[2 * lane + 1] = __expf(tot - bcum[2 * lane + 1] + iiv[2 * lane + 1]);
            if (lane == 0) misc[0] = __expf(tot); }
        __syncthreads();
        ml_stage_conv<true>(c, projb, t0, P_MLK + h * 64, cwp, cbp, 384 + h * 64, 0.125f, wj, Kw);
        ml_stage_plain(c, projb, t0, P_MLV + h * 64, Vt);
        __syncthreads();
        const float eg = misc[0];
        acc[0] = acc[0] * eg; acc[1] = acc[1] * eg;
#pragma unroll
        for (int s = 0; s < 4; ++s) { const int r0 = 32 * s + 8 * g, r1 = r0 + 4;
            const bf16x8 a = frag_tr(Kw, P64, r0, r1, 16 * td, lane);
#pragma unroll
            for (int x = 0; x < 2; ++x) { const bf16x8 bb = frag_tr(Vt, P64, r0, r1, 16 * (te0 + x), lane); acc[x] = MFMA16(a, bb, acc[x]); } }
        if (c.tid < 64) { float s = 0.f; for (int j = 0; j < 128; ++j) s += bf2f(*(const LAS unsigned short*)(Kw + j * P64 + c.tid * 2)); nst[c.tid] = eg * nst[c.tid] + s; }
        __syncthreads();
    }
}

__device__ __forceinline__ void ml_out_item(const Ctx& c0, int l, int item, LAS unsigned char* lds) {
    LAUNDER_CTX(c0, c);
    const int b = item / 96, h = (item % 96) / 16, ch = item % 16, t0 = ch * 128;
    const int lane = c.lane, w = c.wave, i = lane & 15, g = lane >> 4;
    LAS unsigned char* Qt = lds; LAS unsigned char* Kt = lds + 128 * P64; LAS unsigned char* Vt = lds + 2 * 128 * P64;
    LAS unsigned char* Cf = lds + 3 * 128 * P64; LAS unsigned char* Cb = Cf + 80 * P64;
    LAS float* bF = (LAS float*)(Cb + 80 * P64); LAS float* iF = bF + 128; LAS float* bB = bF + 256; LAS float* iB = bF + 384;
    const bf16_t* projb = c.proj() + (size_t)b * T * NPROJ; const float* gatesb = c.gates() + (size_t)b * T * 64;
    const float* cwp = c.in(4) + (size_t)l * 3 * 768; const float* cbp = c.in(5) + (size_t)l * 768; const float* gb = c.in(6) + l * 24;
    if (w == 0) (void)ml_gate_scan(gatesb, t0, 0, h, gb[0 * 6 + h], gb[1 * 6 + h], bF, iF, lane);
    if (w == 1) (void)ml_gate_scan(gatesb, t0, 1, h, gb[2 * 6 + h], gb[3 * 6 + h], bB, iB, lane);
    ml_stage_conv<false>(c, projb, t0, P_MLQ + h * 64, cwp, cbp, h * 64, 1.0f, nullptr, Qt);
    ml_stage_conv<false>(c, projb, t0, P_MLK + h * 64, cwp, cbp, 384 + h * 64, 0.125f, nullptr, Kt);
    ml_stage_plain(c, projb, t0, P_MLV + h * 64, Vt);
    { const bf16_t* sf = mlc_ptr(c, b, h, 0, ch); const bf16_t* sb = mlc_ptr(c, b, h, 1, ch);
      for (int x = c.tid; x < 80 * 8; x += NTHREADS) { const int r = x >> 3, k8 = x & 7;
          *(LAS u32x4*)(Cf + r * P64 + k8 * 16) = *(const u32x4*)(sf + r * 64 + k8 * 8); *(LAS u32x4*)(Cb + r * P64 + k8 * 16) = *(const u32x4*)(sb + r * 64 + k8 * 8); } }
    __syncthreads();
    const int ti = w, qi = 16 * ti + i;
    const bf16x8 q0 = frag_nt(Qt, P64, qi, 16 * g), q1 = frag_nt(Qt, P64, qi, 64 + 16 * g);
    const float bFq = bF[qi], bBq = bB[qi];
    f32x4 of[4], ob[4];
#pragma unroll
    for (int x = 0; x < 4; ++x) { of[x] = (f32x4){0.f, 0.f, 0.f, 0.f}; ob[x] = (f32x4){0.f, 0.f, 0.f, 0.f}; }
    float denf = 0.f, denb = 0.f;
#pragma unroll
    for (int s4 = 0; s4 < 4; ++s4) {
        const bool dof = (2 * s4 <= ti), dob = (2 * s4 + 1 >= ti);
        f32x4 pf[2], pb[2];
#pragma unroll
        for (int x = 0; x < 2; ++x) { const int tj = 2 * s4 + x;
            f32x4 s = (f32x4){0.f, 0.f, 0.f, 0.f};
            s = MFMA16(frag_nt(Kt, P64, 16 * tj + i, 16 * g), q0, s); s = MFMA16(frag_nt(Kt, P64, 16 * tj + i, 64 + 16 * g), q1, s);
#pragma unroll
            for (int r = 0; r < 4; ++r) { const int j = 16 * tj + 4 * g + r;
                const float wf = (j <= qi) ? __expf(bFq - bF[j] + iF[j]) : 0.f, wb = (j >= qi) ? __expf(bBq - bB[j] + iB[j]) : 0.f;
                pf[x][r] = s[r] * wf; pb[x][r] = s[r] * wb; denf += pf[x][r]; denb += pb[x][r]; } }
        const int r0 = 32 * s4 + 4 * g, r1 = r0 + 16;
        if (dof) { const bf16x8 p = pack_frag(pf[0], pf[1]);
#pragma unroll
            for (int te = 0; te < 4; ++te) of[te] = MFMA16(frag_tr(Vt, P64, r0, r1, 16 * te, lane), p, of[te]); }
        if (dob) { const bf16x8 p = pack_frag(pb[0], pb[1]);
#pragma unroll
            for (int te = 0; te < 4; ++te) ob[te] = MFMA16(frag_tr(Vt, P64, r0, r1, 16 * te, lane), p, ob[te]); }
    }
    denf += __shfl_xor(denf, 16); denf += __shfl_xor(denf, 32); denb += __shfl_xor(denb, 16); denb += __shfl_xor(denb, 32);
    { const float ef = __expf(bFq), eb = __expf(bBq);
#pragma unroll
      for (int te = 0; te < 5; ++te) {
          f32x4 tf = (f32x4){0.f, 0.f, 0.f, 0.f}, tb = (f32x4){0.f, 0.f, 0.f, 0.f};
          tf = MFMA16(frag_nt(Cf, P64, 16 * te + i, 16 * g), q0, tf); tf = MFMA16(frag_nt(Cf, P64, 16 * te + i, 64 + 16 * g), q1, tf);
          tb = MFMA16(frag_nt(Cb, P64, 16 * te + i, 16 * g), q0, tb); tb = MFMA16(frag_nt(Cb, P64, 16 * te + i, 64 + 16 * g), q1, tb);
          if (te < 4) { of[te] = of[te] + tf * ef; ob[te] = ob[te] + tb * eb; }
          else { denf += ef * __shfl(tf[0], i); denb += eb * __shfl(tb[0], i); } } }
    const float rf = 1.0f / fmaxf(fabsf(denf), 1.f), rb = 1.0f / fmaxf(fabsf(denb), 1.f);
    float ss = 0.f;
#pragma unroll
    for (int te = 0; te < 4; ++te) { of[te] = of[te] * rf + ob[te] * rb; ss += (of[te][0] * of[te][0] + of[te][1] * of[te][1]) + (of[te][2] * of[te][2] + of[te][3] * of[te][3]); }
    ss += __shfl_xor(ss, 16); ss += __shfl_xor(ss, 32);
    const float rn = 1.0f / sqrtf(ss * (1.0f / 64) + EPS);
    const float* ng = c.in(7) + l * 384 + h * 64;
    const size_t row = (size_t)b * T + t0 + qi;
#pragma unroll
    for (int te = 0; te < 4; ++te) { const int e = 16 * te + 4 * g;
        const unsigned long long ow = *(const unsigned long long*)(projb + (size_t)(t0 + qi) * NPROJ + P_MLO + h * 64 + e);
        float o4[4];
#pragma unroll
        for (int r = 0; r < 4; ++r) { const float og = bf2f((unsigned)(ow >> (16 * r)) & 0xffffu); o4[r] = of[te][r] * rn * ng[e + r] * sigmoidf_(og); }
        *(unsigned long long*)(c.mixed() + row * D + h * 64 + e) = (unsigned long long)pk2(o4[0], o4[1]) | ((unsigned long long)pk2(o4[2], o4[3]) << 32); }
    __syncthreads();
}

constexpr int P32 = 80;
constexpr int LAP = 33;
__device__ __forceinline__ bf16_t* glc_ptr(const Ctx& c, int b, int h, int dir, int ch) { return c.wsp<bf16_t>(WS_HSGL) + (size_t)((((b * 5 + h) * 2 + dir) * 32) + ch) * 64 * 32; }
__device__ __forceinline__ void gla_loga(const Ctx& c, const float* gatesb, int t0, int nrows, int dir, const LAS float* w2s  , const LAS float* abs_  , LAS float* la  ) {
    for (int x = c.tid; x < nrows * 8; x += NTHREADS) { const int j = x >> 3, d4 = (x & 7) * 4;
        const float* gp = gatesb + (size_t)(t0 + j) * 64 + 24 + dir * 16; float ga[16];
#pragma unroll
        for (int r4 = 0; r4 < 4; ++r4) { const f32x4 v = *(const f32x4*)(gp + 4 * r4); ga[4 * r4] = v[0]; ga[4 * r4 + 1] = v[1]; ga[4 * r4 + 2] = v[2]; ga[4 * r4 + 3] = v[3]; }
#pragma unroll
        for (int y = 0; y < 4; ++y) { float z = abs_[d4 + y];
#pragma unroll
            for (int r = 0; r < 16; ++r) z += ga[r] * w2s[r * 32 + d4 + y];
            la[j * LAP + d4 + y] = logsigmoidf_(z) * (1.0f / 16.0f); } }
}
__device__ __forceinline__ void gla_scan64(LAS float* la  , int dir, int d, int lane, LAS float* tot) {
    const float v = la[lane * LAP + d]; const float inc = wave_incl_scan(v, lane), t = __shfl(inc, 63);
    la[lane * LAP + d] = dir ? (t - inc + v) : inc;
    if (tot && lane == 0) tot[d] = t;
}

__device__ __forceinline__ void gla_state_item(const Ctx& c0, int l, int item, LAS unsigned char* lds) {
    LAUNDER_CTX(c0, c);
    const int b = item / 10, h = (item % 10) >> 1, dir = item & 1;
    const int lane = c.lane, w = c.wave, i = lane & 15, g = lane >> 4;
    LAS unsigned char* Kt = lds;
    LAS unsigned char* Vt = lds + 64 * P32;
    LAS float* la = (LAS float*)(lds + 64 * P32 + 64 * P64);
    LAS float* btot = la + 64 * LAP; LAS float* w2s = btot + 32; LAS float* abs_ = w2s + 512;
    const bf16_t* projb = c.proj() + (size_t)b * T * NPROJ; const float* gatesb = c.gates() + (size_t)b * T * 64;
    { const float* w2 = c.in(9) + ((size_t)l * 2 + dir) * 16 * 160; const float* ab = c.in(10) + ((size_t)l * 2 + dir) * 160;
      w2s[c.tid] = w2[(c.tid >> 5) * 160 + h * 32 + (c.tid & 31)]; if (c.tid < 32) abs_[c.tid] = ab[h * 32 + c.tid]; }
    const int td = w >> 2, te = w & 3;
    f32x4 acc = {0.f, 0.f, 0.f, 0.f};
    __syncthreads();
    for (int cc = 0; cc < 32; ++cc) {
        const int ch = dir ? 31 - cc : cc, t0 = ch * 64;
        { bf16_t* st = glc_ptr(c, b, h, dir, ch); const int e = 16 * te + i, d = 16 * td + 4 * g;
          *(unsigned long long*)(st + e * 32 + d) = (unsigned long long)cvt_pk_bf16(acc[0], acc[1]) | ((unsigned long long)cvt_pk_bf16(acc[2], acc[3]) << 32); }
        if (cc == 31) break;
        gla_loga(c, gatesb, t0, 64, dir, w2s, abs_, la);
        __syncthreads();
#pragma unroll
        for (int y = 0; y < 4; ++y) gla_scan64(la, dir, w * 4 + y, lane, btot);
        __syncthreads();
        { const int j = c.tid >> 3, d4 = (c.tid & 7) * 4;
          const unsigned long long kw = *(const unsigned long long*)(projb + (size_t)(t0 + j) * NPROJ + P_GK + h * 32 + d4); float o[4];
#pragma unroll
          for (int y = 0; y < 4; ++y) o[y] = bf2f((unsigned)(kw >> (16 * y)) & 0xffffu) * __expf(btot[d4 + y] - la[j * LAP + d4 + y]);
          *(LAS unsigned long long*)(Kt + j * P32 + d4 * 2) = (unsigned long long)pk2(o[0], o[1]) | ((unsigned long long)pk2(o[2], o[3]) << 32);
          const int e8 = (c.tid & 7) * 8; *(LAS u32x4*)(Vt + j * P64 + e8 * 2) = *(const u32x4*)(projb + (size_t)(t0 + j) * NPROJ + P_GV + h * 64 + e8); }
        __syncthreads();
#pragma unroll
        for (int r = 0; r < 4; ++r) acc[r] *= __expf(btot[16 * td + 4 * g + r]);
#pragma unroll
        for (int s = 0; s < 2; ++s) { const int r0 = 32 * s + 8 * g, r1 = r0 + 4;
            acc = MFMA16(frag_tr(Kt, P32, r0, r1, 16 * td, lane), frag_tr(Vt, P64, r0, r1, 16 * te, lane), acc); }
        __syncthreads();
    }
}

__device__ __forceinline__ void gla_out_item(const Ctx& c0, int l, int item, LAS unsigned char* lds) {
    LAUNDER_CTX(c0, c);
    const int b = item / 80, h = (item % 80) / 16, cp = item % 16, t0 = cp * 128;
    const int lane = c.lane, w = c.wave, i = lane & 15, g = lane >> 4;
    LAS unsigned char* Qf = lds; LAS unsigned char* Kf = Qf + 128 * P32; LAS unsigned char* Qb = Kf + 128 * P32; LAS unsigned char* Kb = Qb + 128 * P32;
    LAS unsigned char* Vt = Kb + 128 * P32;
    LAS unsigned char* Sf = Vt + 128 * P64;
    LAS unsigned char* Sb = Sf + 2 * 64 * P32;
    LAS float* laf = (LAS float*)(Sb + 2 * 64 * P32);
    LAS float* lab = laf + 128 * LAP; LAS float* w2s = lab + 128 * LAP; LAS float* abs_ = w2s + 1024;
    const bf16_t* projb = c.proj() + (size_t)b * T * NPROJ; const float* gatesb = c.gates() + (size_t)b * T * 64;
    { const float* w2 = c.in(9) + (size_t)l * 2 * 16 * 160; const float* ab = c.in(10) + (size_t)l * 2 * 160;
      for (int x = c.tid; x < 1024; x += NTHREADS) w2s[x] = w2[(x >> 5) * 160 + h * 32 + (x & 31)];
      if (c.tid < 64) abs_[c.tid] = ab[(c.tid >> 5) * 160 + h * 32 + (c.tid & 31)]; }
    __syncthreads();
    gla_loga(c, gatesb, t0, 128, 0, w2s, abs_, laf);
    gla_loga(c, gatesb, t0, 128, 1, w2s + 512, abs_ + 32, lab);
    __syncthreads();
#pragma unroll 4
    for (int y = 0; y < 16; ++y) { const int sidx = w * 16 + y, dir = sidx >> 6, sub = (sidx >> 5) & 1, d = sidx & 31;
        gla_scan64((dir ? lab : laf) + sub * 64 * LAP, dir, d, lane, nullptr); }
    __syncthreads();
    { const int j = c.tid >> 2, d8 = (c.tid & 3) * 8;
      float q8[8], k8[8];
      unpack8(*(const u32x4*)(projb + (size_t)(t0 + j) * NPROJ + P_GQ + h * 32 + d8), q8); unpack8(*(const u32x4*)(projb + (size_t)(t0 + j) * NPROJ + P_GK + h * 32 + d8), k8);
      float oqf[8], okf[8], oqb[8], okb[8];
#pragma unroll
      for (int y = 0; y < 8; ++y) { const float bf_ = laf[j * LAP + d8 + y], bb_ = lab[j * LAP + d8 + y];
          oqf[y] = q8[y] * 0.17677669529663687f * __expf(bf_); okf[y] = k8[y] * __expf(-bf_); oqb[y] = q8[y] * 0.17677669529663687f * __expf(bb_); okb[y] = k8[y] * __expf(-bb_); }
      u32x4 x;
      x.x = pk2(oqf[0], oqf[1]); x.y = pk2(oqf[2], oqf[3]); x.z = pk2(oqf[4], oqf[5]); x.w = pk2(oqf[6], oqf[7]); *(LAS u32x4*)(Qf + j * P32 + d8 * 2) = x;
      x.x = pk2(okf[0], okf[1]); x.y = pk2(okf[2], okf[3]); x.z = pk2(okf[4], okf[5]); x.w = pk2(okf[6], okf[7]); *(LAS u32x4*)(Kf + j * P32 + d8 * 2) = x;
      x.x = pk2(oqb[0], oqb[1]); x.y = pk2(oqb[2], oqb[3]); x.z = pk2(oqb[4], oqb[5]); x.w = pk2(oqb[6], oqb[7]); *(LAS u32x4*)(Qb + j * P32 + d8 * 2) = x;
      x.x = pk2(okb[0], okb[1]); x.y = pk2(okb[2], okb[3]); x.z = pk2(okb[4], okb[5]); x.w = pk2(okb[6], okb[7]); *(LAS u32x4*)(Kb + j * P32 + d8 * 2) = x; }
    ml_stage_plain(c, projb, t0, P_GV + h * 64, Vt);
    for (int x = c.tid; x < 2 * 2 * 64 * 4; x += NTHREADS) { const int dir = x >> 9, sub = (x >> 8) & 1, r = (x >> 2) & 63, k4 = x & 3;
        const bf16_t* s = glc_ptr(c, b, h, dir, 2 * cp + sub); *(LAS u32x4*)((dir ? Sb : Sf) + (sub * 64 + r) * P32 + k4 * 16) = *(const u32x4*)(s + r * 32 + k4 * 8); }
    __syncthreads();
    const int sub = w >> 2, ti = w & 3, R = 64 * sub, qi = 16 * ti + i;
    const bf16x8 qf = frag_nt(Qf, P32, R + qi, 16 * g), qb = frag_nt(Qb, P32, R + qi, 16 * g);
    f32x4 o[4];
#pragma unroll
    for (int te = 0; te < 4; ++te) o[te] = (f32x4){0.f, 0.f, 0.f, 0.f};
#pragma unroll
    for (int s2 = 0; s2 < 2; ++s2) {
        f32x4 p[2];
#pragma unroll
        for (int x = 0; x < 2; ++x) { const int tj = 2 * s2 + x; const f32x4 z = {0.f, 0.f, 0.f, 0.f};
            const f32x4 sf = MFMA16(frag_nt(Kf, P32, R + 16 * tj + i, 16 * g), qf, z), sb = MFMA16(frag_nt(Kb, P32, R + 16 * tj + i, 16 * g), qb, z);
#pragma unroll
            for (int r = 0; r < 4; ++r) { const int j = 16 * tj + 4 * g + r; p[x][r] = ((j <= qi) ? sf[r] : 0.f) + ((j >= qi) ? sb[r] : 0.f); } }
        const bf16x8 pp = pack_frag(p[0], p[1]); const int r0 = R + 32 * s2 + 4 * g, r1 = r0 + 16;
#pragma unroll
        for (int te = 0; te < 4; ++te) o[te] = MFMA16(frag_tr(Vt, P64, r0, r1, 16 * te, lane), pp, o[te]);
    }
#pragma unroll
    for (int te = 0; te < 4; ++te) { o[te] = MFMA16(frag_nt(Sf, P32, R + 16 * te + i, 16 * g), qf, o[te]); o[te] = MFMA16(frag_nt(Sb, P32, R + 16 * te + i, 16 * g), qb, o[te]); }
    float ss = 0.f;
#pragma unroll
    for (int te = 0; te < 4; ++te) ss += (o[te][0] * o[te][0] + o[te][1] * o[te][1]) + (o[te][2] * o[te][2] + o[te][3] * o[te][3]);
    ss += __shfl_xor(ss, 16); ss += __shfl_xor(ss, 32);
    const float rn = 1.0f / sqrtf(ss * (1.0f / 64) + EPS);
    const float* ng = c.in(11) + l * 320 + h * 64;
    const int tq = t0 + R + qi;
#pragma unroll
    for (int te = 0; te < 4; ++te) { const int e = 16 * te + 4 * g;
        const unsigned long long gw = *(const unsigned long long*)(projb + (size_t)tq * NPROJ + P_GG + h * 64 + e); float o4[4];
#pragma unroll
        for (int r = 0; r < 4; ++r) { const float gg = bf2f((unsigned)(gw >> (16 * r)) & 0xffffu); o4[r] = o[te][r] * rn * ng[e + r] * gg * sigmoidf_(gg); }
        *(unsigned long long*)(c.mixed() + ((size_t)b * T + tq) * D + 704 + h * 64 + e) = (unsigned long long)pk2(o4[0], o4[1]) | ((unsigned long long)pk2(o4[2], o4[3]) << 32); }
    __syncthreads();
}

__device__ __forceinline__ int clampi(int v, int lo, int hi) { return min(max(v, lo), hi); }
__device__ __forceinline__ void na_mfma_item(const Ctx& c0, int l, int item, LAS unsigned char* lds) {
    LAUNDER_CTX(c0, c);
    const int b = item / 40, h = (item % 40) / 8, r0 = (item % 8) * 4;
    const int lane = c.lane, w = c.wave, i = lane & 15, g = lane >> 4;
    LAS unsigned char* Vb = lds;
    LAS float* rp = (LAS float*)(lds + 704 * P64);
    const bf16_t* projb = c.proj() + (size_t)b * T * NPROJ;
    const int base = clampi(r0 - 4, 0, 24), nrow = clampi(r0 - 1, 0, 24) + 8 - base;
    for (int x = c.tid; x < nrow * 64 * 8; x += NTHREADS) { const int key = x >> 3, c8 = x & 7;
        *(LAS u32x4*)(Vb + key * P64 + c8 * 16) = *(const u32x4*)(projb + (size_t)(base * 64 + key) * NPROJ + P_NAV + h * 64 + c8 * 8); }
    { const float* rpb = c.in(8) + ((size_t)l * 5 + h) * 15 * 31; if (c.tid < 465) rp[c.tid] = rpb[c.tid]; }
    __syncthreads();
#pragma unroll 1
    for (int qq = 0; qq < 2; ++qq) {
        const int qb = 2 * w + qq, r = r0 + (qb >> 2), jq = qb & 3;
        const int rs = clampi(r - 4, 0, 24), kc0 = clampi(16 * jq - 8, 0, 32), cq = 16 * jq + i, cs = clampi(cq - 8, 0, 48);
        const bf16_t* qp = projb + (size_t)(r * 64 + cq) * NPROJ + P_NAQ + h * 64;
        const bf16x8 q0 = *(const bf16x8*)(qp + 8 * g), q1 = *(const bf16x8*)(qp + 32 + 8 * g);
        f32x4 s[16];
#pragma unroll
        for (int kt = 0; kt < 16; ++kt) { const int kr = kt >> 1, ct = kt & 1;
            const bf16_t* kp = projb + (size_t)((rs + kr) * 64 + kc0 + 16 * ct + i) * NPROJ + P_NAK + h * 64;
            const bf16x8 a0 = *(const bf16x8*)(kp + 8 * g), a1 = *(const bf16x8*)(kp + 32 + 8 * g);
            f32x4 z = {0.f, 0.f, 0.f, 0.f}; z = MFMA16(a0, q0, z); s[kt] = MFMA16(a1, q1, z); }
        float mx = -3.0e38f;
#pragma unroll
        for (int kt = 0; kt < 16; ++kt) { const int kr = kt >> 1, ct = kt & 1; const LAS float* rrow = rp + (rs + kr - r + 7) * 31;
#pragma unroll
            for (int rr = 0; rr < 4; ++rr) { const int tc = kc0 + 16 * ct + 4 * g + rr; const bool valid = (tc >= cs) && (tc < cs + 16);
                const float v = s[kt][rr] * 0.125f + rrow[clampi(tc - cq, -15, 15) + 15];
                s[kt][rr] = valid ? v : -3.0e38f; mx = fmaxf(mx, s[kt][rr]); } }
        mx = fmaxf(mx, __shfl_xor(mx, 16)); mx = fmaxf(mx, __shfl_xor(mx, 32));
        float sum = 0.f;
#pragma unroll
        for (int kt = 0; kt < 16; ++kt)
#pragma unroll
            for (int rr = 0; rr < 4; ++rr) { const float p = (s[kt][rr] > -1.0e38f) ? __expf(s[kt][rr] - mx) : 0.f; s[kt][rr] = p; sum += p; }
        sum += __shfl_xor(sum, 16); sum += __shfl_xor(sum, 32);
        f32x4 o[4];
#pragma unroll
        for (int te = 0; te < 4; ++te) o[te] = (f32x4){0.f, 0.f, 0.f, 0.f};
#pragma unroll
        for (int kr = 0; kr < 8; ++kr) { const bf16x8 pp = pack_frag(s[2 * kr], s[2 * kr + 1]); const int ra = (rs + kr - base) * 64 + kc0 + 4 * g, rb = ra + 16;
#pragma unroll
            for (int te = 0; te < 4; ++te) o[te] = MFMA16(frag_tr(Vb, P64, ra, rb, 16 * te, lane), pp, o[te]); }
        const float inv = 1.0f / sum;
        bf16_t* op = c.mixed() + ((size_t)b * T + r * 64 + cq) * D + 384 + h * 64;
#pragma unroll
        for (int te = 0; te < 4; ++te) *(unsigned long long*)(op + 16 * te + 4 * g) = (unsigned long long)pk2(o[te][0] * inv, o[te][1] * inv) | ((unsigned long long)pk2(o[te][2] * inv, o[te][3] * inv) << 32);
    }
    __syncthreads();
}

__device__ __forceinline__ void frag_tr_x4(LAS const unsigned char* tile, int pitch, int r0, int r1, int n0, int lane, bf16x8 (&out)[4]) {
    const int q4 = (lane & 15) >> 2, p4 = lane & 3;
    const unsigned a0 = (unsigned)(size_t)tile + (unsigned)((r0 + q4) * pitch + (n0 + 4 * p4) * 2), a1 = (unsigned)(size_t)tile + (unsigned)((r1 + q4) * pitch + (n0 + 4 * p4) * 2);
    s16x4 x0, y0, x1, y1, x2, y2, x3, y3;
    asm volatile("ds_read_b64_tr_b16 %0, %8\n\tds_read_b64_tr_b16 %1, %9\n\tds_read_b64_tr_b16 %2, %8 offset:32\n\tds_read_b64_tr_b16 %3, %9 offset:32\n\t"
                 "ds_read_b64_tr_b16 %4, %8 offset:64\n\tds_read_b64_tr_b16 %5, %9 offset:64\n\tds_read_b64_tr_b16 %6, %8 offset:96\n\tds_read_b64_tr_b16 %7, %9 offset:96\n\ts_waitcnt lgkmcnt(0)"
                 : "=&v"(x0), "=&v"(y0), "=&v"(x1), "=&v"(y1), "=&v"(x2), "=&v"(y2), "=&v"(x3), "=&v"(y3) : "v"(a0), "v"(a1) : "memory");
    out[0] = (bf16x8){x0[0], x0[1], x0[2], x0[3], y0[0], y0[1], y0[2], y0[3]}; out[1] = (bf16x8){x1[0], x1[1], x1[2], x1[3], y1[0], y1[1], y1[2], y1[3]};
    out[2] = (bf16x8){x2[0], x2[1], x2[2], x2[3], y2[0], y2[1], y2[2], y2[3]}; out[3] = (bf16x8){x3[0], x3[1], x3[2], x3[3], y3[0], y3[1], y3[2], y3[3]};
}

constexpr int P256 = 528;
__device__ __forceinline__ void xattn_mfma_item(const Ctx& c0, int item, LAS unsigned char* lds) {
    LAUNDER_CTX(c0, c);
    const int b = item / 32, hd = (item / 8) % 4, qc = item % 8; const int row0 = b * T + qc * 256;
    const int lane = c.lane, w = c.wave, i = lane & 15, g = lane >> 4;
    LAS unsigned char* KV = lds;
    const bf16_t* kvb = c.memkv() + (size_t)b * NMEM * 2048 + hd * 256;
    for (int x = c.tid; x < 8192; x += NTHREADS) { const int row = x >> 5, c16 = x & 31; *(LAS u32x4*)(KV + row * P256 + c16 * 16) = *(const u32x4*)(kvb + (size_t)row * 2048 + c16 * 8); }
    __syncthreads();
    bf16x8 P[2][8]; float inv[2];
#pragma unroll
    for (int blk = 0; blk < 2; ++blk) {
        const bf16_t* qp = c.q() + (size_t)(row0 + 16 * (w + 8 * blk) + i) * D + hd * 256 + 8 * g;
        bf16x8 qf[8];
#pragma unroll
        for (int s8 = 0; s8 < 8; ++s8) qf[s8] = *(const bf16x8*)(qp + 32 * s8);
        f32x4 s[16];
#pragma unroll
        for (int tk = 0; tk < 16; ++tk) { f32x4 z = {0.f, 0.f, 0.f, 0.f};
#pragma unroll
            for (int s8 = 0; s8 < 8; ++s8) z = MFMA16(frag_nt(KV, P256, 16 * tk + i, (32 * s8 + 8 * g) * 2), qf[s8], z);
            s[tk] = z; }
        float mx = -3.0e38f;
#pragma unroll
        for (int tk = 0; tk < 16; ++tk) mx = fmaxf(fmaxf(mx, fmaxf(s[tk][0], s[tk][1])), fmaxf(s[tk][2], s[tk][3]));
        mx = fmaxf(mx, __shfl_xor(mx, 16)); mx = fmaxf(mx, __shfl_xor(mx, 32));
        float sum = 0.f;
#pragma unroll
        for (int tk = 0; tk < 16; ++tk)
#pragma unroll
            for (int rr = 0; rr < 4; ++rr) { const float p = __expf((s[tk][rr] - mx) * 0.0625f); s[tk][rr] = p; sum += p; }
        sum += __shfl_xor(sum, 16); sum += __shfl_xor(sum, 32);
        inv[blk] = 1.0f / sum;
#pragma unroll
        for (int ks = 0; ks < 8; ++ks) P[blk][ks] = pack_frag(s[2 * ks], s[2 * ks + 1]);
    }
    __syncthreads();
    for (int x = c.tid; x < 8192; x += NTHREADS) { const int row = x >> 5, c16 = x & 31; *(LAS u32x4*)(KV + row * P256 + c16 * 16) = *(const u32x4*)(kvb + (size_t)row * 2048 + 1024 + c16 * 8); }
    __syncthreads();
#pragma unroll
    for (int blk = 0; blk < 2; ++blk) {
        f32x4 o[16];
#pragma unroll
        for (int te = 0; te < 16; ++te) o[te] = (f32x4){0.f, 0.f, 0.f, 0.f};
#pragma unroll
        for (int ks = 0; ks < 8; ++ks) { const int ra = 32 * ks + 4 * g, rb = ra + 16;
#pragma unroll
            for (int t4 = 0; t4 < 4; ++t4) { bf16x8 a4[4]; frag_tr_x4(KV, P256, ra, rb, 64 * t4, lane, a4);
#pragma unroll
                for (int x = 0; x < 4; ++x) o[4 * t4 + x] = MFMA16(a4[x], P[blk][ks], o[4 * t4 + x]); } }
        bf16_t* op = c.mixed() + (size_t)(row0 + 16 * (w + 8 * blk) + i) * D + hd * 256 + 4 * g;
        const float iv = inv[blk];
#pragma unroll
        for (int te = 0; te < 16; ++te) *(unsigned long long*)(op + 16 * te) = (unsigned long long)pk2(o[te][0] * iv, o[te][1] * iv) | ((unsigned long long)pk2(o[te][2] * iv, o[te][3] * iv) << 32);
    }
    __syncthreads();
}
#ifndef MK_PER_PHASE
#define MK_PER_PHASE 0
#endif
constexpr int PH_PER_LAYER = 11, NP = 2 + DEPTH * PH_PER_LAYER;
struct Args { const float* in[25]; float* out; unsigned char* ws; int ph_lo, ph_hi; };

__global__ void __launch_bounds__(NTHREADS, 2) mega(Args a) {
    extern __shared__ __attribute__((aligned(16))) unsigned char lds_raw[];
    LAS unsigned char* lds = (LAS unsigned char*)lds_raw;
    Ctx c;
    c.out = a.out; c.ws = a.ws;
    cg::grid_group grid = cg::this_grid();

    for (int p = a.ph_lo; p < a.ph_hi; ++p) {
        { int t_ = threadIdx.x, b_ = blockIdx.x, g_ = gridDim.x;
          asm volatile("" : "+v"(t_)); asm volatile("" : "+s"(b_)); asm volatile("" : "+s"(g_));
          c.tid = t_; c.lane = t_ & 63; c.wave = __builtin_amdgcn_readfirstlane(t_ >> 6); c.bid = b_; c.G = g_; }
        if (p == 0) {
            convert_layer(c, 0, lds);
            rows_to_bf16(c, c.in(0), c.hb(), c.rs0(), M);
            rows_to_bf16(c, c.in(1), c.memb(), c.rsm(), MM);
        } else if (p == NP - 1) {
            final_norm(c);
        } else {
            const int l = (p - 1) / PH_PER_LAYER, st = (p - 1) % PH_PER_LAYER;
            if (st == 0) {
                { pg8::Gemm g{c.hb(), c.w_in(), M, NPROJ, D}; pg8::StaticOrder S; S.init(M, NPROJ, c.G, c.bid);
                  EpiScale E{c.proj(), NPROJ, c.rs0(), c.gates(), 13};
                  pg8::gemm_phase<EpiScale, pg8::StaticOrder, true, true>(lds, g, S, E); }
                { pg8::Gemm g{c.memb(), c.wkv(), MM, 2 * D, D}; pg8::StaticOrder S; S.init(MM, 2 * D, c.G, c.bid);
                  EpiScale E{c.memkv(), 2 * D, c.rsm(), nullptr, -1};
                  pg8::gemm_phase<EpiScale, pg8::StaticOrder, true, true>(lds, g, S, E); }
            } else if (st == 1) {
                if (c.bid < 96) ml_state_item(c, l, c.bid, lds);
                else if (c.bid < 176) gla_state_item(c, l, c.bid - 96, lds);
                else for (int i = c.bid - 176; i < NB * 5 * 8; i += c.G - 176) na_mfma_item(c, l, i, lds);
            } else if (st == 2) {
                for (int i = c.bid; i < NB * 6 * 16 + NB * 5 * 16; i += c.G) { if (i < NB * 6 * 16) ml_out_item(c, l, i, lds); else gla_out_item(c, l, i - NB * 6 * 16, lds); }
            } else if (st == 3) {
                pg8::Gemm g{c.mixed(), c.w_out(), M, D, D}; pg8::StaticOrder S; S.init(M, D, c.G, c.bid);
                EpiResid E{l == 0 ? c.in(0) : c.out, c.out, c.hb(), c.rs1()};
                pg8::gemm_phase<EpiResid, pg8::StaticOrder, true, true>(lds, g, S, E);
            } else if (st == 4) {
                pg8::Gemm g{c.hb(), c.wq(), M, D, D}; pg8::StaticOrder S; S.init(M, D, c.G, c.bid);
                EpiScale E{c.q(), D, c.rs1(), nullptr, -1};
                pg8::gemm_phase<EpiScale, pg8::StaticOrder, true, true>(lds, g, S, E);
            } else if (st == 5) {
                for (int i = c.bid; i < NB * 4 * 8; i += c.G) xattn_mfma_item(c, i, lds);
            } else if (st == 6) {
                pg8::Gemm g{c.mixed(), c.wo(), M, D, D}; pg8::StaticOrder S; S.init(M, D, c.G, c.bid);
                EpiResid E{c.out, c.out, c.hb(), c.rs2()};
                pg8::gemm_phase<EpiResid, pg8::StaticOrder, true, true>(lds, g, S, E);
            } else if (st == 7) {
                pg8::Gemm g{c.hb(), c.w_up(), M, NUP, D}; pg8::StaticOrder S; S.init(M, NUP, c.G, c.bid);
                EpiScale E{c.u(), NUP, c.rs2(), nullptr, -1};
                pg8::gemm_phase<EpiScale, pg8::StaticOrder, true, true>(lds, g, S, E);
            } else if (st == 8) {
                act_pass(c, l);
            } else if (st == 9) {
                pg8::Gemm g{c.act(), c.w_dn(), M, D, DFF}; pg8::StaticOrder S; S.init(M, D, c.G, c.bid);
                EpiResid E{c.out, c.out, c.hb(), c.rs0()};
                pg8::gemm_phase<EpiResid, pg8::StaticOrder, true, true>(lds, g, S, E);
            } else {
                if (l + 1 < DEPTH) convert_layer(c, l + 1, lds);
            }
        }
        if (p + 1 < a.ph_hi) grid.sync();
    }
}
}

extern "C" void kernel_launch(void* const* d_in, const int* in_sizes, int n_in, void* d_out, int out_size, void* d_ws, size_t ws_size, hipStream_t stream) {
    static int grid = 0;
    if (grid == 0) {
        if (n_in != 25 || out_size != mk::M * mk::D || ws_size < mk::WS_END) { fprintf(stderr, "kernel_launch: unexpected shapes / workspace (n_in %d out %d ws %zu need %zu)\n", n_in, out_size, ws_size, (size_t)mk::WS_END); grid = -1; return; }
        int dev = 0, cus = 0, per_cu = 0;
        (void)hipGetDevice(&dev); (void)hipDeviceGetAttribute(&cus, hipDeviceAttributeMultiprocessorCount, dev);
        if (hipFuncSetAttribute((const void*)mk::mega, hipFuncAttributeMaxDynamicSharedMemorySize, mk::LDS_BYTES) != hipSuccess) { fprintf(stderr, "kernel_launch: hipFuncSetAttribute failed\n"); grid = -1; return; }
        (void)hipOccupancyMaxActiveBlocksPerMultiprocessor(&per_cu, (const void*)mk::mega, mk::NTHREADS, mk::LDS_BYTES);
        if (per_cu < 1) { fprintf(stderr, "kernel_launch: occupancy query says %d blocks per CU\n", per_cu); grid = -1; return; }
        grid = cus;
        if (grid < 192) { fprintf(stderr, "kernel_launch: needs >= 192 CUs\n"); grid = -1; return; }
    }
    if (grid < 0) return;
    mk::Args a{};
    for (int i = 0; i < 25; ++i) a.in[i] = (const float*)d_in[i];
    a.out = (float*)d_out; a.ws = (unsigned char*)d_ws;
#if MK_PER_PHASE
    for (int p = 0; p < mk::NP; ++p) { a.ph_lo = p; a.ph_hi = p + 1; hipLaunchKernelGGL(mk::mega, dim3(grid), dim3(mk::NTHREADS), mk::LDS_BYTES, stream, a); }
#else
    a.ph_lo = 0; a.ph_hi = mk::NP;
    void* args[] = {&a};
    hipError_t e = hipLaunchCooperativeKernel((const void*)mk::mega, dim3(grid), dim3(mk::NTHREADS), args, mk::LDS_BYTES, stream);
    if (e != hipSuccess) fprintf(stderr, "cooperative launch failed: %s (grid %d)\n", hipGetErrorString(e), grid);
#endif
}
```

```cpp
#include <hip/hip_runtime.h>
#include <hip/hip_cooperative_groups.h>
#include <cstdio>
#include <cstdint>
namespace cg = cooperative_groups;
#define MK_PER_PHASE 0
#define MK_CG_SYNC 0
namespace pg8 {
#define PG8_LAS __attribute__((address_space(3)))
typedef unsigned short bf16_t;
typedef short bf16x8 __attribute__((ext_vector_type(8)));
typedef float f32x4 __attribute__((ext_vector_type(4)));
typedef unsigned u32x4 __attribute__((ext_vector_type(4)));
constexpr int BM = 256, BK = 64, HALF = 128, HTB = HALF * BK * 2  , STAGE_BYTES = 8 * HTB, NXCD = 8, WGM = 8;

__host__ __device__ __forceinline__ int lds_byte(int r, int c) { const int st = (r >> 4) * 2 + (c >> 5), rr = r & 15, cc = c & 31, ob = rr * 64 + cc * 2; return st * 1024 + (ob ^ (((ob >> 9) & 1) << 5)); }
__host__ __device__ __forceinline__ void stage_rc(int b, int& R, int& C) { const int st = b / 1024, sb = b % 1024, swz = sb ^ (((sb >> 9) & 1) << 5); R = (st >> 1) * 16 + swz / 64; C = (st & 1) * 32 + (swz % 64) / 2; }
__host__ __device__ __forceinline__ int perm32(int rho) { const int n = rho >> 4, i = rho & 15; return 8 * (i >> 2) + 4 * n + (i & 3); }

struct Unit { int pm, pn; };
struct Gemm { const bf16_t* A; const bf16_t* Bt; int M, N, K; };

struct StaticOrder {
    int nM, nN, nwg, G, c;
    __host__ __device__ void init(int M, int N, int G_, int c_) { nM = M / BM; nN = N / BM; nwg = nM * nN; G = G_; c = c_; }
    __host__ __device__ bool next(int i, Unit& u) const {
        const long L = (long)i * G + c; if (L >= nwg) return false;
        int wgid = (int)L; { const int q = nwg / NXCD, r = nwg % NXCD, xcd = wgid % NXCD, off = wgid / NXCD; wgid = (xcd < r ? xcd * (q + 1) : r * (q + 1) + (xcd - r) * q) + off; }
        const int nig = WGM * nN, gid = wgid / nig, fm = gid * WGM, gsz = (nM - fm) < WGM ? (nM - fm) : WGM;
        u.pm = fm + ((wgid % nig) % gsz); u.pn = (wgid % nig) / gsz; return true;
    }
    __device__ __forceinline__ void a_ready(const Unit&) const {}
    __device__ __forceinline__ void done(const Unit&) const {}
};

template <class Epi, class Sched, bool ALIGN_EPI = false, bool SP2 = false>
__device__ __forceinline__ void gemm_phase(PG8_LAS unsigned char* lds, const Gemm g, const Sched& S, const Epi& E) {
    int tid_l = threadIdx.x; asm volatile("" : "+v"(tid_l));
    const int tid = tid_l, wid = __builtin_amdgcn_readfirstlane(tid >> 6), lane = tid & 63, wr = wid >> 2, wc = wid & 3, fr = lane & 15, fq = lane >> 4;
    const int K = g.K, nt = K / BK;
    unsigned voffA[2], voffB[2];
#pragma unroll
    for (int i = 0; i < 2; ++i) { int R, C; stage_rc(tid * 16 + i * 8192, R, C); const int Rb = Epi::PERM ? ((R & ~31) + perm32(R & 31)) : R;
        voffA[i] = (unsigned)(R * K + C) * 2u; voffB[i] = (unsigned)(Rb * K + C) * 2u; }
    const size_t kstep = (size_t)(BK * 2);
    const size_t hstep = (size_t)HALF * K * 2;
    const size_t tstep = 2 * hstep;
    const unsigned ldsw = (unsigned)wid * 1024u;
    const int aoff = lds_byte(wr * 64 + fr, fq * 8), boff = lds_byte(wc * 32 + fr, fq * 8);
#define PG8_SA(b, h) (((b) * 2 + (h)) * HTB)
#define PG8_SB(b, h) ((4 + (b) * 2 + (h)) * HTB)
#define PG8_STAGE(bufoff, gbase, voff) do { _Pragma("unroll") for (int _i = 0; _i < 2; ++_i) \
        __builtin_amdgcn_global_load_lds((const unsigned*)((const char*)(gbase) + (voff)[_i]), (PG8_LAS unsigned*)(lds + (bufoff) + ldsw + _i * 8192), 16, 0, 0); } while (0)
#define PG8_LDA(dst, b, h) do { _Pragma("unroll") for (int m = 0; m < 4; ++m) _Pragma("unroll") for (int k = 0; k < 2; ++k) dst[m][k] = *(const PG8_LAS bf16x8*)(lds + PG8_SA(b, h) + aoff + m * 2048 + k * 1024); } while (0)
#define PG8_LDB(dst, b, h) do { _Pragma("unroll") for (int n = 0; n < 2; ++n) _Pragma("unroll") for (int k = 0; k < 2; ++k) dst[n][k] = *(const PG8_LAS bf16x8*)(lds + PG8_SB(b, h) + boff + n * 2048 + k * 1024); } while (0)
#define PG8_MMA(ai, bj, At, Bt) do { __builtin_amdgcn_s_setprio(1); _Pragma("unroll") for (int m = 0; m < 4; ++m) _Pragma("unroll") for (int n = 0; n < 2; ++n) _Pragma("unroll") for (int k = 0; k < 2; ++k) \
        acc[ai][bj][m][n] = __builtin_amdgcn_mfma_f32_16x16x32_bf16(Bt[n][k], At[m][k], acc[ai][bj][m][n], 0, 0, 0); __builtin_amdgcn_s_setprio(0); } while (0)
#define PG8_WAIT_V(n) asm volatile("s_waitcnt vmcnt(" #n ")" ::: "memory")
#define PG8_WAIT_L(n) asm volatile("s_waitcnt lgkmcnt(" #n ")" ::: "memory")
#define PG8_BAR __builtin_amdgcn_s_barrier()
#define PG8_SCHED __builtin_amdgcn_sched_barrier(0)
    Unit cur, nxt; int ui = 0;
    if (!S.next(0, cur)) return;
    f32x4 acc[2][2][4][2];
#pragma unroll
    for (int a = 0; a < 2; ++a)
#pragma unroll
        for (int b = 0; b < 2; ++b)
#pragma unroll
            for (int m = 0; m < 4; ++m)
#pragma unroll
                for (int n = 0; n < 2; ++n) acc[a][b][m][n] = (f32x4){0.f, 0.f, 0.f, 0.f};
    bf16x8 At[4][2], B0[2][2], B1[2][2];
    const char* cA = (const char*)g.A + (size_t)cur.pm * tstep; const char* cB = (const char*)g.Bt + (size_t)cur.pn * tstep;
    S.a_ready(cur);
    if constexpr (SP2) {
        PG8_STAGE(PG8_SB(0, 0), cB, voffB); PG8_STAGE(PG8_SB(0, 1), cB + hstep, voffB); PG8_STAGE(PG8_SA(0, 0), cA, voffA); PG8_STAGE(PG8_SA(0, 1), cA + hstep, voffA);
        if (wr == 1) PG8_BAR;
        PG8_WAIT_V(2); PG8_BAR;
        PG8_STAGE(PG8_SB(1, 0), cB + kstep, voffB); PG8_STAGE(PG8_SA(1, 0), cA + kstep, voffA); PG8_STAGE(PG8_SB(1, 1), cB + hstep + kstep, voffB);
        PG8_WAIT_V(6); PG8_BAR;
    } else {
        PG8_STAGE(PG8_SB(0, 0), cB, voffB); PG8_STAGE(PG8_SA(0, 0), cA, voffA); PG8_STAGE(PG8_SB(0, 1), cB + hstep, voffB); PG8_STAGE(PG8_SA(0, 1), cA + hstep, voffA);
        if (wr == 1) PG8_BAR;
        PG8_WAIT_V(4); PG8_BAR;
        PG8_STAGE(PG8_SB(1, 0), cB + kstep, voffB); PG8_STAGE(PG8_SA(1, 0), cA + kstep, voffA); PG8_STAGE(PG8_SB(1, 1), cB + hstep + kstep, voffB);
        PG8_WAIT_V(6); PG8_BAR;
    }
    for (;;) {
        const bool has_next = S.next(ui + 1, nxt);
        const char* nA = has_next ? (const char*)g.A + (size_t)nxt.pm * tstep : cA; const char* nB = has_next ? (const char*)g.Bt + (size_t)nxt.pn * tstep : cB;
        for (int t = 0; t < nt; t += 2) {
            const bool last = (t == nt - 2);
            const char* a1 = cA + (size_t)(t + 1) * kstep;
            const char* a2 = last ? nA : cA + (size_t)(t + 2) * kstep; const char* b2 = last ? nB : cB + (size_t)(t + 2) * kstep;
            const char* a3 = a2 + kstep; const char* b3 = b2 + kstep;
            if (last && has_next) S.a_ready(nxt);
            if constexpr (SP2) {
            PG8_LDB(B0, 0, 0); PG8_LDB(B1, 0, 1); PG8_SCHED; PG8_LDA(At, 0, 0); PG8_STAGE(PG8_SA(1, 1), a1 + hstep, voffA);
            PG8_WAIT_V(8); PG8_WAIT_L(0); PG8_BAR; PG8_MMA(0, 0, At, B0); PG8_MMA(0, 1, At, B1); PG8_BAR; PG8_SCHED;
            PG8_LDA(At, 0, 1); PG8_STAGE(PG8_SB(0, 0), b2, voffB); PG8_STAGE(PG8_SB(0, 1), b2 + hstep, voffB); PG8_STAGE(PG8_SA(0, 0), a2, voffA);
            PG8_WAIT_V(8); PG8_WAIT_L(0); PG8_BAR; PG8_MMA(1, 0, At, B0); PG8_MMA(1, 1, At, B1); PG8_BAR; PG8_SCHED;
            PG8_LDB(B0, 1, 0); PG8_LDB(B1, 1, 1); PG8_SCHED; PG8_LDA(At, 1, 0); PG8_STAGE(PG8_SA(0, 1), a2 + hstep, voffA);
            PG8_WAIT_V(8); PG8_WAIT_L(0); PG8_BAR; PG8_MMA(0, 0, At, B0); PG8_MMA(0, 1, At, B1); PG8_BAR; PG8_SCHED;
            PG8_LDA(At, 1, 1); PG8_STAGE(PG8_SB(1, 0), b3, voffB); PG8_STAGE(PG8_SB(1, 1), b3 + hstep, voffB); PG8_STAGE(PG8_SA(1, 0), a3, voffA);
            PG8_WAIT_V(8); PG8_WAIT_L(0); PG8_BAR; PG8_MMA(1, 0, At, B0); PG8_MMA(1, 1, At, B1); PG8_BAR; PG8_SCHED;
            } else {
            PG8_LDB(B0, 0, 0); PG8_SCHED; PG8_LDA(At, 0, 0); PG8_STAGE(PG8_SA(1, 1), a1 + hstep, voffA);
            PG8_WAIT_L(8); PG8_BAR; PG8_WAIT_L(0); PG8_MMA(0, 0, At, B0); PG8_BAR; PG8_SCHED;
            PG8_LDB(B1, 0, 1); PG8_STAGE(PG8_SB(0, 0), b2, voffB);
            PG8_BAR; PG8_WAIT_L(0); PG8_MMA(0, 1, At, B1); PG8_BAR;
            PG8_LDA(At, 0, 1); PG8_STAGE(PG8_SA(0, 0), a2, voffA);
            PG8_BAR; PG8_WAIT_L(0); PG8_MMA(1, 0, At, B0); PG8_BAR; PG8_SCHED;
            PG8_STAGE(PG8_SB(0, 1), b2 + hstep, voffB);
            PG8_WAIT_V(6); PG8_BAR; PG8_MMA(1, 1, At, B1); PG8_BAR;
            PG8_LDB(B0, 1, 0); PG8_SCHED; PG8_LDA(At, 1, 0); PG8_STAGE(PG8_SA(0, 1), a2 + hstep, voffA);
            PG8_WAIT_L(8); PG8_BAR; PG8_WAIT_L(0); PG8_MMA(0, 0, At, B0); PG8_BAR; PG8_SCHED;
            PG8_LDB(B1, 1, 1); PG8_STAGE(PG8_SB(1, 0), b3, voffB);
            PG8_BAR; PG8_WAIT_L(0); PG8_MMA(0, 1, At, B1); PG8_BAR;
            PG8_LDA(At, 1, 1); PG8_STAGE(PG8_SA(1, 0), a3, voffA);
            PG8_BAR; PG8_WAIT_L(0); PG8_MMA(1, 0, At, B0); PG8_BAR; PG8_SCHED;
            PG8_STAGE(PG8_SB(1, 1), b3 + hstep, voffB);
            PG8_WAIT_V(6); PG8_BAR; PG8_MMA(1, 1, At, B1); PG8_BAR;
            }
        }
        if constexpr (ALIGN_EPI) { if (wr == 0) PG8_BAR; }
        if constexpr (!Epi::AFTER_DRAIN) { E(acc, cur, wr, wc, fr, fq); S.done(cur); }
        if (!has_next) break;
#pragma unroll
        for (int a = 0; a < 2; ++a)
#pragma unroll
            for (int b = 0; b < 2; ++b)
#pragma unroll
                for (int m = 0; m < 4; ++m)
#pragma unroll
                    for (int n = 0; n < 2; ++n) acc[a][b][m][n] = (f32x4){0.f, 0.f, 0.f, 0.f};
        cur = nxt; cA = nA; cB = nB; ++ui;
        if constexpr (ALIGN_EPI) { if (wr == 1) PG8_BAR; }
    }
    PG8_WAIT_V(0);
    if constexpr (!ALIGN_EPI) { if (wr == 0) PG8_BAR; }
    PG8_BAR;
    if constexpr (Epi::AFTER_DRAIN) { E.fused(acc, cur, wr, wc, fr, fq, lds, wid, lane); S.done(cur); }
#undef PG8_SA
#undef PG8_SB
#undef PG8_STAGE
#undef PG8_LDA
#undef PG8_LDB
#undef PG8_MMA
#undef PG8_WAIT_V
#undef PG8_WAIT_L
#undef PG8_BAR
#undef PG8_SCHED
}
}
namespace mk {
using pg8::bf16_t; using pg8::f32x4; using pg8::u32x4; using pg8::bf16x8;
#define LAS __attribute__((address_space(3)))
constexpr int NB = 8, T = 2048, M = NB * T, D = 1024, DEPTH = 4, NMEM = 256, MM = NB * NMEM;
constexpr int NPROJ = 3584, IN_COLS = 3512, DFF = 2816, NUP = 2 * DFF;
constexpr float EPS = 1e-6f;
constexpr int P_MLQ = 0, P_MLK = 384, P_MLV = 768, P_MLO = 1152, P_NAQ = 1536, P_NAK = 1856, P_NAV = 2176, P_GQ = 2496, P_GK = 2656, P_GV = 2816, P_GG = 3136, P_MLG = 3456, P_GA = 3480;
constexpr int NTHREADS = 512, NWAVES = 8;
constexpr int LDS_BYTES = 160 * 1024, LDS_MISC = LDS_BYTES - 64;
constexpr size_t MiB = (size_t)1 << 20;
constexpr size_t WS_RS0 = 0, WS_RS1 = 1 * MiB, WS_RS2 = 2 * MiB, WS_RSM = 3 * MiB;
constexpr size_t WS_BAR = 3 * MiB + 512 * 1024, WS_BAR_BYTES = 16 * 1024;
constexpr size_t WS_GATES = 4 * MiB;
constexpr size_t WS_MEMB = 8 * MiB;
constexpr size_t WS_MEMKV = 12 * MiB;
constexpr size_t WS_WIN = 20 * MiB, WS_WOUT = 27 * MiB, WS_WQ = 29 * MiB, WS_WO = 31 * MiB, WS_WUP = 33 * MiB, WS_WDN = 44 * MiB, WS_WKV = 50 * MiB;
constexpr size_t WS_HB = 54 * MiB;
constexpr size_t WS_BIG = 86 * MiB;
constexpr size_t WS_HSML = WS_BIG + 112 * MiB, WS_HSGL = WS_HSML + 24 * MiB;
constexpr size_t WS_ACT = 262 * MiB;
constexpr size_t WS_MIXED = WS_ACT, WS_Q = WS_ACT + 32 * MiB;
constexpr size_t WS_END = 350 * MiB;

__device__ __forceinline__ float bf2f(unsigned v) { return __uint_as_float(v << 16); }
__device__ __forceinline__ unsigned f2bf(float f) { const unsigned u = __float_as_uint(f); return (u + 0x7fffu + ((u >> 16) & 1u)) >> 16; }
__device__ __forceinline__ unsigned pk2(float lo, float hi) { return f2bf(lo) | (f2bf(hi) << 16); }
__device__ __forceinline__ unsigned cvt_pk_bf16(float lo, float hi) { unsigned r; asm volatile("v_cvt_pk_bf16_f32 %0, %1, %2" : "=v"(r) : "v"(lo), "v"(hi)); return r; }
__device__ __forceinline__ void unpack8(const u32x4 w, float (&o)[8]) {
    o[0] = bf2f(w.x & 0xffffu); o[1] = bf2f(w.x >> 16); o[2] = bf2f(w.y & 0xffffu); o[3] = bf2f(w.y >> 16);
    o[4] = bf2f(w.z & 0xffffu); o[5] = bf2f(w.z >> 16); o[6] = bf2f(w.w & 0xffffu); o[7] = bf2f(w.w >> 16);
}
__device__ __forceinline__ float wave_sum(float v) {
#pragma unroll
    for (int o = 1; o < 64; o <<= 1) v += __shfl_xor(v, o);
    return v;
}
__device__ __forceinline__ float sigmoidf_(float x) { return 1.f / (1.f + __expf(-x)); }

typedef const float* cfptr;
struct Ctx {
    float* out; unsigned char* ws;
    int G, bid, tid, lane, wave;
    __device__ __forceinline__ const float* in(int i) const {
        asm volatile("" : "+s"(i));
        const __attribute__((address_space(4))) cfptr* tbl = (const __attribute__((address_space(4))) cfptr*)__builtin_amdgcn_kernarg_segment_ptr();
        return tbl[i];
    }
    template <class Tp> __device__ __forceinline__ Tp* wsp(size_t off) const { unsigned o = (unsigned)off; asm volatile("" : "+s"(o)); return (Tp*)(ws + o); }
    __device__ __forceinline__ float* rs0() const { return wsp<float>(WS_RS0); }
    __device__ __forceinline__ float* rs1() const { return wsp<float>(WS_RS1); }
    __device__ __forceinline__ float* rs2() const { return wsp<float>(WS_RS2); }
    __device__ __forceinline__ float* rsm() const { return wsp<float>(WS_RSM); }
    __device__ __forceinline__ float* gates() const { return wsp<float>(WS_GATES); }
    __device__ __forceinline__ float* hsml() const { return wsp<float>(WS_HSML); }
    __device__ __forceinline__ float* hsgl() const { return wsp<float>(WS_HSGL); }
    __device__ __forceinline__ bf16_t* memb() const { return wsp<bf16_t>(WS_MEMB); }
    __device__ __forceinline__ bf16_t* memkv() const { return wsp<bf16_t>(WS_MEMKV); }
    __device__ __forceinline__ bf16_t* w_in() const { return wsp<bf16_t>(WS_WIN); }
    __device__ __forceinline__ bf16_t* w_out() const { return wsp<bf16_t>(WS_WOUT); }
    __device__ __forceinline__ bf16_t* wq() const { return wsp<bf16_t>(WS_WQ); }
    __device__ __forceinline__ bf16_t* wo() const { return wsp<bf16_t>(WS_WO); }
    __device__ __forceinline__ bf16_t* w_up() const { return wsp<bf16_t>(WS_WUP); }
    __device__ __forceinline__ bf16_t* w_dn() const { return wsp<bf16_t>(WS_WDN); }
    __device__ __forceinline__ bf16_t* wkv() const { return wsp<bf16_t>(WS_WKV); }
    __device__ __forceinline__ bf16_t* hb() const { return wsp<bf16_t>(WS_HB); }
    __device__ __forceinline__ bf16_t* proj() const { return wsp<bf16_t>(WS_BIG); }
    __device__ __forceinline__ bf16_t* u() const { return wsp<bf16_t>(WS_BIG); }
    __device__ __forceinline__ bf16_t* act() const { return wsp<bf16_t>(WS_ACT); }
    __device__ __forceinline__ bf16_t* mixed() const { return wsp<bf16_t>(WS_MIXED); }
    __device__ __forceinline__ bf16_t* q() const { return wsp<bf16_t>(WS_Q); }
};

#define LAUNDER_CTX(c0, c) Ctx c = (c0); { int t_ = c.tid; asm volatile("" : "+v"(t_)); c.tid = t_; c.lane = t_ & 63; c.wave = __builtin_amdgcn_readfirstlane(t_ >> 6); }

struct EpiScale {
    static constexpr bool PERM = true, AFTER_DRAIN = false;
    bf16_t* O; int ldc; const float* rowss; float* gates; int gate_pn;
    __device__ __forceinline__ void operator()(const f32x4 (&acc)[2][2][4][2], const pg8::Unit& u, int wr, int wc, int fr, int fq) const {
        const int row0 = u.pm * 256 + wr * 64 + fr, col0 = u.pn * 256 + wc * 32 + 8 * fq;
        const bool gt = (u.pn == gate_pn) && (wc < 2);
#pragma unroll
        for (int ai = 0; ai < 2; ++ai)
#pragma unroll
            for (int m = 0; m < 4; ++m) {
                const int row = row0 + ai * 128 + m * 16;
                float rs = 1.0f;
                if (rowss) { const f32x4* rp = (const f32x4*)(rowss + (size_t)row * 16); const f32x4 p0 = rp[0], p1 = rp[1], p2 = rp[2], p3 = rp[3];
                    const float ssum = (((p0[0] + p0[1]) + (p0[2] + p0[3])) + ((p1[0] + p1[1]) + (p1[2] + p1[3]))) + (((p2[0] + p2[1]) + (p2[2] + p2[3])) + ((p3[0] + p3[1]) + (p3[2] + p3[3])));
                    rs = 1.0f / sqrtf(ssum * (1.0f / D) + EPS); }
                bf16_t* rowp = O + (size_t)row * ldc + col0;
#pragma unroll
                for (int bj = 0; bj < 2; ++bj) {
                    const f32x4 v0 = acc[ai][bj][m][0] * rs, v1 = acc[ai][bj][m][1] * rs;
                    u32x4 w; w.x = cvt_pk_bf16(v0[0], v0[1]); w.y = cvt_pk_bf16(v0[2], v0[3]); w.z = cvt_pk_bf16(v1[0], v1[1]); w.w = cvt_pk_bf16(v1[2], v1[3]);
                    *(u32x4*)(rowp + bj * 128) = w;
                    if (bj == 1 && gt) { float* gp = gates + (size_t)row * 64 + wc * 32 + 8 * fq; *(f32x4*)gp = v0; *(f32x4*)(gp + 4) = v1; }
                }
            }
    }
};
struct EpiResid {
    static constexpr bool PERM = true, AFTER_DRAIN = false;
    const float* base; float* out; bf16_t* hb; float* rowss_out;
    __device__ __forceinline__ void operator()(const f32x4 (&acc)[2][2][4][2], const pg8::Unit& u, int wr, int wc, int fr, int fq) const {
        const int row0 = u.pm * 256 + wr * 64 + fr, col0 = u.pn * 256 + wc * 32 + 8 * fq;
#pragma unroll
        for (int ai = 0; ai < 2; ++ai)
#pragma unroll
            for (int m = 0; m < 4; ++m) {
                const int row = row0 + ai * 128 + m * 16; const size_t off = (size_t)row * D + col0; float ss = 0.f;
#pragma unroll
                for (int bj = 0; bj < 2; ++bj) {
                    const f32x4 v0 = acc[ai][bj][m][0] + *(const f32x4*)(base + off + bj * 128), v1 = acc[ai][bj][m][1] + *(const f32x4*)(base + off + bj * 128 + 4);
                    *(f32x4*)(out + off + bj * 128) = v0; *(f32x4*)(out + off + bj * 128 + 4) = v1;
                    u32x4 w; w.x = cvt_pk_bf16(v0[0], v0[1]); w.y = cvt_pk_bf16(v0[2], v0[3]); w.z = cvt_pk_bf16(v1[0], v1[1]); w.w = cvt_pk_bf16(v1[2], v1[3]);
                    *(u32x4*)(hb + off + bj * 128) = w;
                    ss += (v0[0] * v0[0] + v0[1] * v0[1]) + (v0[2] * v0[2] + v0[3] * v0[3]) + (v1[0] * v1[0] + v1[1] * v1[1]) + (v1[2] * v1[2] + v1[3] * v1[3]);
                }
                ss += __shfl_xor(ss, 16); ss += __shfl_xor(ss, 32);
                if (fq == 0) rowss_out[(size_t)row * 16 + u.pn * 4 + wc] = ss;
                asm volatile("" ::: "memory");
            }
    }
};

template <class Map>
__device__ __forceinline__ void cvt_item(const float* W, int K, int N, const float* gain, bf16_t* WT, LAS float* scr, int item, int lane, Map map) {
    const int nblk = (N + 31) / 32, kb = item / nblk, nb = item % nblk, k0 = 64 * kb, n0 = 32 * nb;
    const int nn = n0 + (lane & 31);
#pragma unroll 8
    for (int i = 0; i < 32; ++i) { const int kk = 2 * i + (lane >> 5); float w = (nn < N) ? W[(size_t)(k0 + kk) * N + nn] : 0.f; if (gain) w *= gain[k0 + kk]; scr[kk * 33 + (lane & 31)] = w; }
    asm volatile("s_waitcnt lgkmcnt(0)" ::: "memory");
    const int c = lane & 7;
#pragma unroll
    for (int j = 0; j < 4; ++j) { const int n = (lane >> 3) + 8 * j; const LAS float* s = scr + (8 * c) * 33 + n;
        u32x4 o; o.x = pk2(s[0 * 33], s[1 * 33]); o.y = pk2(s[2 * 33], s[3 * 33]); o.z = pk2(s[4 * 33], s[5 * 33]); o.w = pk2(s[6 * 33], s[7 * 33]);
        if (n0 + n < N) *(u32x4*)(WT + (size_t)map(n0 + n) * K + k0 + 8 * c) = o; }
    asm volatile("s_waitcnt lgkmcnt(0)" ::: "memory");
}
struct MapId { int off; __device__ __forceinline__ int operator()(int n) const { return n + off; } };
struct MapIn { __device__ __forceinline__ int operator()(int n) const { return n < 1536 ? n : (n < 1560 ? n + (P_MLG - 1536) : (n < 3480 ? n - 24 : n)); } };

__device__ __forceinline__ void convert_layer(const Ctx& c, int l, LAS unsigned char* lds) {
    LAS float* scr = (LAS float*)(lds + c.wave * 16384);
    const int gw = c.bid * NWAVES + c.wave, NGW = c.G * NWAVES;
    constexpr int I_IN = 16 * 110, I_SQ = 16 * 32, I_UP = 16 * 176, I_DN = 44 * 32;
    constexpr int NITEMS = I_IN + 5 * I_SQ + I_UP + I_DN;
    for (int it = gw; it < NITEMS; it += NGW) {
        int r = it;
        if (r < I_IN) { cvt_item(c.in(3) + (size_t)l * D * IN_COLS, D, IN_COLS, c.in(2) + l * D, c.w_in(), scr, r, c.lane, MapIn{}); continue; } r -= I_IN;
        if (r < I_SQ) { cvt_item(c.in(12) + (size_t)l * D * D, D, D, nullptr, c.w_out(), scr, r, c.lane, MapId{0}); continue; } r -= I_SQ;
        if (r < I_SQ) { cvt_item(c.in(15) + (size_t)l * D * D, D, D, c.in(13) + l * D, c.wq(), scr, r, c.lane, MapId{0}); continue; } r -= I_SQ;
        if (r < I_SQ) { cvt_item(c.in(16) + (size_t)l * D * D, D, D, c.in(14) + l * D, c.wkv(), scr, r, c.lane, MapId{0}); continue; } r -= I_SQ;
        if (r < I_SQ) { cvt_item(c.in(17) + (size_t)l * D * D, D, D, c.in(14) + l * D, c.wkv(), scr, r, c.lane, MapId{D}); continue; } r -= I_SQ;
        if (r < I_SQ) { cvt_item(c.in(18) + (size_t)l * D * D, D, D, nullptr, c.wo(), scr, r, c.lane, MapId{0}); continue; } r -= I_SQ;
        if (r < I_UP) { cvt_item(c.in(20) + (size_t)l * D * NUP, D, NUP, c.in(19) + l * D, c.w_up(), scr, r, c.lane, MapId{0}); continue; } r -= I_UP;
        cvt_item(c.in(23) + (size_t)l * DFF * D, DFF, D, nullptr, c.w_dn(), scr, r, c.lane, MapId{0});
    }
    const int gt = c.bid * NTHREADS + c.tid;
    for (int i = gt; i < (NPROJ - IN_COLS) * D / 8; i += c.G * NTHREADS) *(u32x4*)(c.w_in() + (size_t)IN_COLS * D + (size_t)i * 8) = (u32x4){0u, 0u, 0u, 0u};
}
__device__ __forceinline__ void rows_to_bf16(const Ctx& c, const float* X, bf16_t* Y, float* rss, int rows) {
    const int gw = c.bid * NWAVES + c.wave, NGW = c.G * NWAVES;
    for (int m = gw; m < rows; m += NGW) {
        const f32x4* xr = (const f32x4*)(X + (size_t)m * D) + c.lane; float s = 0.f;
        unsigned long long* o8 = (unsigned long long*)(Y + (size_t)m * D) + c.lane;
#pragma unroll
        for (int j = 0; j < 4; ++j) { const f32x4 v = xr[64 * j]; s += (v[0] * v[0] + v[1] * v[1]) + (v[2] * v[2] + v[3] * v[3]);
            o8[64 * j] = (unsigned long long)pk2(v[0], v[1]) | ((unsigned long long)pk2(v[2], v[3]) << 32); }
        s = wave_sum(s); if (c.lane < 16) rss[(size_t)m * 16 + c.lane] = (c.lane == 0) ? s : 0.f;
    }
}
__device__ __forceinline__ void final_norm(const Ctx& c) {
    const int gw = c.bid * NWAVES + c.wave, NGW = c.G * NWAVES; const float* g = c.in(24);
    for (int m = gw; m < M; m += NGW) {
        f32x4* xr = (f32x4*)(c.out + (size_t)m * D) + c.lane; f32x4 v[4]; float s = 0.f;
#pragma unroll
        for (int j = 0; j < 4; ++j) { v[j] = xr[64 * j]; s += (v[j][0] * v[j][0] + v[j][1] * v[j][1]) + (v[j][2] * v[j][2] + v[j][3] * v[j][3]); }
        const float r = 1.0f / sqrtf(wave_sum(s) * (1.0f / D) + EPS);
#pragma unroll
        for (int j = 0; j < 4; ++j) xr[64 * j] = v[j] * r * ((const f32x4*)g)[c.lane + 64 * j];
    }
}
typedef __attribute__((address_space(1))) unsigned gu32;
#define XB_TMO      128
#define XB_XCNT(j)  (256  + 64 * (j))
#define XB_XSUB(j)  (1280 + 64 * (j))
#define XB_XGEN(j)  (2304 + 64 * (j))
#define XB_TOP      3328
#define XB_TOPGEN   3392
#define XCD_BAR_WORDS 3456
#define XB_SPIN_CAP (1u << 18)

__device__ __forceinline__ unsigned xb_ld(unsigned* p)              { return __hip_atomic_load(p, __ATOMIC_RELAXED, __HIP_MEMORY_SCOPE_AGENT); }
__device__ __forceinline__ unsigned xb_add(unsigned* p, unsigned v) { return __hip_atomic_fetch_add(p, v, __ATOMIC_RELAXED, __HIP_MEMORY_SCOPE_AGENT); }
__device__ __forceinline__ unsigned xb_xcc_id() { return (unsigned)__builtin_amdgcn_s_getreg((3 << 11) | 20) & 0xFu; }
#define XB_SPIN(cond, bar) do { unsigned _sp = 0; while (cond) { __builtin_amdgcn_s_sleep(1); \
    if ((++_sp & 255u) == 0u) { if (xb_ld(&(bar)[XB_TMO])) break; if (_sp > XB_SPIN_CAP) { atomicAdd(&(bar)[XB_TMO], 1u); break; } } } } while (0)

struct XcdBarrier {
    unsigned* bar; unsigned x;
    volatile LAS unsigned* st;
};

__device__ __forceinline__ XcdBarrier xcd_barrier_post(unsigned* bar, volatile LAS unsigned* st) {
    XcdBarrier b; b.bar = bar; b.x = xb_xcc_id(); b.st = st;
    if (threadIdx.x == 0) (void)xb_add(&bar[XB_XCNT(b.x)], 1u);
    return b;
}
__device__ __forceinline__ void xcd_barrier_complete(unsigned* bar, unsigned x, unsigned& nloc, unsigned& nx) {
    const unsigned G = gridDim.x * gridDim.y * gridDim.z;
    unsigned sum, cnt, mine, sp = 0u;
    for (;;) {
        sum = 0u; cnt = 0u; mine = 0u;
#pragma unroll
        for (unsigned j = 0; j < 16; ++j) { const unsigned c = xb_ld(&bar[XB_XCNT(j)]); sum += c; cnt += (c > 0u) ? 1u : 0u; mine = (j == x) ? c : mine; }
        if (sum == G) break;
        __builtin_amdgcn_s_sleep(1);
        if ((++sp & 255u) == 0u) { if (xb_ld(&bar[XB_TMO])) break; if (sp > XB_SPIN_CAP) { atomicAdd(&bar[XB_TMO], 1u); break; } }
    }
    nloc = mine > 0u ? mine : 1u; nx = cnt > 0u ? cnt : 1u;
}

__device__ __forceinline__ void xcd_barrier(const XcdBarrier& b) {
    asm volatile("s_waitcnt vmcnt(0)" ::: "memory");
    __syncthreads();
    if (threadIdx.x == 0) {
        unsigned* bar = b.bar;
        __builtin_amdgcn_s_waitcnt(0);
        unsigned nloc = b.st[0], nx = b.st[1];
        if (nloc == 0u) { xcd_barrier_complete(bar, b.x, nloc, nx); b.st[0] = nloc; b.st[1] = nx; }
        const unsigned old = xb_add(&bar[XB_XSUB(b.x)], 1u);
        const unsigned gen = old / nloc;
        if (old + 1u == (gen + 1u) * nloc) {
            __builtin_amdgcn_fence(__ATOMIC_RELEASE, "agent");
            asm volatile("s_waitcnt vmcnt(0)" ::: "memory");
            const unsigned og = xb_add(&bar[XB_TOP], 1u);
            const unsigned tg = og / nx;
            if (og + 1u == (tg + 1u) * nx) xb_add(&bar[XB_TOPGEN], 1u);
            else XB_SPIN(xb_ld(&bar[XB_TOPGEN]) == tg, bar);
            __builtin_amdgcn_fence(__ATOMIC_ACQUIRE, "agent");
            xb_add(&bar[XB_XGEN(b.x)], 1u);
            asm volatile("s_waitcnt vmcnt(0)" ::: "memory");
        } else {
            XB_SPIN(xb_ld(&bar[XB_XGEN(b.x)]) == gen, bar);
            __builtin_amdgcn_fence(__ATOMIC_ACQUIRE, "agent");
            asm volatile("s_waitcnt vmcnt(0)" ::: "memory");
        }
    }
    __syncthreads();
}
__device__ __forceinline__ void ml_load_row(const bf16_t* projb, int t, int coff, float (&dst)[2][8]) {
    if (t < 0 || t >= T) {
#pragma unroll
        for (int j = 0; j < 8; ++j) { dst[0][j] = 0.f; dst[1][j] = 0.f; }
    } else {
        const u32x4 a = *(const u32x4*)(projb + (size_t)t * NPROJ + P_MLQ + coff), b = *(const u32x4*)(projb + (size_t)t * NPROJ + P_MLK + coff);
        unpack8(a, dst[0]); unpack8(b, dst[1]);
    }
}
__device__ __forceinline__ void ml_item(const Ctx& c0, int l, int item, LAS unsigned char* lds) {
    LAUNDER_CTX(c0, c);
    const int b = item / 6, h = item % 6, e = c.tid & 63, dg = c.tid >> 6;
    LAS float* rnum = (LAS float*)lds;
    LAS float* rden = (LAS float*)lds + 1024;
    const bf16_t* projb = c.proj() + (size_t)b * T * NPROJ;
    const float* gatesb = c.gates() + (size_t)b * T * 64;
    float* hs = c.hsml() + (size_t)b * T * 384 + h * 64;
    const float* cwp = c.in(4) + (size_t)l * 3 * 768; const float* cbp = c.in(5) + (size_t)l * 768;
    const float* gb = c.in(6) + l * 24; const float* ng = c.in(7) + l * 384;
    const int coff = h * 64 + dg * 8;
    float cw[2][8][4];
#pragma unroll
    for (int qk = 0; qk < 2; ++qk)
#pragma unroll
        for (int j = 0; j < 8; ++j) { const int ch = qk * 384 + coff + j; cw[qk][j][0] = cwp[ch]; cw[qk][j][1] = cwp[768 + ch]; cw[qk][j][2] = cwp[1536 + ch]; cw[qk][j][3] = cbp[ch]; }
    for (int dir = 0; dir < 2; ++dir) {
        float C[8], n[8];
#pragma unroll
        for (int j = 0; j < 8; ++j) { C[j] = 0.f; n[j] = 0.f; }
        const float bi = gb[(2 * dir) * 6 + h], bff = gb[(2 * dir + 1) * 6 + h];
        float lo[2][8], mid[2][8], hi[2][8];
        const int t0 = dir ? T - 1 : 0;
        ml_load_row(projb, t0 - 1, coff, lo); ml_load_row(projb, t0, coff, mid); ml_load_row(projb, t0 + 1, coff, hi);
        for (int s = 0; s < T; ++s) {
            const int t = dir ? T - 1 - s : s;
            const float ip = gatesb[(size_t)t * 64 + (2 * dir) * 6 + h] + bi, fp = gatesb[(size_t)t * 64 + (2 * dir + 1) * 6 + h] + bff;
            const float f = sigmoidf_(fp), ig = __expf(ip);
            const float v = bf2f(projb[(size_t)t * NPROJ + P_MLV + h * 64 + e]);
            float pn = 0.f, pd = 0.f;
#pragma unroll
            for (int j = 0; j < 8; ++j) {
                float yq = lo[0][j] * cw[0][j][0] + mid[0][j] * cw[0][j][1] + hi[0][j] * cw[0][j][2] + cw[0][j][3];
                float yk = lo[1][j] * cw[1][j][0] + mid[1][j] * cw[1][j][1] + hi[1][j] * cw[1][j][2] + cw[1][j][3];
                const float qd = yq * sigmoidf_(yq), kd = yk * sigmoidf_(yk) * 0.125f;
                C[j] = f * C[j] + ig * kd * v; n[j] = f * n[j] + ig * kd; pn += C[j] * qd; pd += n[j] * qd;
            }
            const int p = s & 1;
            rnum[(p * 8 + dg) * 64 + e] = pn; if (e == 0) rden[p * 8 + dg] = pd;
            __syncthreads();
            if (dg == 0) {
                float num = 0.f, den = 0.f;
#pragma unroll
                for (int g = 0; g < 8; ++g) { num += rnum[(p * 8 + g) * 64 + e]; den += rden[p * 8 + g]; }
                const float hv = num / fmaxf(fabsf(den), 1.f);
                if (dir == 0) hs[(size_t)t * 384 + e] = hv;
                else { const float tot = hs[(size_t)t * 384 + e] + hv; const float ss = wave_sum(tot * tot);
                    const float r = 1.0f / sqrtf(ss * (1.0f / 64) + EPS); const float og = bf2f(projb[(size_t)t * NPROJ + P_MLO + h * 64 + e]);
                    c.mixed()[((size_t)b * T + t) * D + h * 64 + e] = (bf16_t)f2bf(tot * r * ng[h * 64 + e] * sigmoidf_(og)); }
            }
            if (dir == 0) {
#pragma unroll
                for (int j = 0; j < 8; ++j) { lo[0][j] = mid[0][j]; lo[1][j] = mid[1][j]; mid[0][j] = hi[0][j]; mid[1][j] = hi[1][j]; }
                ml_load_row(projb, t + 2, coff, hi);
            } else {
#pragma unroll
                for (int j = 0; j < 8; ++j) { hi[0][j] = mid[0][j]; hi[1][j] = mid[1][j]; mid[0][j] = lo[0][j]; mid[1][j] = lo[1][j]; }
                ml_load_row(projb, t - 2, coff, lo);
            }
        }
        __syncthreads();
    }
}
__device__ __forceinline__ void gla_item(const Ctx& c0, int l, int item, LAS unsigned char* lds) {
    LAUNDER_CTX(c0, c);
    const int b = item / 5, h = item % 5, e = c.tid & 63, kg = c.tid >> 6;
    LAS float* rnum = (LAS float*)lds;
    const bf16_t* projb = c.proj() + (size_t)b * T * NPROJ;
    const float* gatesb = c.gates() + (size_t)b * T * 64;
    float* gs = c.hsgl() + (size_t)b * T * 320 + h * 64;
    const float* ng = c.in(11) + l * 320;
    const int doff = h * 32 + kg * 4;
    for (int dir = 0; dir < 2; ++dir) {
        const float* w2 = c.in(9) + ((size_t)l * 2 + dir) * 16 * 160; const float* ab = c.in(10) + ((size_t)l * 2 + dir) * 160;
        float w2r[16][4], abv[4], S[4];
#pragma unroll
        for (int j = 0; j < 4; ++j) { abv[j] = ab[doff + j]; S[j] = 0.f;
#pragma unroll
            for (int r = 0; r < 16; ++r) w2r[r][j] = w2[r * 160 + doff + j]; }
        for (int s = 0; s < T; ++s) {
            const int t = dir ? T - 1 - s : s;
            const float* gp = gatesb + (size_t)t * 64 + 24 + dir * 16;
            float ga[16];
#pragma unroll
            for (int r4 = 0; r4 < 4; ++r4) { const f32x4 x = *(const f32x4*)(gp + 4 * r4); ga[4 * r4] = x[0]; ga[4 * r4 + 1] = x[1]; ga[4 * r4 + 2] = x[2]; ga[4 * r4 + 3] = x[3]; }
            const unsigned long long qw = *(const unsigned long long*)(projb + (size_t)t * NPROJ + P_GQ + doff), kw = *(const unsigned long long*)(projb + (size_t)t * NPROJ + P_GK + doff);
            const float v = bf2f(projb[(size_t)t * NPROJ + P_GV + h * 64 + e]);
            float pn = 0.f;
#pragma unroll
            for (int j = 0; j < 4; ++j) {
                float z = abv[j];
#pragma unroll
                for (int r = 0; r < 16; ++r) z += ga[r] * w2r[r][j];
                const float la = (fminf(z, 0.f) - log1pf(__expf(-fabsf(z)))) * (1.0f / 16.0f);
                const float a = __expf(la);
                const float qd = bf2f((unsigned)(qw >> (16 * j)) & 0xffffu), kd = bf2f((unsigned)(kw >> (16 * j)) & 0xffffu);
                S[j] = a * S[j] + kd * v; pn += S[j] * qd;
            }
            const int p = s & 1;
            rnum[(p * 8 + kg) * 64 + e] = pn * 0.17677669529663687f;
            __syncthreads();
            if (kg == 0) {
                float o = 0.f;
#pragma unroll
                for (int g = 0; g < 8; ++g) o += rnum[(p * 8 + g) * 64 + e];
                if (dir == 0) gs[(size_t)t * 320 + e] = o;
                else { const float tot = gs[(size_t)t * 320 + e] + o; const float ss = wave_sum(tot * tot);
                    const float r = 1.0f / sqrtf(ss * (1.0f / 64) + EPS); const float gg = bf2f(projb[(size_t)t * NPROJ + P_GG + h * 64 + e]);
                    c.mixed()[((size_t)b * T + t) * D + 704 + h * 64 + e] = (bf16_t)f2bf(tot * r * ng[h * 64 + e] * gg * sigmoidf_(gg)); }
            }
        }
        __syncthreads();
    }
}
__device__ __forceinline__ void na_item(const Ctx& c0, int l, int item, LAS unsigned char* lds) {
    LAUNDER_CTX(c0, c);
    const int b = item / 160, h = (item % 160) / 32, r = item % 32;
    const int q = c.tid >> 3, s = c.tid & 7;
    LAS float* sc = (LAS float*)lds;
    const bf16_t* projb = c.proj() + (size_t)b * T * NPROJ;
    const float* rpb = c.in(8) + ((size_t)l * 5 + h) * 15 * 31;
    const int rs = min(max(r - 4, 0), 24), cs = min(max(q - 8, 0), 48);
    float qv[64];
    { const bf16_t* qp = projb + (size_t)(r * 64 + q) * NPROJ + P_NAQ + h * 64;
#pragma unroll
      for (int i = 0; i < 8; ++i) { float t8[8]; unpack8(*(const u32x4*)(qp + 8 * i), t8);
#pragma unroll
          for (int j = 0; j < 8; ++j) qv[8 * i + j] = t8[j]; } }
    const int tr = rs + s;
    for (int kk = 0; kk < 16; ++kk) { const int tc = cs + kk;
        const bf16_t* kp = projb + (size_t)(tr * 64 + tc) * NPROJ + P_NAK + h * 64; float d = 0.f;
#pragma unroll
        for (int i = 0; i < 8; ++i) { float t8[8]; unpack8(*(const u32x4*)(kp + 8 * i), t8);
#pragma unroll
            for (int j = 0; j < 8; ++j) d += qv[8 * i + j] * t8[j]; }
        const int dr = tr - r + 7, dc = min(max(tc - q, -15), 15) + 15;
        sc[q * 129 + s * 16 + kk] = d * 0.125f + rpb[dr * 31 + dc]; }
    __syncthreads();
    float mx = -3.0e38f; for (int k = 0; k < 128; ++k) mx = fmaxf(mx, sc[q * 129 + k]);
    float sum = 0.f; for (int k = 0; k < 128; ++k) sum += __expf(sc[q * 129 + k] - mx);
    __syncthreads();
    const float inv = 1.0f / sum;
    for (int kk = 0; kk < 16; ++kk) sc[q * 129 + s * 16 + kk] = __expf(sc[q * 129 + s * 16 + kk] - mx) * inv;
    __syncthreads();
    float o[8];
#pragma unroll
    for (int j = 0; j < 8; ++j) o[j] = 0.f;
    for (int key = 0; key < 128; ++key) { const int trr = rs + (key >> 4), tcc = cs + (key & 15);
        float t8[8]; unpack8(*(const u32x4*)(projb + (size_t)(trr * 64 + tcc) * NPROJ + P_NAV + h * 64 + s * 8), t8); const float p = sc[q * 129 + key];
#pragma unroll
        for (int j = 0; j < 8; ++j) o[j] += p * t8[j]; }
    u32x4 w; w.x = pk2(o[0], o[1]); w.y = pk2(o[2], o[3]); w.z = pk2(o[4], o[5]); w.w = pk2(o[6], o[7]);
    *(u32x4*)(c.mixed() + ((size_t)b * T + r * 64 + q) * D + 384 + h * 64 + s * 8) = w;
    __syncthreads();
}
__device__ __forceinline__ void xattn_item(const Ctx& c0, int item, LAS unsigned char* lds) {
    LAUNDER_CTX(c0, c);
    const int b = item / 256, hd = (item / 64) % 4, qt = item % 64; const int row0 = b * T + qt * 32;
    LAS float* qs = (LAS float*)lds;
    LAS float* ps = (LAS float*)lds + 8192;
    const int qi = c.tid >> 4, sub = c.tid & 15;
    { const bf16_t* qp = c.q() + (size_t)(row0 + qi) * D + hd * 256 + sub * 16; float t8[8];
      unpack8(*(const u32x4*)qp, t8);
#pragma unroll
      for (int j = 0; j < 8; ++j) qs[qi * 256 + sub * 16 + j] = t8[j];
      unpack8(*(const u32x4*)(qp + 8), t8);
#pragma unroll
      for (int j = 0; j < 8; ++j) qs[qi * 256 + sub * 16 + 8 + j] = t8[j]; }
    __syncthreads();
    const bf16_t* kvb = c.memkv() + (size_t)b * NMEM * 2048 + hd * 256;
    float acc[16];
#pragma unroll
    for (int j = 0; j < 16; ++j) acc[j] = 0.f;
    for (int dc = 0; dc < 32; ++dc) {
        float qr[8];
#pragma unroll
        for (int i = 0; i < 8; ++i) qr[i] = qs[qi * 256 + dc * 8 + i];
#pragma unroll
        for (int j = 0; j < 16; ++j) { float t8[8]; unpack8(*(const u32x4*)(kvb + (size_t)(sub + 16 * j) * 2048 + dc * 8), t8);
#pragma unroll
            for (int i = 0; i < 8; ++i) acc[j] += qr[i] * t8[i]; }
    }
    float mx = -3.0e38f;
#pragma unroll
    for (int j = 0; j < 16; ++j) { acc[j] *= 0.0625f; mx = fmaxf(mx, acc[j]); }
#pragma unroll
    for (int o = 1; o < 16; o <<= 1) mx = fmaxf(mx, __shfl_xor(mx, o));
    float sum = 0.f;
#pragma unroll
    for (int j = 0; j < 16; ++j) { acc[j] = __expf(acc[j] - mx); sum += acc[j]; }
#pragma unroll
    for (int o = 1; o < 16; o <<= 1) sum += __shfl_xor(sum, o);
    const float inv = 1.0f / sum;
#pragma unroll
    for (int j = 0; j < 16; ++j) ps[qi * 256 + sub + 16 * j] = acc[j] * inv;
    __syncthreads();
    float o[16];
#pragma unroll
    for (int j = 0; j < 16; ++j) o[j] = 0.f;
    for (int key = 0; key < 256; ++key) { const float p = ps[qi * 256 + key]; const bf16_t* vp = kvb + (size_t)key * 2048 + 1024 + sub * 16; float t8[8];
        unpack8(*(const u32x4*)vp, t8);
#pragma unroll
        for (int j = 0; j < 8; ++j) o[j] += p * t8[j];
        unpack8(*(const u32x4*)(vp + 8), t8);
#pragma unroll
        for (int j = 0; j < 8; ++j) o[8 + j] += p * t8[j]; }
    bf16_t* op = c.mixed() + (size_t)(row0 + qi) * D + hd * 256 + sub * 16;
    u32x4 w; w.x = pk2(o[0], o[1]); w.y = pk2(o[2], o[3]); w.z = pk2(o[4], o[5]); w.w = pk2(o[6], o[7]); *(u32x4*)op = w;
    w.x = pk2(o[8], o[9]); w.y = pk2(o[10], o[11]); w.z = pk2(o[12], o[13]); w.w = pk2(o[14], o[15]); *(u32x4*)(op + 8) = w;
    __syncthreads();
}
__device__ __forceinline__ void act_pass(const Ctx& c, int l) {
    const float* cw = c.in(21) + (size_t)l * 3 * DFF; const float* cb = c.in(22) + (size_t)l * DFF;
    constexpr int CH = DFF / 8;
    for (int idx = c.bid * NTHREADS + c.tid; idx < M * CH; idx += c.G * NTHREADS) {
        const int row = idx / CH, c8 = (idx % CH) * 8, t = row % T;
        const bf16_t* up = c.u() + (size_t)row * NUP + c8;
        float a0[8], am[8], ap[8], g[8];
        unpack8(*(const u32x4*)up, a0); unpack8(*(const u32x4*)(up + DFF), g);
        if (t > 0) unpack8(*(const u32x4*)(up - NUP), am); else {
#pragma unroll
            for (int j = 0; j < 8; ++j) am[j] = 0.f; }
        if (t < T - 1) unpack8(*(const u32x4*)(up + NUP), ap); else {
#pragma unroll
            for (int j = 0; j < 8; ++j) ap[j] = 0.f; }
        float o[8];
#pragma unroll
        for (int j = 0; j < 8; ++j) { const float a = am[j] * cw[c8 + j] + a0[j] * cw[DFF + c8 + j] + ap[j] * cw[2 * DFF + c8 + j] + cb[c8 + j];
            const float uu = 0.7978845608028654f * (a + 0.044715f * a * a * a);
            o[j] = a / (1.f + __expf(-2.f * uu)) * g[j]; }
        u32x4 w; w.x = pk2(o[0], o[1]); w.y = pk2(o[2], o[3]); w.z = pk2(o[4], o[5]); w.w = pk2(o[6], o[7]);
        *(u32x4*)(c.act() + (size_t)row * DFF + c8) = w;
    }
}
typedef short s16x4 __attribute__((ext_vector_type(4)));
#define MFMA16(a, b, c) __builtin_amdgcn_mfma_f32_16x16x32_bf16((a), (b), (c), 0, 0, 0)
__device__ __forceinline__ bf16x8 frag_nt(LAS const unsigned char* tile, int pitch, int row, int kbyte) {
    return *(const LAS bf16x8*)(tile + row * pitch + kbyte);
}
__device__ __forceinline__ bf16x8 frag_tr(LAS const unsigned char* tile, int pitch, int r0, int r1, int n0, int lane) {
    const int q4 = (lane & 15) >> 2, p4 = lane & 3;
    const unsigned a0 = (unsigned)(size_t)tile + (unsigned)((r0 + q4) * pitch + (n0 + 4 * p4) * 2), a1 = (unsigned)(size_t)tile + (unsigned)((r1 + q4) * pitch + (n0 + 4 * p4) * 2);
    s16x4 x, y;
    asm volatile("ds_read_b64_tr_b16 %0, %2\n\tds_read_b64_tr_b16 %1, %3\n\ts_waitcnt lgkmcnt(0)" : "=&v"(x), "=&v"(y) : "v"(a0), "v"(a1) : "memory");
    return (bf16x8){x[0], x[1], x[2], x[3], y[0], y[1], y[2], y[3]};
}
__device__ __forceinline__ bf16x8 pack_frag(const f32x4 lo, const f32x4 hi) {
    u32x4 w; w.x = cvt_pk_bf16(lo[0], lo[1]); w.y = cvt_pk_bf16(lo[2], lo[3]); w.z = cvt_pk_bf16(hi[0], hi[1]); w.w = cvt_pk_bf16(hi[2], hi[3]);
    return __builtin_bit_cast(bf16x8, w);
}
__device__ __forceinline__ float logsigmoidf_(float x) { return fminf(x, 0.f) - log1pf(__expf(-fabsf(x))); }
__device__ __forceinline__ float wave_incl_scan(float v, int lane) {
#pragma unroll
    for (int o = 1; o < 64; o <<= 1) { const float t = __shfl_up(v, o); if (lane >= o) v += t; }
    return v;
}
constexpr int P64 = 144;

__device__ __forceinline__ bf16_t* mlc_ptr(const Ctx& c, int b, int h, int dir, int ch) { return c.wsp<bf16_t>(WS_HSML) + (size_t)((((b * 6 + h) * 2 + dir) * 16) + ch) * 80 * 64; }

template <bool ROWW>
__device__ __forceinline__ void ml_stage_conv(const Ctx& c, const bf16_t* projb, int t0, int pcol, const float* cwp, const float* cbp, int cch, float scale, const LAS float* roww, LAS unsigned char* tile) {
    const int j = c.tid >> 2, cb = (c.tid & 3) * 16, t = t0 + j;
    float lo[16], mid[16], hi[16];
    { const bf16_t* p = projb + (size_t)t * NPROJ + pcol + cb; float t8[8];
      unpack8(*(const u32x4*)p, t8);
#pragma unroll
      for (int x = 0; x < 8; ++x) mid[x] = t8[x];
      unpack8(*(const u32x4*)(p + 8), t8);
#pragma unroll
      for (int x = 0; x < 8; ++x) mid[8 + x] = t8[x];
      if (t > 0) { unpack8(*(const u32x4*)(p - NPROJ), t8);
#pragma unroll
          for (int x = 0; x < 8; ++x) lo[x] = t8[x];
          unpack8(*(const u32x4*)(p - NPROJ + 8), t8);
#pragma unroll
          for (int x = 0; x < 8; ++x) lo[8 + x] = t8[x]; }
      else {
#pragma unroll
          for (int x = 0; x < 16; ++x) lo[x] = 0.f; }
      if (t < T - 1) { unpack8(*(const u32x4*)(p + NPROJ), t8);
#pragma unroll
          for (int x = 0; x < 8; ++x) hi[x] = t8[x];
          unpack8(*(const u32x4*)(p + NPROJ + 8), t8);
#pragma unroll
          for (int x = 0; x < 8; ++x) hi[8 + x] = t8[x]; }
      else {
#pragma unroll
          for (int x = 0; x < 16; ++x) hi[x] = 0.f; } }
    const float rw = ROWW ? roww[j] * scale : scale;
    float o[16];
#pragma unroll
    for (int x = 0; x < 16; ++x) { const int ch = cch + cb + x;
        const float y = lo[x] * cwp[ch] + mid[x] * cwp[768 + ch] + hi[x] * cwp[1536 + ch] + cbp[ch];
        o[x] = y * sigmoidf_(y) * rw; }
    u32x4 w0, w1; w0.x = pk2(o[0], o[1]); w0.y = pk2(o[2], o[3]); w0.z = pk2(o[4], o[5]); w0.w = pk2(o[6], o[7]);
    w1.x = pk2(o[8], o[9]); w1.y = pk2(o[10], o[11]); w1.z = pk2(o[12], o[13]); w1.w = pk2(o[14], o[15]);
    *(LAS u32x4*)(tile + j * P64 + cb * 2) = w0; *(LAS u32x4*)(tile + j * P64 + cb * 2 + 16) = w1;
}
__device__ __forceinline__ void ml_stage_plain(const Ctx& c, const bf16_t* projb, int t0, int pcol, LAS unsigned char* tile) {
    const int j = c.tid >> 2, cb = (c.tid & 3) * 16; const bf16_t* p = projb + (size_t)(t0 + j) * NPROJ + pcol + cb;
    *(LAS u32x4*)(tile + j * P64 + cb * 2) = *(const u32x4*)p; *(LAS u32x4*)(tile + j * P64 + cb * 2 + 16) = *(const u32x4*)(p + 8);
}
__device__ __forceinline__ float ml_gate_scan(const float* gatesb, int t0, int dir, int h, float bi, float bf_, LAS float* bcum, LAS float* ii, int lane) {
    const float* g0 = gatesb + (size_t)(t0 + 2 * lane) * 64; const float* g1 = g0 + 64;
    const float i0 = g0[(2 * dir) * 6 + h] + bi, i1 = g1[(2 * dir) * 6 + h] + bi;
    const float f0 = logsigmoidf_(g0[(2 * dir + 1) * 6 + h] + bf_), f1 = logsigmoidf_(g1[(2 * dir + 1) * 6 + h] + bf_);
    const float inc = wave_incl_scan(f0 + f1, lane), tot = __shfl(inc, 63);
    float b0, b1;
    if (dir == 0) { b0 = inc - f1; b1 = inc; } else { b1 = tot - inc + f1; b0 = b1 + f0; }
    bcum[2 * lane] = b0; bcum[2 * lane + 1] = b1; ii[2 * lane] = i0; ii[2 * lane + 1] = i1;
    return tot;
}

__device__ __forceinline__ void ml_state_item(const Ctx& c0, int l, int item, LAS unsigned char* lds) {
    LAUNDER_CTX(c0, c);
    const int b = item / 12, h = (item % 12) >> 1, dir = item & 1;
    const int lane = c.lane, w = c.wave, i = lane & 15, g = lane >> 4;
    LAS unsigned char* Kw = lds;
    LAS unsigned char* Vt = lds + 128 * P64;
    LAS float* wj = (LAS float*)(lds + 2 * 128 * P64);
    LAS float* bcum = wj + 128; LAS float* iiv = wj + 256; LAS float* nst = wj + 384; LAS float* misc = wj + 448;
    const bf16_t* projb = c.proj() + (size_t)b * T * NPROJ; const float* gatesb = c.gates() + (size_t)b * T * 64;
    const float* cwp = c.in(4) + (size_t)l * 3 * 768; const float* cbp = c.in(5) + (size_t)l * 768; const float* gb = c.in(6) + l * 24;
    const float bi = gb[(2 * dir) * 6 + h], bf_ = gb[(2 * dir + 1) * 6 + h];
    const int td = w >> 1, te0 = (w & 1) * 2;
    f32x4 acc[2] = {{0.f, 0.f, 0.f, 0.f}, {0.f, 0.f, 0.f, 0.f}};
    if (c.tid < 64) nst[c.tid] = 0.f;
    __syncthreads();
    for (int cc = 0; cc < 16; ++cc) {
        const int ch = dir ? 15 - cc : cc, t0 = ch * 128;
        bf16_t* st = mlc_ptr(c, b, h, dir, ch);
#pragma unroll
        for (int x = 0; x < 2; ++x) { const int e = 16 * (te0 + x) + i, d = 16 * td + 4 * g;
            *(unsigned long long*)(st + e * 64 + d) = (unsigned long long)cvt_pk_bf16(acc[x][0], acc[x][1]) | ((unsigned long long)cvt_pk_bf16(acc[x][2], acc[x][3]) << 32); }
        if (c.tid < 64) st[64 * 64 + c.tid] = (bf16_t)f2bf(nst[c.tid]);
        for (int x = c.tid; x < 15 * 64 / 8; x += NTHREADS) *(u32x4*)(st + 65 * 64 + x * 8) = (u32x4){0u, 0u, 0u, 0u};
        if (cc == 15) break;
        if (w == 0) { const float tot = ml_gate_scan(gatesb, t0, dir, h, bi, bf_, bcum, iiv, lane);
            wj[2 * lane] = __expf(tot - bcum[2 * lane] + iiv[2 * lane]); wj[2 * lane + 1] = __expf(tot - bcum[2 * lane + 1] + iiv[2 * lane + 1]);
            if (lane == 0) misc[0] = __expf(tot); }
        __syncthreads();
        ml_stage_conv<true>(c, projb, t0, P_MLK + h * 64, cwp, cbp, 384 + h * 64, 0.125f, wj, Kw);
        ml_stage_plain(c, projb, t0, P_MLV + h * 64, Vt);
        __syncthreads();
        const float eg = misc[0];
        acc[0] = acc[0] * eg; acc[1] = acc[1] * eg;
#pragma unroll
        for (int s = 0; s < 4; ++s) { const int r0 = 32 * s + 8 * g, r1 = r0 + 4;
            const bf16x8 a = frag_tr(Kw, P64, r0, r1, 16 * td, lane);
#pragma unroll
            for (int x = 0; x < 2; ++x) { const bf16x8 bb = frag_tr(Vt, P64, r0, r1, 16 * (te0 + x), lane); acc[x] = MFMA16(a, bb, acc[x]); } }
        if (c.tid < 64) { float s = 0.f; for (int j = 0; j < 128; ++j) s += bf2f(*(const LAS unsigned short*)(Kw + j * P64 + c.tid * 2)); nst[c.tid] = eg * nst[c.tid] + s; }
        __syncthreads();
    }
}

__device__ __forceinline__ void ml_out_item(const Ctx& c0, int l, int item, LAS unsigned char* lds) {
    LAUNDER_CTX(c0, c);
    const int b = item / 96, h = (item % 96) / 16, ch = item % 16, t0 = ch * 128;
    const int lane = c.lane, w = c.wave, i = lane & 15, g = lane >> 4;
    LAS unsigned char* Qt = lds; LAS unsigned char* Kt = lds + 128 * P64; LAS unsigned char* Vt = lds + 2 * 128 * P64;
    LAS unsigned char* Cf = lds + 3 * 128 * P64; LAS unsigned char* Cb = Cf + 80 * P64;
    LAS float* bF = (LAS float*)(Cb + 80 * P64); LAS float* iF = bF + 128; LAS float* bB = bF + 256; LAS float* iB = bF + 384;
    const bf16_t* projb = c.proj() + (size_t)b * T * NPROJ; const float* gatesb = c.gates() + (size_t)b * T * 64;
    const float* cwp = c.in(4) + (size_t)l * 3 * 768; const float* cbp = c.in(5) + (size_t)l * 768; const float* gb = c.in(6) + l * 24;
    if (w == 0) (void)ml_gate_scan(gatesb, t0, 0, h, gb[0 * 6 + h], gb[1 * 6 + h], bF, iF, lane);
    if (w == 1) (void)ml_gate_scan(gatesb, t0, 1, h, gb[2 * 6 + h], gb[3 * 6 + h], bB, iB, lane);
    ml_stage_conv<false>(c, projb, t0, P_MLQ + h * 64, cwp, cbp, h * 64, 1.0f, nullptr, Qt);
    ml_stage_conv<false>(c, projb, t0, P_MLK + h * 64, cwp, cbp, 384 + h * 64, 0.125f, nullptr, Kt);
    ml_stage_plain(c, projb, t0, P_MLV + h * 64, Vt);
    { const bf16_t* sf = mlc_ptr(c, b, h, 0, ch); const bf16_t* sb = mlc_ptr(c, b, h, 1, ch);
      for (int x = c.tid; x < 80 * 8; x += NTHREADS) { const int r = x >> 3, k8 = x & 7;
          *(LAS u32x4*)(Cf + r * P64 + k8 * 16) = *(const u32x4*)(sf + r * 64 + k8 * 8); *(LAS u32x4*)(Cb + r * P64 + k8 * 16) = *(const u32x4*)(sb + r * 64 + k8 * 8); } }
    __syncthreads();
    const int ti = w, qi = 16 * ti + i;
    const bf16x8 q0 = frag_nt(Qt, P64, qi, 16 * g), q1 = frag_nt(Qt, P64, qi, 64 + 16 * g);
    const float bFq = bF[qi], bBq = bB[qi];
    f32x4 of[4], ob[4];
#pragma unroll
    for (int x = 0; x < 4; ++x) { of[x] = (f32x4){0.f, 0.f, 0.f, 0.f}; ob[x] = (f32x4){0.f, 0.f, 0.f, 0.f}; }
    float denf = 0.f, denb = 0.f;
#pragma unroll
    for (int s4 = 0; s4 < 4; ++s4) {
        const bool dof = (2 * s4 <= ti), dob = (2 * s4 + 1 >= ti);
        f32x4 pf[2], pb[2];
#pragma unroll
        for (int x = 0; x < 2; ++x) { const int tj = 2 * s4 + x;
            f32x4 s = (f32x4){0.f, 0.f, 0.f, 0.f};
            s = MFMA16(frag_nt(Kt, P64, 16 * tj + i, 16 * g), q0, s); s = MFMA16(frag_nt(Kt, P64, 16 * tj + i, 64 + 16 * g), q1, s);
#pragma unroll
            for (int r = 0; r < 4; ++r) { const int j = 16 * tj + 4 * g + r;
                const float wf = (j <= qi) ? __expf(bFq - bF[j] + iF[j]) : 0.f, wb = (j >= qi) ? __expf(bBq - bB[j] + iB[j]) : 0.f;
                pf[x][r] = s[r] * wf; pb[x][r] = s[r] * wb; denf += pf[x][r]; denb += pb[x][r]; } }
        const int r0 = 32 * s4 + 4 * g, r1 = r0 + 16;
        if (dof) { const bf16x8 p = pack_frag(pf[0], pf[1]);
#pragma unroll
            for (int te = 0; te < 4; ++te) of[te] = MFMA16(frag_tr(Vt, P64, r0, r1, 16 * te, lane), p, of[te]); }
        if (dob) { const bf16x8 p = pack_frag(pb[0], pb[1]);
#pragma unroll
            for (int te = 0; te < 4; ++te) ob[te] = MFMA16(frag_tr(Vt, P64, r0, r1, 16 * te, lane), p, ob[te]); }
    }
    denf += __shfl_xor(denf, 16); denf += __shfl_xor(denf, 32); denb += __shfl_xor(denb, 16); denb += __shfl_xor(denb, 32);
    { const float ef = __expf(bFq), eb = __expf(bBq);
#pragma unroll
      for (int te = 0; te < 5; ++te) {
          f32x4 tf = (f32x4){0.f, 0.f, 0.f, 0.f}, tb = (f32x4){0.f, 0.f, 0.f, 0.f};
          tf = MFMA16(frag_nt(Cf, P64, 16 * te + i, 16 * g), q0, tf); tf = MFMA16(frag_nt(Cf, P64, 16 * te + i, 64 + 16 * g), q1, tf);
          tb = MFMA16(frag_nt(Cb, P64, 16 * te + i, 16 * g), q0, tb); tb = MFMA16(frag_nt(Cb, P64, 16 * te + i, 64 + 16 * g), q1, tb);
          if (te < 4) { of[te] = of[te] + tf * ef; ob[te] = ob[te] + tb * eb; }
          else { denf += ef * __shfl(tf[0], i); denb += eb * __shfl(tb[0], i); } } }
    const float rf = 1.0f / fmaxf(fabsf(denf), 1.f), rb = 1.0f / fmaxf(fabsf(denb), 1.f);
    float ss = 0.f;
#pragma unroll
    for (int te = 0; te < 4; ++te) { of[te] = of[te] * rf + ob[te] * rb; ss += (of[te][0] * of[te][0] + of[te][1] * of[te][1]) + (of[te][2] * of[te][2] + of[te][3] * of[te][3]); }
    ss += __shfl_xor(ss, 16); ss += __shfl_xor(ss, 32);
    const float rn = 1.0f / sqrtf(ss * (1.0f / 64) + EPS);
    const float* ng = c.in(7) + l * 384 + h * 64;
    const size_t row = (size_t)b * T + t0 + qi;
#pragma unroll
    for (int te = 0; te < 4; ++te) { const int e = 16 * te + 4 * g;
        const unsigned long long ow = *(const unsigned long long*)(projb + (size_t)(t0 + qi) * NPROJ + P_MLO + h * 64 + e);
        float o4[4];
#pragma unroll
        for (int r = 0; r < 4; ++r) { const float og = bf2f((unsigned)(ow >> (16 * r)) & 0xffffu); o4[r] = of[te][r] * rn * ng[e + r] * sigmoidf_(og); }
        *(unsigned long long*)(c.mixed() + row * D + h * 64 + e) = (unsigned long long)pk2(o4[0], o4[1]) | ((unsigned long long)pk2(o4[2], o4[3]) << 32); }
    __syncthreads();
}

constexpr int P32 = 80;
constexpr int LAP = 33;
__device__ __forceinline__ bf16_t* glc_ptr(const Ctx& c, int b, int h, int dir, int ch) { return c.wsp<bf16_t>(WS_HSGL) + (size_t)((((b * 5 + h) * 2 + dir) * 32) + ch) * 64 * 32; }
__device__ __forceinline__ void gla_loga(const Ctx& c, const float* gatesb, int t0, int nrows, int dir, const LAS float* w2s  , const LAS float* abs_  , LAS float* la  ) {
    for (int x = c.tid; x < nrows * 8; x += NTHREADS) { const int j = x >> 3, d4 = (x & 7) * 4;
        const float* gp = gatesb + (size_t)(t0 + j) * 64 + 24 + dir * 16; float ga[16];
#pragma unroll
        for (int r4 = 0; r4 < 4; ++r4) { const f32x4 v = *(const f32x4*)(gp + 4 * r4); ga[4 * r4] = v[0]; ga[4 * r4 + 1] = v[1]; ga[4 * r4 + 2] = v[2]; ga[4 * r4 + 3] = v[3]; }
#pragma unroll
        for (int y = 0; y < 4; ++y) { float z = abs_[d4 + y];
#pragma unroll
            for (int r = 0; r < 16; ++r) z += ga[r] * w2s[r * 32 + d4 + y];
            la[j * LAP + d4 + y] = logsigmoidf_(z) * (1.0f / 16.0f); } }
}
__device__ __forceinline__ void gla_scan64(LAS float* la  , int dir, int d, int lane, LAS float* tot) {
    const float v = la[lane * LAP + d]; const float inc = wave_incl_scan(v, lane), t = __shfl(inc, 63);
    la[lane * LAP + d] = dir ? (t - inc + v) : inc;
    if (tot && lane == 0) tot[d] = t;
}

__device__ __forceinline__ void gla_state_item(const Ctx& c0, int l, int item, LAS unsigned char* lds) {
    LAUNDER_CTX(c0, c);
    const int b = item / 10, h = (item % 10) >> 1, dir = item & 1;
    const int lane = c.lane, w = c.wave, i = lane & 15, g = lane >> 4;
    LAS unsigned char* Kt = lds;
    LAS unsigned char* Vt = lds + 64 * P32;
    LAS float* la = (LAS float*)(lds + 64 * P32 + 64 * P64);
    LAS float* btot = la + 64 * LAP; LAS float* w2s = btot + 32; LAS float* abs_ = w2s + 512;
    const bf16_t* projb = c.proj() + (size_t)b * T * NPROJ; const float* gatesb = c.gates() + (size_t)b * T * 64;
    { const float* w2 = c.in(9) + ((size_t)l * 2 + dir) * 16 * 160; const float* ab = c.in(10) + ((size_t)l * 2 + dir) * 160;
      w2s[c.tid] = w2[(c.tid >> 5) * 160 + h * 32 + (c.tid & 31)]; if (c.tid < 32) abs_[c.tid] = ab[h * 32 + c.tid]; }
    const int td = w >> 2, te = w & 3;
    f32x4 acc = {0.f, 0.f, 0.f, 0.f};
    __syncthreads();
    for (int cc = 0; cc < 32; ++cc) {
        const int ch = dir ? 31 - cc : cc, t0 = ch * 64;
        { bf16_t* st = glc_ptr(c, b, h, dir, ch); const int e = 16 * te + i, d = 16 * td + 4 * g;
          *(unsigned long long*)(st + e * 32 + d) = (unsigned long long)cvt_pk_bf16(acc[0], acc[1]) | ((unsigned long long)cvt_pk_bf16(acc[2], acc[3]) << 32); }
        if (cc == 31) break;
        gla_loga(c, gatesb, t0, 64, dir, w2s, abs_, la);
        __syncthreads();
#pragma unroll
        for (int y = 0; y < 4; ++y) gla_scan64(la, dir, w * 4 + y, lane, btot);
        __syncthreads();
        { const int j = c.tid >> 3, d4 = (c.tid & 7) * 4;
          const unsigned long long kw = *(const unsigned long long*)(projb + (size_t)(t0 + j) * NPROJ + P_GK + h * 32 + d4); float o[4];
#pragma unroll
          for (int y = 0; y < 4; ++y) o[y] = bf2f((unsigned)(kw >> (16 * y)) & 0xffffu) * __expf(btot[d4 + y] - la[j * LAP + d4 + y]);
          *(LAS unsigned long long*)(Kt + j * P32 + d4 * 2) = (unsigned long long)pk2(o[0], o[1]) | ((unsigned long long)pk2(o[2], o[3]) << 32);
          const int e8 = (c.tid & 7) * 8; *(LAS u32x4*)(Vt + j * P64 + e8 * 2) = *(const u32x4*)(projb + (size_t)(t0 + j) * NPROJ + P_GV + h * 64 + e8); }
        __syncthreads();
#pragma unroll
        for (int r = 0; r < 4; ++r) acc[r] *= __expf(btot[16 * td + 4 * g + r]);
#pragma unroll
        for (int s = 0; s < 2; ++s) { const int r0 = 32 * s + 8 * g, r1 = r0 + 4;
            acc = MFMA16(frag_tr(Kt, P32, r0, r1, 16 * td, lane), frag_tr(Vt, P64, r0, r1, 16 * te, lane), acc); }
        __syncthreads();
    }
}

__device__ __forceinline__ void gla_out_item(const Ctx& c0, int l, int item, LAS unsigned char* lds) {
    LAUNDER_CTX(c0, c);
    const int b = item / 80, h = (item % 80) / 16, cp = item % 16, t0 = cp * 128;
    const int lane = c.lane, w = c.wave, i = lane & 15, g = lane >> 4;
    LAS unsigned char* Qf = lds; LAS unsigned char* Kf = Qf + 128 * P32; LAS unsigned char* Qb = Kf + 128 * P32; LAS unsigned char* Kb = Qb + 128 * P32;
    LAS unsigned char* Vt = Kb + 128 * P32;
    LAS unsigned char* Sf = Vt + 128 * P64;
    LAS unsigned char* Sb = Sf + 2 * 64 * P32;
    LAS float* laf = (LAS float*)(Sb + 2 * 64 * P32);
    LAS float* lab = laf + 128 * LAP; LAS float* w2s = lab + 128 * LAP; LAS float* abs_ = w2s + 1024;
    const bf16_t* projb = c.proj() + (size_t)b * T * NPROJ; const float* gatesb = c.gates() + (size_t)b * T * 64;
    { const float* w2 = c.in(9) + (size_t)l * 2 * 16 * 160; const float* ab = c.in(10) + (size_t)l * 2 * 160;
      for (int x = c.tid; x < 1024; x += NTHREADS) w2s[x] = w2[(x >> 5) * 160 + h * 32 + (x & 31)];
      if (c.tid < 64) abs_[c.tid] = ab[(c.tid >> 5) * 160 + h * 32 + (c.tid & 31)]; }
    __syncthreads();
    gla_loga(c, gatesb, t0, 128, 0, w2s, abs_, laf);
    gla_loga(c, gatesb, t0, 128, 1, w2s + 512, abs_ + 32, lab);
    __syncthreads();
#pragma unroll 4
    for (int y = 0; y < 16; ++y) { const int sidx = w * 16 + y, dir = sidx >> 6, sub = (sidx >> 5) & 1, d = sidx & 31;
        gla_scan64((dir ? lab : laf) + sub * 64 * LAP, dir, d, lane, nullptr); }
    __syncthreads();
    { const int j = c.tid >> 2, d8 = (c.tid & 3) * 8;
      float q8[8], k8[8];
      unpack8(*(const u32x4*)(projb + (size_t)(t0 + j) * NPROJ + P_GQ + h * 32 + d8), q8); unpack8(*(const u32x4*)(projb + (size_t)(t0 + j) * NPROJ + P_GK + h * 32 + d8), k8);
      float oqf[8], okf[8], oqb[8], okb[8];
#pragma unroll
      for (int y = 0; y < 8; ++y) { const float bf_ = laf[j * LAP + d8 + y], bb_ = lab[j * LAP + d8 + y];
          oqf[y] = q8[y] * 0.17677669529663687f * __expf(bf_); okf[y] = k8[y] * __expf(-bf_); oqb[y] = q8[y] * 0.17677669529663687f * __expf(bb_); okb[y] = k8[y] * __expf(-bb_); }
      u32x4 x;
      x.x = pk2(oqf[0], oqf[1]); x.y = pk2(oqf[2], oqf[3]); x.z = pk2(oqf[4], oqf[5]); x.w = pk2(oqf[6], oqf[7]); *(LAS u32x4*)(Qf + j * P32 + d8 * 2) = x;
      x.x = pk2(okf[0], okf[1]); x.y = pk2(okf[2], okf[3]); x.z = pk2(okf[4], okf[5]); x.w = pk2(okf[6], okf[7]); *(LAS u32x4*)(Kf + j * P32 + d8 * 2) = x;
      x.x = pk2(oqb[0], oqb[1]); x.y = pk2(oqb[2], oqb[3]); x.z = pk2(oqb[4], oqb[5]); x.w = pk2(oqb[6], oqb[7]); *(LAS u32x4*)(Qb + j * P32 + d8 * 2) = x;
      x.x = pk2(okb[0], okb[1]); x.y = pk2(okb[2], okb[3]); x.z = pk2(okb[4], okb[5]); x.w = pk2(okb[6], okb[7]); *(LAS u32x4*)(Kb + j * P32 + d8 * 2) = x; }
    ml_stage_plain(c, projb, t0, P_GV + h * 64, Vt);
    for (int x = c.tid; x < 2 * 2 * 64 * 4; x += NTHREADS) { const int dir = x >> 9, sub = (x >> 8) & 1, r = (x >> 2) & 63, k4 = x & 3;
        const bf16_t* s = glc_ptr(c, b, h, dir, 2 * cp + sub); *(LAS u32x4*)((dir ? Sb : Sf) + (sub * 64 + r) * P32 + k4 * 16) = *(const u32x4*)(s + r * 32 + k4 * 8); }
    __syncthreads();
    const int sub = w >> 2, ti = w & 3, R = 64 * sub, qi = 16 * ti + i;
    const bf16x8 qf = frag_nt(Qf, P32, R + qi, 16 * g), qb = frag_nt(Qb, P32, R + qi, 16 * g);
    f32x4 o[4];
#pragma unroll
    for (int te = 0; te < 4; ++te) o[te] = (f32x4){0.f, 0.f, 0.f, 0.f};
#pragma unroll
    for (int s2 = 0; s2 < 2; ++s2) {
        f32x4 p[2];
#pragma unroll
        for (int x = 0; x < 2; ++x) { const int tj = 2 * s2 + x; const f32x4 z = {0.f, 0.f, 0.f, 0.f};
            const f32x4 sf = MFMA16(frag_nt(Kf, P32, R + 16 * tj + i, 16 * g), qf, z), sb = MFMA16(frag_nt(Kb, P32, R + 16 * tj + i, 16 * g), qb, z);
#pragma unroll
            for (int r = 0; r < 4; ++r) { const int j = 16 * tj + 4 * g + r; p[x][r] = ((j <= qi) ? sf[r] : 0.f) + ((j >= qi) ? sb[r] : 0.f); } }
        const bf16x8 pp = pack_frag(p[0], p[1]); const int r0 = R + 32 * s2 + 4 * g, r1 = r0 + 16;
#pragma unroll
        for (int te = 0; te < 4; ++te) o[te] = MFMA16(frag_tr(Vt, P64, r0, r1, 16 * te, lane), pp, o[te]);
    }
#pragma unroll
    for (int te = 0; te < 4; ++te) { o[te] = MFMA16(frag_nt(Sf, P32, R + 16 * te + i, 16 * g), qf, o[te]); o[te] = MFMA16(frag_nt(Sb, P32, R + 16 * te + i, 16 * g), qb, o[te]); }
    float ss = 0.f;
#pragma unroll
    for (int te = 0; te < 4; ++te) ss += (o[te][0] * o[te][0] + o[te][1] * o[te][1]) + (o[te][2] * o[te][2] + o[te][3] * o[te][3]);
    ss += __shfl_xor(ss, 16); ss += __shfl_xor(ss, 32);
    const float rn = 1.0f / sqrtf(ss * (1.0f / 64) + EPS);
    const float* ng = c.in(11) + l * 320 + h * 64;
    const int tq = t0 + R + qi;
#pragma unroll
    for (int te = 0; te < 4; ++te) { const int e = 16 * te + 4 * g;
        const unsigned long long gw = *(const unsigned long long*)(projb + (size_t)tq * NPROJ + P_GG + h * 64 + e); float o4[4];
#pragma unroll
        for (int r = 0; r < 4; ++r) { const float gg = bf2f((unsigned)(gw >> (16 * r)) & 0xffffu); o4[r] = o[te][r] * rn * ng[e + r] * gg * sigmoidf_(gg); }
        *(unsigned long long*)(c.mixed() + ((size_t)b * T + tq) * D + 704 + h * 64 + e) = (unsigned long long)pk2(o4[0], o4[1]) | ((unsigned long long)pk2(o4[2], o4[3]) << 32); }
    __syncthreads();
}

__device__ __forceinline__ int clampi(int v, int lo, int hi) { return min(max(v, lo), hi); }
__device__ __forceinline__ void na_mfma_item(const Ctx& c0, int l, int item, LAS unsigned char* lds) {
    LAUNDER_CTX(c0, c);
    const int b = item / 40, h = (item % 40) / 8, r0 = (item % 8) * 4;
    const int lane = c.lane, w = c.wave, i = lane & 15, g = lane >> 4;
    LAS unsigned char* Vb = lds;
    LAS float* rp = (LAS float*)(lds + 704 * P64);
    const bf16_t* projb = c.proj() + (size_t)b * T * NPROJ;
    const int base = clampi(r0 - 4, 0, 24), nrow = clampi(r0 - 1, 0, 24) + 8 - base;
    for (int x = c.tid; x < nrow * 64 * 8; x += NTHREADS) { const int key = x >> 3, c8 = x & 7;
        *(LAS u32x4*)(Vb + key * P64 + c8 * 16) = *(const u32x4*)(projb + (size_t)(base * 64 + key) * NPROJ + P_NAV + h * 64 + c8 * 8); }
    { const float* rpb = c.in(8) + ((size_t)l * 5 + h) * 15 * 31; if (c.tid < 465) rp[c.tid] = rpb[c.tid]; }
    __syncthreads();
#pragma unroll 1
    for (int qq = 0; qq < 2; ++qq) {
        const int qb = 2 * w + qq, r = r0 + (qb >> 2), jq = qb & 3;
        const int rs = clampi(r - 4, 0, 24), kc0 = clampi(16 * jq - 8, 0, 32), cq = 16 * jq + i, cs = clampi(cq - 8, 0, 48);
        const bf16_t* qp = projb + (size_t)(r * 64 + cq) * NPROJ + P_NAQ + h * 64;
        const bf16x8 q0 = *(const bf16x8*)(qp + 8 * g), q1 = *(const bf16x8*)(qp + 32 + 8 * g);
        f32x4 s[16];
#pragma unroll
        for (int kt = 0; kt < 16; ++kt) { const int kr = kt >> 1, ct = kt & 1;
            const bf16_t* kp = projb + (size_t)((rs + kr) * 64 + kc0 + 16 * ct + i) * NPROJ + P_NAK + h * 64;
            const bf16x8 a0 = *(const bf16x8*)(kp + 8 * g), a1 = *(const bf16x8*)(kp + 32 + 8 * g);
            f32x4 z = {0.f, 0.f, 0.f, 0.f}; z = MFMA16(a0, q0, z); s[kt] = MFMA16(a1, q1, z); }
        float mx = -3.0e38f;
#pragma unroll
        for (int kt = 0; kt < 16; ++kt) { const int kr = kt >> 1, ct = kt & 1; const LAS float* rrow = rp + (rs + kr - r + 7) * 31;
#pragma unroll
            for (int rr = 0; rr < 4; ++rr) { const int tc = kc0 + 16 * ct + 4 * g + rr; const bool valid = (tc >= cs) && (tc < cs + 16);
                const float v = s[kt][rr] * 0.125f + rrow[clampi(tc - cq, -15, 15) + 15];
                s[kt][rr] = valid ? v : -3.0e38f; mx = fmaxf(mx, s[kt][rr]); } }
        mx = fmaxf(mx, __shfl_xor(mx, 16)); mx = fmaxf(mx, __shfl_xor(mx, 32));
        float sum = 0.f;
#pragma unroll
        for (int kt = 0; kt < 16; ++kt)
#pragma unroll
            for (int rr = 0; rr < 4; ++rr) { const float p = (s[kt][rr] > -1.0e38f) ? __expf(s[kt][rr] - mx) : 0.f; s[kt][rr] = p; sum += p; }
        sum += __shfl_xor(sum, 16); sum += __shfl_xor(sum, 32);
        f32x4 o[4];
#pragma unroll
        for (int te = 0; te < 4; ++te) o[te] = (f32x4){0.f, 0.f, 0.f, 0.f};
#pragma unroll
        for (int kr = 0; kr < 8; ++kr) { const bf16x8 pp = pack_frag(s[2 * kr], s[2 * kr + 1]); const int ra = (rs + kr - base) * 64 + kc0 + 4 * g, rb = ra + 16;
#pragma unroll
            for (int te = 0; te < 4; ++te) o[te] = MFMA16(frag_tr(Vb, P64, ra, rb, 16 * te, lane), pp, o[te]); }
        const float inv = 1.0f / sum;
        bf16_t* op = c.mixed() + ((size_t)b * T + r * 64 + cq) * D + 384 + h * 64;
#pragma unroll
        for (int te = 0; te < 4; ++te) *(unsigned long long*)(op + 16 * te + 4 * g) = (unsigned long long)pk2(o[te][0] * inv, o[te][1] * inv) | ((unsigned long long)pk2(o[te][2] * inv, o[te][3] * inv) << 32);
    }
    __syncthreads();
}

__device__ __forceinline__ void frag_tr_x4(LAS const unsigned char* tile, int pitch, int r0, int r1, int n0, int lane, bf16x8 (&out)[4]) {
    const int q4 = (lane & 15) >> 2, p4 = lane & 3;
    const unsigned a0 = (unsigned)(size_t)tile + (unsigned)((r0 + q4) * pitch + (n0 + 4 * p4) * 2), a1 = (unsigned)(size_t)tile + (unsigned)((r1 + q4) * pitch + (n0 + 4 * p4) * 2);
    s16x4 x0, y0, x1, y1, x2, y2, x3, y3;
    asm volatile("ds_read_b64_tr_b16 %0, %8\n\tds_read_b64_tr_b16 %1, %9\n\tds_read_b64_tr_b16 %2, %8 offset:32\n\tds_read_b64_tr_b16 %3, %9 offset:32\n\t"
                 "ds_read_b64_tr_b16 %4, %8 offset:64\n\tds_read_b64_tr_b16 %5, %9 offset:64\n\tds_read_b64_tr_b16 %6, %8 offset:96\n\tds_read_b64_tr_b16 %7, %9 offset:96\n\ts_waitcnt lgkmcnt(0)"
                 : "=&v"(x0), "=&v"(y0), "=&v"(x1), "=&v"(y1), "=&v"(x2), "=&v"(y2), "=&v"(x3), "=&v"(y3) : "v"(a0), "v"(a1) : "memory");
    out[0] = (bf16x8){x0[0], x0[1], x0[2], x0[3], y0[0], y0[1], y0[2], y0[3]}; out[1] = (bf16x8){x1[0], x1[1], x1[2], x1[3], y1[0], y1[1], y1[2], y1[3]};
    out[2] = (bf16x8){x2[0], x2[1], x2[2], x2[3], y2[0], y2[1], y2[2], y2[3]}; out[3] = (bf16x8){x3[0], x3[1], x3[2], x3[3], y3[0], y3[1], y3[2], y3[3]};
}

constexpr int P256 = 528;
__device__ __forceinline__ void xattn_mfma_item(const Ctx& c0, int item, LAS unsigned char* lds) {
    LAUNDER_CTX(c0, c);
    const int b = item / 32, hd = (item / 8) % 4, qc = item % 8; const int row0 = b * T + qc * 256;
    const int lane = c.lane, w = c.wave, i = lane & 15, g = lane >> 4;
    LAS unsigned char* KV = lds;
    const bf16_t* kvb = c.memkv() + (size_t)b * NMEM * 2048 + hd * 256;
    for (int x = c.tid; x < 8192; x += NTHREADS) { const int row = x >> 5, c16 = x & 31; *(LAS u32x4*)(KV + row * P256 + c16 * 16) = *(const u32x4*)(kvb + (size_t)row * 2048 + c16 * 8); }
    __syncthreads();
    bf16x8 P[2][8]; float inv[2];
#pragma unroll
    for (int blk = 0; blk < 2; ++blk) {
        const bf16_t* qp = c.q() + (size_t)(row0 + 16 * (w + 8 * blk) + i) * D + hd * 256 + 8 * g;
        bf16x8 qf[8];
#pragma unroll
        for (int s8 = 0; s8 < 8; ++s8) qf[s8] = *(const bf16x8*)(qp + 32 * s8);
        f32x4 s[16];
#pragma unroll
        for (int tk = 0; tk < 16; ++tk) { f32x4 z = {0.f, 0.f, 0.f, 0.f};
#pragma unroll
            for (int s8 = 0; s8 < 8; ++s8) z = MFMA16(frag_nt(KV, P256, 16 * tk + i, (32 * s8 + 8 * g) * 2), qf[s8], z);
            s[tk] = z; }
        float mx = -3.0e38f;
#pragma unroll
        for (int tk = 0; tk < 16; ++tk) mx = fmaxf(fmaxf(mx, fmaxf(s[tk][0], s[tk][1])), fmaxf(s[tk][2], s[tk][3]));
        mx = fmaxf(mx, __shfl_xor(mx, 16)); mx = fmaxf(mx, __shfl_xor(mx, 32));
        float sum = 0.f;
#pragma unroll
        for (int tk = 0; tk < 16; ++tk)
#pragma unroll
            for (int rr = 0; rr < 4; ++rr) { const float p = __expf((s[tk][rr] - mx) * 0.0625f); s[tk][rr] = p; sum += p; }
        sum += __shfl_xor(sum, 16); sum += __shfl_xor(sum, 32);
        inv[blk] = 1.0f / sum;
#pragma unroll
        for (int ks = 0; ks < 8; ++ks) P[blk][ks] = pack_frag(s[2 * ks], s[2 * ks + 1]);
    }
    __syncthreads();
    for (int x = c.tid; x < 8192; x += NTHREADS) { const int row = x >> 5, c16 = x & 31; *(LAS u32x4*)(KV + row * P256 + c16 * 16) = *(const u32x4*)(kvb + (size_t)row * 2048 + 1024 + c16 * 8); }
    __syncthreads();
#pragma unroll
    for (int blk = 0; blk < 2; ++blk) {
        f32x4 o[16];
#pragma unroll
        for (int te = 0; te < 16; ++te) o[te] = (f32x4){0.f, 0.f, 0.f, 0.f};
#pragma unroll
        for (int ks = 0; ks < 8; ++ks) { const int ra = 32 * ks + 4 * g, rb = ra + 16;
#pragma unroll
            for (int t4 = 0; t4 < 4; ++t4) { bf16x8 a4[4]; frag_tr_x4(KV, P256, ra, rb, 64 * t4, lane, a4);
#pragma unroll
                for (int x = 0; x < 4; ++x) o[4 * t4 + x] = MFMA16(a4[x], P[blk][ks], o[4 * t4 + x]); } }
        bf16_t* op = c.mixed() + (size_t)(row0 + 16 * (w + 8 * blk) + i) * D + hd * 256 + 4 * g;
        const float iv = inv[blk];
#pragma unroll
        for (int te = 0; te < 16; ++te) *(unsigned long long*)(op + 16 * te) = (unsigned long long)pk2(o[te][0] * iv, o[te][1] * iv) | ((unsigned long long)pk2(o[te][2] * iv, o[te][3] * iv) << 32);
    }
    __syncthreads();
}
#ifndef MK_PER_PHASE
#define MK_PER_PHASE 0
#endif
constexpr int PH_PER_LAYER = 11, NP = 2 + DEPTH * PH_PER_LAYER;
struct Args { const float* in[25]; float* out; unsigned char* ws; int ph_lo, ph_hi; };

__global__ void __launch_bounds__(NTHREADS, 2) mega(Args a) {
    extern __shared__ __attribute__((aligned(16))) unsigned char lds_raw[];
    LAS unsigned char* lds = (LAS unsigned char*)lds_raw;
    Ctx c;
    c.out = a.out; c.ws = a.ws;
#if MK_CG_SYNC
    cg::grid_group grid = cg::this_grid();
#else
    if (threadIdx.x < 16) ((LAS unsigned*)(lds + LDS_MISC))[threadIdx.x] = 0u;
    __syncthreads();
    const XcdBarrier bar = xcd_barrier_post((unsigned*)(a.ws + WS_BAR), (volatile LAS unsigned*)(lds + LDS_MISC));
#endif

    for (int p = a.ph_lo; p < a.ph_hi; ++p) {
        { int t_ = threadIdx.x, b_ = blockIdx.x, g_ = gridDim.x;
          asm volatile("" : "+v"(t_)); asm volatile("" : "+s"(b_)); asm volatile("" : "+s"(g_));
          c.tid = t_; c.lane = t_ & 63; c.wave = __builtin_amdgcn_readfirstlane(t_ >> 6); c.bid = b_; c.G = g_; }
        if (p == 0) {
            convert_layer(c, 0, lds);
            rows_to_bf16(c, c.in(0), c.hb(), c.rs0(), M);
            rows_to_bf16(c, c.in(1), c.memb(), c.rsm(), MM);
        } else if (p == NP - 1) {
            final_norm(c);
        } else {
            const int l = (p - 1) / PH_PER_LAYER, st = (p - 1) % PH_PER_LAYER;
            if (st == 0) {
                { pg8::Gemm g{c.hb(), c.w_in(), M, NPROJ, D}; pg8::StaticOrder S; S.init(M, NPROJ, c.G, c.bid);
                  EpiScale E{c.proj(), NPROJ, c.rs0(), c.gates(), 13};
                  pg8::gemm_phase<EpiScale, pg8::StaticOrder, true, true>(lds, g, S, E); }
                { pg8::Gemm g{c.memb(), c.wkv(), MM, 2 * D, D}; pg8::StaticOrder S; S.init(MM, 2 * D, c.G, c.bid);
                  EpiScale E{c.memkv(), 2 * D, c.rsm(), nullptr, -1};
                  pg8::gemm_phase<EpiScale, pg8::StaticOrder, true, true>(lds, g, S, E); }
            } else if (st == 1) {
                if (c.bid < 96) ml_state_item(c, l, c.bid, lds);
                else if (c.bid < 176) gla_state_item(c, l, c.bid - 96, lds);
                else for (int i = c.bid - 176; i < NB * 5 * 8; i += c.G - 176) na_mfma_item(c, l, i, lds);
            } else if (st == 2) {
                for (int i = c.bid; i < NB * 6 * 16 + NB * 5 * 16; i += c.G) { if (i < NB * 6 * 16) ml_out_item(c, l, i, lds); else gla_out_item(c, l, i - NB * 6 * 16, lds); }
            } else if (st == 3) {
                pg8::Gemm g{c.mixed(), c.w_out(), M, D, D}; pg8::StaticOrder S; S.init(M, D, c.G, c.bid);
                EpiResid E{l == 0 ? c.in(0) : c.out, c.out, c.hb(), c.rs1()};
                pg8::gemm_phase<EpiResid, pg8::StaticOrder, true, true>(lds, g, S, E);
            } else if (st == 4) {
                pg8::Gemm g{c.hb(), c.wq(), M, D, D}; pg8::StaticOrder S; S.init(M, D, c.G, c.bid);
                EpiScale E{c.q(), D, c.rs1(), nullptr, -1};
                pg8::gemm_phase<EpiScale, pg8::StaticOrder, true, true>(lds, g, S, E);
            } else if (st == 5) {
                for (int i = c.bid; i < NB * 4 * 8; i += c.G) xattn_mfma_item(c, i, lds);
            } else if (st == 6) {
                pg8::Gemm g{c.mixed(), c.wo(), M, D, D}; pg8::StaticOrder S; S.init(M, D, c.G, c.bid);
                EpiResid E{c.out, c.out, c.hb(), c.rs2()};
                pg8::gemm_phase<EpiResid, pg8::StaticOrder, true, true>(lds, g, S, E);
            } else if (st == 7) {
                pg8::Gemm g{c.hb(), c.w_up(), M, NUP, D}; pg8::StaticOrder S; S.init(M, NUP, c.G, c.bid);
                EpiScale E{c.u(), NUP, c.rs2(), nullptr, -1};
                pg8::gemm_phase<EpiScale, pg8::StaticOrder, true, true>(lds, g, S, E);
            } else if (st == 8) {
                act_pass(c, l);
            } else if (st == 9) {
                pg8::Gemm g{c.act(), c.w_dn(), M, D, DFF}; pg8::StaticOrder S; S.init(M, D, c.G, c.bid);
                EpiResid E{c.out, c.out, c.hb(), c.rs0()};
                pg8::gemm_phase<EpiResid, pg8::StaticOrder, true, true>(lds, g, S, E);
            } else {
                if (l + 1 < DEPTH) convert_layer(c, l + 1, lds);
            }
        }
#if MK_CG_SYNC
        if (p + 1 < a.ph_hi) grid.sync();
#else
        if (p + 1 < a.ph_hi) xcd_barrier(bar);
#endif
    }
}
}

extern "C" void kernel_launch(void* const* d_in, const int* in_sizes, int n_in, void* d_out, int out_size, void* d_ws, size_t ws_size, hipStream_t stream) {
    static int grid = 0;
    if (grid == 0) {
        if (n_in != 25 || out_size != mk::M * mk::D || ws_size < mk::WS_END) { fprintf(stderr, "kernel_launch: unexpected shapes / workspace (n_in %d out %d ws %zu need %zu)\n", n_in, out_size, ws_size, (size_t)mk::WS_END); grid = -1; return; }
        int dev = 0, cus = 0, per_cu = 0;
        (void)hipGetDevice(&dev); (void)hipDeviceGetAttribute(&cus, hipDeviceAttributeMultiprocessorCount, dev);
        if (hipFuncSetAttribute((const void*)mk::mega, hipFuncAttributeMaxDynamicSharedMemorySize, mk::LDS_BYTES) != hipSuccess) { fprintf(stderr, "kernel_launch: hipFuncSetAttribute failed\n"); grid = -1; return; }
        (void)hipOccupancyMaxActiveBlocksPerMultiprocessor(&per_cu, (const void*)mk::mega, mk::NTHREADS, mk::LDS_BYTES);
        if (per_cu < 1) { fprintf(stderr, "kernel_launch: occupancy query says %d blocks per CU\n", per_cu); grid = -1; return; }
        grid = cus;
        if (grid < 192) { fprintf(stderr, "kernel_launch: needs >= 192 CUs\n"); grid = -1; return; }
    }
    if (grid < 0) return;
    mk::Args a{};
    for (int i = 0; i < 25; ++i) a.in[i] = (const float*)d_in[i];
    a.out = (float*)d_out; a.ws = (unsigned char*)d_ws;
#if MK_PER_PHASE
    for (int p = 0; p < mk::NP; ++p) { a.ph_lo = p; a.ph_hi = p + 1; hipLaunchKernelGGL(mk::mega, dim3(grid), dim3(mk::NTHREADS), mk::LDS_BYTES, stream, a); }
#else
    a.ph_lo = 0; a.ph_hi = mk::NP;
#if MK_CG_SYNC
    void* args[] = {&a};
    hipError_t e = hipLaunchCooperativeKernel((const void*)mk::mega, dim3(grid), dim3(mk::NTHREADS), args, mk::LDS_BYTES, stream);
    if (e != hipSuccess) fprintf(stderr, "cooperative launch failed: %s (grid %d)\n", hipGetErrorString(e), grid);
#else
    if (hipMemsetAsync((char*)d_ws + mk::WS_BAR, 0, mk::WS_BAR_BYTES, stream) != hipSuccess) { fprintf(stderr, "kernel_launch: memset of the barrier words failed\n"); return; }
    hipLaunchKernelGGL(mk::mega, dim3(grid), dim3(mk::NTHREADS), mk::LDS_BYTES, stream, a);
#endif
#endif
}
```

```cpp
#include <hip/hip_runtime.h>
#include <hip/hip_cooperative_groups.h>
#include <cstdio>
#include <cstdint>
namespace cg = cooperative_groups;
#define MK_PER_PHASE 0
#define MK_CG_SYNC 0
namespace pg8 {
#define PG8_LAS __attribute__((address_space(3)))
typedef unsigned short bf16_t;
typedef short bf16x8 __attribute__((ext_vector_type(8)));
typedef float f32x4 __attribute__((ext_vector_type(4)));
typedef unsigned u32x4 __attribute__((ext_vector_type(4)));
constexpr int BM = 256, BK = 64, HALF = 128, HTB = HALF * BK * 2  , STAGE_BYTES = 8 * HTB, NXCD = 8, WGM = 8;

__host__ __device__ __forceinline__ int lds_byte(int r, int c) { const int st = (r >> 4) * 2 + (c >> 5), rr = r & 15, cc = c & 31, ob = rr * 64 + cc * 2; return st * 1024 + (ob ^ (((ob >> 9) & 1) << 5)); }
__host__ __device__ __forceinline__ void stage_rc(int b, int& R, int& C) { const int st = b / 1024, sb = b % 1024, swz = sb ^ (((sb >> 9) & 1) << 5); R = (st >> 1) * 16 + swz / 64; C = (st & 1) * 32 + (swz % 64) / 2; }
__host__ __device__ __forceinline__ int perm32(int rho) { const int n = rho >> 4, i = rho & 15; return 8 * (i >> 2) + 4 * n + (i & 3); }

struct Unit { int pm, pn; };
struct Gemm { const bf16_t* A; const bf16_t* Bt; int M, N, K; };

struct StaticOrder {
    int nM, nN, nwg, G, c;
    __host__ __device__ void init(int M, int N, int G_, int c_) { nM = M / BM; nN = N / BM; nwg = nM * nN; G = G_; c = c_; }
    __host__ __device__ bool next(int i, Unit& u) const {
        const long L = (long)i * G + c; if (L >= nwg) return false;
        int wgid = (int)L; { const int q = nwg / NXCD, r = nwg % NXCD, xcd = wgid % NXCD, off = wgid / NXCD; wgid = (xcd < r ? xcd * (q + 1) : r * (q + 1) + (xcd - r) * q) + off; }
        const int nig = WGM * nN, gid = wgid / nig, fm = gid * WGM, gsz = (nM - fm) < WGM ? (nM - fm) : WGM;
        u.pm = fm + ((wgid % nig) % gsz); u.pn = (wgid % nig) / gsz; return true;
    }
    __device__ __forceinline__ void a_ready(const Unit&) const {}
    __device__ __forceinline__ void done(const Unit&) const {}
};

template <class Epi, class Sched, bool ALIGN_EPI = false, bool SP2 = false>
__device__ __forceinline__ void gemm_phase(PG8_LAS unsigned char* lds, const Gemm g, const Sched& S, const Epi& E) {
    int tid_l = threadIdx.x; asm volatile("" : "+v"(tid_l));
    const int tid = tid_l, wid = __builtin_amdgcn_readfirstlane(tid >> 6), lane = tid & 63, wr = wid >> 2, wc = wid & 3, fr = lane & 15, fq = lane >> 4;
    const int K = g.K, nt = K / BK;
    unsigned voffA[2], voffB[2];
#pragma unroll
    for (int i = 0; i < 2; ++i) { int R, C; stage_rc(tid * 16 + i * 8192, R, C); const int Rb = Epi::PERM ? ((R & ~31) + perm32(R & 31)) : R;
        voffA[i] = (unsigned)(R * K + C) * 2u; voffB[i] = (unsigned)(Rb * K + C) * 2u; }
    const size_t kstep = (size_t)(BK * 2);
    const size_t hstep = (size_t)HALF * K * 2;
    const size_t tstep = 2 * hstep;
    const unsigned ldsw = (unsigned)wid * 1024u;
    const int aoff = lds_byte(wr * 64 + fr, fq * 8), boff = lds_byte(wc * 32 + fr, fq * 8);
#define PG8_SA(b, h) (((b) * 2 + (h)) * HTB)
#define PG8_SB(b, h) ((4 + (b) * 2 + (h)) * HTB)
#define PG8_STAGE(bufoff, gbase, voff) do { _Pragma("unroll") for (int _i = 0; _i < 2; ++_i) \
        __builtin_amdgcn_global_load_lds((const unsigned*)((const char*)(gbase) + (voff)[_i]), (PG8_LAS unsigned*)(lds + (bufoff) + ldsw + _i * 8192), 16, 0, 0); } while (0)
#define PG8_LDA(dst, b, h) do { _Pragma("unroll") for (int m = 0; m < 4; ++m) _Pragma("unroll") for (int k = 0; k < 2; ++k) dst[m][k] = *(const PG8_LAS bf16x8*)(lds + PG8_SA(b, h) + aoff + m * 2048 + k * 1024); } while (0)
#define PG8_LDB(dst, b, h) do { _Pragma("unroll") for (int n = 0; n < 2; ++n) _Pragma("unroll") for (int k = 0; k < 2; ++k) dst[n][k] = *(const PG8_LAS bf16x8*)(lds + PG8_SB(b, h) + boff + n * 2048 + k * 1024); } while (0)
#define PG8_MMA(ai, bj, At, Bt) do { __builtin_amdgcn_s_setprio(1); _Pragma("unroll") for (int m = 0; m < 4; ++m) _Pragma("unroll") for (int n = 0; n < 2; ++n) _Pragma("unroll") for (int k = 0; k < 2; ++k) \
        acc[ai][bj][m][n] = __builtin_amdgcn_mfma_f32_16x16x32_bf16(Bt[n][k], At[m][k], acc[ai][bj][m][n], 0, 0, 0); __builtin_amdgcn_s_setprio(0); } while (0)
#define PG8_WAIT_V(n) asm volatile("s_waitcnt vmcnt(" #n ")" ::: "memory")
#define PG8_WAIT_L(n) asm volatile("s_waitcnt lgkmcnt(" #n ")" ::: "memory")
#define PG8_BAR __builtin_amdgcn_s_barrier()
#define PG8_SCHED __builtin_amdgcn_sched_barrier(0)
    Unit cur, nxt; int ui = 0;
    if (!S.next(0, cur)) return;
    f32x4 acc[2][2][4][2];
#pragma unroll
    for (int a = 0; a < 2; ++a)
#pragma unroll
        for (int b = 0; b < 2; ++b)
#pragma unroll
            for (int m = 0; m < 4; ++m)
#pragma unroll
                for (int n = 0; n < 2; ++n) acc[a][b][m][n] = (f32x4){0.f, 0.f, 0.f, 0.f};
    bf16x8 At[4][2], B0[2][2], B1[2][2];
    const char* cA = (const char*)g.A + (size_t)cur.pm * tstep; const char* cB = (const char*)g.Bt + (size_t)cur.pn * tstep;
    S.a_ready(cur);
    if constexpr (SP2) {
        PG8_STAGE(PG8_SB(0, 0), cB, voffB); PG8_STAGE(PG8_SB(0, 1), cB + hstep, voffB); PG8_STAGE(PG8_SA(0, 0), cA, voffA); PG8_STAGE(PG8_SA(0, 1), cA + hstep, voffA);
        if (wr == 1) PG8_BAR;
        PG8_WAIT_V(2); PG8_BAR;
        PG8_STAGE(PG8_SB(1, 0), cB + kstep, voffB); PG8_STAGE(PG8_SA(1, 0), cA + kstep, voffA); PG8_STAGE(PG8_SB(1, 1), cB + hstep + kstep, voffB);
        PG8_WAIT_V(6); PG8_BAR;
    } else {
        PG8_STAGE(PG8_SB(0, 0), cB, voffB); PG8_STAGE(PG8_SA(0, 0), cA, voffA); PG8_STAGE(PG8_SB(0, 1), cB + hstep, voffB); PG8_STAGE(PG8_SA(0, 1), cA + hstep, voffA);
        if (wr == 1) PG8_BAR;
        PG8_WAIT_V(4); PG8_BAR;
        PG8_STAGE(PG8_SB(1, 0), cB + kstep, voffB); PG8_STAGE(PG8_SA(1, 0), cA + kstep, voffA); PG8_STAGE(PG8_SB(1, 1), cB + hstep + kstep, voffB);
        PG8_WAIT_V(6); PG8_BAR;
    }
    for (;;) {
        const bool has_next = S.next(ui + 1, nxt);
        const char* nA = has_next ? (const char*)g.A + (size_t)nxt.pm * tstep : cA; const char* nB = has_next ? (const char*)g.Bt + (size_t)nxt.pn * tstep : cB;
        for (int t = 0; t < nt; t += 2) {
            const bool last = (t == nt - 2);
            const char* a1 = cA + (size_t)(t + 1) * kstep;
            const char* a2 = last ? nA : cA + (size_t)(t + 2) * kstep; const char* b2 = last ? nB : cB + (size_t)(t + 2) * kstep;
            const char* a3 = a2 + kstep; const char* b3 = b2 + kstep;
            if (last && has_next) S.a_ready(nxt);
            if constexpr (SP2) {
            PG8_LDB(B0, 0, 0); PG8_LDB(B1, 0, 1); PG8_SCHED; PG8_LDA(At, 0, 0); PG8_STAGE(PG8_SA(1, 1), a1 + hstep, voffA);
            PG8_WAIT_V(8); PG8_WAIT_L(0); PG8_BAR; PG8_MMA(0, 0, At, B0); PG8_MMA(0, 1, At, B1); PG8_BAR; PG8_SCHED;
            PG8_LDA(At, 0, 1); PG8_STAGE(PG8_SB(0, 0), b2, voffB); PG8_STAGE(PG8_SB(0, 1), b2 + hstep, voffB); PG8_STAGE(PG8_SA(0, 0), a2, voffA);
            PG8_WAIT_V(8); PG8_WAIT_L(0); PG8_BAR; PG8_MMA(1, 0, At, B0); PG8_MMA(1, 1, At, B1); PG8_BAR; PG8_SCHED;
            PG8_LDB(B0, 1, 0); PG8_LDB(B1, 1, 1); PG8_SCHED; PG8_LDA(At, 1, 0); PG8_STAGE(PG8_SA(0, 1), a2 + hstep, voffA);
            PG8_WAIT_V(8); PG8_WAIT_L(0); PG8_BAR; PG8_MMA(0, 0, At, B0); PG8_MMA(0, 1, At, B1); PG8_BAR; PG8_SCHED;
            PG8_LDA(At, 1, 1); PG8_STAGE(PG8_SB(1, 0), b3, voffB); PG8_STAGE(PG8_SB(1, 1), b3 + hstep, voffB); PG8_STAGE(PG8_SA(1, 0), a3, voffA);
            PG8_WAIT_V(8); PG8_WAIT_L(0); PG8_BAR; PG8_MMA(1, 0, At, B0); PG8_MMA(1, 1, At, B1); PG8_BAR; PG8_SCHED;
            } else {
            PG8_LDB(B0, 0, 0); PG8_SCHED; PG8_LDA(At, 0, 0); PG8_STAGE(PG8_SA(1, 1), a1 + hstep, voffA);
            PG8_WAIT_L(8); PG8_BAR; PG8_WAIT_L(0); PG8_MMA(0, 0, At, B0); PG8_BAR; PG8_SCHED;
            PG8_LDB(B1, 0, 1); PG8_STAGE(PG8_SB(0, 0), b2, voffB);
            PG8_BAR; PG8_WAIT_L(0); PG8_MMA(0, 1, At, B1); PG8_BAR;
            PG8_LDA(At, 0, 1); PG8_STAGE(PG8_SA(0, 0), a2, voffA);
            PG8_BAR; PG8_WAIT_L(0); PG8_MMA(1, 0, At, B0); PG8_BAR; PG8_SCHED;
            PG8_STAGE(PG8_SB(0, 1), b2 + hstep, voffB);
            PG8_WAIT_V(6); PG8_BAR; PG8_MMA(1, 1, At, B1); PG8_BAR;
            PG8_LDB(B0, 1, 0); PG8_SCHED; PG8_LDA(At, 1, 0); PG8_STAGE(PG8_SA(0, 1), a2 + hstep, voffA);
            PG8_WAIT_L(8); PG8_BAR; PG8_WAIT_L(0); PG8_MMA(0, 0, At, B0); PG8_BAR; PG8_SCHED;
            PG8_LDB(B1, 1, 1); PG8_STAGE(PG8_SB(1, 0), b3, voffB);
            PG8_BAR; PG8_WAIT_L(0); PG8_MMA(0, 1, At, B1); PG8_BAR;
            PG8_LDA(At, 1, 1); PG8_STAGE(PG8_SA(1, 0), a3, voffA);
            PG8_BAR; PG8_WAIT_L(0); PG8_MMA(1, 0, At, B0); PG8_BAR; PG8_SCHED;
            PG8_STAGE(PG8_SB(1, 1), b3 + hstep, voffB);
            PG8_WAIT_V(6); PG8_BAR; PG8_MMA(1, 1, At, B1); PG8_BAR;
            }
        }
        if constexpr (ALIGN_EPI) { if (wr == 0) PG8_BAR; }
        if constexpr (!Epi::AFTER_DRAIN) { E(acc, cur, wr, wc, fr, fq); S.done(cur); }
        if (!has_next) break;
#pragma unroll
        for (int a = 0; a < 2; ++a)
#pragma unroll
            for (int b = 0; b < 2; ++b)
#pragma unroll
                for (int m = 0; m < 4; ++m)
#pragma unroll
                    for (int n = 0; n < 2; ++n) acc[a][b][m][n] = (f32x4){0.f, 0.f, 0.f, 0.f};
        cur = nxt; cA = nA; cB = nB; ++ui;
        if constexpr (ALIGN_EPI) { if (wr == 1) PG8_BAR; }
    }
    PG8_WAIT_V(0);
    if constexpr (!ALIGN_EPI) { if (wr == 0) PG8_BAR; }
    PG8_BAR;
    if constexpr (Epi::AFTER_DRAIN) { E.fused(acc, cur, wr, wc, fr, fq, lds, wid, lane); S.done(cur); }
#undef PG8_SA
#undef PG8_SB
#undef PG8_STAGE
#undef PG8_LDA
#undef PG8_LDB
#undef PG8_MMA
#undef PG8_WAIT_V
#undef PG8_WAIT_L
#undef PG8_BAR
#undef PG8_SCHED
}
}
namespace mk {
using pg8::bf16_t; using pg8::f32x4; using pg8::u32x4; using pg8::bf16x8;
#define LAS __attribute__((address_space(3)))
constexpr int NB = 8, T = 2048, M = NB * T, D = 1024, DEPTH = 4, NMEM = 256, MM = NB * NMEM;
constexpr int NPROJ = 3584, IN_COLS = 3512, DFF = 2816, NUP = 2 * DFF;
constexpr float EPS = 1e-6f;
constexpr int P_MLQ = 0, P_MLK = 384, P_MLV = 768, P_MLO = 1152, P_NAQ = 1536, P_NAK = 1856, P_NAV = 2176, P_GQ = 2496, P_GK = 2656, P_GV = 2816, P_GG = 3136, P_MLG = 3456, P_GA = 3480;
constexpr int NTHREADS = 512, NWAVES = 8;
constexpr int LDS_BYTES = 160 * 1024, LDS_MISC = LDS_BYTES - 64;
constexpr size_t MiB = (size_t)1 << 20;
constexpr size_t WS_RS0 = 0, WS_RS1 = 1 * MiB, WS_RS2 = 2 * MiB, WS_RSM = 3 * MiB;
constexpr size_t WS_BAR = 3 * MiB + 512 * 1024, WS_BAR_BYTES = 16 * 1024;
constexpr size_t WS_GATES = 4 * MiB;
constexpr size_t WS_MEMB = 8 * MiB;
constexpr size_t WS_MEMKV = 12 * MiB;
constexpr size_t WS_WIN = 20 * MiB, WS_WOUT = 27 * MiB, WS_WQ = 29 * MiB, WS_WO = 31 * MiB, WS_WUP = 33 * MiB, WS_WDN = 44 * MiB, WS_WKV = 50 * MiB;
constexpr size_t WS_HB = 54 * MiB;
constexpr size_t WS_BIG = 86 * MiB;
constexpr size_t WS_BND = WS_BIG + 170 * MiB;
constexpr size_t WS_HSML = WS_BIG + 112 * MiB, WS_HSGL = WS_HSML + 24 * MiB;
constexpr size_t WS_ACT = 262 * MiB;
constexpr size_t WS_MIXED = WS_ACT, WS_Q = WS_ACT + 32 * MiB;
constexpr size_t WS_END = 350 * MiB;

__device__ __forceinline__ float bf2f(unsigned v) { return __uint_as_float(v << 16); }
__device__ __forceinline__ unsigned f2bf(float f) { const unsigned u = __float_as_uint(f); return (u + 0x7fffu + ((u >> 16) & 1u)) >> 16; }
__device__ __forceinline__ unsigned cvt_pk_bf16(float lo, float hi) { unsigned r; asm volatile("v_cvt_pk_bf16_f32 %0, %1, %2" : "=v"(r) : "v"(lo), "v"(hi)); return r; }
__device__ __forceinline__ unsigned pk2(float lo, float hi) { return cvt_pk_bf16(lo, hi); }
__device__ __forceinline__ void unpack8(const u32x4 w, float (&o)[8]) {
    o[0] = bf2f(w.x & 0xffffu); o[1] = bf2f(w.x >> 16); o[2] = bf2f(w.y & 0xffffu); o[3] = bf2f(w.y >> 16);
    o[4] = bf2f(w.z & 0xffffu); o[5] = bf2f(w.z >> 16); o[6] = bf2f(w.w & 0xffffu); o[7] = bf2f(w.w >> 16);
}
__device__ __forceinline__ float wave_sum(float v) {
#pragma unroll
    for (int o = 1; o < 64; o <<= 1) v += __shfl_xor(v, o);
    return v;
}
__device__ __forceinline__ float rcpf_(float x) { return __builtin_amdgcn_rcpf(x); }
__device__ __forceinline__ float rsqf_(float x) { return __builtin_amdgcn_rsqf(x); }
__device__ __forceinline__ float sigmoidf_(float x) { return rcpf_(1.f + __expf(-x)); }

typedef const float* cfptr;
struct Ctx {
    float* out; unsigned char* ws;
    int G, bid, tid, lane, wave;
    __device__ __forceinline__ const float* in(int i) const {
        asm volatile("" : "+s"(i));
        const __attribute__((address_space(4))) cfptr* tbl = (const __attribute__((address_space(4))) cfptr*)__builtin_amdgcn_kernarg_segment_ptr();
        return tbl[i];
    }
    template <class Tp> __device__ __forceinline__ Tp* wsp(size_t off) const { unsigned o = (unsigned)off; asm volatile("" : "+s"(o)); return (Tp*)(ws + o); }
    __device__ __forceinline__ float* rs0() const { return wsp<float>(WS_RS0); }
    __device__ __forceinline__ float* rs1() const { return wsp<float>(WS_RS1); }
    __device__ __forceinline__ float* rs2() const { return wsp<float>(WS_RS2); }
    __device__ __forceinline__ float* rsm() const { return wsp<float>(WS_RSM); }
    __device__ __forceinline__ float* gates() const { return wsp<float>(WS_GATES); }
    __device__ __forceinline__ float* hsml() const { return wsp<float>(WS_HSML); }
    __device__ __forceinline__ float* hsgl() const { return wsp<float>(WS_HSGL); }
    __device__ __forceinline__ bf16_t* memb() const { return wsp<bf16_t>(WS_MEMB); }
    __device__ __forceinline__ bf16_t* memkv() const { return wsp<bf16_t>(WS_MEMKV); }
    __device__ __forceinline__ bf16_t* w_in() const { return wsp<bf16_t>(WS_WIN); }
    __device__ __forceinline__ bf16_t* w_out() const { return wsp<bf16_t>(WS_WOUT); }
    __device__ __forceinline__ bf16_t* wq() const { return wsp<bf16_t>(WS_WQ); }
    __device__ __forceinline__ bf16_t* wo() const { return wsp<bf16_t>(WS_WO); }
    __device__ __forceinline__ bf16_t* w_up() const { return wsp<bf16_t>(WS_WUP); }
    __device__ __forceinline__ bf16_t* w_dn() const { return wsp<bf16_t>(WS_WDN); }
    __device__ __forceinline__ bf16_t* wkv() const { return wsp<bf16_t>(WS_WKV); }
    __device__ __forceinline__ bf16_t* hb() const { return wsp<bf16_t>(WS_HB); }
    __device__ __forceinline__ bf16_t* proj() const { return wsp<bf16_t>(WS_BIG); }
    __device__ __forceinline__ bf16_t* u() const { return wsp<bf16_t>(WS_BIG); }
    __device__ __forceinline__ bf16_t* act() const { return wsp<bf16_t>(WS_ACT); }
    __device__ __forceinline__ bf16_t* mixed() const { return wsp<bf16_t>(WS_MIXED); }
    __device__ __forceinline__ bf16_t* q() const { return wsp<bf16_t>(WS_Q); }
};

#define LAUNDER_CTX(c0, c) Ctx c = (c0); { int t_ = c.tid; asm volatile("" : "+v"(t_)); c.tid = t_; c.lane = t_ & 63; c.wave = __builtin_amdgcn_readfirstlane(t_ >> 6); }

struct EpiScale {
    static constexpr bool PERM = true, AFTER_DRAIN = false;
    bf16_t* O; int ldc; const float* rowss; float* gates; int gate_pn;
    __device__ __forceinline__ void operator()(const f32x4 (&acc)[2][2][4][2], const pg8::Unit& u, int wr, int wc, int fr, int fq) const {
        const int row0 = u.pm * 256 + wr * 64 + fr, col0 = u.pn * 256 + wc * 32 + 8 * fq;
        const bool gt = (u.pn == gate_pn) && (wc < 2);
#pragma unroll
        for (int ai = 0; ai < 2; ++ai)
#pragma unroll
            for (int m = 0; m < 4; ++m) {
                const int row = row0 + ai * 128 + m * 16;
                float rs = 1.0f;
                if (rowss) { const f32x4* rp = (const f32x4*)(rowss + (size_t)row * 16); const f32x4 p0 = rp[0], p1 = rp[1], p2 = rp[2], p3 = rp[3];
                    const float ssum = (((p0[0] + p0[1]) + (p0[2] + p0[3])) + ((p1[0] + p1[1]) + (p1[2] + p1[3]))) + (((p2[0] + p2[1]) + (p2[2] + p2[3])) + ((p3[0] + p3[1]) + (p3[2] + p3[3])));
                    rs = 1.0f / sqrtf(ssum * (1.0f / D) + EPS); }
                bf16_t* rowp = O + (size_t)row * ldc + col0;
#pragma unroll
                for (int bj = 0; bj < 2; ++bj) {
                    const f32x4 v0 = acc[ai][bj][m][0] * rs, v1 = acc[ai][bj][m][1] * rs;
                    u32x4 w; w.x = cvt_pk_bf16(v0[0], v0[1]); w.y = cvt_pk_bf16(v0[2], v0[3]); w.z = cvt_pk_bf16(v1[0], v1[1]); w.w = cvt_pk_bf16(v1[2], v1[3]);
                    *(u32x4*)(rowp + bj * 128) = w;
                    if (bj == 1 && gt) { float* gp = gates + (size_t)row * 64 + wc * 32 + 8 * fq; *(f32x4*)gp = v0; *(f32x4*)(gp + 4) = v1; }
                }
            }
    }
};
struct EpiResid {
    static constexpr bool PERM = true, AFTER_DRAIN = false;
    const float* base; float* out; bf16_t* hb; float* rowss_out;
    __device__ __forceinline__ void operator()(const f32x4 (&acc)[2][2][4][2], const pg8::Unit& u, int wr, int wc, int fr, int fq) const {
        const int row0 = u.pm * 256 + wr * 64 + fr, col0 = u.pn * 256 + wc * 32 + 8 * fq;
#pragma unroll
        for (int ai = 0; ai < 2; ++ai)
#pragma unroll
            for (int m = 0; m < 4; ++m) {
                const int row = row0 + ai * 128 + m * 16; const size_t off = (size_t)row * D + col0; float ss = 0.f;
#pragma unroll
                for (int bj = 0; bj < 2; ++bj) {
                    const f32x4 v0 = acc[ai][bj][m][0] + *(const f32x4*)(base + off + bj * 128), v1 = acc[ai][bj][m][1] + *(const f32x4*)(base + off + bj * 128 + 4);
                    *(f32x4*)(out + off + bj * 128) = v0; *(f32x4*)(out + off + bj * 128 + 4) = v1;
                    u32x4 w; w.x = cvt_pk_bf16(v0[0], v0[1]); w.y = cvt_pk_bf16(v0[2], v0[3]); w.z = cvt_pk_bf16(v1[0], v1[1]); w.w = cvt_pk_bf16(v1[2], v1[3]);
                    *(u32x4*)(hb + off + bj * 128) = w;
                    ss += (v0[0] * v0[0] + v0[1] * v0[1]) + (v0[2] * v0[2] + v0[3] * v0[3]) + (v1[0] * v1[0] + v1[1] * v1[1]) + (v1[2] * v1[2] + v1[3] * v1[3]);
                }
                ss += __shfl_xor(ss, 16); ss += __shfl_xor(ss, 32);
                if (fq == 0) rowss_out[(size_t)row * 16 + u.pn * 4 + wc] = ss;
                asm volatile("" ::: "memory");
            }
    }
};

__device__ __forceinline__ float gelu_tanh_(float y) { const float uu = 0.7978845608028654f * (y + 0.044715f * y * y * y); return y * rcpf_(1.f + __expf(-2.f * uu)); }
struct EpiFfn {
    static constexpr bool PERM = true, AFTER_DRAIN = false;
    bf16_t* act; const float* rowss; const float* cw; const float* cb; float* bnd; LAS float* X;
    __device__ __forceinline__ float rstd(int row) const {
        const f32x4* rp = (const f32x4*)(rowss + (size_t)row * 16); const f32x4 p0 = rp[0], p1 = rp[1], p2 = rp[2], p3 = rp[3];
        const float ssum = (((p0[0] + p0[1]) + (p0[2] + p0[3])) + ((p1[0] + p1[1]) + (p1[2] + p1[3]))) + (((p2[0] + p2[1]) + (p2[2] + p2[3])) + ((p3[0] + p3[1]) + (p3[2] + p3[3])));
        return rsqf_(ssum * (1.0f / D) + EPS); }
    __device__ __forceinline__ void operator()(const f32x4 (&acc)[2][2][4][2], const pg8::Unit& u, int wr, int wc, int fr_in, int fq_in) const {
        int fr = fr_in, fq = fq_in; asm volatile("" : "+v"(fr), "+v"(fq));
        const int lane = fq * 16 + fr, colw = 32 * wc + 8 * fq, ch0 = 128 * u.pn + colw, rowb = u.pm * 256 + wr * 64 + fr;
        const int lprev = (lane & 48) | ((lane - 1) & 15), lnext = (lane & 48) | ((lane + 1) & 15);
#pragma unroll
        for (int ai = 0; ai < 2; ++ai) { const int blk = 2 * ai + wr; const bool last = (fr == 15);
            const float s_ = rstd(rowb + ai * 128 + (last ? 48 : 0));
            f32x4 v0, v1;
#pragma unroll
            for (int j = 0; j < 4; ++j) { v0[j] = (last ? acc[ai][0][3][0][j] : acc[ai][0][0][0][j]) * s_; v1[j] = (last ? acc[ai][0][3][1][j] : acc[ai][0][0][1][j]) * s_; }
            if (fr == 0 || fr == 15) { LAS float* xp = X + (blk * 2 + (last ? 1 : 0)) * 128 + colw; *(LAS f32x4*)xp = v0; *(LAS f32x4*)(xp + 4) = v1; } }
        asm volatile("s_waitcnt lgkmcnt(0)" ::: "memory"); __builtin_amdgcn_s_barrier(); asm volatile("" ::: "memory");
#pragma unroll
        for (int ai = 0; ai < 2; ++ai) { const int blk = 2 * ai + wr;
            float rs[4];
#pragma unroll
            for (int m = 0; m < 4; ++m) rs[m] = rstd(rowb + ai * 128 + m * 16);
#pragma unroll
            for (int n = 0; n < 2; ++n) {
                const int chn = ch0 + 4 * n;
                const LAS float* xprev = X + ((blk > 0 ? blk - 1 : 0) * 2 + 1) * 128 + colw + 4 * n; const LAS float* xnext = X + ((blk < 3 ? blk + 1 : 3) * 2 + 0) * 128 + colw + 4 * n;
                float o[4][4];
#pragma unroll
                for (int j = 0; j < 4; ++j) {
                    const float w0 = cw[chn + j], w1 = cw[DFF + chn + j], w2 = cw[2 * DFF + chn + j], bb = cb[chn + j];
                    const float ep = blk > 0 ? xprev[j] : 0.f, en = blk < 3 ? xnext[j] : 0.f;
                    float x[4], R[4], L[4];
#pragma unroll
                    for (int m = 0; m < 4; ++m) { x[m] = acc[ai][0][m][n][j] * rs[m]; R[m] = __shfl(x[m], lprev); L[m] = __shfl(x[m], lnext); }
#pragma unroll
                    for (int m = 0; m < 4; ++m) { const float pv = (fr == 0) ? (m > 0 ? R[m > 0 ? m - 1 : 0] : ep) : R[m], nx = (fr == 15) ? (m < 3 ? L[m < 3 ? m + 1 : 3] : en) : L[m];
                        const float y = w0 * pv + w1 * x[m] + w2 * nx + bb;
                        o[m][j] = gelu_tanh_(y) * (acc[ai][1][m][n][j] * rs[m]); } }
#pragma unroll
                for (int m = 0; m < 4; ++m) { const size_t row = (size_t)rowb + ai * 128 + m * 16;
                    *(unsigned long long*)(act + row * DFF + chn) = (unsigned long long)cvt_pk_bf16(o[m][0], o[m][1]) | ((unsigned long long)cvt_pk_bf16(o[m][2], o[m][3]) << 32); }
                asm volatile("" ::: "memory");
            }
        }
        { const bool hi = (wr == 1); const float s_ = rstd(rowb + (hi ? 128 + 48 : 0));
          f32x4 a0, a1, g0, g1;
#pragma unroll
          for (int j = 0; j < 4; ++j) { a0[j] = (hi ? acc[1][0][3][0][j] : acc[0][0][0][0][j]) * s_; a1[j] = (hi ? acc[1][0][3][1][j] : acc[0][0][0][1][j]) * s_;
                                        g0[j] = (hi ? acc[1][1][3][0][j] : acc[0][1][0][0][j]) * s_; g1[j] = (hi ? acc[1][1][3][1][j] : acc[0][1][0][1][j]) * s_; }
          float* bp = bnd + (size_t)u.pm * 6 * DFF + ch0;
          const bool doa = hi ? (fr >= 14) : (fr < 2), dog = hi ? (fr == 15) : (fr == 0);
          const int slot = hi ? fr - 12 : fr;
          if (doa) { *(f32x4*)(bp + slot * DFF) = a0; *(f32x4*)(bp + slot * DFF + 4) = a1; }
          if (dog) { *(f32x4*)(bp + (hi ? 5 : 4) * DFF) = g0; *(f32x4*)(bp + (hi ? 5 : 4) * DFF + 4) = g1; } }
    }
};
__device__ __forceinline__ void ffn_fixup(const float* bnd, const float* cw, const float* cb, bf16_t* act, int pm, int tid) {
    for (int idx = tid; idx < 2 * (DFF / 4); idx += NTHREADS) { const int which = idx / (DFF / 4), c4 = (idx % (DFF / 4)) * 4;
        if (which == 0 ? (pm % 8 == 0) : (pm % 8 == 7)) continue;
        const float* b0 = bnd + (size_t)pm * 6 * DFF + c4;
        const f32x4 ap = which == 0 ? *(const f32x4*)(b0 - 6 * DFF + 3 * DFF) : *(const f32x4*)(b0 + 2 * DFF);
        const f32x4 a0 = which == 0 ? *(const f32x4*)(b0) : *(const f32x4*)(b0 + 3 * DFF);
        const f32x4 an = which == 0 ? *(const f32x4*)(b0 + DFF) : *(const f32x4*)(b0 + 6 * DFF);
        const f32x4 gg = which == 0 ? *(const f32x4*)(b0 + 4 * DFF) : *(const f32x4*)(b0 + 5 * DFF);
        const f32x4 v0 = *(const f32x4*)(cw + c4), v1 = *(const f32x4*)(cw + DFF + c4), v2 = *(const f32x4*)(cw + 2 * DFF + c4), vb = *(const f32x4*)(cb + c4);
        float o[4];
#pragma unroll
        for (int j = 0; j < 4; ++j) o[j] = gelu_tanh_(v0[j] * ap[j] + v1[j] * a0[j] + v2[j] * an[j] + vb[j]) * gg[j];
        *(unsigned long long*)(act + ((size_t)pm * 256 + (which ? 255 : 0)) * DFF + c4) = (unsigned long long)cvt_pk_bf16(o[0], o[1]) | ((unsigned long long)cvt_pk_bf16(o[2], o[3]) << 32); }
    asm volatile("s_waitcnt vmcnt(0)" ::: "memory"); __syncthreads();
}

template <class Map>
__device__ __forceinline__ void cvt_item(const float* W, int K, int N, const float* gain, bf16_t* WT, LAS float* scr, int item, int lane, Map map) {
    const int nblk = (N + 31) / 32, kb = item / nblk, nb = item % nblk, k0 = 64 * kb, n0 = 32 * nb;
    const int nn = n0 + (lane & 31);
#pragma unroll 8
    for (int i = 0; i < 32; ++i) { const int kk = 2 * i + (lane >> 5); float w = (nn < N) ? W[(size_t)(k0 + kk) * N + nn] : 0.f; if (gain) w *= gain[k0 + kk]; scr[kk * 33 + (lane & 31)] = w; }
    asm volatile("s_waitcnt lgkmcnt(0)" ::: "memory");
    const int c = lane & 7;
#pragma unroll
    for (int j = 0; j < 4; ++j) { const int n = (lane >> 3) + 8 * j; const LAS float* s = scr + (8 * c) * 33 + n;
        u32x4 o; o.x = pk2(s[0 * 33], s[1 * 33]); o.y = pk2(s[2 * 33], s[3 * 33]); o.z = pk2(s[4 * 33], s[5 * 33]); o.w = pk2(s[6 * 33], s[7 * 33]);
        if (n0 + n < N) *(u32x4*)(WT + (size_t)map(n0 + n) * K + k0 + 8 * c) = o; }
    asm volatile("s_waitcnt lgkmcnt(0)" ::: "memory");
}
struct MapId { int off; __device__ __forceinline__ int operator()(int n) const { return n + off; } };
struct MapUp { __device__ __forceinline__ int operator()(int n) const { return n < DFF ? (n >> 7) * 256 + (n & 127) : ((n - DFF) >> 7) * 256 + 128 + ((n - DFF) & 127); } };
struct MapIn { __device__ __forceinline__ int operator()(int n) const { return n < 1536 ? n : (n < 1560 ? n + (P_MLG - 1536) : (n < 3480 ? n - 24 : n)); } };

__device__ __forceinline__ void convert_part(const Ctx& c, int l, int part, int gw, int NGW, LAS unsigned char* lds) {
    LAS float* scr = (LAS float*)(lds + c.wave * 16384);
    constexpr int I_IN = 16 * 110, I_SQ = 16 * 32, I_UP = 16 * 176, I_DN = 44 * 32;
    if (part == 0) {
        for (int it = gw; it < I_IN + 2 * I_SQ; it += NGW) {
            int r = it;
            if (r < I_IN) { cvt_item(c.in(3) + (size_t)l * D * IN_COLS, D, IN_COLS, c.in(2) + l * D, c.w_in(), scr, r, c.lane, MapIn{}); continue; } r -= I_IN;
            if (r < I_SQ) { cvt_item(c.in(16) + (size_t)l * D * D, D, D, c.in(14) + l * D, c.wkv(), scr, r, c.lane, MapId{0}); continue; } r -= I_SQ;
            cvt_item(c.in(17) + (size_t)l * D * D, D, D, c.in(14) + l * D, c.wkv(), scr, r, c.lane, MapId{D});
        }
        for (int i = gw * 64 + c.lane; i < (NPROJ - IN_COLS) * D / 8; i += NGW * 64) *(u32x4*)(c.w_in() + (size_t)IN_COLS * D + (size_t)i * 8) = (u32x4){0u, 0u, 0u, 0u};
    } else {
        for (int it = gw; it < 3 * I_SQ + I_UP + I_DN; it += NGW) {
            int r = it;
            if (r < I_SQ) { cvt_item(c.in(12) + (size_t)l * D * D, D, D, nullptr, c.w_out(), scr, r, c.lane, MapId{0}); continue; } r -= I_SQ;
            if (r < I_SQ) { cvt_item(c.in(15) + (size_t)l * D * D, D, D, c.in(13) + l * D, c.wq(), scr, r, c.lane, MapId{0}); continue; } r -= I_SQ;
            if (r < I_SQ) { cvt_item(c.in(18) + (size_t)l * D * D, D, D, nullptr, c.wo(), scr, r, c.lane, MapId{0}); continue; } r -= I_SQ;
            if (r < I_UP) { cvt_item(c.in(20) + (size_t)l * D * NUP, D, NUP, c.in(19) + l * D, c.w_up(), scr, r, c.lane, MapUp{}); continue; } r -= I_UP;
            cvt_item(c.in(23) + (size_t)l * DFF * D, DFF, D, nullptr, c.w_dn(), scr, r, c.lane, MapId{0});
        }
    }
}
__device__ __forceinline__ void rows_to_bf16(const Ctx& c, const float* X, bf16_t* Y, float* rss, int rows) {
    const int gw = c.bid * NWAVES + c.wave, NGW = c.G * NWAVES;
    for (int m = gw; m < rows; m += NGW) {
        const f32x4* xr = (const f32x4*)(X + (size_t)m * D) + c.lane; float s = 0.f;
        unsigned long long* o8 = (unsigned long long*)(Y + (size_t)m * D) + c.lane;
#pragma unroll
        for (int j = 0; j < 4; ++j) { const f32x4 v = xr[64 * j]; s += (v[0] * v[0] + v[1] * v[1]) + (v[2] * v[2] + v[3] * v[3]);
            o8[64 * j] = (unsigned long long)pk2(v[0], v[1]) | ((unsigned long long)pk2(v[2], v[3]) << 32); }
        s = wave_sum(s); if (c.lane < 16) rss[(size_t)m * 16 + c.lane] = (c.lane == 0) ? s : 0.f;
    }
}
__device__ __forceinline__ void final_norm(const Ctx& c) {
    const int gw = c.bid * NWAVES + c.wave, NGW = c.G * NWAVES; const float* g = c.in(24);
    for (int m = gw; m < M; m += NGW) {
        f32x4* xr = (f32x4*)(c.out + (size_t)m * D) + c.lane; f32x4 v[4]; float s = 0.f;
#pragma unroll
        for (int j = 0; j < 4; ++j) { v[j] = xr[64 * j]; s += (v[j][0] * v[j][0] + v[j][1] * v[j][1]) + (v[j][2] * v[j][2] + v[j][3] * v[j][3]); }
        const float r = 1.0f / sqrtf(wave_sum(s) * (1.0f / D) + EPS);
#pragma unroll
        for (int j = 0; j < 4; ++j) xr[64 * j] = v[j] * r * ((const f32x4*)g)[c.lane + 64 * j];
    }
}
typedef __attribute__((address_space(1))) unsigned gu32;
#define XB_TMO      128
#define XB_XCNT(j)  (256  + 64 * (j))
#define XB_XSUB(j)  (1280 + 64 * (j))
#define XB_XGEN(j)  (2304 + 64 * (j))
#define XB_TOP      3328
#define XB_TOPGEN   3392
#define XCD_BAR_WORDS 3456
#define XB_SPIN_CAP (1u << 18)

__device__ __forceinline__ unsigned xb_ld(unsigned* p)              { return __hip_atomic_load(p, __ATOMIC_RELAXED, __HIP_MEMORY_SCOPE_AGENT); }
__device__ __forceinline__ unsigned xb_add(unsigned* p, unsigned v) { return __hip_atomic_fetch_add(p, v, __ATOMIC_RELAXED, __HIP_MEMORY_SCOPE_AGENT); }
__device__ __forceinline__ unsigned xb_xcc_id() { return (unsigned)__builtin_amdgcn_s_getreg((3 << 11) | 20) & 0xFu; }
#define XB_SPIN(cond, bar) do { unsigned _sp = 0; while (cond) { __builtin_amdgcn_s_sleep(1); \
    if ((++_sp & 255u) == 0u) { if (xb_ld(&(bar)[XB_TMO])) break; if (_sp > XB_SPIN_CAP) { atomicAdd(&(bar)[XB_TMO], 1u); break; } } } } while (0)

struct XcdBarrier {
    unsigned* bar; unsigned x;
    volatile LAS unsigned* st;
};

__device__ __forceinline__ XcdBarrier xcd_barrier_post(unsigned* bar, volatile LAS unsigned* st) {
    XcdBarrier b; b.bar = bar; b.x = xb_xcc_id(); b.st = st;
    if (threadIdx.x == 0) (void)xb_add(&bar[XB_XCNT(b.x)], 1u);
    return b;
}
__device__ __forceinline__ void xcd_barrier_complete(unsigned* bar, unsigned x, unsigned& nloc, unsigned& nx) {
    const unsigned G = gridDim.x * gridDim.y * gridDim.z;
    unsigned sum, cnt, mine, sp = 0u;
    for (;;) {
        sum = 0u; cnt = 0u; mine = 0u;
#pragma unroll
        for (unsigned j = 0; j < 16; ++j) { const unsigned c = xb_ld(&bar[XB_XCNT(j)]); sum += c; cnt += (c > 0u) ? 1u : 0u; mine = (j == x) ? c : mine; }
        if (sum == G) break;
        __builtin_amdgcn_s_sleep(1);
        if ((++sp & 255u) == 0u) { if (xb_ld(&bar[XB_TMO])) break; if (sp > XB_SPIN_CAP) { atomicAdd(&bar[XB_TMO], 1u); break; } }
    }
    nloc = mine > 0u ? mine : 1u; nx = cnt > 0u ? cnt : 1u;
}

__device__ __forceinline__ void xcd_barrier(const XcdBarrier& b) {
    asm volatile("s_waitcnt vmcnt(0)" ::: "memory");
    __syncthreads();
    if (threadIdx.x == 0) {
        unsigned* bar = b.bar;
        __builtin_amdgcn_s_waitcnt(0);
        unsigned nloc = b.st[0], nx = b.st[1];
        if (nloc == 0u) { xcd_barrier_complete(bar, b.x, nloc, nx); b.st[0] = nloc; b.st[1] = nx; }
        const unsigned old = xb_add(&bar[XB_XSUB(b.x)], 1u);
        const unsigned gen = old / nloc;
        if (old + 1u == (gen + 1u) * nloc) {
            __builtin_amdgcn_fence(__ATOMIC_RELEASE, "agent");
            asm volatile("s_waitcnt vmcnt(0)" ::: "memory");
            const unsigned og = xb_add(&bar[XB_TOP], 1u);
            const unsigned tg = og / nx;
            if (og + 1u == (tg + 1u) * nx) xb_add(&bar[XB_TOPGEN], 1u);
            else XB_SPIN(xb_ld(&bar[XB_TOPGEN]) == tg, bar);
            __builtin_amdgcn_fence(__ATOMIC_ACQUIRE, "agent");
            xb_add(&bar[XB_XGEN(b.x)], 1u);
            asm volatile("s_waitcnt vmcnt(0)" ::: "memory");
        } else {
            XB_SPIN(xb_ld(&bar[XB_XGEN(b.x)]) == gen, bar);
            __builtin_amdgcn_fence(__ATOMIC_ACQUIRE, "agent");
            asm volatile("s_waitcnt vmcnt(0)" ::: "memory");
        }
    }
    __syncthreads();
}
__device__ __forceinline__ void ml_load_row(const bf16_t* projb, int t, int coff, float (&dst)[2][8]) {
    if (t < 0 || t >= T) {
#pragma unroll
        for (int j = 0; j < 8; ++j) { dst[0][j] = 0.f; dst[1][j] = 0.f; }
    } else {
        const u32x4 a = *(const u32x4*)(projb + (size_t)t * NPROJ + P_MLQ + coff), b = *(const u32x4*)(projb + (size_t)t * NPROJ + P_MLK + coff);
        unpack8(a, dst[0]); unpack8(b, dst[1]);
    }
}
__device__ __forceinline__ void ml_item(const Ctx& c0, int l, int item, LAS unsigned char* lds) {
    LAUNDER_CTX(c0, c);
    const int b = item / 6, h = item % 6, e = c.tid & 63, dg = c.tid >> 6;
    LAS float* rnum = (LAS float*)lds;
    LAS float* rden = (LAS float*)lds + 1024;
    const bf16_t* projb = c.proj() + (size_t)b * T * NPROJ;
    const float* gatesb = c.gates() + (size_t)b * T * 64;
    float* hs = c.hsml() + (size_t)b * T * 384 + h * 64;
    const float* cwp = c.in(4) + (size_t)l * 3 * 768; const float* cbp = c.in(5) + (size_t)l * 768;
    const float* gb = c.in(6) + l * 24; const float* ng = c.in(7) + l * 384;
    const int coff = h * 64 + dg * 8;
    float cw[2][8][4];
#pragma unroll
    for (int qk = 0; qk < 2; ++qk)
#pragma unroll
        for (int j = 0; j < 8; ++j) { const int ch = qk * 384 + coff + j; cw[qk][j][0] = cwp[ch]; cw[qk][j][1] = cwp[768 + ch]; cw[qk][j][2] = cwp[1536 + ch]; cw[qk][j][3] = cbp[ch]; }
    for (int dir = 0; dir < 2; ++dir) {
        float C[8], n[8];
#pragma unroll
        for (int j = 0; j < 8; ++j) { C[j] = 0.f; n[j] = 0.f; }
        const float bi = gb[(2 * dir) * 6 + h], bff = gb[(2 * dir + 1) * 6 + h];
        float lo[2][8], mid[2][8], hi[2][8];
        const int t0 = dir ? T - 1 : 0;
        ml_load_row(projb, t0 - 1, coff, lo); ml_load_row(projb, t0, coff, mid); ml_load_row(projb, t0 + 1, coff, hi);
        for (int s = 0; s < T; ++s) {
            const int t = dir ? T - 1 - s : s;
            const float ip = gatesb[(size_t)t * 64 + (2 * dir) * 6 + h] + bi, fp = gatesb[(size_t)t * 64 + (2 * dir + 1) * 6 + h] + bff;
            const float f = sigmoidf_(fp), ig = __expf(ip);
            const float v = bf2f(projb[(size_t)t * NPROJ + P_MLV + h * 64 + e]);
            float pn = 0.f, pd = 0.f;
#pragma unroll
            for (int j = 0; j < 8; ++j) {
                float yq = lo[0][j] * cw[0][j][0] + mid[0][j] * cw[0][j][1] + hi[0][j] * cw[0][j][2] + cw[0][j][3];
                float yk = lo[1][j] * cw[1][j][0] + mid[1][j] * cw[1][j][1] + hi[1][j] * cw[1][j][2] + cw[1][j][3];
                const float qd = yq * sigmoidf_(yq), kd = yk * sigmoidf_(yk) * 0.125f;
                C[j] = f * C[j] + ig * kd * v; n[j] = f * n[j] + ig * kd; pn += C[j] * qd; pd += n[j] * qd;
            }
            const int p = s & 1;
            rnum[(p * 8 + dg) * 64 + e] = pn; if (e == 0) rden[p * 8 + dg] = pd;
            __syncthreads();
            if (dg == 0) {
                float num = 0.f, den = 0.f;
#pragma unroll
                for (int g = 0; g < 8; ++g) { num += rnum[(p * 8 + g) * 64 + e]; den += rden[p * 8 + g]; }
                const float hv = num / fmaxf(fabsf(den), 1.f);
                if (dir == 0) hs[(size_t)t * 384 + e] = hv;
                else { const float tot = hs[(size_t)t * 384 + e] + hv; const float ss = wave_sum(tot * tot);
                    const float r = 1.0f / sqrtf(ss * (1.0f / 64) + EPS); const float og = bf2f(projb[(size_t)t * NPROJ + P_MLO + h * 64 + e]);
                    c.mixed()[((size_t)b * T + t) * D + h * 64 + e] = (bf16_t)f2bf(tot * r * ng[h * 64 + e] * sigmoidf_(og)); }
            }
            if (dir == 0) {
#pragma unroll
                for (int j = 0; j < 8; ++j) { lo[0][j] = mid[0][j]; lo[1][j] = mid[1][j]; mid[0][j] = hi[0][j]; mid[1][j] = hi[1][j]; }
                ml_load_row(projb, t + 2, coff, hi);
            } else {
#pragma unroll
                for (int j = 0; j < 8; ++j) { hi[0][j] = mid[0][j]; hi[1][j] = mid[1][j]; mid[0][j] = lo[0][j]; mid[1][j] = lo[1][j]; }
                ml_load_row(projb, t - 2, coff, lo);
            }
        }
        __syncthreads();
    }
}
__device__ __forceinline__ void gla_item(const Ctx& c0, int l, int item, LAS unsigned char* lds) {
    LAUNDER_CTX(c0, c);
    const int b = item / 5, h = item % 5, e = c.tid & 63, kg = c.tid >> 6;
    LAS float* rnum = (LAS float*)lds;
    const bf16_t* projb = c.proj() + (size_t)b * T * NPROJ;
    const float* gatesb = c.gates() + (size_t)b * T * 64;
    float* gs = c.hsgl() + (size_t)b * T * 320 + h * 64;
    const float* ng = c.in(11) + l * 320;
    const int doff = h * 32 + kg * 4;
    for (int dir = 0; dir < 2; ++dir) {
        const float* w2 = c.in(9) + ((size_t)l * 2 + dir) * 16 * 160; const float* ab = c.in(10) + ((size_t)l * 2 + dir) * 160;
        float w2r[16][4], abv[4], S[4];
#pragma unroll
        for (int j = 0; j < 4; ++j) { abv[j] = ab[doff + j]; S[j] = 0.f;
#pragma unroll
            for (int r = 0; r < 16; ++r) w2r[r][j] = w2[r * 160 + doff + j]; }
        for (int s = 0; s < T; ++s) {
            const int t = dir ? T - 1 - s : s;
            const float* gp = gatesb + (size_t)t * 64 + 24 + dir * 16;
            float ga[16];
#pragma unroll
            for (int r4 = 0; r4 < 4; ++r4) { const f32x4 x = *(const f32x4*)(gp + 4 * r4); ga[4 * r4] = x[0]; ga[4 * r4 + 1] = x[1]; ga[4 * r4 + 2] = x[2]; ga[4 * r4 + 3] = x[3]; }
            const unsigned long long qw = *(const unsigned long long*)(projb + (size_t)t * NPROJ + P_GQ + doff), kw = *(const unsigned long long*)(projb + (size_t)t * NPROJ + P_GK + doff);
            const float v = bf2f(projb[(size_t)t * NPROJ + P_GV + h * 64 + e]);
            float pn = 0.f;
#pragma unroll
            for (int j = 0; j < 4; ++j) {
                float z = abv[j];
#pragma unroll
                for (int r = 0; r < 16; ++r) z += ga[r] * w2r[r][j];
                const float la = (fminf(z, 0.f) - log1pf(__expf(-fabsf(z)))) * (1.0f / 16.0f);
                const float a = __expf(la);
                const float qd = bf2f((unsigned)(qw >> (16 * j)) & 0xffffu), kd = bf2f((unsigned)(kw >> (16 * j)) & 0xffffu);
                S[j] = a * S[j] + kd * v; pn += S[j] * qd;
            }
            const int p = s & 1;
            rnum[(p * 8 + kg) * 64 + e] = pn * 0.17677669529663687f;
            __syncthreads();
            if (kg == 0) {
                float o = 0.f;
#pragma unroll
                for (int g = 0; g < 8; ++g) o += rnum[(p * 8 + g) * 64 + e];
                if (dir == 0) gs[(size_t)t * 320 + e] = o;
                else { const float tot = gs[(size_t)t * 320 + e] + o; const float ss = wave_sum(tot * tot);
                    const float r = 1.0f / sqrtf(ss * (1.0f / 64) + EPS); const float gg = bf2f(projb[(size_t)t * NPROJ + P_GG + h * 64 + e]);
                    c.mixed()[((size_t)b * T + t) * D + 704 + h * 64 + e] = (bf16_t)f2bf(tot * r * ng[h * 64 + e] * gg * sigmoidf_(gg)); }
            }
        }
        __syncthreads();
    }
}
__device__ __forceinline__ void na_item(const Ctx& c0, int l, int item, LAS unsigned char* lds) {
    LAUNDER_CTX(c0, c);
    const int b = item / 160, h = (item % 160) / 32, r = item % 32;
    const int q = c.tid >> 3, s = c.tid & 7;
    LAS float* sc = (LAS float*)lds;
    const bf16_t* projb = c.proj() + (size_t)b * T * NPROJ;
    const float* rpb = c.in(8) + ((size_t)l * 5 + h) * 15 * 31;
    const int rs = min(max(r - 4, 0), 24), cs = min(max(q - 8, 0), 48);
    float qv[64];
    { const bf16_t* qp = projb + (size_t)(r * 64 + q) * NPROJ + P_NAQ + h * 64;
#pragma unroll
      for (int i = 0; i < 8; ++i) { float t8[8]; unpack8(*(const u32x4*)(qp + 8 * i), t8);
#pragma unroll
          for (int j = 0; j < 8; ++j) qv[8 * i + j] = t8[j]; } }
    const int tr = rs + s;
    for (int kk = 0; kk < 16; ++kk) { const int tc = cs + kk;
        const bf16_t* kp = projb + (size_t)(tr * 64 + tc) * NPROJ + P_NAK + h * 64; float d = 0.f;
#pragma unroll
        for (int i = 0; i < 8; ++i) { float t8[8]; unpack8(*(const u32x4*)(kp + 8 * i), t8);
#pragma unroll
            for (int j = 0; j < 8; ++j) d += qv[8 * i + j] * t8[j]; }
        const int dr = tr - r + 7, dc = min(max(tc - q, -15), 15) + 15;
        sc[q * 129 + s * 16 + kk] = d * 0.125f + rpb[dr * 31 + dc]; }
    __syncthreads();
    float mx = -3.0e38f; for (int k = 0; k < 128; ++k) mx = fmaxf(mx, sc[q * 129 + k]);
    float sum = 0.f; for (int k = 0; k < 128; ++k) sum += __expf(sc[q * 129 + k] - mx);
    __syncthreads();
    const float inv = 1.0f / sum;
    for (int kk = 0; kk < 16; ++kk) sc[q * 129 + s * 16 + kk] = __expf(sc[q * 129 + s * 16 + kk] - mx) * inv;
    __syncthreads();
    float o[8];
#pragma unroll
    for (int j = 0; j < 8; ++j) o[j] = 0.f;
    for (int key = 0; key < 128; ++key) { const int trr = rs + (key >> 4), tcc = cs + (key & 15);
        float t8[8]; unpack8(*(const u32x4*)(projb + (size_t)(trr * 64 + tcc) * NPROJ + P_NAV + h * 64 + s * 8), t8); const float p = sc[q * 129 + key];
#pragma unroll
        for (int j = 0; j < 8; ++j) o[j] += p * t8[j]; }
    u32x4 w; w.x = pk2(o[0], o[1]); w.y = pk2(o[2], o[3]); w.z = pk2(o[4], o[5]); w.w = pk2(o[6], o[7]);
    *(u32x4*)(c.mixed() + ((size_t)b * T + r * 64 + q) * D + 384 + h * 64 + s * 8) = w;
    __syncthreads();
}
__device__ __forceinline__ void xattn_item(const Ctx& c0, int item, LAS unsigned char* lds) {
    LAUNDER_CTX(c0, c);
    const int b = item / 256, hd = (item / 64) % 4, qt = item % 64; const int row0 = b * T + qt * 32;
    LAS float* qs = (LAS float*)lds;
    LAS float* ps = (LAS float*)lds + 8192;
    const int qi = c.tid >> 4, sub = c.tid & 15;
    { const bf16_t* qp = c.q() + (size_t)(row0 + qi) * D + hd * 256 + sub * 16; float t8[8];
      unpack8(*(const u32x4*)qp, t8);
#pragma unroll
      for (int j = 0; j < 8; ++j) qs[qi * 256 + sub * 16 + j] = t8[j];
      unpack8(*(const u32x4*)(qp + 8), t8);
#pragma unroll
      for (int j = 0; j < 8; ++j) qs[qi * 256 + sub * 16 + 8 + j] = t8[j]; }
    __syncthreads();
    const bf16_t* kvb = c.memkv() + (size_t)b * NMEM * 2048 + hd * 256;
    float acc[16];
#pragma unroll
    for (int j = 0; j < 16; ++j) acc[j] = 0.f;
    for (int dc = 0; dc < 32; ++dc) {
        float qr[8];
#pragma unroll
        for (int i = 0; i < 8; ++i) qr[i] = qs[qi * 256 + dc * 8 + i];
#pragma unroll
        for (int j = 0; j < 16; ++j) { float t8[8]; unpack8(*(const u32x4*)(kvb + (size_t)(sub + 16 * j) * 2048 + dc * 8), t8);
#pragma unroll
            for (int i = 0; i < 8; ++i) acc[j] += qr[i] * t8[i]; }
    }
    float mx = -3.0e38f;
#pragma unroll
    for (int j = 0; j < 16; ++j) { acc[j] *= 0.0625f; mx = fmaxf(mx, acc[j]); }
#pragma unroll
    for (int o = 1; o < 16; o <<= 1) mx = fmaxf(mx, __shfl_xor(mx, o));
    float sum = 0.f;
#pragma unroll
    for (int j = 0; j < 16; ++j) { acc[j] = __expf(acc[j] - mx); sum += acc[j]; }
#pragma unroll
    for (int o = 1; o < 16; o <<= 1) sum += __shfl_xor(sum, o);
    const float inv = 1.0f / sum;
#pragma unroll
    for (int j = 0; j < 16; ++j) ps[qi * 256 + sub + 16 * j] = acc[j] * inv;
    __syncthreads();
    float o[16];
#pragma unroll
    for (int j = 0; j < 16; ++j) o[j] = 0.f;
    for (int key = 0; key < 256; ++key) { const float p = ps[qi * 256 + key]; const bf16_t* vp = kvb + (size_t)key * 2048 + 1024 + sub * 16; float t8[8];
        unpack8(*(const u32x4*)vp, t8);
#pragma unroll
        for (int j = 0; j < 8; ++j) o[j] += p * t8[j];
        unpack8(*(const u32x4*)(vp + 8), t8);
#pragma unroll
        for (int j = 0; j < 8; ++j) o[8 + j] += p * t8[j]; }
    bf16_t* op = c.mixed() + (size_t)(row0 + qi) * D + hd * 256 + sub * 16;
    u32x4 w; w.x = pk2(o[0], o[1]); w.y = pk2(o[2], o[3]); w.z = pk2(o[4], o[5]); w.w = pk2(o[6], o[7]); *(u32x4*)op = w;
    w.x = pk2(o[8], o[9]); w.y = pk2(o[10], o[11]); w.z = pk2(o[12], o[13]); w.w = pk2(o[14], o[15]); *(u32x4*)(op + 8) = w;
    __syncthreads();
}
__device__ __forceinline__ void act_pass(const Ctx& c, int l) {
    const float* cw = c.in(21) + (size_t)l * 3 * DFF; const float* cb = c.in(22) + (size_t)l * DFF;
    constexpr int CH = DFF / 8;
    for (int idx = c.bid * NTHREADS + c.tid; idx < M * CH; idx += c.G * NTHREADS) {
        const int row = idx / CH, c8 = (idx % CH) * 8, t = row % T;
        const bf16_t* up = c.u() + (size_t)row * NUP + c8;
        float a0[8], am[8], ap[8], g[8];
        unpack8(*(const u32x4*)up, a0); unpack8(*(const u32x4*)(up + DFF), g);
        if (t > 0) unpack8(*(const u32x4*)(up - NUP), am); else {
#pragma unroll
            for (int j = 0; j < 8; ++j) am[j] = 0.f; }
        if (t < T - 1) unpack8(*(const u32x4*)(up + NUP), ap); else {
#pragma unroll
            for (int j = 0; j < 8; ++j) ap[j] = 0.f; }
        float o[8];
#pragma unroll
        for (int j = 0; j < 8; ++j) { const float a = am[j] * cw[c8 + j] + a0[j] * cw[DFF + c8 + j] + ap[j] * cw[2 * DFF + c8 + j] + cb[c8 + j];
            const float uu = 0.7978845608028654f * (a + 0.044715f * a * a * a);
            o[j] = a * rcpf_(1.f + __expf(-2.f * uu)) * g[j]; }
        u32x4 w; w.x = pk2(o[0], o[1]); w.y = pk2(o[2], o[3]); w.z = pk2(o[4], o[5]); w.w = pk2(o[6], o[7]);
        *(u32x4*)(c.act() + (size_t)row * DFF + c8) = w;
    }
}
typedef short s16x4 __attribute__((ext_vector_type(4)));
#define MFMA16(a, b, c) __builtin_amdgcn_mfma_f32_16x16x32_bf16((a), (b), (c), 0, 0, 0)
__device__ __forceinline__ bf16x8 frag_nt(LAS const unsigned char* tile, int pitch, int row, int kbyte) {
    return *(const LAS bf16x8*)(tile + row * pitch + kbyte);
}
__device__ __forceinline__ bf16x8 frag_tr(LAS const unsigned char* tile, int pitch, int r0, int r1, int n0, int lane) {
    const int q4 = (lane & 15) >> 2, p4 = lane & 3;
    const unsigned a0 = (unsigned)(size_t)tile + (unsigned)((r0 + q4) * pitch + (n0 + 4 * p4) * 2), a1 = (unsigned)(size_t)tile + (unsigned)((r1 + q4) * pitch + (n0 + 4 * p4) * 2);
    s16x4 x, y;
    asm volatile("ds_read_b64_tr_b16 %0, %2\n\tds_read_b64_tr_b16 %1, %3\n\ts_waitcnt lgkmcnt(0)" : "=&v"(x), "=&v"(y) : "v"(a0), "v"(a1) : "memory");
    return (bf16x8){x[0], x[1], x[2], x[3], y[0], y[1], y[2], y[3]};
}
__device__ __forceinline__ void frag_tr_x4(LAS const unsigned char* tile, int pitch, int r0, int r1, int n0, int lane, bf16x8 (&out)[4]) {
    const int q4 = (lane & 15) >> 2, p4 = lane & 3;
    const unsigned a0 = (unsigned)(size_t)tile + (unsigned)((r0 + q4) * pitch + (n0 + 4 * p4) * 2), a1 = (unsigned)(size_t)tile + (unsigned)((r1 + q4) * pitch + (n0 + 4 * p4) * 2);
    s16x4 x0, y0, x1, y1, x2, y2, x3, y3;
    asm volatile("ds_read_b64_tr_b16 %0, %8\n\tds_read_b64_tr_b16 %1, %9\n\tds_read_b64_tr_b16 %2, %8 offset:32\n\tds_read_b64_tr_b16 %3, %9 offset:32\n\t"
                 "ds_read_b64_tr_b16 %4, %8 offset:64\n\tds_read_b64_tr_b16 %5, %9 offset:64\n\tds_read_b64_tr_b16 %6, %8 offset:96\n\tds_read_b64_tr_b16 %7, %9 offset:96\n\ts_waitcnt lgkmcnt(0)"
                 : "=&v"(x0), "=&v"(y0), "=&v"(x1), "=&v"(y1), "=&v"(x2), "=&v"(y2), "=&v"(x3), "=&v"(y3) : "v"(a0), "v"(a1) : "memory");
    out[0] = (bf16x8){x0[0], x0[1], x0[2], x0[3], y0[0], y0[1], y0[2], y0[3]}; out[1] = (bf16x8){x1[0], x1[1], x1[2], x1[3], y1[0], y1[1], y1[2], y1[3]};
    out[2] = (bf16x8){x2[0], x2[1], x2[2], x2[3], y2[0], y2[1], y2[2], y2[3]}; out[3] = (bf16x8){x3[0], x3[1], x3[2], x3[3], y3[0], y3[1], y3[2], y3[3]};
}

__device__ __forceinline__ bf16x8 pack_frag(const f32x4 lo, const f32x4 hi) {
    u32x4 w; w.x = cvt_pk_bf16(lo[0], lo[1]); w.y = cvt_pk_bf16(lo[2], lo[3]); w.z = cvt_pk_bf16(hi[0], hi[1]); w.w = cvt_pk_bf16(hi[2], hi[3]);
    return __builtin_bit_cast(bf16x8, w);
}
__device__ __forceinline__ float logsigmoidf_(float x) { return fminf(x, 0.f) - __logf(1.f + __expf(-fabsf(x))); }
__device__ __forceinline__ float wave_incl_scan(float v, int lane) {
#pragma unroll
    for (int o = 1; o < 64; o <<= 1) { const float t = __shfl_up(v, o); if (lane >= o) v += t; }
    return v;
}
constexpr int P64 = 144;

constexpr size_t WS_MLC2 = WS_Q;
constexpr size_t WS_MLC = WS_HSML, WS_GLC = WS_MLC + 15 * MiB, WS_MLD = WS_GLC + 10 * MiB, WS_GLD = WS_MLD + 15 * MiB, WS_MLG = WS_GLD + 10 * MiB, WS_GLB = WS_MLG + 64 * 1024;
__device__ __forceinline__ bf16_t* mlc_ptr(const Ctx& c, int b, int h, int dir, int ch) { return c.wsp<bf16_t>(WS_MLC) + (size_t)((((b * 6 + h) * 2 + dir) * 16) + ch) * 80 * 64; }

template <bool ROWW>
__device__ __forceinline__ void ml_stage_conv(const Ctx& c, const bf16_t* projb, int t0, int pcol, const float* cwp, const float* cbp, int cch, float scale, const LAS float* roww, LAS unsigned char* tile) {
    const int j = c.tid >> 2, cb = (c.tid & 3) * 16, t = t0 + j;
    float lo[16], mid[16], hi[16];
    { const bf16_t* p = projb + (size_t)t * NPROJ + pcol + cb; float t8[8];
      unpack8(*(const u32x4*)p, t8);
#pragma unroll
      for (int x = 0; x < 8; ++x) mid[x] = t8[x];
      unpack8(*(const u32x4*)(p + 8), t8);
#pragma unroll
      for (int x = 0; x < 8; ++x) mid[8 + x] = t8[x];
      if (t > 0) { unpack8(*(const u32x4*)(p - NPROJ), t8);
#pragma unroll
          for (int x = 0; x < 8; ++x) lo[x] = t8[x];
          unpack8(*(const u32x4*)(p - NPROJ + 8), t8);
#pragma unroll
          for (int x = 0; x < 8; ++x) lo[8 + x] = t8[x]; }
      else {
#pragma unroll
          for (int x = 0; x < 16; ++x) lo[x] = 0.f; }
      if (t < T - 1) { unpack8(*(const u32x4*)(p + NPROJ), t8);
#pragma unroll
          for (int x = 0; x < 8; ++x) hi[x] = t8[x];
          unpack8(*(const u32x4*)(p + NPROJ + 8), t8);
#pragma unroll
          for (int x = 0; x < 8; ++x) hi[8 + x] = t8[x]; }
      else {
#pragma unroll
          for (int x = 0; x < 16; ++x) hi[x] = 0.f; } }
    const float rw = ROWW ? roww[j] * scale : scale;
    float o[16];
#pragma unroll
    for (int x = 0; x < 16; ++x) { const int ch = cch + cb + x;
        const float y = lo[x] * cwp[ch] + mid[x] * cwp[768 + ch] + hi[x] * cwp[1536 + ch] + cbp[ch];
        o[x] = y * sigmoidf_(y) * rw; }
    u32x4 w0, w1; w0.x = pk2(o[0], o[1]); w0.y = pk2(o[2], o[3]); w0.z = pk2(o[4], o[5]); w0.w = pk2(o[6], o[7]);
    w1.x = pk2(o[8], o[9]); w1.y = pk2(o[10], o[11]); w1.z = pk2(o[12], o[13]); w1.w = pk2(o[14], o[15]);
    *(LAS u32x4*)(tile + j * P64 + cb * 2) = w0; *(LAS u32x4*)(tile + j * P64 + cb * 2 + 16) = w1;
}
__device__ __forceinline__ void ml_stage_plain(const Ctx& c, const bf16_t* projb, int t0, int pcol, LAS unsigned char* tile) {
    const int j = c.tid >> 2, cb = (c.tid & 3) * 16; const bf16_t* p = projb + (size_t)(t0 + j) * NPROJ + pcol + cb;
    *(LAS u32x4*)(tile + j * P64 + cb * 2) = *(const u32x4*)p; *(LAS u32x4*)(tile + j * P64 + cb * 2 + 16) = *(const u32x4*)(p + 8);
}
__device__ __forceinline__ float ml_gate_scan(const float* gatesb, int t0, int dir, int h, float bi, float bf_, LAS float* bcum, LAS float* ii, int lane) {
    const float* g0 = gatesb + (size_t)(t0 + 2 * lane) * 64; const float* g1 = g0 + 64;
    const float i0 = g0[(2 * dir) * 6 + h] + bi, i1 = g1[(2 * dir) * 6 + h] + bi;
    const float f0 = logsigmoidf_(g0[(2 * dir + 1) * 6 + h] + bf_), f1 = logsigmoidf_(g1[(2 * dir + 1) * 6 + h] + bf_);
    const float inc = wave_incl_scan(f0 + f1, lane), tot = __shfl(inc, 63);
    float b0, b1;
    if (dir == 0) { b0 = inc - f1; b1 = inc; } else { b1 = tot - inc + f1; b0 = b1 + f0; }
    bcum[2 * lane] = b0; bcum[2 * lane + 1] = b1; ii[2 * lane] = i0; ii[2 * lane + 1] = i1;
    return tot;
}

__device__ __forceinline__ bf16_t* mld_ptr(const Ctx& c, int b, int h, int dir, int ch) { return c.wsp<bf16_t>(WS_MLD) + (size_t)((((b * 6 + h) * 2 + dir) * 16) + ch) * 80 * 64; }
constexpr int P80 = 176;

__device__ __forceinline__ void ml_delta_item(const Ctx& c0, int l, int item, LAS unsigned char* lds) {
    LAUNDER_CTX(c0, c);
    const int b = item / 96, h = (item % 96) / 16, ch = item % 16, t0 = ch * 128;
    const int lane = c.lane, w = c.wave, i = lane & 15, g = lane >> 4;
    LAS unsigned char* Kf = lds; LAS unsigned char* Kb = lds + 128 * P64; LAS unsigned char* Vx = lds + 2 * 128 * P64;
    LAS float* bF = (LAS float*)(Vx + 128 * P80); LAS float* iF = bF + 128; LAS float* bB = bF + 256; LAS float* iB = bF + 384; LAS float* wf = bF + 512; LAS float* wb = bF + 640;
    const bf16_t* projb = c.proj() + (size_t)b * T * NPROJ; const float* gatesb = c.gates() + (size_t)b * T * 64;
    const float* cwp = c.in(4) + (size_t)l * 3 * 768; const float* cbp = c.in(5) + (size_t)l * 768; const float* gb = c.in(6) + l * 24;
    if (w < 2) { const int dir = w; LAS float* bc = dir ? bB : bF; LAS float* ii = dir ? iB : iF; LAS float* ww = dir ? wb : wf;
        const float tot = ml_gate_scan(gatesb, t0, dir, h, gb[(2 * dir) * 6 + h], gb[(2 * dir + 1) * 6 + h], bc, ii, lane);
        ww[2 * lane] = __expf(tot - bc[2 * lane] + ii[2 * lane]); ww[2 * lane + 1] = __expf(tot - bc[2 * lane + 1] + ii[2 * lane + 1]);
        if (lane == 0) c.wsp<float>(WS_MLG)[(((b * 6 + h) * 2 + dir) * 16) + ch] = tot; }
    __syncthreads();
    ml_stage_conv<true>(c, projb, t0, P_MLK + h * 64, cwp, cbp, 384 + h * 64, 0.125f, wf, Kf);
    ml_stage_conv<true>(c, projb, t0, P_MLK + h * 64, cwp, cbp, 384 + h * 64, 0.125f, wb, Kb);
    { const int j = c.tid >> 2, cb = (c.tid & 3) * 16; const bf16_t* p = projb + (size_t)(t0 + j) * NPROJ + P_MLV + h * 64 + cb;
      *(LAS u32x4*)(Vx + j * P80 + cb * 2) = *(const u32x4*)p; *(LAS u32x4*)(Vx + j * P80 + cb * 2 + 16) = *(const u32x4*)(p + 8);
      if ((c.tid & 3) == 0) { unsigned one = 0x3f80u, zero = 0u; asm volatile("" : "+v"(one), "+v"(zero));
          *(LAS u32x4*)(Vx + j * P80 + 128) = (u32x4){one, zero, zero, zero}; *(LAS u32x4*)(Vx + j * P80 + 144) = (u32x4){zero, zero, zero, zero}; } }
    __syncthreads();
    const int dir = w >> 2, td = w & 3; LAS unsigned char* Kw = dir ? Kb : Kf;
    f32x4 acc[5];
#pragma unroll
    for (int x = 0; x < 5; ++x) acc[x] = (f32x4){0.f, 0.f, 0.f, 0.f};
#pragma unroll
    for (int s = 0; s < 4; ++s) { const int r0 = 32 * s + 8 * g, r1 = r0 + 4;
        const bf16x8 a = frag_tr(Kw, P64, r0, r1, 16 * td, lane);
        bf16x8 b4[4];
#pragma unroll
        for (int x = 0; x < 4; ++x) b4[x] = frag_tr(Vx, P80, r0, r1, 16 * x, lane);
        const bf16x8 b5 = frag_tr(Vx, P80, r0, r1, 64, lane);
#pragma unroll
        for (int x = 0; x < 4; ++x) acc[x] = MFMA16(a, b4[x], acc[x]);
        acc[4] = MFMA16(a, b5, acc[4]); }
    bf16_t* dst = mld_ptr(c, b, h, dir, ch);
#pragma unroll
    for (int x = 0; x < 5; ++x) { const int e = 16 * x + i, d = 16 * td + 4 * g;
        *(unsigned long long*)(dst + e * 64 + d) = (unsigned long long)cvt_pk_bf16(acc[x][0], acc[x][1]) | ((unsigned long long)cvt_pk_bf16(acc[x][2], acc[x][3]) << 32); }
    __syncthreads();
}
__device__ __forceinline__ void ml_scan(const Ctx& c, int gt, int ngt) {
    for (int t = gt; t < 96 * 1280; t += ngt) { const int bhd = t / 1280, off = (t % 1280) * 4, dir = bhd & 1;
        const bf16_t* dsrc = c.wsp<bf16_t>(WS_MLD) + (size_t)bhd * 16 * 5120 + off;
#if MK_OLD_STATES == 3
        bf16_t* cdst = c.wsp<bf16_t>(WS_MLC2) + (size_t)bhd * 16 * 5120 + off;
#else
        bf16_t* cdst = c.wsp<bf16_t>(WS_MLC) + (size_t)bhd * 16 * 5120 + off;
#endif
        const float* gs = c.wsp<float>(WS_MLG) + bhd * 16;
        float C0 = 0.f, C1 = 0.f, C2 = 0.f, C3 = 0.f;
#pragma unroll
        for (int cc = 0; cc < 16; ++cc) { const int ch = dir ? 15 - cc : cc;
            *(unsigned long long*)(cdst + (size_t)ch * 5120) = (unsigned long long)pk2(C0, C1) | ((unsigned long long)pk2(C2, C3) << 32);
            if (cc == 15) break;
            const unsigned long long dw = *(const unsigned long long*)(dsrc + (size_t)ch * 5120); const float eg = __expf(gs[ch]);
            C0 = eg * C0 + bf2f((unsigned)dw & 0xffffu); C1 = eg * C1 + bf2f((unsigned)(dw >> 16) & 0xffffu); C2 = eg * C2 + bf2f((unsigned)(dw >> 32) & 0xffffu); C3 = eg * C3 + bf2f((unsigned)(dw >> 48)); }
    }
}

__device__ __forceinline__ void ml_out_item(const Ctx& c0, int l, int item, LAS unsigned char* lds) {
    LAUNDER_CTX(c0, c);
    const int b = item / 96, h = (item % 96) / 16, ch = item % 16, t0 = ch * 128;
    const int lane = c.lane, w = c.wave, i = lane & 15, g = lane >> 4;
    LAS unsigned char* Qt = lds; LAS unsigned char* Kt = lds + 128 * P64; LAS unsigned char* Vt = lds + 2 * 128 * P64;
    LAS unsigned char* Cf = lds + 3 * 128 * P64; LAS unsigned char* Cb = Cf + 80 * P64;
    LAS float* bF = (LAS float*)(Cb + 80 * P64); LAS float* iF = bF + 128; LAS float* bB = bF + 256; LAS float* iB = bF + 384;
    const bf16_t* projb = c.proj() + (size_t)b * T * NPROJ; const float* gatesb = c.gates() + (size_t)b * T * 64;
    const float* cwp = c.in(4) + (size_t)l * 3 * 768; const float* cbp = c.in(5) + (size_t)l * 768; const float* gb = c.in(6) + l * 24;
    if (w == 0) (void)ml_gate_scan(gatesb, t0, 0, h, gb[0 * 6 + h], gb[1 * 6 + h], bF, iF, lane);
    if (w == 1) (void)ml_gate_scan(gatesb, t0, 1, h, gb[2 * 6 + h], gb[3 * 6 + h], bB, iB, lane);
    ml_stage_conv<false>(c, projb, t0, P_MLQ + h * 64, cwp, cbp, h * 64, 1.0f, nullptr, Qt);
    ml_stage_conv<false>(c, projb, t0, P_MLK + h * 64, cwp, cbp, 384 + h * 64, 0.125f, nullptr, Kt);
    ml_stage_plain(c, projb, t0, P_MLV + h * 64, Vt);
    { const bf16_t* sf = mlc_ptr(c, b, h, 0, ch); const bf16_t* sb = mlc_ptr(c, b, h, 1, ch);
      for (int x = c.tid; x < 80 * 8; x += NTHREADS) { const int r = x >> 3, k8 = x & 7;
          *(LAS u32x4*)(Cf + r * P64 + k8 * 16) = *(const u32x4*)(sf + r * 64 + k8 * 8); *(LAS u32x4*)(Cb + r * P64 + k8 * 16) = *(const u32x4*)(sb + r * 64 + k8 * 8); } }
    __syncthreads();
    const int ti = w, qi = 16 * ti + i;
    const bf16x8 q0 = frag_nt(Qt, P64, qi, 16 * g), q1 = frag_nt(Qt, P64, qi, 64 + 16 * g);
    const float bFq = bF[qi], bBq = bB[qi];
    f32x4 of[4], ob[4];
#pragma unroll
    for (int x = 0; x < 4; ++x) { of[x] = (f32x4){0.f, 0.f, 0.f, 0.f}; ob[x] = (f32x4){0.f, 0.f, 0.f, 0.f}; }
    float denf = 0.f, denb = 0.f;
#pragma unroll
    for (int s4 = 0; s4 < 4; ++s4) {
        const bool dof = (2 * s4 <= ti), dob = (2 * s4 + 1 >= ti);
        f32x4 pf[2], pb[2];
#pragma unroll
        for (int x = 0; x < 2; ++x) { const int tj = 2 * s4 + x;
            f32x4 s = (f32x4){0.f, 0.f, 0.f, 0.f};
            s = MFMA16(frag_nt(Kt, P64, 16 * tj + i, 16 * g), q0, s); s = MFMA16(frag_nt(Kt, P64, 16 * tj + i, 64 + 16 * g), q1, s);
#pragma unroll
            for (int r = 0; r < 4; ++r) { const int j = 16 * tj + 4 * g + r;
                const float wf = (j <= qi) ? __expf(bFq - bF[j] + iF[j]) : 0.f, wb = (j >= qi) ? __expf(bBq - bB[j] + iB[j]) : 0.f;
                pf[x][r] = s[r] * wf; pb[x][r] = s[r] * wb; denf += pf[x][r]; denb += pb[x][r]; } }
        const int r0 = 32 * s4 + 4 * g, r1 = r0 + 16;
        if (dof) { const bf16x8 p = pack_frag(pf[0], pf[1]);
#pragma unroll
            for (int te = 0; te < 4; ++te) of[te] = MFMA16(frag_tr(Vt, P64, r0, r1, 16 * te, lane), p, of[te]); }
        if (dob) { const bf16x8 p = pack_frag(pb[0], pb[1]);
#pragma unroll
            for (int te = 0; te < 4; ++te) ob[te] = MFMA16(frag_tr(Vt, P64, r0, r1, 16 * te, lane), p, ob[te]); }
    }
    denf += __shfl_xor(denf, 16); denf += __shfl_xor(denf, 32); denb += __shfl_xor(denb, 16); denb += __shfl_xor(denb, 32);
    { const float ef = __expf(bFq), eb = __expf(bBq);
#pragma unroll
      for (int te = 0; te < 5; ++te) {
          f32x4 tf = (f32x4){0.f, 0.f, 0.f, 0.f}, tb = (f32x4){0.f, 0.f, 0.f, 0.f};
          tf = MFMA16(frag_nt(Cf, P64, 16 * te + i, 16 * g), q0, tf); tf = MFMA16(frag_nt(Cf, P64, 16 * te + i, 64 + 16 * g), q1, tf);
          tb = MFMA16(frag_nt(Cb, P64, 16 * te + i, 16 * g), q0, tb); tb = MFMA16(frag_nt(Cb, P64, 16 * te + i, 64 + 16 * g), q1, tb);
          if (te < 4) { of[te] = of[te] + tf * ef; ob[te] = ob[te] + tb * eb; }
          else { denf += ef * __shfl(tf[0], i); denb += eb * __shfl(tb[0], i); } } }
    const float rf = rcpf_(fmaxf(fabsf(denf), 1.f)), rb = rcpf_(fmaxf(fabsf(denb), 1.f));
    float ss = 0.f;
#pragma unroll
    for (int te = 0; te < 4; ++te) { of[te] = of[te] * rf + ob[te] * rb; ss += (of[te][0] * of[te][0] + of[te][1] * of[te][1]) + (of[te][2] * of[te][2] + of[te][3] * of[te][3]); }
    ss += __shfl_xor(ss, 16); ss += __shfl_xor(ss, 32);
    const float rn = rsqf_(ss * (1.0f / 64) + EPS);
    const float* ng = c.in(7) + l * 384 + h * 64;
    const size_t row = (size_t)b * T + t0 + qi;
#pragma unroll
    for (int te = 0; te < 4; ++te) { const int e = 16 * te + 4 * g;
        const unsigned long long ow = *(const unsigned long long*)(projb + (size_t)(t0 + qi) * NPROJ + P_MLO + h * 64 + e);
        float o4[4];
#pragma unroll
        for (int r = 0; r < 4; ++r) { const float og = bf2f((unsigned)(ow >> (16 * r)) & 0xffffu); o4[r] = of[te][r] * rn * ng[e + r] * sigmoidf_(og); }
        *(unsigned long long*)(c.mixed() + row * D + h * 64 + e) = (unsigned long long)pk2(o4[0], o4[1]) | ((unsigned long long)pk2(o4[2], o4[3]) << 32); }
    __syncthreads();
}

constexpr int P32 = 80;
constexpr int LAP = 33;
__device__ __forceinline__ bf16_t* glc_ptr(const Ctx& c, int b, int h, int dir, int ch) { return c.wsp<bf16_t>(WS_GLC) + (size_t)((((b * 5 + h) * 2 + dir) * 32) + ch) * 64 * 32; }
__device__ __forceinline__ void gla_loga(const Ctx& c, const float* gatesb, int t0, int nrows, int dir, const LAS float* w2s  , const LAS float* abs_  , LAS float* la  ) {
    for (int x = c.tid; x < nrows * 8; x += NTHREADS) { const int j = x >> 3, d4 = (x & 7) * 4;
        const float* gp = gatesb + (size_t)(t0 + j) * 64 + 24 + dir * 16; float ga[16];
#pragma unroll
        for (int r4 = 0; r4 < 4; ++r4) { const f32x4 v = *(const f32x4*)(gp + 4 * r4); ga[4 * r4] = v[0]; ga[4 * r4 + 1] = v[1]; ga[4 * r4 + 2] = v[2]; ga[4 * r4 + 3] = v[3]; }
#pragma unroll
        for (int y = 0; y < 4; ++y) { float z = abs_[d4 + y];
#pragma unroll
            for (int r = 0; r < 16; ++r) z += ga[r] * w2s[r * 32 + d4 + y];
            la[j * LAP + d4 + y] = logsigmoidf_(z) * (1.0f / 16.0f); } }
}
__device__ __forceinline__ void gla_scan64(LAS float* la  , int dir, int d, int lane, LAS float* tot) {
    const float v = la[lane * LAP + d]; const float inc = wave_incl_scan(v, lane), t = __shfl(inc, 63);
    la[lane * LAP + d] = dir ? (t - inc + v) : inc;
    if (tot && lane == 0) tot[d] = t;
}

__device__ __forceinline__ bf16_t* gld_ptr(const Ctx& c, int b, int h, int dir, int ch) { return c.wsp<bf16_t>(WS_GLD) + (size_t)((((b * 5 + h) * 2 + dir) * 32) + ch) * 64 * 32; }
__device__ __forceinline__ void gla_delta_item(const Ctx& c0, int l, int item, LAS unsigned char* lds) {
    LAUNDER_CTX(c0, c);
    const int b = item / 80, h = (item % 80) / 16, cp = item % 16, t0 = cp * 128;
    const int lane = c.lane, w = c.wave, i = lane & 15, g = lane >> 4;
    LAS unsigned char* Kf = lds; LAS unsigned char* Kb = Kf + 128 * P32;
    LAS unsigned char* Vt = Kb + 128 * P32;
    LAS float* laf = (LAS float*)(Vt + 128 * P64); LAS float* lab = laf + 128 * LAP;
    LAS float* w2s = lab + 128 * LAP; LAS float* abs_ = w2s + 1024; LAS float* btot = abs_ + 64;
    const bf16_t* projb = c.proj() + (size_t)b * T * NPROJ; const float* gatesb = c.gates() + (size_t)b * T * 64;
    { const float* w2 = c.in(9) + (size_t)l * 2 * 16 * 160; const float* ab = c.in(10) + (size_t)l * 2 * 160;
      for (int x = c.tid; x < 1024; x += NTHREADS) w2s[x] = w2[(x >> 5) * 160 + h * 32 + (x & 31)];
      if (c.tid < 64) abs_[c.tid] = ab[(c.tid >> 5) * 160 + h * 32 + (c.tid & 31)]; }
    __syncthreads();
    gla_loga(c, gatesb, t0, 128, 0, w2s, abs_, laf);
    gla_loga(c, gatesb, t0, 128, 1, w2s + 512, abs_ + 32, lab);
    __syncthreads();
#pragma unroll 4
    for (int y = 0; y < 16; ++y) { const int sidx = w * 16 + y, dir = sidx >> 6, sub = (sidx >> 5) & 1, d = sidx & 31;
        gla_scan64((dir ? lab : laf) + sub * 64 * LAP, dir, d, lane, btot + (dir * 2 + sub) * 32); }
    __syncthreads();
    { const int j = c.tid >> 2, d8 = (c.tid & 3) * 8, sub = j >> 6;
      float k8[8]; unpack8(*(const u32x4*)(projb + (size_t)(t0 + j) * NPROJ + P_GK + h * 32 + d8), k8);
      float of[8], ob[8];
#pragma unroll
      for (int y = 0; y < 8; ++y) { of[y] = k8[y] * __expf(btot[(0 + sub) * 32 + d8 + y] - laf[j * LAP + d8 + y]); ob[y] = k8[y] * __expf(btot[(2 + sub) * 32 + d8 + y] - lab[j * LAP + d8 + y]); }
      u32x4 x;
      x.x = pk2(of[0], of[1]); x.y = pk2(of[2], of[3]); x.z = pk2(of[4], of[5]); x.w = pk2(of[6], of[7]); *(LAS u32x4*)(Kf + j * P32 + d8 * 2) = x;
      x.x = pk2(ob[0], ob[1]); x.y = pk2(ob[2], ob[3]); x.z = pk2(ob[4], ob[5]); x.w = pk2(ob[6], ob[7]); *(LAS u32x4*)(Kb + j * P32 + d8 * 2) = x; }
    ml_stage_plain(c, projb, t0, P_GV + h * 64, Vt);
    if (c.tid < 128) { const int dir = c.tid >> 6, sub = (c.tid >> 5) & 1, d = c.tid & 31;
        c.wsp<float>(WS_GLB)[(size_t)((((b * 5 + h) * 2 + dir) * 32) + 2 * cp + sub) * 32 + d] = __expf(btot[(dir * 2 + sub) * 32 + d]); }
    __syncthreads();
    const int dir = w >> 2, sub = (w >> 1) & 1, td = w & 1, R = 64 * sub; LAS unsigned char* Kt = dir ? Kb : Kf;
    f32x4 acc[4];
#pragma unroll
    for (int x = 0; x < 4; ++x) acc[x] = (f32x4){0.f, 0.f, 0.f, 0.f};
#pragma unroll
    for (int s = 0; s < 2; ++s) { const int r0 = R + 32 * s + 8 * g, r1 = r0 + 4;
        const bf16x8 a = frag_tr(Kt, P32, r0, r1, 16 * td, lane); bf16x8 b4[4]; frag_tr_x4(Vt, P64, r0, r1, 0, lane, b4);
#pragma unroll
        for (int x = 0; x < 4; ++x) acc[x] = MFMA16(a, b4[x], acc[x]); }
    bf16_t* dst = gld_ptr(c, b, h, dir, 2 * cp + sub);
#pragma unroll
    for (int x = 0; x < 4; ++x) { const int e = 16 * x + i, d = 16 * td + 4 * g;
        *(unsigned long long*)(dst + e * 32 + d) = (unsigned long long)cvt_pk_bf16(acc[x][0], acc[x][1]) | ((unsigned long long)cvt_pk_bf16(acc[x][2], acc[x][3]) << 32); }
    __syncthreads();
}
__device__ __forceinline__ void gla_scan(const Ctx& c, int gt, int ngt) {
    for (int t = gt; t < 80 * 512; t += ngt) { const int bhd = t / 512, off = (t % 512) * 4, dir = bhd & 1, d = off & 31;
        const bf16_t* dsrc = c.wsp<bf16_t>(WS_GLD) + (size_t)bhd * 32 * 2048 + off; bf16_t* sdst = c.wsp<bf16_t>(WS_GLC) + (size_t)bhd * 32 * 2048 + off;
        const float* eb = c.wsp<float>(WS_GLB) + (size_t)bhd * 32 * 32 + d;
        float S0 = 0.f, S1 = 0.f, S2 = 0.f, S3 = 0.f;
#pragma unroll 8
        for (int cc = 0; cc < 32; ++cc) { const int ch = dir ? 31 - cc : cc;
            *(unsigned long long*)(sdst + (size_t)ch * 2048) = (unsigned long long)pk2(S0, S1) | ((unsigned long long)pk2(S2, S3) << 32);
            if (cc == 31) break;
            const unsigned long long dw = *(const unsigned long long*)(dsrc + (size_t)ch * 2048); const f32x4 e4 = *(const f32x4*)(eb + ch * 32);
            S0 = e4[0] * S0 + bf2f((unsigned)dw & 0xffffu); S1 = e4[1] * S1 + bf2f((unsigned)(dw >> 16) & 0xffffu); S2 = e4[2] * S2 + bf2f((unsigned)(dw >> 32) & 0xffffu); S3 = e4[3] * S3 + bf2f((unsigned)(dw >> 48)); }
    }
}

__device__ __forceinline__ void gla_out_item(const Ctx& c0, int l, int item, LAS unsigned char* lds) {
    LAUNDER_CTX(c0, c);
    const int b = item / 80, h = (item % 80) / 16, cp = item % 16, t0 = cp * 128;
    const int lane = c.lane, w = c.wave, i = lane & 15, g = lane >> 4;
    LAS unsigned char* Qf = lds; LAS unsigned char* Kf = Qf + 128 * P32; LAS unsigned char* Qb = Kf + 128 * P32; LAS unsigned char* Kb = Qb + 128 * P32;
    LAS unsigned char* Vt = Kb + 128 * P32;
    LAS unsigned char* Sf = Vt + 128 * P64;
    LAS unsigned char* Sb = Sf + 2 * 64 * P32;
    LAS float* laf = (LAS float*)(Sb + 2 * 64 * P32);
    LAS float* lab = laf + 128 * LAP; LAS float* w2s = lab + 128 * LAP; LAS float* abs_ = w2s + 1024;
    const bf16_t* projb = c.proj() + (size_t)b * T * NPROJ; const float* gatesb = c.gates() + (size_t)b * T * 64;
    { const float* w2 = c.in(9) + (size_t)l * 2 * 16 * 160; const float* ab = c.in(10) + (size_t)l * 2 * 160;
      for (int x = c.tid; x < 1024; x += NTHREADS) w2s[x] = w2[(x >> 5) * 160 + h * 32 + (x & 31)];
      if (c.tid < 64) abs_[c.tid] = ab[(c.tid >> 5) * 160 + h * 32 + (c.tid & 31)]; }
    __syncthreads();
    gla_loga(c, gatesb, t0, 128, 0, w2s, abs_, laf);
    gla_loga(c, gatesb, t0, 128, 1, w2s + 512, abs_ + 32, lab);
    __syncthreads();
#pragma unroll 4
    for (int y = 0; y < 16; ++y) { const int sidx = w * 16 + y, dir = sidx >> 6, sub = (sidx >> 5) & 1, d = sidx & 31;
        gla_scan64((dir ? lab : laf) + sub * 64 * LAP, dir, d, lane, nullptr); }
    __syncthreads();
    { const int j = c.tid >> 2, d8 = (c.tid & 3) * 8;
      float q8[8], k8[8];
      unpack8(*(const u32x4*)(projb + (size_t)(t0 + j) * NPROJ + P_GQ + h * 32 + d8), q8); unpack8(*(const u32x4*)(projb + (size_t)(t0 + j) * NPROJ + P_GK + h * 32 + d8), k8);
      float oqf[8], okf[8], oqb[8], okb[8];
#pragma unroll
      for (int y = 0; y < 8; ++y) { const float bf_ = laf[j * LAP + d8 + y], bb_ = lab[j * LAP + d8 + y];
          oqf[y] = q8[y] * 0.17677669529663687f * __expf(bf_); okf[y] = k8[y] * __expf(-bf_); oqb[y] = q8[y] * 0.17677669529663687f * __expf(bb_); okb[y] = k8[y] * __expf(-bb_); }
      u32x4 x;
      x.x = pk2(oqf[0], oqf[1]); x.y = pk2(oqf[2], oqf[3]); x.z = pk2(oqf[4], oqf[5]); x.w = pk2(oqf[6], oqf[7]); *(LAS u32x4*)(Qf + j * P32 + d8 * 2) = x;
      x.x = pk2(okf[0], okf[1]); x.y = pk2(okf[2], okf[3]); x.z = pk2(okf[4], okf[5]); x.w = pk2(okf[6], okf[7]); *(LAS u32x4*)(Kf + j * P32 + d8 * 2) = x;
      x.x = pk2(oqb[0], oqb[1]); x.y = pk2(oqb[2], oqb[3]); x.z = pk2(oqb[4], oqb[5]); x.w = pk2(oqb[6], oqb[7]); *(LAS u32x4*)(Qb + j * P32 + d8 * 2) = x;
      x.x = pk2(okb[0], okb[1]); x.y = pk2(okb[2], okb[3]); x.z = pk2(okb[4], okb[5]); x.w = pk2(okb[6], okb[7]); *(LAS u32x4*)(Kb + j * P32 + d8 * 2) = x; }
    ml_stage_plain(c, projb, t0, P_GV + h * 64, Vt);
    for (int x = c.tid; x < 2 * 2 * 64 * 4; x += NTHREADS) { const int dir = x >> 9, sub = (x >> 8) & 1, r = (x >> 2) & 63, k4 = x & 3;
        const bf16_t* s = glc_ptr(c, b, h, dir, 2 * cp + sub); *(LAS u32x4*)((dir ? Sb : Sf) + (sub * 64 + r) * P32 + k4 * 16) = *(const u32x4*)(s + r * 32 + k4 * 8); }
    __syncthreads();
    const int sub = w >> 2, ti = w & 3, R = 64 * sub, qi = 16 * ti + i;
    const bf16x8 qf = frag_nt(Qf, P32, R + qi, 16 * g), qb = frag_nt(Qb, P32, R + qi, 16 * g);
    f32x4 o[4];
#pragma unroll
    for (int te = 0; te < 4; ++te) o[te] = (f32x4){0.f, 0.f, 0.f, 0.f};
#pragma unroll
    for (int s2 = 0; s2 < 2; ++s2) {
        f32x4 p[2];
#pragma unroll
        for (int x = 0; x < 2; ++x) { const int tj = 2 * s2 + x; const f32x4 z = {0.f, 0.f, 0.f, 0.f};
            const f32x4 sf = MFMA16(frag_nt(Kf, P32, R + 16 * tj + i, 16 * g), qf, z), sb = MFMA16(frag_nt(Kb, P32, R + 16 * tj + i, 16 * g), qb, z);
#pragma unroll
            for (int r = 0; r < 4; ++r) { const int j = 16 * tj + 4 * g + r; p[x][r] = ((j <= qi) ? sf[r] : 0.f) + ((j >= qi) ? sb[r] : 0.f); } }
        const bf16x8 pp = pack_frag(p[0], p[1]); const int r0 = R + 32 * s2 + 4 * g, r1 = r0 + 16;
#pragma unroll
        for (int te = 0; te < 4; ++te) o[te] = MFMA16(frag_tr(Vt, P64, r0, r1, 16 * te, lane), pp, o[te]);
    }
#pragma unroll
    for (int te = 0; te < 4; ++te) { o[te] = MFMA16(frag_nt(Sf, P32, R + 16 * te + i, 16 * g), qf, o[te]); o[te] = MFMA16(frag_nt(Sb, P32, R + 16 * te + i, 16 * g), qb, o[te]); }
    float ss = 0.f;
#pragma unroll
    for (int te = 0; te < 4; ++te) ss += (o[te][0] * o[te][0] + o[te][1] * o[te][1]) + (o[te][2] * o[te][2] + o[te][3] * o[te][3]);
    ss += __shfl_xor(ss, 16); ss += __shfl_xor(ss, 32);
    const float rn = rsqf_(ss * (1.0f / 64) + EPS);
    const float* ng = c.in(11) + l * 320 + h * 64;
    const int tq = t0 + R + qi;
#pragma unroll
    for (int te = 0; te < 4; ++te) { const int e = 16 * te + 4 * g;
        const unsigned long long gw = *(const unsigned long long*)(projb + (size_t)tq * NPROJ + P_GG + h * 64 + e); float o4[4];
#pragma unroll
        for (int r = 0; r < 4; ++r) { const float gg = bf2f((unsigned)(gw >> (16 * r)) & 0xffffu); o4[r] = o[te][r] * rn * ng[e + r] * gg * sigmoidf_(gg); }
        *(unsigned long long*)(c.mixed() + ((size_t)b * T + tq) * D + 704 + h * 64 + e) = (unsigned long long)pk2(o4[0], o4[1]) | ((unsigned long long)pk2(o4[2], o4[3]) << 32); }
    __syncthreads();
}

__device__ __forceinline__ int clampi(int v, int lo, int hi) { return min(max(v, lo), hi); }
__device__ __forceinline__ void na_mfma_item(const Ctx& c0, int l, int item, LAS unsigned char* lds) {
    LAUNDER_CTX(c0, c);
    const int b = item / 40, h = (item % 40) / 8, r0 = (item % 8) * 4;
    const int lane = c.lane, w = c.wave, i = lane & 15, g = lane >> 4;
    LAS unsigned char* Vb = lds;
    LAS float* rp = (LAS float*)(lds + 704 * P64);
    const bf16_t* projb = c.proj() + (size_t)b * T * NPROJ;
    const int base = clampi(r0 - 4, 0, 24), nrow = clampi(r0 - 1, 0, 24) + 8 - base;
    for (int x = c.tid; x < nrow * 64 * 8; x += NTHREADS) { const int key = x >> 3, c8 = x & 7;
        *(LAS u32x4*)(Vb + key * P64 + c8 * 16) = *(const u32x4*)(projb + (size_t)(base * 64 + key) * NPROJ + P_NAV + h * 64 + c8 * 8); }
    { const float* rpb = c.in(8) + ((size_t)l * 5 + h) * 15 * 31; if (c.tid < 465) rp[c.tid] = rpb[c.tid]; }
    __syncthreads();
#pragma unroll 1
    for (int qq = 0; qq < 2; ++qq) {
        const int qb = 2 * w + qq, r = r0 + (qb >> 2), jq = qb & 3;
        const int rs = clampi(r - 4, 0, 24), kc0 = clampi(16 * jq - 8, 0, 32), cq = 16 * jq + i, cs = clampi(cq - 8, 0, 48);
        const bf16_t* qp = projb + (size_t)(r * 64 + cq) * NPROJ + P_NAQ + h * 64;
        const bf16x8 q0 = *(const bf16x8*)(qp + 8 * g), q1 = *(const bf16x8*)(qp + 32 + 8 * g);
        f32x4 s[16];
#pragma unroll
        for (int kt = 0; kt < 16; ++kt) { const int kr = kt >> 1, ct = kt & 1;
            const bf16_t* kp = projb + (size_t)((rs + kr) * 64 + kc0 + 16 * ct + i) * NPROJ + P_NAK + h * 64;
            const bf16x8 a0 = *(const bf16x8*)(kp + 8 * g), a1 = *(const bf16x8*)(kp + 32 + 8 * g);
            f32x4 z = {0.f, 0.f, 0.f, 0.f}; z = MFMA16(a0, q0, z); s[kt] = MFMA16(a1, q1, z); }
        float mx = -3.0e38f;
#pragma unroll
        for (int kt = 0; kt < 16; ++kt) { const int kr = kt >> 1, ct = kt & 1; const LAS float* rrow = rp + (rs + kr - r + 7) * 31;
#pragma unroll
            for (int rr = 0; rr < 4; ++rr) { const int tc = kc0 + 16 * ct + 4 * g + rr; const bool valid = (tc >= cs) && (tc < cs + 16);
                const float v = s[kt][rr] * 0.125f + rrow[clampi(tc - cq, -15, 15) + 15];
                s[kt][rr] = valid ? v : -3.0e38f; mx = fmaxf(mx, s[kt][rr]); } }
        mx = fmaxf(mx, __shfl_xor(mx, 16)); mx = fmaxf(mx, __shfl_xor(mx, 32));
        float sum = 0.f;
#pragma unroll
        for (int kt = 0; kt < 16; ++kt)
#pragma unroll
            for (int rr = 0; rr < 4; ++rr) { const float p = (s[kt][rr] > -1.0e38f) ? __expf(s[kt][rr] - mx) : 0.f; s[kt][rr] = p; sum += p; }
        sum += __shfl_xor(sum, 16); sum += __shfl_xor(sum, 32);
        f32x4 o[4];
#pragma unroll
        for (int te = 0; te < 4; ++te) o[te] = (f32x4){0.f, 0.f, 0.f, 0.f};
#pragma unroll
        for (int kr = 0; kr < 8; ++kr) { const bf16x8 pp = pack_frag(s[2 * kr], s[2 * kr + 1]); const int ra = (rs + kr - base) * 64 + kc0 + 4 * g, rb = ra + 16;
#pragma unroll
            for (int te = 0; te < 4; ++te) o[te] = MFMA16(frag_tr(Vb, P64, ra, rb, 16 * te, lane), pp, o[te]); }
        const float inv = rcpf_(sum);
        bf16_t* op = c.mixed() + ((size_t)b * T + r * 64 + cq) * D + 384 + h * 64;
#pragma unroll
        for (int te = 0; te < 4; ++te) *(unsigned long long*)(op + 16 * te + 4 * g) = (unsigned long long)pk2(o[te][0] * inv, o[te][1] * inv) | ((unsigned long long)pk2(o[te][2] * inv, o[te][3] * inv) << 32);
    }
    __syncthreads();
}

constexpr int P256 = 528;
__device__ __forceinline__ void xattn_mfma_item(const Ctx& c0, int item, LAS unsigned char* lds) {
    LAUNDER_CTX(c0, c);
    const int b = item / 32, hd = (item / 8) % 4, qc = item % 8; const int row0 = b * T + qc * 256;
    const int lane = c.lane, w = c.wave, i = lane & 15, g = lane >> 4;
    LAS unsigned char* KV = lds;
    const bf16_t* kvb = c.memkv() + (size_t)b * NMEM * 2048 + hd * 256;
    for (int x = c.tid; x < 8192; x += NTHREADS) { const int row = x >> 5, c16 = x & 31; *(LAS u32x4*)(KV + row * P256 + c16 * 16) = *(const u32x4*)(kvb + (size_t)row * 2048 + c16 * 8); }
    __syncthreads();
    bf16x8 P[2][8]; float inv[2];
#pragma unroll
    for (int blk = 0; blk < 2; ++blk) {
        const bf16_t* qp = c.q() + (size_t)(row0 + 16 * (w + 8 * blk) + i) * D + hd * 256 + 8 * g;
        bf16x8 qf[8];
#pragma unroll
        for (int s8 = 0; s8 < 8; ++s8) qf[s8] = *(const bf16x8*)(qp + 32 * s8);
        f32x4 s[16];
#pragma unroll
        for (int tk = 0; tk < 16; ++tk) { f32x4 z = {0.f, 0.f, 0.f, 0.f};
#pragma unroll
            for (int s8 = 0; s8 < 8; ++s8) z = MFMA16(frag_nt(KV, P256, 16 * tk + i, (32 * s8 + 8 * g) * 2), qf[s8], z);
            s[tk] = z; }
        float mx = -3.0e38f;
#pragma unroll
        for (int tk = 0; tk < 16; ++tk) mx = fmaxf(fmaxf(mx, fmaxf(s[tk][0], s[tk][1])), fmaxf(s[tk][2], s[tk][3]));
        mx = fmaxf(mx, __shfl_xor(mx, 16)); mx = fmaxf(mx, __shfl_xor(mx, 32));
        float sum = 0.f;
#pragma unroll
        for (int tk = 0; tk < 16; ++tk)
#pragma unroll
            for (int rr = 0; rr < 4; ++rr) { const float p = __expf((s[tk][rr] - mx) * 0.0625f); s[tk][rr] = p; sum += p; }
        sum += __shfl_xor(sum, 16); sum += __shfl_xor(sum, 32);
        inv[blk] = rcpf_(sum);
#pragma unroll
        for (int ks = 0; ks < 8; ++ks) P[blk][ks] = pack_frag(s[2 * ks], s[2 * ks + 1]);
    }
    __syncthreads();
    for (int x = c.tid; x < 8192; x += NTHREADS) { const int row = x >> 5, c16 = x & 31; *(LAS u32x4*)(KV + row * P256 + c16 * 16) = *(const u32x4*)(kvb + (size_t)row * 2048 + 1024 + c16 * 8); }
    __syncthreads();
#pragma unroll
    for (int blk = 0; blk < 2; ++blk) {
        f32x4 o[16];
#pragma unroll
        for (int te = 0; te < 16; ++te) o[te] = (f32x4){0.f, 0.f, 0.f, 0.f};
#pragma unroll
        for (int ks = 0; ks < 8; ++ks) { const int ra = 32 * ks + 4 * g, rb = ra + 16;
#pragma unroll
            for (int t4 = 0; t4 < 4; ++t4) { bf16x8 a4[4]; frag_tr_x4(KV, P256, ra, rb, 64 * t4, lane, a4);
#pragma unroll
                for (int x = 0; x < 4; ++x) o[4 * t4 + x] = MFMA16(a4[x], P[blk][ks], o[4 * t4 + x]); } }
        bf16_t* op = c.mixed() + (size_t)(row0 + 16 * (w + 8 * blk) + i) * D + hd * 256 + 4 * g;
        const float iv = inv[blk];
#pragma unroll
        for (int te = 0; te < 16; ++te) *(unsigned long long*)(op + 16 * te) = (unsigned long long)pk2(o[te][0] * iv, o[te][1] * iv) | ((unsigned long long)pk2(o[te][2] * iv, o[te][3] * iv) << 32);
    }
    __syncthreads();
}
#ifndef MK_PER_PHASE
#define MK_PER_PHASE 0
#endif
#if defined(MK_DUP) || defined(MK_WPHASE)
constexpr int PH_SLOTS = 11;
#else
constexpr int PH_SLOTS = 10;
#endif
constexpr int NP = 2 + DEPTH * PH_SLOTS;
struct Args { const float* in[25]; float* out; unsigned char* ws; int ph_lo, ph_hi; };

__global__ void __launch_bounds__(NTHREADS, 2) mega(Args a) {
    extern __shared__ __attribute__((aligned(16))) unsigned char lds_raw[];
    LAS unsigned char* lds = (LAS unsigned char*)lds_raw;
    Ctx c;
    c.out = a.out; c.ws = a.ws;
#if MK_CG_SYNC
    cg::grid_group grid = cg::this_grid();
#else
    if (threadIdx.x < 16) ((LAS unsigned*)(lds + LDS_MISC))[threadIdx.x] = 0u;
    __syncthreads();
    const XcdBarrier bar = xcd_barrier_post((unsigned*)(a.ws + WS_BAR), (volatile LAS unsigned*)(lds + LDS_MISC));
#endif

    for (int p = a.ph_lo; p < a.ph_hi; ++p) {
        { int t_ = threadIdx.x, b_ = blockIdx.x, g_ = gridDim.x;
          asm volatile("" : "+v"(t_)); asm volatile("" : "+s"(b_)); asm volatile("" : "+s"(g_));
          c.tid = t_; c.lane = t_ & 63; c.wave = __builtin_amdgcn_readfirstlane(t_ >> 6); c.bid = b_; c.G = g_; }
        if (p == 0) {
            convert_part(c, 0, 0, c.bid * NWAVES + c.wave, c.G * NWAVES, lds); convert_part(c, 0, 1, c.bid * NWAVES + c.wave, c.G * NWAVES, lds);
            rows_to_bf16(c, c.in(0), c.hb(), c.rs0(), M);
            rows_to_bf16(c, c.in(1), c.memb(), c.rsm(), MM);
        } else if (p == NP - 1) {
            final_norm(c);
#if MK_OLD_STATES == 3
            if (c.bid == 0) { __syncthreads(); if (c.tid == 0) { float m2 = 0.f; for (int k_ = 0; k_ < c.G; ++k_) m2 = fmaxf(m2, c.wsp<float>(WS_BAR + 15 * 1024)[k_]); c.out[0] += 100.f * fminf(m2, 1.0e4f); } }
#endif
        } else {
            const int l = (p - 1) / PH_SLOTS;
#ifdef MK_DUP
            const int sl_ = (p - 1) % PH_SLOTS, st = sl_ > MK_DUP ? sl_ - 1 : sl_;
#else
            const int st = (p - 1) % PH_SLOTS;
#endif
            if (st == 0) {
                { pg8::Gemm g{c.hb(), c.w_in(), M, NPROJ, D}; pg8::StaticOrder S; S.init(M, NPROJ, c.G, c.bid);
                  EpiScale E{c.proj(), NPROJ, c.rs0(), c.gates(), 13};
                  pg8::gemm_phase<EpiScale, pg8::StaticOrder, true, true>(lds, g, S, E); }
                { pg8::Gemm g{c.memb(), c.wkv(), MM, 2 * D, D}; pg8::StaticOrder S; S.init(MM, 2 * D, c.G, c.bid);
                  EpiScale E{c.memkv(), 2 * D, c.rsm(), nullptr, -1};
                  pg8::gemm_phase<EpiScale, pg8::StaticOrder, true, true>(lds, g, S, E); }
            } else if (st == 1) {
#if MK_OLD_STATES == 1
                if (c.bid < 80) gla_state_item(c, l, c.bid, lds);
                else for (int i = c.bid - 80; i < 768 + 320; i += c.G - 80) { if (i < 768) ml_delta_item(c, l, i, lds); else na_mfma_item(c, l, i - 768, lds); }
#elif MK_OLD_STATES == 3
                if (c.bid < 96) ml_state_item(c, l, c.bid, lds);
                else if (c.bid < 176) gla_state_item(c, l, c.bid - 96, lds);
                else for (int i = c.bid - 176; i < 768 + 320; i += c.G - 176) { if (i < 768) ml_delta_item(c, l, i, lds); else na_mfma_item(c, l, i - 768, lds); }
#elif MK_OLD_STATES == 2
                if (c.bid < 96) ml_state_item(c, l, c.bid, lds);
                else for (int i = c.bid - 96; i < 640 + 320; i += c.G - 96) { if (i < 640) gla_delta_item(c, l, i, lds); else na_mfma_item(c, l, i - 640, lds); }
#else
                for (int i = c.bid; i < 1728; i += c.G) {
                    if (i < 768) ml_delta_item(c, l, i, lds); else if (i < 1408) gla_delta_item(c, l, i - 768, lds); else na_mfma_item(c, l, i - 1408, lds); }
#endif
#ifndef MK_WPHASE
                if (l > 0) convert_part(c, l, 1, c.bid * NWAVES + c.wave, c.G * NWAVES, lds);
                if (l + 1 < DEPTH) convert_part(c, l + 1, 0, c.bid * NWAVES + c.wave, c.G * NWAVES, lds);
#endif
            } else if (st == 2) {
#if MK_OLD_STATES == 1
                ml_scan(c, c.bid * NTHREADS + c.tid, c.G * NTHREADS);
#elif MK_OLD_STATES == 3
                ml_scan(c, c.bid * NTHREADS + c.tid, c.G * NTHREADS);
#elif MK_OLD_STATES == 2
                gla_scan(c, c.bid * NTHREADS + c.tid, c.G * NTHREADS);
#else
                ml_scan(c, c.bid * NTHREADS + c.tid, c.G * NTHREADS); gla_scan(c, c.bid * NTHREADS + c.tid, c.G * NTHREADS);
#endif
            } else if (st == 3) {
#if MK_OLD_STATES == 3
                if (l == MK_PROBE_L) { float mx = 0.f; const bf16_t* A_ = c.wsp<bf16_t>(WS_MLC); const bf16_t* B_ = c.wsp<bf16_t>(WS_MLC2);
                    for (size_t x = (size_t)c.bid * NTHREADS + c.tid; x < (size_t)96 * 16 * 5120; x += (size_t)c.G * NTHREADS) {
                        const int row_ = (int)((x % 5120) / 64), chk_ = (int)((x / 5120) % 16), dir_ = (int)((x / (5120 * 16)) & 1); (void)row_; (void)chk_; (void)dir_;
                        if (!(MK_PROBE_SEL)) continue;
                        const float a_ = bf2f(A_[x]), b_ = bf2f(B_[x]); float d_ = fabsf(a_ - b_); if (!(d_ == d_) || !(b_ == b_)) d_ = 1.0e6f;
                        if (MK_PROBE_REL) d_ = d_ / (fabsf(a_) + 1e-3f); mx = fmaxf(mx, d_); }
#pragma unroll
                    for (int o_ = 1; o_ < 64; o_ <<= 1) mx = fmaxf(mx, __shfl_xor(mx, o_));
                    LAS float* red_ = (LAS float*)lds; if (c.lane == 0) red_[c.wave] = mx; __syncthreads();
                    if (c.tid == 0) { float m2 = 0.f; for (int k_ = 0; k_ < 8; ++k_) m2 = fmaxf(m2, red_[k_]); c.wsp<float>(WS_BAR + 15 * 1024)[c.bid] = m2; }
                    __syncthreads(); }
#endif
                for (int i = c.bid; i < NB * 6 * 16 + NB * 5 * 16; i += c.G) { if (i < NB * 6 * 16) ml_out_item(c, l, i, lds); else gla_out_item(c, l, i - NB * 6 * 16, lds); }
            } else if (st == 4) {
                pg8::Gemm g{c.mixed(), c.w_out(), M, D, D}; pg8::StaticOrder S; S.init(M, D, c.G, c.bid);
                EpiResid E{l == 0 ? c.in(0) : c.out, c.out, c.hb(), c.rs1()};
                pg8::gemm_phase<EpiResid, pg8::StaticOrder, true, true>(lds, g, S, E);
            } else if (st == 5) {
                pg8::Gemm g{c.hb(), c.wq(), M, D, D}; pg8::StaticOrder S; S.init(M, D, c.G, c.bid);
                EpiScale E{c.q(), D, c.rs1(), nullptr, -1};
                pg8::gemm_phase<EpiScale, pg8::StaticOrder, true, true>(lds, g, S, E);
            } else if (st == 6) {
                for (int i = c.bid; i < NB * 4 * 8; i += c.G) xattn_mfma_item(c, i, lds);
            } else if (st == 7) {
                pg8::Gemm g{c.mixed(), c.wo(), M, D, D}; pg8::StaticOrder S; S.init(M, D, c.G, c.bid);
                EpiResid E{c.out, c.out, c.hb(), c.rs2()};
                pg8::gemm_phase<EpiResid, pg8::StaticOrder, true, true>(lds, g, S, E);
            } else if (st == 8) {
                pg8::Gemm g{c.hb(), c.w_up(), M, NUP, D}; pg8::StaticOrder S; S.init(M, NUP, c.G, c.bid);
                EpiFfn E{c.act(), c.rs2(), c.in(21) + (size_t)l * 3 * DFF, c.in(22) + (size_t)l * DFF, c.wsp<float>(WS_BND), (LAS float*)(lds + 131072)};
                pg8::gemm_phase<EpiFfn, pg8::StaticOrder, true, true>(lds, g, S, E);
            } else if (st == 9) {
                pg8::Gemm g{c.act(), c.w_dn(), M, D, DFF}; pg8::StaticOrder S; S.init(M, D, c.G, c.bid);
                { pg8::Unit u0; if (S.next(0, u0)) ffn_fixup(c.wsp<float>(WS_BND), c.in(21) + (size_t)l * 3 * DFF, c.in(22) + (size_t)l * DFF, c.act(), u0.pm, c.tid); }
                EpiResid E{c.out, c.out, c.hb(), c.rs0()};
                pg8::gemm_phase<EpiResid, pg8::StaticOrder, true, true>(lds, g, S, E);
#ifdef MK_WPHASE
            } else if (st == 10) { if (l + 1 < DEPTH) { convert_part(c, l + 1, 0, c.bid * NWAVES + c.wave, c.G * NWAVES, lds); convert_part(c, l + 1, 1, c.bid * NWAVES + c.wave, c.G * NWAVES, lds); }
#endif
            }
        }
#if MK_CG_SYNC
        if (p + 1 < a.ph_hi) grid.sync();
#else
        if (p + 1 < a.ph_hi) xcd_barrier(bar);
#endif
    }
}
}

extern "C" void kernel_launch(void* const* d_in, const int* in_sizes, int n_in, void* d_out, int out_size, void* d_ws, size_t ws_size, hipStream_t stream) {
    static int grid = 0;
    if (grid == 0) {
        if (n_in != 25 || out_size != mk::M * mk::D || ws_size < mk::WS_END) { fprintf(stderr, "kernel_launch: unexpected shapes / workspace (n_in %d out %d ws %zu need %zu)\n", n_in, out_size, ws_size, (size_t)mk::WS_END); grid = -1; return; }
        int dev = 0, cus = 0, per_cu = 0;
        (void)hipGetDevice(&dev); (void)hipDeviceGetAttribute(&cus, hipDeviceAttributeMultiprocessorCount, dev);
        if (hipFuncSetAttribute((const void*)mk::mega, hipFuncAttributeMaxDynamicSharedMemorySize, mk::LDS_BYTES) != hipSuccess) { fprintf(stderr, "kernel_launch: hipFuncSetAttribute failed\n"); grid = -1; return; }
        (void)hipOccupancyMaxActiveBlocksPerMultiprocessor(&per_cu, (const void*)mk::mega, mk::NTHREADS, mk::LDS_BYTES);
        if (per_cu < 1) { fprintf(stderr, "kernel_launch: occupancy query says %d blocks per CU\n", per_cu); grid = -1; return; }
        grid = cus;
        if (grid < 192) { fprintf(stderr, "kernel_launch: needs >= 192 CUs\n"); grid = -1; return; }
    }
    if (grid < 0) return;
    mk::Args a{};
    for (int i = 0; i < 25; ++i) a.in[i] = (const float*)d_in[i];
    a.out = (float*)d_out; a.ws = (unsigned char*)d_ws;
#if MK_PER_PHASE
    for (int p = 0; p < mk::NP; ++p) { a.ph_lo = p; a.ph_hi = p + 1; hipLaunchKernelGGL(mk::mega, dim3(grid), dim3(mk::NTHREADS), mk::LDS_BYTES, stream, a); }
#else
    a.ph_lo = 0; a.ph_hi = mk::NP;
#if MK_CG_SYNC
    void* args[] = {&a};
    hipError_t e = hipLaunchCooperativeKernel((const void*)mk::mega, dim3(grid), dim3(mk::NTHREADS), args, mk::LDS_BYTES, stream);
    if (e != hipSuccess) fprintf(stderr, "cooperative launch failed: %s (grid %d)\n", hipGetErrorString(e), grid);
#else
    if (hipMemsetAsync((char*)d_ws + mk::WS_BAR, 0, mk::WS_BAR_BYTES, stream) != hipSuccess) { fprintf(stderr, "kernel_launch: memset of the barrier words failed\n"); return; }
    hipLaunchKernelGGL(mk::mega, dim3(grid), dim3(mk::NTHREADS), mk::LDS_BYTES, stream, a);
#endif
#endif
}
```

```cpp
#include <hip/hip_runtime.h>
#include <hip/hip_cooperative_groups.h>
#include <cstdio>
#include <cstdint>
namespace cg = cooperative_groups;
#define MK_PER_PHASE 0
#define MK_CG_SYNC 0
#define MK_LIB_SHFL 0
namespace pg8 {
#define PG8_LAS __attribute__((address_space(3)))
typedef unsigned short bf16_t;
typedef short bf16x8 __attribute__((ext_vector_type(8)));
typedef float f32x4 __attribute__((ext_vector_type(4)));
typedef unsigned u32x4 __attribute__((ext_vector_type(4)));
constexpr int BM = 256, BK = 64, HALF = 128, HTB = HALF * BK * 2  , STAGE_BYTES = 8 * HTB, NXCD = 8, WGM = 8;

__host__ __device__ __forceinline__ int lds_byte(int r, int c) { const int st = (r >> 4) * 2 + (c >> 5), rr = r & 15, cc = c & 31, ob = rr * 64 + cc * 2; return st * 1024 + (ob ^ (((ob >> 9) & 1) << 5)); }
__host__ __device__ __forceinline__ void stage_rc(int b, int& R, int& C) { const int st = b / 1024, sb = b % 1024, swz = sb ^ (((sb >> 9) & 1) << 5); R = (st >> 1) * 16 + swz / 64; C = (st & 1) * 32 + (swz % 64) / 2; }
__host__ __device__ __forceinline__ int perm32(int rho) { const int n = rho >> 4, i = rho & 15; return 8 * (i >> 2) + 4 * n + (i & 3); }

struct Unit { int pm, pn; };
struct Gemm { const bf16_t* A; const bf16_t* Bt; int M, N, K; };

struct StaticOrder {
    int nM, nN, nwg, G, c;
    __host__ __device__ void init(int M, int N, int G_, int c_) { nM = M / BM; nN = N / BM; nwg = nM * nN; G = G_; c = c_; }
    __host__ __device__ bool next(int i, Unit& u) const {
        const long L = (long)i * G + c; if (L >= nwg) return false;
        int wgid = (int)L; { const int q = nwg / NXCD, r = nwg % NXCD, xcd = wgid % NXCD, off = wgid / NXCD; wgid = (xcd < r ? xcd * (q + 1) : r * (q + 1) + (xcd - r) * q) + off; }
        const int nig = WGM * nN, gid = wgid / nig, fm = gid * WGM, gsz = (nM - fm) < WGM ? (nM - fm) : WGM;
        u.pm = fm + ((wgid % nig) % gsz); u.pn = (wgid % nig) / gsz; return true;
    }
    __device__ __forceinline__ void a_ready(const Unit&) const {}
    __device__ __forceinline__ void done(const Unit&) const {}
};

template <class Epi, class Sched, bool ALIGN_EPI = false, bool SP2 = false>
__device__ __forceinline__ void gemm_phase(PG8_LAS unsigned char* lds, const Gemm g, const Sched& S, const Epi& E) {
    int tid_l = threadIdx.x; asm volatile("" : "+v"(tid_l));
    const int tid = tid_l, wid = __builtin_amdgcn_readfirstlane(tid >> 6), lane = tid & 63, wr = wid >> 2, wc = wid & 3, fr = lane & 15, fq = lane >> 4;
    const int K = g.K, nt = K / BK;
    unsigned voffA[2], voffB[2];
#pragma unroll
    for (int i = 0; i < 2; ++i) { int R, C; stage_rc(tid * 16 + i * 8192, R, C); const int Rb = Epi::PERM ? ((R & ~31) + perm32(R & 31)) : R;
        voffA[i] = (unsigned)(R * K + C) * 2u; voffB[i] = (unsigned)(Rb * K + C) * 2u; }
    const size_t kstep = (size_t)(BK * 2);
    const size_t hstep = (size_t)HALF * K * 2;
    const size_t tstep = 2 * hstep;
    const unsigned ldsw = (unsigned)wid * 1024u;
    const int aoff = lds_byte(wr * 64 + fr, fq * 8), boff = lds_byte(wc * 32 + fr, fq * 8);
#define PG8_SA(b, h) (((b) * 2 + (h)) * HTB)
#define PG8_SB(b, h) ((4 + (b) * 2 + (h)) * HTB)
#define PG8_STAGE(bufoff, gbase, voff) do { _Pragma("unroll") for (int _i = 0; _i < 2; ++_i) \
        __builtin_amdgcn_global_load_lds((const unsigned*)((const char*)(gbase) + (voff)[_i]), (PG8_LAS unsigned*)(lds + (bufoff) + ldsw + _i * 8192), 16, 0, 0); } while (0)
#define PG8_LDA(dst, b, h) do { _Pragma("unroll") for (int m = 0; m < 4; ++m) _Pragma("unroll") for (int k = 0; k < 2; ++k) dst[m][k] = *(const PG8_LAS bf16x8*)(lds + PG8_SA(b, h) + aoff + m * 2048 + k * 1024); } while (0)
#define PG8_LDB(dst, b, h) do { _Pragma("unroll") for (int n = 0; n < 2; ++n) _Pragma("unroll") for (int k = 0; k < 2; ++k) dst[n][k] = *(const PG8_LAS bf16x8*)(lds + PG8_SB(b, h) + boff + n * 2048 + k * 1024); } while (0)
#define PG8_MMA(ai, bj, At, Bt) do { __builtin_amdgcn_s_setprio(1); _Pragma("unroll") for (int m = 0; m < 4; ++m) _Pragma("unroll") for (int n = 0; n < 2; ++n) _Pragma("unroll") for (int k = 0; k < 2; ++k) \
        acc[ai][bj][m][n] = __builtin_amdgcn_mfma_f32_16x16x32_bf16(Bt[n][k], At[m][k], acc[ai][bj][m][n], 0, 0, 0); __builtin_amdgcn_s_setprio(0); } while (0)
#define PG8_WAIT_V(n) asm volatile("s_waitcnt vmcnt(" #n ")" ::: "memory")
#define PG8_WAIT_L(n) asm volatile("s_waitcnt lgkmcnt(" #n ")" ::: "memory")
#define PG8_BAR __builtin_amdgcn_s_barrier()
#define PG8_SCHED __builtin_amdgcn_sched_barrier(0)
    Unit cur, nxt; int ui = 0;
    if (!S.next(0, cur)) return;
    f32x4 acc[2][2][4][2];
#pragma unroll
    for (int a = 0; a < 2; ++a)
#pragma unroll
        for (int b = 0; b < 2; ++b)
#pragma unroll
            for (int m = 0; m < 4; ++m)
#pragma unroll
                for (int n = 0; n < 2; ++n) acc[a][b][m][n] = (f32x4){0.f, 0.f, 0.f, 0.f};
    bf16x8 At[4][2], B0[2][2], B1[2][2];
    const char* cA = (const char*)g.A + (size_t)cur.pm * tstep; const char* cB = (const char*)g.Bt + (size_t)cur.pn * tstep;
    S.a_ready(cur);
    if constexpr (SP2) {
        PG8_STAGE(PG8_SB(0, 0), cB, voffB); PG8_STAGE(PG8_SB(0, 1), cB + hstep, voffB); PG8_STAGE(PG8_SA(0, 0), cA, voffA); PG8_STAGE(PG8_SA(0, 1), cA + hstep, voffA);
        if (wr == 1) PG8_BAR;
        PG8_WAIT_V(2); PG8_BAR;
        PG8_STAGE(PG8_SB(1, 0), cB + kstep, voffB); PG8_STAGE(PG8_SA(1, 0), cA + kstep, voffA); PG8_STAGE(PG8_SB(1, 1), cB + hstep + kstep, voffB);
        PG8_WAIT_V(6); PG8_BAR;
    } else {
        PG8_STAGE(PG8_SB(0, 0), cB, voffB); PG8_STAGE(PG8_SA(0, 0), cA, voffA); PG8_STAGE(PG8_SB(0, 1), cB + hstep, voffB); PG8_STAGE(PG8_SA(0, 1), cA + hstep, voffA);
        if (wr == 1) PG8_BAR;
        PG8_WAIT_V(4); PG8_BAR;
        PG8_STAGE(PG8_SB(1, 0), cB + kstep, voffB); PG8_STAGE(PG8_SA(1, 0), cA + kstep, voffA); PG8_STAGE(PG8_SB(1, 1), cB + hstep + kstep, voffB);
        PG8_WAIT_V(6); PG8_BAR;
    }
    for (;;) {
        const bool has_next = S.next(ui + 1, nxt);
        const char* nA = has_next ? (const char*)g.A + (size_t)nxt.pm * tstep : cA; const char* nB = has_next ? (const char*)g.Bt + (size_t)nxt.pn * tstep : cB;
        for (int t = 0; t < nt; t += 2) {
            const bool last = (t == nt - 2);
            const char* a1 = cA + (size_t)(t + 1) * kstep;
            const char* a2 = last ? nA : cA + (size_t)(t + 2) * kstep; const char* b2 = last ? nB : cB + (size_t)(t + 2) * kstep;
            const char* a3 = a2 + kstep; const char* b3 = b2 + kstep;
            if (last && has_next) S.a_ready(nxt);
            if constexpr (SP2) {
            PG8_LDB(B0, 0, 0); PG8_LDB(B1, 0, 1); PG8_SCHED; PG8_LDA(At, 0, 0); PG8_STAGE(PG8_SA(1, 1), a1 + hstep, voffA);
            PG8_WAIT_V(8); PG8_WAIT_L(0); PG8_BAR; PG8_MMA(0, 0, At, B0); PG8_MMA(0, 1, At, B1); PG8_BAR; PG8_SCHED;
            PG8_LDA(At, 0, 1); PG8_STAGE(PG8_SB(0, 0), b2, voffB); PG8_STAGE(PG8_SB(0, 1), b2 + hstep, voffB); PG8_STAGE(PG8_SA(0, 0), a2, voffA);
            PG8_WAIT_V(8); PG8_WAIT_L(0); PG8_BAR; PG8_MMA(1, 0, At, B0); PG8_MMA(1, 1, At, B1); PG8_BAR; PG8_SCHED;
            PG8_LDB(B0, 1, 0); PG8_LDB(B1, 1, 1); PG8_SCHED; PG8_LDA(At, 1, 0); PG8_STAGE(PG8_SA(0, 1), a2 + hstep, voffA);
            PG8_WAIT_V(8); PG8_WAIT_L(0); PG8_BAR; PG8_MMA(0, 0, At, B0); PG8_MMA(0, 1, At, B1); PG8_BAR; PG8_SCHED;
            PG8_LDA(At, 1, 1); PG8_STAGE(PG8_SB(1, 0), b3, voffB); PG8_STAGE(PG8_SB(1, 1), b3 + hstep, voffB); PG8_STAGE(PG8_SA(1, 0), a3, voffA);
            PG8_WAIT_V(8); PG8_WAIT_L(0); PG8_BAR; PG8_MMA(1, 0, At, B0); PG8_MMA(1, 1, At, B1); PG8_BAR; PG8_SCHED;
            } else {
            PG8_LDB(B0, 0, 0); PG8_SCHED; PG8_LDA(At, 0, 0); PG8_STAGE(PG8_SA(1, 1), a1 + hstep, voffA);
            PG8_WAIT_L(8); PG8_BAR; PG8_WAIT_L(0); PG8_MMA(0, 0, At, B0); PG8_BAR; PG8_SCHED;
            PG8_LDB(B1, 0, 1); PG8_STAGE(PG8_SB(0, 0), b2, voffB);
            PG8_BAR; PG8_WAIT_L(0); PG8_MMA(0, 1, At, B1); PG8_BAR;
            PG8_LDA(At, 0, 1); PG8_STAGE(PG8_SA(0, 0), a2, voffA);
            PG8_BAR; PG8_WAIT_L(0); PG8_MMA(1, 0, At, B0); PG8_BAR; PG8_SCHED;
            PG8_STAGE(PG8_SB(0, 1), b2 + hstep, voffB);
            PG8_WAIT_V(6); PG8_BAR; PG8_MMA(1, 1, At, B1); PG8_BAR;
            PG8_LDB(B0, 1, 0); PG8_SCHED; PG8_LDA(At, 1, 0); PG8_STAGE(PG8_SA(0, 1), a2 + hstep, voffA);
            PG8_WAIT_L(8); PG8_BAR; PG8_WAIT_L(0); PG8_MMA(0, 0, At, B0); PG8_BAR; PG8_SCHED;
            PG8_LDB(B1, 1, 1); PG8_STAGE(PG8_SB(1, 0), b3, voffB);
            PG8_BAR; PG8_WAIT_L(0); PG8_MMA(0, 1, At, B1); PG8_BAR;
            PG8_LDA(At, 1, 1); PG8_STAGE(PG8_SA(1, 0), a3, voffA);
            PG8_BAR; PG8_WAIT_L(0); PG8_MMA(1, 0, At, B0); PG8_BAR; PG8_SCHED;
            PG8_STAGE(PG8_SB(1, 1), b3 + hstep, voffB);
            PG8_WAIT_V(6); PG8_BAR; PG8_MMA(1, 1, At, B1); PG8_BAR;
            }
        }
        if constexpr (ALIGN_EPI) { if (wr == 0) PG8_BAR; }
        if constexpr (!Epi::AFTER_DRAIN) { E(acc, cur, wr, wc, fr, fq); S.done(cur); }
        if (!has_next) break;
#pragma unroll
        for (int a = 0; a < 2; ++a)
#pragma unroll
            for (int b = 0; b < 2; ++b)
#pragma unroll
                for (int m = 0; m < 4; ++m)
#pragma unroll
                    for (int n = 0; n < 2; ++n) acc[a][b][m][n] = (f32x4){0.f, 0.f, 0.f, 0.f};
        cur = nxt; cA = nA; cB = nB; ++ui;
        if constexpr (ALIGN_EPI) { if (wr == 1) PG8_BAR; }
    }
    PG8_WAIT_V(0);
    if constexpr (!ALIGN_EPI) { if (wr == 0) PG8_BAR; }
    PG8_BAR;
    if constexpr (Epi::AFTER_DRAIN) { E.fused(acc, cur, wr, wc, fr, fq, lds, wid, lane); S.done(cur); }
#undef PG8_SA
#undef PG8_SB
#undef PG8_STAGE
#undef PG8_LDA
#undef PG8_LDB
#undef PG8_MMA
#undef PG8_WAIT_V
#undef PG8_WAIT_L
#undef PG8_BAR
#undef PG8_SCHED
}
}
namespace mk {
using pg8::bf16_t; using pg8::f32x4; using pg8::u32x4; using pg8::bf16x8;
#define LAS __attribute__((address_space(3)))
constexpr int NB = 8, T = 2048, M = NB * T, D = 1024, DEPTH = 4, NMEM = 256, MM = NB * NMEM;
constexpr int NPROJ = 3584, IN_COLS = 3512, DFF = 2816, NUP = 2 * DFF;
constexpr float EPS = 1e-6f;
constexpr int P_MLQ = 0, P_MLK = 384, P_MLV = 768, P_MLO = 1152, P_NAQ = 1536, P_NAK = 1856, P_NAV = 2176, P_GQ = 2496, P_GK = 2656, P_GV = 2816, P_GG = 3136, P_MLG = 3456, P_GA = 3480;
constexpr int NTHREADS = 512, NWAVES = 8;
constexpr int LDS_BYTES = 160 * 1024, LDS_MISC = LDS_BYTES - 64;
constexpr size_t MiB = (size_t)1 << 20;
constexpr size_t WS_RS0 = 0, WS_RS1 = 1 * MiB, WS_RS2 = 2 * MiB, WS_RSM = 3 * MiB;
constexpr size_t WS_BAR = 3 * MiB + 512 * 1024, WS_BAR_BYTES = 16 * 1024;
constexpr size_t WS_GATES = 4 * MiB;
constexpr size_t WS_MEMB = 8 * MiB;
constexpr size_t WS_MEMKV = 12 * MiB;
constexpr size_t WS_WIN = 20 * MiB, WS_WOUT = 27 * MiB, WS_WQ = 29 * MiB, WS_WO = 31 * MiB, WS_WUP = 33 * MiB, WS_WDN = 44 * MiB, WS_WKV = 50 * MiB;
constexpr size_t WS_HB = 54 * MiB;
constexpr size_t WS_BIG = 86 * MiB;
constexpr size_t WS_BND = WS_BIG + 170 * MiB;
constexpr size_t WS_HSML = WS_BIG + 112 * MiB, WS_HSGL = WS_HSML + 24 * MiB;
constexpr size_t WS_ACT = 262 * MiB;
constexpr size_t WS_MIXED = WS_ACT, WS_Q = WS_ACT + 32 * MiB;
constexpr size_t WS_END = 350 * MiB;

__device__ __forceinline__ float bf2f(unsigned v) { return __uint_as_float(v << 16); }
__device__ __forceinline__ unsigned f2bf(float f) { const unsigned u = __float_as_uint(f); return (u + 0x7fffu + ((u >> 16) & 1u)) >> 16; }
__device__ __forceinline__ unsigned cvt_pk_bf16(float lo, float hi) { unsigned r; asm volatile("v_cvt_pk_bf16_f32 %0, %1, %2" : "=v"(r) : "v"(lo), "v"(hi)); return r; }
__device__ __forceinline__ unsigned pk2(float lo, float hi) { return cvt_pk_bf16(lo, hi); }
__device__ __forceinline__ void unpack8(const u32x4 w, float (&o)[8]) {
    o[0] = bf2f(w.x & 0xffffu); o[1] = bf2f(w.x >> 16); o[2] = bf2f(w.y & 0xffffu); o[3] = bf2f(w.y >> 16);
    o[4] = bf2f(w.z & 0xffffu); o[5] = bf2f(w.z >> 16); o[6] = bf2f(w.w & 0xffffu); o[7] = bf2f(w.w >> 16);
}
__device__ __forceinline__ int lane_() { int l = (int)__lane_id(); asm volatile("" : "+v"(l)); return l; }
#if MK_LIB_SHFL
__device__ __forceinline__ float shl(float v, int src) { return __shfl(v, src); }
__device__ __forceinline__ float shx(float v, int o) { return __shfl_xor(v, o); }
__device__ __forceinline__ float shup(float v, int o) { return __shfl_up(v, o); }
#else
__device__ __forceinline__ float shl(float v, int src) { return __builtin_bit_cast(float, __builtin_amdgcn_ds_bpermute(src << 2, __builtin_bit_cast(int, v))); }
__device__ __forceinline__ float shx(float v, int o) { return shl(v, lane_() ^ o); }
__device__ __forceinline__ float shup(float v, int o) { return shl(v, lane_() - o); }
#endif
__device__ __forceinline__ float wave_sum(float v) {
#pragma unroll
    for (int o = 1; o < 64; o <<= 1) v += shx(v, o);
    return v;
}
__device__ __forceinline__ f32x4 zero4() { return (f32x4){0.f, 0.f, 0.f, 0.f}; }
__device__ __forceinline__ float rcpf_(float x) { return __builtin_amdgcn_rcpf(x); }
__device__ __forceinline__ float rsqf_(float x) { return __builtin_amdgcn_rsqf(x); }
__device__ __forceinline__ float sigmoidf_(float x) { return rcpf_(1.f + __expf(-x)); }

typedef const float* cfptr;
struct Ctx {
    float* out; unsigned char* ws;
    int G, bid, tid, lane, wave;
    __device__ __forceinline__ const float* in(int i) const {
        asm volatile("" : "+s"(i));
        const __attribute__((address_space(4))) cfptr* tbl = (const __attribute__((address_space(4))) cfptr*)__builtin_amdgcn_kernarg_segment_ptr();
        return tbl[i];
    }
    template <class Tp> __device__ __forceinline__ Tp* wsp(size_t off) const { unsigned o = (unsigned)off; asm volatile("" : "+s"(o)); return (Tp*)(ws + o); }
    __device__ __forceinline__ float* rs0() const { return wsp<float>(WS_RS0); }
    __device__ __forceinline__ float* rs1() const { return wsp<float>(WS_RS1); }
    __device__ __forceinline__ float* rs2() const { return wsp<float>(WS_RS2); }
    __device__ __forceinline__ float* rsm() const { return wsp<float>(WS_RSM); }
    __device__ __forceinline__ float* gates() const { return wsp<float>(WS_GATES); }
    __device__ __forceinline__ float* hsml() const { return wsp<float>(WS_HSML); }
    __device__ __forceinline__ float* hsgl() const { return wsp<float>(WS_HSGL); }
    __device__ __forceinline__ bf16_t* memb() const { return wsp<bf16_t>(WS_MEMB); }
    __device__ __forceinline__ bf16_t* memkv() const { return wsp<bf16_t>(WS_MEMKV); }
    __device__ __forceinline__ bf16_t* w_in() const { return wsp<bf16_t>(WS_WIN); }
    __device__ __forceinline__ bf16_t* w_out() const { return wsp<bf16_t>(WS_WOUT); }
    __device__ __forceinline__ bf16_t* wq() const { return wsp<bf16_t>(WS_WQ); }
    __device__ __forceinline__ bf16_t* wo() const { return wsp<bf16_t>(WS_WO); }
    __device__ __forceinline__ bf16_t* w_up() const { return wsp<bf16_t>(WS_WUP); }
    __device__ __forceinline__ bf16_t* w_dn() const { return wsp<bf16_t>(WS_WDN); }
    __device__ __forceinline__ bf16_t* wkv() const { return wsp<bf16_t>(WS_WKV); }
    __device__ __forceinline__ bf16_t* hb() const { return wsp<bf16_t>(WS_HB); }
    __device__ __forceinline__ bf16_t* proj() const { return wsp<bf16_t>(WS_BIG); }
    __device__ __forceinline__ bf16_t* u() const { return wsp<bf16_t>(WS_BIG); }
    __device__ __forceinline__ bf16_t* act() const { return wsp<bf16_t>(WS_ACT); }
    __device__ __forceinline__ bf16_t* mixed() const { return wsp<bf16_t>(WS_MIXED); }
    __device__ __forceinline__ bf16_t* q() const { return wsp<bf16_t>(WS_Q); }
};

#define LAUNDER_CTX(c0, c) Ctx c = (c0); { int t_ = c.tid; asm volatile("" : "+v"(t_)); c.tid = t_; c.lane = t_ & 63; c.wave = __builtin_amdgcn_readfirstlane(t_ >> 6); }

struct EpiScale {
    static constexpr bool PERM = true, AFTER_DRAIN = false;
    bf16_t* O; int ldc; const float* rowss; float* gates; int gate_pn;
    __device__ __forceinline__ void operator()(const f32x4 (&acc)[2][2][4][2], const pg8::Unit& u, int wr, int wc, int fr, int fq) const {
        const int row0 = u.pm * 256 + wr * 64 + fr, col0 = u.pn * 256 + wc * 32 + 8 * fq;
        const bool gt = (u.pn == gate_pn) && (wc < 2);
#pragma unroll
        for (int ai = 0; ai < 2; ++ai)
#pragma unroll
            for (int m = 0; m < 4; ++m) {
                const int row = row0 + ai * 128 + m * 16;
                float rs = 1.0f;
                if (rowss) { const f32x4* rp = (const f32x4*)(rowss + (size_t)row * 16); const f32x4 p0 = rp[0], p1 = rp[1], p2 = rp[2], p3 = rp[3];
                    const float ssum = (((p0[0] + p0[1]) + (p0[2] + p0[3])) + ((p1[0] + p1[1]) + (p1[2] + p1[3]))) + (((p2[0] + p2[1]) + (p2[2] + p2[3])) + ((p3[0] + p3[1]) + (p3[2] + p3[3])));
                    rs = 1.0f / sqrtf(ssum * (1.0f / D) + EPS); }
                bf16_t* rowp = O + (size_t)row * ldc + col0;
#pragma unroll
                for (int bj = 0; bj < 2; ++bj) {
                    const f32x4 v0 = acc[ai][bj][m][0] * rs, v1 = acc[ai][bj][m][1] * rs;
                    u32x4 w; w.x = cvt_pk_bf16(v0[0], v0[1]); w.y = cvt_pk_bf16(v0[2], v0[3]); w.z = cvt_pk_bf16(v1[0], v1[1]); w.w = cvt_pk_bf16(v1[2], v1[3]);
                    *(u32x4*)(rowp + bj * 128) = w;
                    if (bj == 1 && gt) { float* gp = gates + (size_t)row * 64 + wc * 32 + 8 * fq; *(f32x4*)gp = v0; *(f32x4*)(gp + 4) = v1; }
                }
            }
    }
};
struct EpiResid {
    static constexpr bool PERM = true, AFTER_DRAIN = false;
    const float* base; float* out; bf16_t* hb; float* rowss_out;
    __device__ __forceinline__ void operator()(const f32x4 (&acc)[2][2][4][2], const pg8::Unit& u, int wr, int wc, int fr, int fq) const {
        const int row0 = u.pm * 256 + wr * 64 + fr, col0 = u.pn * 256 + wc * 32 + 8 * fq;
#pragma unroll
        for (int ai = 0; ai < 2; ++ai)
#pragma unroll
            for (int m = 0; m < 4; ++m) {
                const int row = row0 + ai * 128 + m * 16; const size_t off = (size_t)row * D + col0; float ss = 0.f;
#pragma unroll
                for (int bj = 0; bj < 2; ++bj) {
                    const f32x4 v0 = acc[ai][bj][m][0] + *(const f32x4*)(base + off + bj * 128), v1 = acc[ai][bj][m][1] + *(const f32x4*)(base + off + bj * 128 + 4);
                    *(f32x4*)(out + off + bj * 128) = v0; *(f32x4*)(out + off + bj * 128 + 4) = v1;
                    u32x4 w; w.x = cvt_pk_bf16(v0[0], v0[1]); w.y = cvt_pk_bf16(v0[2], v0[3]); w.z = cvt_pk_bf16(v1[0], v1[1]); w.w = cvt_pk_bf16(v1[2], v1[3]);
                    *(u32x4*)(hb + off + bj * 128) = w;
                    ss += (v0[0] * v0[0] + v0[1] * v0[1]) + (v0[2] * v0[2] + v0[3] * v0[3]) + (v1[0] * v1[0] + v1[1] * v1[1]) + (v1[2] * v1[2] + v1[3] * v1[3]);
                }
                ss += shx(ss, 16); ss += shx(ss, 32);
                if (fq == 0) rowss_out[(size_t)row * 16 + u.pn * 4 + wc] = ss;
                asm volatile("" ::: "memory");
            }
    }
};

__device__ __forceinline__ float gelu_tanh_(float y) { const float uu = 0.7978845608028654f * (y + 0.044715f * y * y * y); return y * rcpf_(1.f + __expf(-2.f * uu)); }
struct EpiFfn {
    static constexpr bool PERM = true, AFTER_DRAIN = false;
    bf16_t* act; const float* rowss; const float* cw; const float* cb; float* bnd; LAS float* X;
    __device__ __forceinline__ float rstd(int row) const {
        const f32x4* rp = (const f32x4*)(rowss + (size_t)row * 16); const f32x4 p0 = rp[0], p1 = rp[1], p2 = rp[2], p3 = rp[3];
        const float ssum = (((p0[0] + p0[1]) + (p0[2] + p0[3])) + ((p1[0] + p1[1]) + (p1[2] + p1[3]))) + (((p2[0] + p2[1]) + (p2[2] + p2[3])) + ((p3[0] + p3[1]) + (p3[2] + p3[3])));
        return rsqf_(ssum * (1.0f / D) + EPS); }
    __device__ __forceinline__ void operator()(const f32x4 (&acc)[2][2][4][2], const pg8::Unit& u, int wr, int wc, int fr_in, int fq_in) const {
        int fr = fr_in, fq = fq_in; asm volatile("" : "+v"(fr), "+v"(fq));
        const int lane = fq * 16 + fr, colw = 32 * wc + 8 * fq, ch0 = 128 * u.pn + colw, rowb = u.pm * 256 + wr * 64 + fr;
        const int lprev = (lane & 48) | ((lane - 1) & 15), lnext = (lane & 48) | ((lane + 1) & 15);
#pragma unroll
        for (int ai = 0; ai < 2; ++ai) { const int blk = 2 * ai + wr; const bool last = (fr == 15);
            const float s_ = rstd(rowb + ai * 128 + (last ? 48 : 0));
            f32x4 v0, v1;
#pragma unroll
            for (int j = 0; j < 4; ++j) { v0[j] = (last ? acc[ai][0][3][0][j] : acc[ai][0][0][0][j]) * s_; v1[j] = (last ? acc[ai][0][3][1][j] : acc[ai][0][0][1][j]) * s_; }
            if (fr == 0 || fr == 15) { LAS float* xp = X + (blk * 2 + (last ? 1 : 0)) * 128 + colw; *(LAS f32x4*)xp = v0; *(LAS f32x4*)(xp + 4) = v1; } }
        asm volatile("s_waitcnt lgkmcnt(0)" ::: "memory"); __builtin_amdgcn_s_barrier(); asm volatile("" ::: "memory");
#pragma unroll
        for (int ai = 0; ai < 2; ++ai) { const int blk = 2 * ai + wr;
            float rs[4];
#pragma unroll
            for (int m = 0; m < 4; ++m) rs[m] = rstd(rowb + ai * 128 + m * 16);
#pragma unroll
            for (int n = 0; n < 2; ++n) {
                const int chn = ch0 + 4 * n;
                const LAS float* xprev = X + ((blk > 0 ? blk - 1 : 0) * 2 + 1) * 128 + colw + 4 * n; const LAS float* xnext = X + ((blk < 3 ? blk + 1 : 3) * 2 + 0) * 128 + colw + 4 * n;
                float o[4][4];
#pragma unroll
                for (int j = 0; j < 4; ++j) {
                    const float w0 = cw[chn + j], w1 = cw[DFF + chn + j], w2 = cw[2 * DFF + chn + j], bb = cb[chn + j];
                    const float ep = blk > 0 ? xprev[j] : 0.f, en = blk < 3 ? xnext[j] : 0.f;
                    float x[4], R[4], L[4];
#pragma unroll
                    for (int m = 0; m < 4; ++m) { x[m] = acc[ai][0][m][n][j] * rs[m]; R[m] = shl(x[m], lprev); L[m] = shl(x[m], lnext); }
#pragma unroll
                    for (int m = 0; m < 4; ++m) { const float pv = (fr == 0) ? (m > 0 ? R[m > 0 ? m - 1 : 0] : ep) : R[m], nx = (fr == 15) ? (m < 3 ? L[m < 3 ? m + 1 : 3] : en) : L[m];
                        const float y = w0 * pv + w1 * x[m] + w2 * nx + bb;
                        o[m][j] = gelu_tanh_(y) * (acc[ai][1][m][n][j] * rs[m]); } }
#pragma unroll
                for (int m = 0; m < 4; ++m) { const size_t row = (size_t)rowb + ai * 128 + m * 16;
                    *(unsigned long long*)(act + row * DFF + chn) = (unsigned long long)cvt_pk_bf16(o[m][0], o[m][1]) | ((unsigned long long)cvt_pk_bf16(o[m][2], o[m][3]) << 32); }
                asm volatile("" ::: "memory");
            }
        }
        { const bool hi = (wr == 1); const float s_ = rstd(rowb + (hi ? 128 + 48 : 0));
          f32x4 a0, a1, g0, g1;
#pragma unroll
          for (int j = 0; j < 4; ++j) { a0[j] = (hi ? acc[1][0][3][0][j] : acc[0][0][0][0][j]) * s_; a1[j] = (hi ? acc[1][0][3][1][j] : acc[0][0][0][1][j]) * s_;
                                        g0[j] = (hi ? acc[1][1][3][0][j] : acc[0][1][0][0][j]) * s_; g1[j] = (hi ? acc[1][1][3][1][j] : acc[0][1][0][1][j]) * s_; }
          float* bp = bnd + (size_t)u.pm * 6 * DFF + ch0;
          const bool doa = hi ? (fr >= 14) : (fr < 2), dog = hi ? (fr == 15) : (fr == 0);
          const int slot = hi ? fr - 12 : fr;
          if (doa) { *(f32x4*)(bp + slot * DFF) = a0; *(f32x4*)(bp + slot * DFF + 4) = a1; }
          if (dog) { *(f32x4*)(bp + (hi ? 5 : 4) * DFF) = g0; *(f32x4*)(bp + (hi ? 5 : 4) * DFF + 4) = g1; } }
    }
};
__device__ __forceinline__ void ffn_fixup(const float* bnd, const float* cw, const float* cb, bf16_t* act, int pm, int tid) {
    for (int idx = tid; idx < 2 * (DFF / 4); idx += NTHREADS) { const int which = idx / (DFF / 4), c4 = (idx % (DFF / 4)) * 4;
        if (which == 0 ? (pm % 8 == 0) : (pm % 8 == 7)) continue;
        const float* b0 = bnd + (size_t)pm * 6 * DFF + c4;
        const f32x4 ap = which == 0 ? *(const f32x4*)(b0 - 6 * DFF + 3 * DFF) : *(const f32x4*)(b0 + 2 * DFF);
        const f32x4 a0 = which == 0 ? *(const f32x4*)(b0) : *(const f32x4*)(b0 + 3 * DFF);
        const f32x4 an = which == 0 ? *(const f32x4*)(b0 + DFF) : *(const f32x4*)(b0 + 6 * DFF);
        const f32x4 gg = which == 0 ? *(const f32x4*)(b0 + 4 * DFF) : *(const f32x4*)(b0 + 5 * DFF);
        const f32x4 v0 = *(const f32x4*)(cw + c4), v1 = *(const f32x4*)(cw + DFF + c4), v2 = *(const f32x4*)(cw + 2 * DFF + c4), vb = *(const f32x4*)(cb + c4);
        float o[4];
#pragma unroll
        for (int j = 0; j < 4; ++j) o[j] = gelu_tanh_(v0[j] * ap[j] + v1[j] * a0[j] + v2[j] * an[j] + vb[j]) * gg[j];
        *(unsigned long long*)(act + ((size_t)pm * 256 + (which ? 255 : 0)) * DFF + c4) = (unsigned long long)cvt_pk_bf16(o[0], o[1]) | ((unsigned long long)cvt_pk_bf16(o[2], o[3]) << 32); }
    asm volatile("s_waitcnt vmcnt(0)" ::: "memory"); __syncthreads();
}

template <class Map>
__device__ __forceinline__ void cvt_item(const float* W, int K, int N, const float* gain, bf16_t* WT, LAS float* scr, int item, int lane, Map map) {
    const int nblk = (N + 31) / 32, kb = item / nblk, nb = item % nblk, k0 = 64 * kb, n0 = 32 * nb;
    const int nn = n0 + (lane & 31);
#pragma unroll 8
    for (int i = 0; i < 32; ++i) { const int kk = 2 * i + (lane >> 5); float w = (nn < N) ? W[(size_t)(k0 + kk) * N + nn] : 0.f; if (gain) w *= gain[k0 + kk]; scr[kk * 33 + (lane & 31)] = w; }
    asm volatile("s_waitcnt lgkmcnt(0)" ::: "memory");
    const int c = lane & 7;
#pragma unroll
    for (int j = 0; j < 4; ++j) { const int n = (lane >> 3) + 8 * j; const LAS float* s = scr + (8 * c) * 33 + n;
        u32x4 o; o.x = pk2(s[0 * 33], s[1 * 33]); o.y = pk2(s[2 * 33], s[3 * 33]); o.z = pk2(s[4 * 33], s[5 * 33]); o.w = pk2(s[6 * 33], s[7 * 33]);
        if (n0 + n < N) *(u32x4*)(WT + (size_t)map(n0 + n) * K + k0 + 8 * c) = o; }
    asm volatile("s_waitcnt lgkmcnt(0)" ::: "memory");
}
struct MapId { int off; __device__ __forceinline__ int operator()(int n) const { return n + off; } };
struct MapUp { __device__ __forceinline__ int operator()(int n) const { return n < DFF ? (n >> 7) * 256 + (n & 127) : ((n - DFF) >> 7) * 256 + 128 + ((n - DFF) & 127); } };
struct MapIn { __device__ __forceinline__ int operator()(int n) const { return n < 1536 ? n : (n < 1560 ? n + (P_MLG - 1536) : (n < 3480 ? n - 24 : n)); } };

__device__ __forceinline__ void convert_part(const Ctx& c, int l, int part, int gw, int NGW, LAS unsigned char* lds) {
    LAS float* scr = (LAS float*)(lds + c.wave * 16384);
    constexpr int I_IN = 16 * 110, I_SQ = 16 * 32, I_UP = 16 * 176, I_DN = 44 * 32;
    if (part == 0) {
        for (int it = gw; it < I_IN + 2 * I_SQ; it += NGW) {
            int r = it;
            if (r < I_IN) { cvt_item(c.in(3) + (size_t)l * D * IN_COLS, D, IN_COLS, c.in(2) + l * D, c.w_in(), scr, r, c.lane, MapIn{}); continue; } r -= I_IN;
            if (r < I_SQ) { cvt_item(c.in(16) + (size_t)l * D * D, D, D, c.in(14) + l * D, c.wkv(), scr, r, c.lane, MapId{0}); continue; } r -= I_SQ;
            cvt_item(c.in(17) + (size_t)l * D * D, D, D, c.in(14) + l * D, c.wkv(), scr, r, c.lane, MapId{D});
        }
        for (int i = gw * 64 + c.lane; i < (NPROJ - IN_COLS) * D / 8; i += NGW * 64) *(u32x4*)(c.w_in() + (size_t)IN_COLS * D + (size_t)i * 8) = (u32x4){0u, 0u, 0u, 0u};
    } else {
        for (int it = gw; it < 3 * I_SQ + I_UP + I_DN; it += NGW) {
            int r = it;
            if (r < I_SQ) { cvt_item(c.in(12) + (size_t)l * D * D, D, D, nullptr, c.w_out(), scr, r, c.lane, MapId{0}); continue; } r -= I_SQ;
            if (r < I_SQ) { cvt_item(c.in(15) + (size_t)l * D * D, D, D, c.in(13) + l * D, c.wq(), scr, r, c.lane, MapId{0}); continue; } r -= I_SQ;
            if (r < I_SQ) { cvt_item(c.in(18) + (size_t)l * D * D, D, D, nullptr, c.wo(), scr, r, c.lane, MapId{0}); continue; } r -= I_SQ;
            if (r < I_UP) { cvt_item(c.in(20) + (size_t)l * D * NUP, D, NUP, c.in(19) + l * D, c.w_up(), scr, r, c.lane, MapUp{}); continue; } r -= I_UP;
            cvt_item(c.in(23) + (size_t)l * DFF * D, DFF, D, nullptr, c.w_dn(), scr, r, c.lane, MapId{0});
        }
    }
}
__device__ __forceinline__ void rows_to_bf16(const Ctx& c, const float* X, bf16_t* Y, float* rss, int rows) {
    const int gw = c.bid * NWAVES + c.wave, NGW = c.G * NWAVES;
    for (int m = gw; m < rows; m += NGW) {
        const f32x4* xr = (const f32x4*)(X + (size_t)m * D) + c.lane; float s = 0.f;
        unsigned long long* o8 = (unsigned long long*)(Y + (size_t)m * D) + c.lane;
#pragma unroll
        for (int j = 0; j < 4; ++j) { const f32x4 v = xr[64 * j]; s += (v[0] * v[0] + v[1] * v[1]) + (v[2] * v[2] + v[3] * v[3]);
            o8[64 * j] = (unsigned long long)pk2(v[0], v[1]) | ((unsigned long long)pk2(v[2], v[3]) << 32); }
        s = wave_sum(s); if (c.lane < 16) rss[(size_t)m * 16 + c.lane] = (c.lane == 0) ? s : 0.f;
    }
}
__device__ __forceinline__ void final_norm(const Ctx& c) {
    const int gw = c.bid * NWAVES + c.wave, NGW = c.G * NWAVES; const float* g = c.in(24);
    for (int m = gw; m < M; m += NGW) {
        f32x4* xr = (f32x4*)(c.out + (size_t)m * D) + c.lane; f32x4 v[4]; float s = 0.f;
#pragma unroll
        for (int j = 0; j < 4; ++j) { v[j] = xr[64 * j]; s += (v[j][0] * v[j][0] + v[j][1] * v[j][1]) + (v[j][2] * v[j][2] + v[j][3] * v[j][3]); }
        const float r = 1.0f / sqrtf(wave_sum(s) * (1.0f / D) + EPS);
#pragma unroll
        for (int j = 0; j < 4; ++j) xr[64 * j] = v[j] * r * ((const f32x4*)g)[c.lane + 64 * j];
    }
}
typedef __attribute__((address_space(1))) unsigned gu32;
#define XB_TMO      128
#define XB_XCNT(j)  (256  + 64 * (j))
#define XB_XSUB(j)  (1280 + 64 * (j))
#define XB_XGEN(j)  (2304 + 64 * (j))
#define XB_TOP      3328
#define XB_TOPGEN   3392
#define XCD_BAR_WORDS 3456
#define XB_SPIN_CAP (1u << 18)

__device__ __forceinline__ unsigned xb_ld(unsigned* p)              { return __hip_atomic_load(p, __ATOMIC_RELAXED, __HIP_MEMORY_SCOPE_AGENT); }
__device__ __forceinline__ unsigned xb_add(unsigned* p, unsigned v) { return __hip_atomic_fetch_add(p, v, __ATOMIC_RELAXED, __HIP_MEMORY_SCOPE_AGENT); }
__device__ __forceinline__ unsigned xb_xcc_id() { return (unsigned)__builtin_amdgcn_s_getreg((3 << 11) | 20) & 0xFu; }
#define XB_SPIN(cond, bar) do { unsigned _sp = 0; while (cond) { __builtin_amdgcn_s_sleep(1); \
    if ((++_sp & 255u) == 0u) { if (xb_ld(&(bar)[XB_TMO])) break; if (_sp > XB_SPIN_CAP) { atomicAdd(&(bar)[XB_TMO], 1u); break; } } } } while (0)

struct XcdBarrier {
    unsigned* bar; unsigned x;
    volatile LAS unsigned* st;
};

__device__ __forceinline__ XcdBarrier xcd_barrier_post(unsigned* bar, volatile LAS unsigned* st) {
    XcdBarrier b; b.bar = bar; b.x = xb_xcc_id(); b.st = st;
    if (threadIdx.x == 0) (void)xb_add(&bar[XB_XCNT(b.x)], 1u);
    return b;
}
__device__ __forceinline__ void xcd_barrier_complete(unsigned* bar, unsigned x, unsigned& nloc, unsigned& nx) {
    const unsigned G = gridDim.x * gridDim.y * gridDim.z;
    unsigned sum, cnt, mine, sp = 0u;
    for (;;) {
        sum = 0u; cnt = 0u; mine = 0u;
#pragma unroll 1
        for (unsigned j = 0; j < 16; ++j) {
            const unsigned c = xb_ld(&bar[XB_XCNT(j)]); sum += c; cnt += (c > 0u) ? 1u : 0u; mine = (j == x) ? c : mine; }
        if (sum == G) break;
        __builtin_amdgcn_s_sleep(1);
        if ((++sp & 255u) == 0u) { if (xb_ld(&bar[XB_TMO])) break; if (sp > XB_SPIN_CAP) { atomicAdd(&bar[XB_TMO], 1u); break; } }
    }
    nloc = mine > 0u ? mine : 1u; nx = cnt > 0u ? cnt : 1u;
}

__device__ __forceinline__ void xcd_barrier(const XcdBarrier& b) {
    asm volatile("s_waitcnt vmcnt(0)" ::: "memory");
    __syncthreads();
    if (threadIdx.x == 0) {
        unsigned* bar = b.bar;
        __builtin_amdgcn_s_waitcnt(0);
        unsigned nloc = b.st[0], nx = b.st[1];
        if (nloc == 0u) { xcd_barrier_complete(bar, b.x, nloc, nx); b.st[0] = nloc; b.st[1] = nx; }
        const unsigned old = xb_add(&bar[XB_XSUB(b.x)], 1u);
        const unsigned gen = old / nloc;
        if (old + 1u == (gen + 1u) * nloc) {
            __builtin_amdgcn_fence(__ATOMIC_RELEASE, "agent");
            asm volatile("s_waitcnt vmcnt(0)" ::: "memory");
            const unsigned og = xb_add(&bar[XB_TOP], 1u);
            const unsigned tg = og / nx;
            if (og + 1u == (tg + 1u) * nx) xb_add(&bar[XB_TOPGEN], 1u);
            else XB_SPIN(xb_ld(&bar[XB_TOPGEN]) == tg, bar);
            __builtin_amdgcn_fence(__ATOMIC_ACQUIRE, "agent");
            xb_add(&bar[XB_XGEN(b.x)], 1u);
            asm volatile("s_waitcnt vmcnt(0)" ::: "memory");
        } else {
            XB_SPIN(xb_ld(&bar[XB_XGEN(b.x)]) == gen, bar);
            __builtin_amdgcn_fence(__ATOMIC_ACQUIRE, "agent");
            asm volatile("s_waitcnt vmcnt(0)" ::: "memory");
        }
    }
    __syncthreads();
}
__device__ __forceinline__ void ml_load_row(const bf16_t* projb, int t, int coff, float (&dst)[2][8]) {
    if (t < 0 || t >= T) {
#pragma unroll
        for (int j = 0; j < 8; ++j) { dst[0][j] = 0.f; dst[1][j] = 0.f; }
    } else {
        const u32x4 a = *(const u32x4*)(projb + (size_t)t * NPROJ + P_MLQ + coff), b = *(const u32x4*)(projb + (size_t)t * NPROJ + P_MLK + coff);
        unpack8(a, dst[0]); unpack8(b, dst[1]);
    }
}
__device__ __forceinline__ void ml_item(const Ctx& c0, int l, int item, LAS unsigned char* lds) {
    LAUNDER_CTX(c0, c);
    const int b = item / 6, h = item % 6, e = c.tid & 63, dg = c.tid >> 6;
    LAS float* rnum = (LAS float*)lds;
    LAS float* rden = (LAS float*)lds + 1024;
    const bf16_t* projb = c.proj() + (size_t)b * T * NPROJ;
    const float* gatesb = c.gates() + (size_t)b * T * 64;
    float* hs = c.hsml() + (size_t)b * T * 384 + h * 64;
    const float* cwp = c.in(4) + (size_t)l * 3 * 768; const float* cbp = c.in(5) + (size_t)l * 768;
    const float* gb = c.in(6) + l * 24; const float* ng = c.in(7) + l * 384;
    const int coff = h * 64 + dg * 8;
    float cw[2][8][4];
#pragma unroll
    for (int qk = 0; qk < 2; ++qk)
#pragma unroll
        for (int j = 0; j < 8; ++j) { const int ch = qk * 384 + coff + j; cw[qk][j][0] = cwp[ch]; cw[qk][j][1] = cwp[768 + ch]; cw[qk][j][2] = cwp[1536 + ch]; cw[qk][j][3] = cbp[ch]; }
    for (int dir = 0; dir < 2; ++dir) {
        float C[8], n[8];
#pragma unroll
        for (int j = 0; j < 8; ++j) { C[j] = 0.f; n[j] = 0.f; }
        const float bi = gb[(2 * dir) * 6 + h], bff = gb[(2 * dir + 1) * 6 + h];
        float lo[2][8], mid[2][8], hi[2][8];
        const int t0 = dir ? T - 1 : 0;
        ml_load_row(projb, t0 - 1, coff, lo); ml_load_row(projb, t0, coff, mid); ml_load_row(projb, t0 + 1, coff, hi);
        for (int s = 0; s < T; ++s) {
            const int t = dir ? T - 1 - s : s;
            const float ip = gatesb[(size_t)t * 64 + (2 * dir) * 6 + h] + bi, fp = gatesb[(size_t)t * 64 + (2 * dir + 1) * 6 + h] + bff;
            const float f = sigmoidf_(fp), ig = __expf(ip);
            const float v = bf2f(projb[(size_t)t * NPROJ + P_MLV + h * 64 + e]);
            float pn = 0.f, pd = 0.f;
#pragma unroll
            for (int j = 0; j < 8; ++j) {
                float yq = lo[0][j] * cw[0][j][0] + mid[0][j] * cw[0][j][1] + hi[0][j] * cw[0][j][2] + cw[0][j][3];
                float yk = lo[1][j] * cw[1][j][0] + mid[1][j] * cw[1][j][1] + hi[1][j] * cw[1][j][2] + cw[1][j][3];
                const float qd = yq * sigmoidf_(yq), kd = yk * sigmoidf_(yk) * 0.125f;
                C[j] = f * C[j] + ig * kd * v; n[j] = f * n[j] + ig * kd; pn += C[j] * qd; pd += n[j] * qd;
            }
            const int p = s & 1;
            rnum[(p * 8 + dg) * 64 + e] = pn; if (e == 0) rden[p * 8 + dg] = pd;
            __syncthreads();
            if (dg == 0) {
                float num = 0.f, den = 0.f;
#pragma unroll
                for (int g = 0; g < 8; ++g) { num += rnum[(p * 8 + g) * 64 + e]; den += rden[p * 8 + g]; }
                const float hv = num / fmaxf(fabsf(den), 1.f);
                if (dir == 0) hs[(size_t)t * 384 + e] = hv;
                else { const float tot = hs[(size_t)t * 384 + e] + hv; const float ss = wave_sum(tot * tot);
                    const float r = 1.0f / sqrtf(ss * (1.0f / 64) + EPS); const float og = bf2f(projb[(size_t)t * NPROJ + P_MLO + h * 64 + e]);
                    c.mixed()[((size_t)b * T + t) * D + h * 64 + e] = (bf16_t)f2bf(tot * r * ng[h * 64 + e] * sigmoidf_(og)); }
            }
            if (dir == 0) {
#pragma unroll
                for (int j = 0; j < 8; ++j) { lo[0][j] = mid[0][j]; lo[1][j] = mid[1][j]; mid[0][j] = hi[0][j]; mid[1][j] = hi[1][j]; }
                ml_load_row(projb, t + 2, coff, hi);
            } else {
#pragma unroll
                for (int j = 0; j < 8; ++j) { hi[0][j] = mid[0][j]; hi[1][j] = mid[1][j]; mid[0][j] = lo[0][j]; mid[1][j] = lo[1][j]; }
                ml_load_row(projb, t - 2, coff, lo);
            }
        }
        __syncthreads();
    }
}
__device__ __forceinline__ void gla_item(const Ctx& c0, int l, int item, LAS unsigned char* lds) {
    LAUNDER_CTX(c0, c);
    const int b = item / 5, h = item % 5, e = c.tid & 63, kg = c.tid >> 6;
    LAS float* rnum = (LAS float*)lds;
    const bf16_t* projb = c.proj() + (size_t)b * T * NPROJ;
    const float* gatesb = c.gates() + (size_t)b * T * 64;
    float* gs = c.hsgl() + (size_t)b * T * 320 + h * 64;
    const float* ng = c.in(11) + l * 320;
    const int doff = h * 32 + kg * 4;
    for (int dir = 0; dir < 2; ++dir) {
        const float* w2 = c.in(9) + ((size_t)l * 2 + dir) * 16 * 160; const float* ab = c.in(10) + ((size_t)l * 2 + dir) * 160;
        float w2r[16][4], abv[4], S[4];
#pragma unroll
        for (int j = 0; j < 4; ++j) { abv[j] = ab[doff + j]; S[j] = 0.f;
#pragma unroll
            for (int r = 0; r < 16; ++r) w2r[r][j] = w2[r * 160 + doff + j]; }
        for (int s = 0; s < T; ++s) {
            const int t = dir ? T - 1 - s : s;
            const float* gp = gatesb + (size_t)t * 64 + 24 + dir * 16;
            float ga[16];
#pragma unroll
            for (int r4 = 0; r4 < 4; ++r4) { const f32x4 x = *(const f32x4*)(gp + 4 * r4); ga[4 * r4] = x[0]; ga[4 * r4 + 1] = x[1]; ga[4 * r4 + 2] = x[2]; ga[4 * r4 + 3] = x[3]; }
            const unsigned long long qw = *(const unsigned long long*)(projb + (size_t)t * NPROJ + P_GQ + doff), kw = *(const unsigned long long*)(projb + (size_t)t * NPROJ + P_GK + doff);
            const float v = bf2f(projb[(size_t)t * NPROJ + P_GV + h * 64 + e]);
            float pn = 0.f;
#pragma unroll
            for (int j = 0; j < 4; ++j) {
                float z = abv[j];
#pragma unroll
                for (int r = 0; r < 16; ++r) z += ga[r] * w2r[r][j];
                const float la = (fminf(z, 0.f) - log1pf(__expf(-fabsf(z)))) * (1.0f / 16.0f);
                const float a = __expf(la);
                const float qd = bf2f((unsigned)(qw >> (16 * j)) & 0xffffu), kd = bf2f((unsigned)(kw >> (16 * j)) & 0xffffu);
                S[j] = a * S[j] + kd * v; pn += S[j] * qd;
            }
            const int p = s & 1;
            rnum[(p * 8 + kg) * 64 + e] = pn * 0.17677669529663687f;
            __syncthreads();
            if (kg == 0) {
                float o = 0.f;
#pragma unroll
                for (int g = 0; g < 8; ++g) o += rnum[(p * 8 + g) * 64 + e];
                if (dir == 0) gs[(size_t)t * 320 + e] = o;
                else { const float tot = gs[(size_t)t * 320 + e] + o; const float ss = wave_sum(tot * tot);
                    const float r = 1.0f / sqrtf(ss * (1.0f / 64) + EPS); const float gg = bf2f(projb[(size_t)t * NPROJ + P_GG + h * 64 + e]);
                    c.mixed()[((size_t)b * T + t) * D + 704 + h * 64 + e] = (bf16_t)f2bf(tot * r * ng[h * 64 + e] * gg * sigmoidf_(gg)); }
            }
        }
        __syncthreads();
    }
}
__device__ __forceinline__ void na_item(const Ctx& c0, int l, int item, LAS unsigned char* lds) {
    LAUNDER_CTX(c0, c);
    const int b = item / 160, h = (item % 160) / 32, r = item % 32;
    const int q = c.tid >> 3, s = c.tid & 7;
    LAS float* sc = (LAS float*)lds;
    const bf16_t* projb = c.proj() + (size_t)b * T * NPROJ;
    const float* rpb = c.in(8) + ((size_t)l * 5 + h) * 15 * 31;
    const int rs = min(max(r - 4, 0), 24), cs = min(max(q - 8, 0), 48);
    float qv[64];
    { const bf16_t* qp = projb + (size_t)(r * 64 + q) * NPROJ + P_NAQ + h * 64;
#pragma unroll
      for (int i = 0; i < 8; ++i) { float t8[8]; unpack8(*(const u32x4*)(qp + 8 * i), t8);
#pragma unroll
          for (int j = 0; j < 8; ++j) qv[8 * i + j] = t8[j]; } }
    const int tr = rs + s;
    for (int kk = 0; kk < 16; ++kk) { const int tc = cs + kk;
        const bf16_t* kp = projb + (size_t)(tr * 64 + tc) * NPROJ + P_NAK + h * 64; float d = 0.f;
#pragma unroll
        for (int i = 0; i < 8; ++i) { float t8[8]; unpack8(*(const u32x4*)(kp + 8 * i), t8);
#pragma unroll
            for (int j = 0; j < 8; ++j) d += qv[8 * i + j] * t8[j]; }
        const int dr = tr - r + 7, dc = min(max(tc - q, -15), 15) + 15;
        sc[q * 129 + s * 16 + kk] = d * 0.125f + rpb[dr * 31 + dc]; }
    __syncthreads();
    float mx = -3.0e38f; for (int k = 0; k < 128; ++k) mx = fmaxf(mx, sc[q * 129 + k]);
    float sum = 0.f; for (int k = 0; k < 128; ++k) sum += __expf(sc[q * 129 + k] - mx);
    __syncthreads();
    const float inv = 1.0f / sum;
    for (int kk = 0; kk < 16; ++kk) sc[q * 129 + s * 16 + kk] = __expf(sc[q * 129 + s * 16 + kk] - mx) * inv;
    __syncthreads();
    float o[8];
#pragma unroll
    for (int j = 0; j < 8; ++j) o[j] = 0.f;
    for (int key = 0; key < 128; ++key) { const int trr = rs + (key >> 4), tcc = cs + (key & 15);
        float t8[8]; unpack8(*(const u32x4*)(projb + (size_t)(trr * 64 + tcc) * NPROJ + P_NAV + h * 64 + s * 8), t8); const float p = sc[q * 129 + key];
#pragma unroll
        for (int j = 0; j < 8; ++j) o[j] += p * t8[j]; }
    u32x4 w; w.x = pk2(o[0], o[1]); w.y = pk2(o[2], o[3]); w.z = pk2(o[4], o[5]); w.w = pk2(o[6], o[7]);
    *(u32x4*)(c.mixed() + ((size_t)b * T + r * 64 + q) * D + 384 + h * 64 + s * 8) = w;
    __syncthreads();
}
__device__ __forceinline__ void xattn_item(const Ctx& c0, int item, LAS unsigned char* lds) {
    LAUNDER_CTX(c0, c);
    const int b = item / 256, hd = (item / 64) % 4, qt = item % 64; const int row0 = b * T + qt * 32;
    LAS float* qs = (LAS float*)lds;
    LAS float* ps = (LAS float*)lds + 8192;
    const int qi = c.tid >> 4, sub = c.tid & 15;
    { const bf16_t* qp = c.q() + (size_t)(row0 + qi) * D + hd * 256 + sub * 16; float t8[8];
      unpack8(*(const u32x4*)qp, t8);
#pragma unroll
      for (int j = 0; j < 8; ++j) qs[qi * 256 + sub * 16 + j] = t8[j];
      unpack8(*(const u32x4*)(qp + 8), t8);
#pragma unroll
      for (int j = 0; j < 8; ++j) qs[qi * 256 + sub * 16 + 8 + j] = t8[j]; }
    __syncthreads();
    const bf16_t* kvb = c.memkv() + (size_t)b * NMEM * 2048 + hd * 256;
    float acc[16];
#pragma unroll
    for (int j = 0; j < 16; ++j) acc[j] = 0.f;
    for (int dc = 0; dc < 32; ++dc) {
        float qr[8];
#pragma unroll
        for (int i = 0; i < 8; ++i) qr[i] = qs[qi * 256 + dc * 8 + i];
#pragma unroll
        for (int j = 0; j < 16; ++j) { float t8[8]; unpack8(*(const u32x4*)(kvb + (size_t)(sub + 16 * j) * 2048 + dc * 8), t8);
#pragma unroll
            for (int i = 0; i < 8; ++i) acc[j] += qr[i] * t8[i]; }
    }
    float mx = -3.0e38f;
#pragma unroll
    for (int j = 0; j < 16; ++j) { acc[j] *= 0.0625f; mx = fmaxf(mx, acc[j]); }
#pragma unroll
    for (int o = 1; o < 16; o <<= 1) mx = fmaxf(mx, __shfl_xor(mx, o));
    float sum = 0.f;
#pragma unroll
    for (int j = 0; j < 16; ++j) { acc[j] = __expf(acc[j] - mx); sum += acc[j]; }
#pragma unroll
    for (int o = 1; o < 16; o <<= 1) sum += __shfl_xor(sum, o);
    const float inv = 1.0f / sum;
#pragma unroll
    for (int j = 0; j < 16; ++j) ps[qi * 256 + sub + 16 * j] = acc[j] * inv;
    __syncthreads();
    float o[16];
#pragma unroll
    for (int j = 0; j < 16; ++j) o[j] = 0.f;
    for (int key = 0; key < 256; ++key) { const float p = ps[qi * 256 + key]; const bf16_t* vp = kvb + (size_t)key * 2048 + 1024 + sub * 16; float t8[8];
        unpack8(*(const u32x4*)vp, t8);
#pragma unroll
        for (int j = 0; j < 8; ++j) o[j] += p * t8[j];
        unpack8(*(const u32x4*)(vp + 8), t8);
#pragma unroll
        for (int j = 0; j < 8; ++j) o[8 + j] += p * t8[j]; }
    bf16_t* op = c.mixed() + (size_t)(row0 + qi) * D + hd * 256 + sub * 16;
    u32x4 w; w.x = pk2(o[0], o[1]); w.y = pk2(o[2], o[3]); w.z = pk2(o[4], o[5]); w.w = pk2(o[6], o[7]); *(u32x4*)op = w;
    w.x = pk2(o[8], o[9]); w.y = pk2(o[10], o[11]); w.z = pk2(o[12], o[13]); w.w = pk2(o[14], o[15]); *(u32x4*)(op + 8) = w;
    __syncthreads();
}
__device__ __forceinline__ void act_pass(const Ctx& c, int l) {
    const float* cw = c.in(21) + (size_t)l * 3 * DFF; const float* cb = c.in(22) + (size_t)l * DFF;
    constexpr int CH = DFF / 8;
    for (int idx = c.bid * NTHREADS + c.tid; idx < M * CH; idx += c.G * NTHREADS) {
        const int row = idx / CH, c8 = (idx % CH) * 8, t = row % T;
        const bf16_t* up = c.u() + (size_t)row * NUP + c8;
        float a0[8], am[8], ap[8], g[8];
        unpack8(*(const u32x4*)up, a0); unpack8(*(const u32x4*)(up + DFF), g);
        if (t > 0) unpack8(*(const u32x4*)(up - NUP), am); else {
#pragma unroll
            for (int j = 0; j < 8; ++j) am[j] = 0.f; }
        if (t < T - 1) unpack8(*(const u32x4*)(up + NUP), ap); else {
#pragma unroll
            for (int j = 0; j < 8; ++j) ap[j] = 0.f; }
        float o[8];
#pragma unroll
        for (int j = 0; j < 8; ++j) { const float a = am[j] * cw[c8 + j] + a0[j] * cw[DFF + c8 + j] + ap[j] * cw[2 * DFF + c8 + j] + cb[c8 + j];
            const float uu = 0.7978845608028654f * (a + 0.044715f * a * a * a);
            o[j] = a * rcpf_(1.f + __expf(-2.f * uu)) * g[j]; }
        u32x4 w; w.x = pk2(o[0], o[1]); w.y = pk2(o[2], o[3]); w.z = pk2(o[4], o[5]); w.w = pk2(o[6], o[7]);
        *(u32x4*)(c.act() + (size_t)row * DFF + c8) = w;
    }
}
typedef short s16x4 __attribute__((ext_vector_type(4)));
#define MFMA16(a, b, c) __builtin_amdgcn_mfma_f32_16x16x32_bf16((a), (b), (c), 0, 0, 0)
__device__ __forceinline__ bf16x8 frag_nt(LAS const unsigned char* tile, int pitch, int row, int kbyte) {
    return *(const LAS bf16x8*)(tile + row * pitch + kbyte);
}
__device__ __forceinline__ bf16x8 frag_tr(LAS const unsigned char* tile, int pitch, int r0, int r1, int n0, int lane) {
    const int q4 = (lane & 15) >> 2, p4 = lane & 3;
    const unsigned a0 = (unsigned)(size_t)tile + (unsigned)((r0 + q4) * pitch + (n0 + 4 * p4) * 2), a1 = (unsigned)(size_t)tile + (unsigned)((r1 + q4) * pitch + (n0 + 4 * p4) * 2);
    s16x4 x, y;
    asm volatile("ds_read_b64_tr_b16 %0, %2\n\tds_read_b64_tr_b16 %1, %3\n\ts_waitcnt lgkmcnt(0)" : "=&v"(x), "=&v"(y) : "v"(a0), "v"(a1) : "memory");
    return (bf16x8){x[0], x[1], x[2], x[3], y[0], y[1], y[2], y[3]};
}
__device__ __forceinline__ void frag_tr_x4(LAS const unsigned char* tile, int pitch, int r0, int r1, int n0, int lane, bf16x8 (&out)[4]) {
    const int q4 = (lane & 15) >> 2, p4 = lane & 3;
    const unsigned a0 = (unsigned)(size_t)tile + (unsigned)((r0 + q4) * pitch + (n0 + 4 * p4) * 2), a1 = (unsigned)(size_t)tile + (unsigned)((r1 + q4) * pitch + (n0 + 4 * p4) * 2);
    s16x4 x0, y0, x1, y1, x2, y2, x3, y3;
    asm volatile("ds_read_b64_tr_b16 %0, %8\n\tds_read_b64_tr_b16 %1, %9\n\tds_read_b64_tr_b16 %2, %8 offset:32\n\tds_read_b64_tr_b16 %3, %9 offset:32\n\t"
                 "ds_read_b64_tr_b16 %4, %8 offset:64\n\tds_read_b64_tr_b16 %5, %9 offset:64\n\tds_read_b64_tr_b16 %6, %8 offset:96\n\tds_read_b64_tr_b16 %7, %9 offset:96\n\ts_waitcnt lgkmcnt(0)"
                 : "=&v"(x0), "=&v"(y0), "=&v"(x1), "=&v"(y1), "=&v"(x2), "=&v"(y2), "=&v"(x3), "=&v"(y3) : "v"(a0), "v"(a1) : "memory");
    out[0] = (bf16x8){x0[0], x0[1], x0[2], x0[3], y0[0], y0[1], y0[2], y0[3]}; out[1] = (bf16x8){x1[0], x1[1], x1[2], x1[3], y1[0], y1[1], y1[2], y1[3]};
    out[2] = (bf16x8){x2[0], x2[1], x2[2], x2[3], y2[0], y2[1], y2[2], y2[3]}; out[3] = (bf16x8){x3[0], x3[1], x3[2], x3[3], y3[0], y3[1], y3[2], y3[3]};
}
__device__ __forceinline__ bf16x8 pack_frag(const f32x4 lo, const f32x4 hi) {
    u32x4 w; w.x = cvt_pk_bf16(lo[0], lo[1]); w.y = cvt_pk_bf16(lo[2], lo[3]); w.z = cvt_pk_bf16(hi[0], hi[1]); w.w = cvt_pk_bf16(hi[2], hi[3]);
    return __builtin_bit_cast(bf16x8, w);
}
__device__ __forceinline__ float logsigmoidf_(float x) { return fminf(x, 0.f) - __logf(1.f + __expf(-fabsf(x))); }
__device__ __forceinline__ float wave_incl_scan(float v, int lane) {
#pragma unroll
    for (int o = 1; o < 64; o <<= 1) { const float t = shup(v, o); if (lane >= o) v += t; }
    return v;
}
constexpr int P64 = 144;

constexpr size_t WS_MLC2 = WS_Q;
constexpr size_t WS_MLC = WS_HSML, WS_GLC = WS_MLC + 15 * MiB, WS_MLD = WS_GLC + 10 * MiB, WS_GLD = WS_MLD + 15 * MiB, WS_MLG = WS_GLD + 10 * MiB, WS_GLB = WS_MLG + 64 * 1024;
__device__ __forceinline__ bf16_t* mlc_ptr(const Ctx& c, int b, int h, int dir, int ch) { return c.wsp<bf16_t>(WS_MLC) + (size_t)((((b * 6 + h) * 2 + dir) * 16) + ch) * 80 * 64; }

template <bool ROWW>
__device__ __forceinline__ void ml_stage_conv(const Ctx& c, const bf16_t* projb, int t0, int pcol, const float* cwp, const float* cbp, int cch, float scale, const LAS float* roww, LAS unsigned char* tile) {
    const int j = c.tid >> 2, cb = (c.tid & 3) * 16, t = t0 + j;
    float lo[16], mid[16], hi[16];
    { const bf16_t* p = projb + (size_t)t * NPROJ + pcol + cb; float t8[8];
      unpack8(*(const u32x4*)p, t8);
#pragma unroll
      for (int x = 0; x < 8; ++x) mid[x] = t8[x];
      unpack8(*(const u32x4*)(p + 8), t8);
#pragma unroll
      for (int x = 0; x < 8; ++x) mid[8 + x] = t8[x];
      if (t > 0) { unpack8(*(const u32x4*)(p - NPROJ), t8);
#pragma unroll
          for (int x = 0; x < 8; ++x) lo[x] = t8[x];
          unpack8(*(const u32x4*)(p - NPROJ + 8), t8);
#pragma unroll
          for (int x = 0; x < 8; ++x) lo[8 + x] = t8[x]; }
      else {
#pragma unroll
          for (int x = 0; x < 16; ++x) lo[x] = 0.f; }
      if (t < T - 1) { unpack8(*(const u32x4*)(p + NPROJ), t8);
#pragma unroll
          for (int x = 0; x < 8; ++x) hi[x] = t8[x];
          unpack8(*(const u32x4*)(p + NPROJ + 8), t8);
#pragma unroll
          for (int x = 0; x < 8; ++x) hi[8 + x] = t8[x]; }
      else {
#pragma unroll
          for (int x = 0; x < 16; ++x) hi[x] = 0.f; } }
    const float rw = ROWW ? roww[j] * scale : scale;
    float o[16];
#pragma unroll
    for (int x = 0; x < 16; ++x) { const int ch = cch + cb + x;
        const float y = lo[x] * cwp[ch] + mid[x] * cwp[768 + ch] + hi[x] * cwp[1536 + ch] + cbp[ch];
        o[x] = y * sigmoidf_(y) * rw; }
    u32x4 w0, w1; w0.x = pk2(o[0], o[1]); w0.y = pk2(o[2], o[3]); w0.z = pk2(o[4], o[5]); w0.w = pk2(o[6], o[7]);
    w1.x = pk2(o[8], o[9]); w1.y = pk2(o[10], o[11]); w1.z = pk2(o[12], o[13]); w1.w = pk2(o[14], o[15]);
    *(LAS u32x4*)(tile + j * P64 + cb * 2) = w0; *(LAS u32x4*)(tile + j * P64 + cb * 2 + 16) = w1;
}
__device__ __forceinline__ void ml_stage_plain(const Ctx& c, const bf16_t* projb, int t0, int pcol, LAS unsigned char* tile) {
    const int j = c.tid >> 2, cb = (c.tid & 3) * 16; const bf16_t* p = projb + (size_t)(t0 + j) * NPROJ + pcol + cb;
    *(LAS u32x4*)(tile + j * P64 + cb * 2) = *(const u32x4*)p; *(LAS u32x4*)(tile + j * P64 + cb * 2 + 16) = *(const u32x4*)(p + 8);
}
__device__ __forceinline__ float ml_gate_scan(const float* gatesb, int t0, int dir, int h, float bi, float bf_, LAS float* bcum, LAS float* ii, int lane) {
    const float* g0 = gatesb + (size_t)(t0 + 2 * lane) * 64; const float* g1 = g0 + 64;
    const float i0 = g0[(2 * dir) * 6 + h] + bi, i1 = g1[(2 * dir) * 6 + h] + bi;
    const float f0 = logsigmoidf_(g0[(2 * dir + 1) * 6 + h] + bf_), f1 = logsigmoidf_(g1[(2 * dir + 1) * 6 + h] + bf_);
    const float inc = wave_incl_scan(f0 + f1, lane), tot = shl(inc, 63);
    float b0, b1;
    if (dir == 0) { b0 = inc - f1; b1 = inc; } else { b1 = tot - inc + f1; b0 = b1 + f0; }
    bcum[2 * lane] = b0; bcum[2 * lane + 1] = b1; ii[2 * lane] = i0; ii[2 * lane + 1] = i1;
    return tot;
}

__device__ __forceinline__ bf16_t* mld_ptr(const Ctx& c, int b, int h, int dir, int ch) { return c.wsp<bf16_t>(WS_MLD) + (size_t)((((b * 6 + h) * 2 + dir) * 16) + ch) * 80 * 64; }
constexpr int P80 = 176;

__device__ __forceinline__ void ml_delta_item(const Ctx& c0, int l, int item, LAS unsigned char* lds) {
    LAUNDER_CTX(c0, c);
    const int b = item / 96, h = (item % 96) / 16, ch = item % 16, t0 = ch * 128;
    const int lane = c.lane, w = c.wave, i = lane & 15, g = lane >> 4;
    LAS unsigned char* Kf = lds; LAS unsigned char* Kb = lds + 128 * P64; LAS unsigned char* Vx = lds + 2 * 128 * P64;
    LAS float* bF = (LAS float*)(Vx + 128 * P80); LAS float* iF = bF + 128; LAS float* bB = bF + 256; LAS float* iB = bF + 384; LAS float* wf = bF + 512; LAS float* wb = bF + 640;
    const bf16_t* projb = c.proj() + (size_t)b * T * NPROJ; const float* gatesb = c.gates() + (size_t)b * T * 64;
    const float* cwp = c.in(4) + (size_t)l * 3 * 768; const float* cbp = c.in(5) + (size_t)l * 768; const float* gb = c.in(6) + l * 24;
    if (w < 2) { const int dir = w; LAS float* bc = dir ? bB : bF; LAS float* ii = dir ? iB : iF; LAS float* ww = dir ? wb : wf;
        const float tot = ml_gate_scan(gatesb, t0, dir, h, gb[(2 * dir) * 6 + h], gb[(2 * dir + 1) * 6 + h], bc, ii, lane);
        ww[2 * lane] = __expf(tot - bc[2 * lane] + ii[2 * lane]); ww[2 * lane + 1] = __expf(tot - bc[2 * lane + 1] + ii[2 * lane + 1]);
        if (lane == 0) c.wsp<float>(WS_MLG)[(((b * 6 + h) * 2 + dir) * 16) + ch] = tot; }
    __syncthreads();
    ml_stage_conv<true>(c, projb, t0, P_MLK + h * 64, cwp, cbp, 384 + h * 64, 0.125f, wf, Kf);
    ml_stage_conv<true>(c, projb, t0, P_MLK + h * 64, cwp, cbp, 384 + h * 64, 0.125f, wb, Kb);
    { const int j = c.tid >> 2, cb = (c.tid & 3) * 16; const bf16_t* p = projb + (size_t)(t0 + j) * NPROJ + P_MLV + h * 64 + cb;
      *(LAS u32x4*)(Vx + j * P80 + cb * 2) = *(const u32x4*)p; *(LAS u32x4*)(Vx + j * P80 + cb * 2 + 16) = *(const u32x4*)(p + 8);
      if ((c.tid & 3) == 0) { unsigned one = 0x3f80u, zero = 0u; asm volatile("" : "+v"(one), "+v"(zero));
          *(LAS u32x4*)(Vx + j * P80 + 128) = (u32x4){one, zero, zero, zero}; *(LAS u32x4*)(Vx + j * P80 + 144) = (u32x4){zero, zero, zero, zero}; } }
    __syncthreads();
    const int dir = w >> 2, td = w & 3; LAS unsigned char* Kw = dir ? Kb : Kf;
    f32x4 acc[5];
#pragma unroll
    for (int x = 0; x < 5; ++x) acc[x] = zero4();
#pragma unroll
    for (int s = 0; s < 4; ++s) { const int r0 = 32 * s + 8 * g, r1 = r0 + 4;
        const bf16x8 a = frag_tr(Kw, P64, r0, r1, 16 * td, lane);
        bf16x8 b4[4];
#pragma unroll
        for (int x = 0; x < 4; ++x) b4[x] = frag_tr(Vx, P80, r0, r1, 16 * x, lane);
        const bf16x8 b5 = frag_tr(Vx, P80, r0, r1, 64, lane);
#pragma unroll
        for (int x = 0; x < 4; ++x) acc[x] = MFMA16(a, b4[x], acc[x]);
        acc[4] = MFMA16(a, b5, acc[4]); }
    bf16_t* dst = mld_ptr(c, b, h, dir, ch);
#pragma unroll
    for (int x = 0; x < 5; ++x) { const int e = 16 * x + i, d = 16 * td + 4 * g;
        *(unsigned long long*)(dst + e * 64 + d) = (unsigned long long)cvt_pk_bf16(acc[x][0], acc[x][1]) | ((unsigned long long)cvt_pk_bf16(acc[x][2], acc[x][3]) << 32); }
    __syncthreads();
}
__device__ __forceinline__ void ml_scan(const Ctx& c, int gt, int ngt) {
    for (int t = gt; t < 96 * 1280; t += ngt) { const int bhd = t / 1280, off = (t % 1280) * 4, dir = bhd & 1;
        const bf16_t* dsrc = c.wsp<bf16_t>(WS_MLD) + (size_t)bhd * 16 * 5120 + off;
#if MK_OLD_STATES == 3
        bf16_t* cdst = c.wsp<bf16_t>(WS_MLC2) + (size_t)bhd * 16 * 5120 + off;
#else
        bf16_t* cdst = c.wsp<bf16_t>(WS_MLC) + (size_t)bhd * 16 * 5120 + off;
#endif
        const float* gs = c.wsp<float>(WS_MLG) + bhd * 16;
        float C0 = 0.f, C1 = 0.f, C2 = 0.f, C3 = 0.f;
#pragma unroll
        for (int cc = 0; cc < 16; ++cc) { const int ch = dir ? 15 - cc : cc;
            *(unsigned long long*)(cdst + (size_t)ch * 5120) = (unsigned long long)pk2(C0, C1) | ((unsigned long long)pk2(C2, C3) << 32);
            if (cc == 15) break;
            const unsigned long long dw = *(const unsigned long long*)(dsrc + (size_t)ch * 5120); const float eg = __expf(gs[ch]);
            C0 = eg * C0 + bf2f((unsigned)dw & 0xffffu); C1 = eg * C1 + bf2f((unsigned)(dw >> 16) & 0xffffu); C2 = eg * C2 + bf2f((unsigned)(dw >> 32) & 0xffffu); C3 = eg * C3 + bf2f((unsigned)(dw >> 48)); }
    }
}

__device__ __forceinline__ void ml_out_item(const Ctx& c0, int l, int item, LAS unsigned char* lds) {
    LAUNDER_CTX(c0, c);
    const int b = item / 96, h = (item % 96) / 16, ch = item % 16, t0 = ch * 128;
    const int lane = c.lane, w = c.wave, i = lane & 15, g = lane >> 4;
    LAS unsigned char* Qt = lds; LAS unsigned char* Kt = lds + 128 * P64; LAS unsigned char* Vt = lds + 2 * 128 * P64;
    LAS unsigned char* Cf = lds + 3 * 128 * P64; LAS unsigned char* Cb = Cf + 80 * P64;
    LAS float* bF = (LAS float*)(Cb + 80 * P64); LAS float* iF = bF + 128; LAS float* bB = bF + 256; LAS float* iB = bF + 384;
    const bf16_t* projb = c.proj() + (size_t)b * T * NPROJ; const float* gatesb = c.gates() + (size_t)b * T * 64;
    const float* cwp = c.in(4) + (size_t)l * 3 * 768; const float* cbp = c.in(5) + (size_t)l * 768; const float* gb = c.in(6) + l * 24;
    if (w == 0) (void)ml_gate_scan(gatesb, t0, 0, h, gb[0 * 6 + h], gb[1 * 6 + h], bF, iF, lane);
    if (w == 1) (void)ml_gate_scan(gatesb, t0, 1, h, gb[2 * 6 + h], gb[3 * 6 + h], bB, iB, lane);
    ml_stage_conv<false>(c, projb, t0, P_MLQ + h * 64, cwp, cbp, h * 64, 1.0f, nullptr, Qt);
    ml_stage_conv<false>(c, projb, t0, P_MLK + h * 64, cwp, cbp, 384 + h * 64, 0.125f, nullptr, Kt);
    ml_stage_plain(c, projb, t0, P_MLV + h * 64, Vt);
    { const bf16_t* sf = mlc_ptr(c, b, h, 0, ch); const bf16_t* sb = mlc_ptr(c, b, h, 1, ch);
      for (int x = c.tid; x < 80 * 8; x += NTHREADS) { const int r = x >> 3, k8 = x & 7;
          *(LAS u32x4*)(Cf + r * P64 + k8 * 16) = *(const u32x4*)(sf + r * 64 + k8 * 8); *(LAS u32x4*)(Cb + r * P64 + k8 * 16) = *(const u32x4*)(sb + r * 64 + k8 * 8); } }
    __syncthreads();
    const int ti = w, qi = 16 * ti + i;
    const bf16x8 q0 = frag_nt(Qt, P64, qi, 16 * g), q1 = frag_nt(Qt, P64, qi, 64 + 16 * g);
    const float bFq = bF[qi], bBq = bB[qi];
    f32x4 of[4], ob[4];
#pragma unroll
    for (int x = 0; x < 4; ++x) { of[x] = zero4(); ob[x] = zero4(); }
    float denf = 0.f, denb = 0.f;
#pragma unroll
    for (int s4 = 0; s4 < 4; ++s4) {
        const bool dof = (2 * s4 <= ti), dob = (2 * s4 + 1 >= ti);
        f32x4 pf[2], pb[2];
#pragma unroll
        for (int x = 0; x < 2; ++x) { const int tj = 2 * s4 + x;
            f32x4 s = zero4();
            s = MFMA16(frag_nt(Kt, P64, 16 * tj + i, 16 * g), q0, s); s = MFMA16(frag_nt(Kt, P64, 16 * tj + i, 64 + 16 * g), q1, s);
#pragma unroll
            for (int r = 0; r < 4; ++r) { const int j = 16 * tj + 4 * g + r;
                const float wf = (j <= qi) ? __expf(bFq - bF[j] + iF[j]) : 0.f, wb = (j >= qi) ? __expf(bBq - bB[j] + iB[j]) : 0.f;
                pf[x][r] = s[r] * wf; pb[x][r] = s[r] * wb; denf += pf[x][r]; denb += pb[x][r]; } }
        const int r0 = 32 * s4 + 4 * g, r1 = r0 + 16;
        if (dof) { const bf16x8 p = pack_frag(pf[0], pf[1]);
#pragma unroll
            for (int te = 0; te < 4; ++te) of[te] = MFMA16(frag_tr(Vt, P64, r0, r1, 16 * te, lane), p, of[te]); }
        if (dob) { const bf16x8 p = pack_frag(pb[0], pb[1]);
#pragma unroll
            for (int te = 0; te < 4; ++te) ob[te] = MFMA16(frag_tr(Vt, P64, r0, r1, 16 * te, lane), p, ob[te]); }
    }
    denf += shx(denf, 16); denf += shx(denf, 32); denb += shx(denb, 16); denb += shx(denb, 32);
    { const float ef = __expf(bFq), eb = __expf(bBq);
#pragma unroll
      for (int te = 0; te < 5; ++te) {
          f32x4 tf = zero4(), tb = zero4();
          tf = MFMA16(frag_nt(Cf, P64, 16 * te + i, 16 * g), q0, tf); tf = MFMA16(frag_nt(Cf, P64, 16 * te + i, 64 + 16 * g), q1, tf);
          tb = MFMA16(frag_nt(Cb, P64, 16 * te + i, 16 * g), q0, tb); tb = MFMA16(frag_nt(Cb, P64, 16 * te + i, 64 + 16 * g), q1, tb);
          if (te < 4) { of[te] = of[te] + tf * ef; ob[te] = ob[te] + tb * eb; }
          else { denf += ef * shl(tf[0], i); denb += eb * shl(tb[0], i); } } }
    const float rf = rcpf_(fmaxf(fabsf(denf), 1.f)), rb = rcpf_(fmaxf(fabsf(denb), 1.f));
    float ss = 0.f;
#pragma unroll
    for (int te = 0; te < 4; ++te) { of[te] = of[te] * rf + ob[te] * rb; ss += (of[te][0] * of[te][0] + of[te][1] * of[te][1]) + (of[te][2] * of[te][2] + of[te][3] * of[te][3]); }
    ss += shx(ss, 16); ss += shx(ss, 32);
    const float rn = rsqf_(ss * (1.0f / 64) + EPS);
    const float* ng = c.in(7) + l * 384 + h * 64;
    const size_t row = (size_t)b * T + t0 + qi;
#pragma unroll
    for (int te = 0; te < 4; ++te) { const int e = 16 * te + 4 * g;
        const unsigned long long ow = *(const unsigned long long*)(projb + (size_t)(t0 + qi) * NPROJ + P_MLO + h * 64 + e);
        float o4[4];
#pragma unroll
        for (int r = 0; r < 4; ++r) { const float og = bf2f((unsigned)(ow >> (16 * r)) & 0xffffu); o4[r] = of[te][r] * rn * ng[e + r] * sigmoidf_(og); }
        *(unsigned long long*)(c.mixed() + row * D + h * 64 + e) = (unsigned long long)pk2(o4[0], o4[1]) | ((unsigned long long)pk2(o4[2], o4[3]) << 32); }
    __syncthreads();
}

constexpr int P32 = 80;
constexpr int LAP = 33;
__device__ __forceinline__ bf16_t* glc_ptr(const Ctx& c, int b, int h, int dir, int ch) { return c.wsp<bf16_t>(WS_GLC) + (size_t)((((b * 5 + h) * 2 + dir) * 32) + ch) * 64 * 32; }
__device__ __forceinline__ void gla_loga(const Ctx& c, const float* gatesb, int t0, int nrows, int dir, const LAS float* w2s  , const LAS float* abs_  , LAS float* la  ) {
    for (int x = c.tid; x < nrows * 8; x += NTHREADS) { const int j = x >> 3, d4 = (x & 7) * 4;
        const float* gp = gatesb + (size_t)(t0 + j) * 64 + 24 + dir * 16; float ga[16];
#pragma unroll
        for (int r4 = 0; r4 < 4; ++r4) { const f32x4 v = *(const f32x4*)(gp + 4 * r4); ga[4 * r4] = v[0]; ga[4 * r4 + 1] = v[1]; ga[4 * r4 + 2] = v[2]; ga[4 * r4 + 3] = v[3]; }
#pragma unroll
        for (int y = 0; y < 4; ++y) { float z = abs_[d4 + y];
#pragma unroll
            for (int r = 0; r < 16; ++r) z += ga[r] * w2s[r * 32 + d4 + y];
            la[j * LAP + d4 + y] = logsigmoidf_(z) * (1.0f / 16.0f); } }
}
__device__ __forceinline__ void gla_scan64(LAS float* la  , int dir, int d, int lane, LAS float* tot) {
    const float v = la[lane * LAP + d]; const float inc = wave_incl_scan(v, lane), t = shl(inc, 63);
    la[lane * LAP + d] = dir ? (t - inc + v) : inc;
    if (tot && lane == 0) tot[d] = t;
}

__device__ __forceinline__ bf16_t* gld_ptr(const Ctx& c, int b, int h, int dir, int ch) { return c.wsp<bf16_t>(WS_GLD) + (size_t)((((b * 5 + h) * 2 + dir) * 32) + ch) * 64 * 32; }
__device__ __forceinline__ void gla_delta_item(const Ctx& c0, int l, int item, LAS unsigned char* lds) {
    LAUNDER_CTX(c0, c);
    const int b = item / 80, h = (item % 80) / 16, cp = item % 16, t0 = cp * 128;
    const int lane = c.lane, w = c.wave, i = lane & 15, g = lane >> 4;
    LAS unsigned char* Kf = lds; LAS unsigned char* Kb = Kf + 128 * P32;
    LAS unsigned char* Vt = Kb + 128 * P32;
    LAS float* laf = (LAS float*)(Vt + 128 * P64); LAS float* lab = laf + 128 * LAP;
    LAS float* w2s = lab + 128 * LAP; LAS float* abs_ = w2s + 1024; LAS float* btot = abs_ + 64;
    const bf16_t* projb = c.proj() + (size_t)b * T * NPROJ; const float* gatesb = c.gates() + (size_t)b * T * 64;
    { const float* w2 = c.in(9) + (size_t)l * 2 * 16 * 160; const float* ab = c.in(10) + (size_t)l * 2 * 160;
      for (int x = c.tid; x < 1024; x += NTHREADS) w2s[x] = w2[(x >> 5) * 160 + h * 32 + (x & 31)];
      if (c.tid < 64) abs_[c.tid] = ab[(c.tid >> 5) * 160 + h * 32 + (c.tid & 31)]; }
    __syncthreads();
    gla_loga(c, gatesb, t0, 128, 0, w2s, abs_, laf);
    gla_loga(c, gatesb, t0, 128, 1, w2s + 512, abs_ + 32, lab);
    __syncthreads();
#pragma unroll 4
    for (int y = 0; y < 16; ++y) { const int sidx = w * 16 + y, dir = sidx >> 6, sub = (sidx >> 5) & 1, d = sidx & 31;
        gla_scan64((dir ? lab : laf) + sub * 64 * LAP, dir, d, lane, btot + (dir * 2 + sub) * 32); }
    __syncthreads();
    { const int j = c.tid >> 2, d8 = (c.tid & 3) * 8, sub = j >> 6;
      float k8[8]; unpack8(*(const u32x4*)(projb + (size_t)(t0 + j) * NPROJ + P_GK + h * 32 + d8), k8);
      float of[8], ob[8];
#pragma unroll
      for (int y = 0; y < 8; ++y) { of[y] = k8[y] * __expf(btot[(0 + sub) * 32 + d8 + y] - laf[j * LAP + d8 + y]); ob[y] = k8[y] * __expf(btot[(2 + sub) * 32 + d8 + y] - lab[j * LAP + d8 + y]); }
      u32x4 x;
      x.x = pk2(of[0], of[1]); x.y = pk2(of[2], of[3]); x.z = pk2(of[4], of[5]); x.w = pk2(of[6], of[7]); *(LAS u32x4*)(Kf + j * P32 + d8 * 2) = x;
      x.x = pk2(ob[0], ob[1]); x.y = pk2(ob[2], ob[3]); x.z = pk2(ob[4], ob[5]); x.w = pk2(ob[6], ob[7]); *(LAS u32x4*)(Kb + j * P32 + d8 * 2) = x; }
    ml_stage_plain(c, projb, t0, P_GV + h * 64, Vt);
    if (c.tid < 128) { const int dir = c.tid >> 6, sub = (c.tid >> 5) & 1, d = c.tid & 31;
        c.wsp<float>(WS_GLB)[(size_t)((((b * 5 + h) * 2 + dir) * 32) + 2 * cp + sub) * 32 + d] = __expf(btot[(dir * 2 + sub) * 32 + d]); }
    __syncthreads();
    const int dir = w >> 2, sub = (w >> 1) & 1, td = w & 1, R = 64 * sub; LAS unsigned char* Kt = dir ? Kb : Kf;
    f32x4 acc[4];
#pragma unroll
    for (int x = 0; x < 4; ++x) acc[x] = zero4();
#pragma unroll
    for (int s = 0; s < 2; ++s) { const int r0 = R + 32 * s + 8 * g, r1 = r0 + 4;
        const bf16x8 a = frag_tr(Kt, P32, r0, r1, 16 * td, lane); bf16x8 b4[4]; frag_tr_x4(Vt, P64, r0, r1, 0, lane, b4);
#pragma unroll
        for (int x = 0; x < 4; ++x) acc[x] = MFMA16(a, b4[x], acc[x]); }
    bf16_t* dst = gld_ptr(c, b, h, dir, 2 * cp + sub);
#pragma unroll
    for (int x = 0; x < 4; ++x) { const int e = 16 * x + i, d = 16 * td + 4 * g;
        *(unsigned long long*)(dst + e * 32 + d) = (unsigned long long)cvt_pk_bf16(acc[x][0], acc[x][1]) | ((unsigned long long)cvt_pk_bf16(acc[x][2], acc[x][3]) << 32); }
    __syncthreads();
}
__device__ __forceinline__ void gla_scan(const Ctx& c, int gt, int ngt) {
    for (int t = gt; t < 80 * 512; t += ngt) { const int bhd = t / 512, off = (t % 512) * 4, dir = bhd & 1, d = off & 31;
        const bf16_t* dsrc = c.wsp<bf16_t>(WS_GLD) + (size_t)bhd * 32 * 2048 + off; bf16_t* sdst = c.wsp<bf16_t>(WS_GLC) + (size_t)bhd * 32 * 2048 + off;
        const float* eb = c.wsp<float>(WS_GLB) + (size_t)bhd * 32 * 32 + d;
        float S0 = 0.f, S1 = 0.f, S2 = 0.f, S3 = 0.f;
#pragma unroll 8
        for (int cc = 0; cc < 32; ++cc) { const int ch = dir ? 31 - cc : cc;
            *(unsigned long long*)(sdst + (size_t)ch * 2048) = (unsigned long long)pk2(S0, S1) | ((unsigned long long)pk2(S2, S3) << 32);
            if (cc == 31) break;
            const unsigned long long dw = *(const unsigned long long*)(dsrc + (size_t)ch * 2048); const f32x4 e4 = *(const f32x4*)(eb + ch * 32);
            S0 = e4[0] * S0 + bf2f((unsigned)dw & 0xffffu); S1 = e4[1] * S1 + bf2f((unsigned)(dw >> 16) & 0xffffu); S2 = e4[2] * S2 + bf2f((unsigned)(dw >> 32) & 0xffffu); S3 = e4[3] * S3 + bf2f((unsigned)(dw >> 48)); }
    }
}

__device__ __forceinline__ void gla_out_item(const Ctx& c0, int l, int item, LAS unsigned char* lds) {
    LAUNDER_CTX(c0, c);
    const int b = item / 80, h = (item % 80) / 16, cp = item % 16, t0 = cp * 128;
    const int lane = c.lane, w = c.wave, i = lane & 15, g = lane >> 4;
    LAS unsigned char* Qf = lds; LAS unsigned char* Kf = Qf + 128 * P32; LAS unsigned char* Qb = Kf + 128 * P32; LAS unsigned char* Kb = Qb + 128 * P32;
    LAS unsigned char* Vt = Kb + 128 * P32;
    LAS unsigned char* Sf = Vt + 128 * P64;
    LAS unsigned char* Sb = Sf + 2 * 64 * P32;
    LAS float* laf = (LAS float*)(Sb + 2 * 64 * P32);
    LAS float* lab = laf + 128 * LAP; LAS float* w2s = lab + 128 * LAP; LAS float* abs_ = w2s + 1024;
    const bf16_t* projb = c.proj() + (size_t)b * T * NPROJ; const float* gatesb = c.gates() + (size_t)b * T * 64;
    { const float* w2 = c.in(9) + (size_t)l * 2 * 16 * 160; const float* ab = c.in(10) + (size_t)l * 2 * 160;
      for (int x = c.tid; x < 1024; x += NTHREADS) w2s[x] = w2[(x >> 5) * 160 + h * 32 + (x & 31)];
      if (c.tid < 64) abs_[c.tid] = ab[(c.tid >> 5) * 160 + h * 32 + (c.tid & 31)]; }
    __syncthreads();
    gla_loga(c, gatesb, t0, 128, 0, w2s, abs_, laf);
    gla_loga(c, gatesb, t0, 128, 1, w2s + 512, abs_ + 32, lab);
    __syncthreads();
#pragma unroll 4
    for (int y = 0; y < 16; ++y) { const int sidx = w * 16 + y, dir = sidx >> 6, sub = (sidx >> 5) & 1, d = sidx & 31;
        gla_scan64((dir ? lab : laf) + sub * 64 * LAP, dir, d, lane, nullptr); }
    __syncthreads();
    { const int j = c.tid >> 2, d8 = (c.tid & 3) * 8;
      float q8[8], k8[8];
      unpack8(*(const u32x4*)(projb + (size_t)(t0 + j) * NPROJ + P_GQ + h * 32 + d8), q8); unpack8(*(const u32x4*)(projb + (size_t)(t0 + j) * NPROJ + P_GK + h * 32 + d8), k8);
      float oqf[8], okf[8], oqb[8], okb[8];
#pragma unroll
      for (int y = 0; y < 8; ++y) { const float bf_ = laf[j * LAP + d8 + y], bb_ = lab[j * LAP + d8 + y];
          oqf[y] = q8[y] * 0.17677669529663687f * __expf(bf_); okf[y] = k8[y] * __expf(-bf_); oqb[y] = q8[y] * 0.17677669529663687f * __expf(bb_); okb[y] = k8[y] * __expf(-bb_); }
      u32x4 x;
      x.x = pk2(oqf[0], oqf[1]); x.y = pk2(oqf[2], oqf[3]); x.z = pk2(oqf[4], oqf[5]); x.w = pk2(oqf[6], oqf[7]); *(LAS u32x4*)(Qf + j * P32 + d8 * 2) = x;
      x.x = pk2(okf[0], okf[1]); x.y = pk2(okf[2], okf[3]); x.z = pk2(okf[4], okf[5]); x.w = pk2(okf[6], okf[7]); *(LAS u32x4*)(Kf + j * P32 + d8 * 2) = x;
      x.x = pk2(oqb[0], oqb[1]); x.y = pk2(oqb[2], oqb[3]); x.z = pk2(oqb[4], oqb[5]); x.w = pk2(oqb[6], oqb[7]); *(LAS u32x4*)(Qb + j * P32 + d8 * 2) = x;
      x.x = pk2(okb[0], okb[1]); x.y = pk2(okb[2], okb[3]); x.z = pk2(okb[4], okb[5]); x.w = pk2(okb[6], okb[7]); *(LAS u32x4*)(Kb + j * P32 + d8 * 2) = x; }
    ml_stage_plain(c, projb, t0, P_GV + h * 64, Vt);
    for (int x = c.tid; x < 2 * 2 * 64 * 4; x += NTHREADS) { const int dir = x >> 9, sub = (x >> 8) & 1, r = (x >> 2) & 63, k4 = x & 3;
        const bf16_t* s = glc_ptr(c, b, h, dir, 2 * cp + sub); *(LAS u32x4*)((dir ? Sb : Sf) + (sub * 64 + r) * P32 + k4 * 16) = *(const u32x4*)(s + r * 32 + k4 * 8); }
    __syncthreads();
    const int sub = w >> 2, ti = w & 3, R = 64 * sub, qi = 16 * ti + i;
    const bf16x8 qf = frag_nt(Qf, P32, R + qi, 16 * g), qb = frag_nt(Qb, P32, R + qi, 16 * g);
    f32x4 o[4];
#pragma unroll
    for (int te = 0; te < 4; ++te) o[te] = zero4();
#pragma unroll
    for (int s2 = 0; s2 < 2; ++s2) {
        f32x4 p[2];
#pragma unroll
        for (int x = 0; x < 2; ++x) { const int tj = 2 * s2 + x; const f32x4 z = zero4();
            const f32x4 sf = MFMA16(frag_nt(Kf, P32, R + 16 * tj + i, 16 * g), qf, z), sb = MFMA16(frag_nt(Kb, P32, R + 16 * tj + i, 16 * g), qb, z);
#pragma unroll
            for (int r = 0; r < 4; ++r) { const int j = 16 * tj + 4 * g + r; p[x][r] = ((j <= qi) ? sf[r] : 0.f) + ((j >= qi) ? sb[r] : 0.f); } }
        const bf16x8 pp = pack_frag(p[0], p[1]); const int r0 = R + 32 * s2 + 4 * g, r1 = r0 + 16;
#pragma unroll
        for (int te = 0; te < 4; ++te) o[te] = MFMA16(frag_tr(Vt, P64, r0, r1, 16 * te, lane), pp, o[te]);
    }
#pragma unroll
    for (int te = 0; te < 4; ++te) { o[te] = MFMA16(frag_nt(Sf, P32, R + 16 * te + i, 16 * g), qf, o[te]); o[te] = MFMA16(frag_nt(Sb, P32, R + 16 * te + i, 16 * g), qb, o[te]); }
    float ss = 0.f;
#pragma unroll
    for (int te = 0; te < 4; ++te) ss += (o[te][0] * o[te][0] + o[te][1] * o[te][1]) + (o[te][2] * o[te][2] + o[te][3] * o[te][3]);
    ss += shx(ss, 16); ss += shx(ss, 32);
    const float rn = rsqf_(ss * (1.0f / 64) + EPS);
    const float* ng = c.in(11) + l * 320 + h * 64;
    const int tq = t0 + R + qi;
#pragma unroll
    for (int te = 0; te < 4; ++te) { const int e = 16 * te + 4 * g;
        const unsigned long long gw = *(const unsigned long long*)(projb + (size_t)tq * NPROJ + P_GG + h * 64 + e); float o4[4];
#pragma unroll
        for (int r = 0; r < 4; ++r) { const float gg = bf2f((unsigned)(gw >> (16 * r)) & 0xffffu); o4[r] = o[te][r] * rn * ng[e + r] * gg * sigmoidf_(gg); }
        *(unsigned long long*)(c.mixed() + ((size_t)b * T + tq) * D + 704 + h * 64 + e) = (unsigned long long)pk2(o4[0], o4[1]) | ((unsigned long long)pk2(o4[2], o4[3]) << 32); }
    __syncthreads();
}

__device__ __forceinline__ int clampi(int v, int lo, int hi) { return min(max(v, lo), hi); }
__device__ __forceinline__ void na_mfma_item(const Ctx& c0, int l, int item, LAS unsigned char* lds) {
    LAUNDER_CTX(c0, c);
    const int b = item / 40, h = (item % 40) / 8, r0 = (item % 8) * 4;
    const int lane = c.lane, w = c.wave, i = lane & 15, g = lane >> 4;
    LAS unsigned char* Vb = lds;
    LAS float* rp = (LAS float*)(lds + 704 * P64);
    const bf16_t* projb = c.proj() + (size_t)b * T * NPROJ;
    const int base = clampi(r0 - 4, 0, 24), nrow = clampi(r0 - 1, 0, 24) + 8 - base;
    { u32x4 t_[11];
#pragma unroll
      for (int y = 0; y < 11; ++y) { const int x = c.tid + y * NTHREADS; if (y < nrow) t_[y] = *(const u32x4*)(projb + (size_t)(base * 64 + (x >> 3)) * NPROJ + P_NAV + h * 64 + (x & 7) * 8); }
#pragma unroll
      for (int y = 0; y < 11; ++y) { const int x = c.tid + y * NTHREADS; if (y < nrow) *(LAS u32x4*)(Vb + (x >> 3) * P64 + (x & 7) * 16) = t_[y]; } }
    { const float* rpb = c.in(8) + ((size_t)l * 5 + h) * 15 * 31; if (c.tid < 465) rp[c.tid] = rpb[c.tid]; }
    __syncthreads();
#pragma unroll 1
    for (int qq = 0; qq < 2; ++qq) {
        const int qb = 2 * w + qq, r = r0 + (qb >> 2), jq = qb & 3;
        const int rs = clampi(r - 4, 0, 24), kc0 = clampi(16 * jq - 8, 0, 32), cq = 16 * jq + i, cs = clampi(cq - 8, 0, 48);
        const bf16_t* qp = projb + (size_t)(r * 64 + cq) * NPROJ + P_NAQ + h * 64;
        const bf16x8 q0 = *(const bf16x8*)(qp + 8 * g), q1 = *(const bf16x8*)(qp + 32 + 8 * g);
        f32x4 s[16];
#pragma unroll
        for (int kt = 0; kt < 16; ++kt) { const int kr = kt >> 1, ct = kt & 1;
            const bf16_t* kp = projb + (size_t)((rs + kr) * 64 + kc0 + 16 * ct + i) * NPROJ + P_NAK + h * 64;
            const bf16x8 a0 = *(const bf16x8*)(kp + 8 * g), a1 = *(const bf16x8*)(kp + 32 + 8 * g);
            f32x4 z = zero4(); z = MFMA16(a0, q0, z); s[kt] = MFMA16(a1, q1, z); }
        float mx = -3.0e38f;
#pragma unroll
        for (int kt = 0; kt < 16; ++kt) { const int kr = kt >> 1, ct = kt & 1; const LAS float* rrow = rp + (rs + kr - r + 7) * 31;
#pragma unroll
            for (int rr = 0; rr < 4; ++rr) { const int tc = kc0 + 16 * ct + 4 * g + rr; const bool valid = (tc >= cs) && (tc < cs + 16);
                const float v = s[kt][rr] * 0.125f + rrow[clampi(tc - cq, -15, 15) + 15];
                s[kt][rr] = valid ? v : -3.0e38f; mx = fmaxf(mx, s[kt][rr]); } }
        mx = fmaxf(mx, shx(mx, 16)); mx = fmaxf(mx, shx(mx, 32));
        float sum = 0.f;
#pragma unroll
        for (int kt = 0; kt < 16; ++kt)
#pragma unroll
            for (int rr = 0; rr < 4; ++rr) { const float p = (s[kt][rr] > -1.0e38f) ? __expf(s[kt][rr] - mx) : 0.f; s[kt][rr] = p; sum += p; }
        sum += shx(sum, 16); sum += shx(sum, 32);
        f32x4 o[4];
#pragma unroll
        for (int te = 0; te < 4; ++te) o[te] = zero4();
#pragma unroll
        for (int kr = 0; kr < 8; ++kr) { const bf16x8 pp = pack_frag(s[2 * kr], s[2 * kr + 1]); const int ra = (rs + kr - base) * 64 + kc0 + 4 * g, rb = ra + 16;
#pragma unroll
            for (int te = 0; te < 4; ++te) o[te] = MFMA16(frag_tr(Vb, P64, ra, rb, 16 * te, lane), pp, o[te]); }
        const float inv = rcpf_(sum);
        bf16_t* op = c.mixed() + ((size_t)b * T + r * 64 + cq) * D + 384 + h * 64;
#pragma unroll
        for (int te = 0; te < 4; ++te) *(unsigned long long*)(op + 16 * te + 4 * g) = (unsigned long long)pk2(o[te][0] * inv, o[te][1] * inv) | ((unsigned long long)pk2(o[te][2] * inv, o[te][3] * inv) << 32);
    }
    __syncthreads();
}

constexpr int P256 = 528;
__device__ __forceinline__ void xattn_mfma_item(const Ctx& c0, int item, LAS unsigned char* lds) {
    LAUNDER_CTX(c0, c);
    const int b = item / 32, hd = (item / 8) % 4, qc = item % 8; const int row0 = b * T + qc * 256;
    const int lane = c.lane, w = c.wave, i = lane & 15, g = lane >> 4;
    LAS unsigned char* KV = lds;
    const bf16_t* kvb = c.memkv() + (size_t)b * NMEM * 2048 + hd * 256;
    { u32x4 t_[16];
#pragma unroll
      for (int y = 0; y < 16; ++y) { const int x = c.tid + y * NTHREADS; t_[y] = *(const u32x4*)(kvb + (size_t)(x >> 5) * 2048 + (x & 31) * 8); }
#pragma unroll
      for (int y = 0; y < 16; ++y) { const int x = c.tid + y * NTHREADS; *(LAS u32x4*)(KV + (x >> 5) * P256 + (x & 31) * 16) = t_[y]; } }
    __syncthreads();
    bf16x8 P[2][8]; float inv[2];
#pragma unroll
    for (int blk = 0; blk < 2; ++blk) {
        const bf16_t* qp = c.q() + (size_t)(row0 + 16 * (w + 8 * blk) + i) * D + hd * 256 + 8 * g;
        bf16x8 qf[8];
#pragma unroll
        for (int s8 = 0; s8 < 8; ++s8) qf[s8] = *(const bf16x8*)(qp + 32 * s8);
        f32x4 s[16];
#pragma unroll
        for (int tk = 0; tk < 16; ++tk) { f32x4 z = zero4();
#pragma unroll
            for (int s8 = 0; s8 < 8; ++s8) z = MFMA16(frag_nt(KV, P256, 16 * tk + i, (32 * s8 + 8 * g) * 2), qf[s8], z);
            s[tk] = z; }
        float mx = -3.0e38f;
#pragma unroll
        for (int tk = 0; tk < 16; ++tk) mx = fmaxf(fmaxf(mx, fmaxf(s[tk][0], s[tk][1])), fmaxf(s[tk][2], s[tk][3]));
        mx = fmaxf(mx, shx(mx, 16)); mx = fmaxf(mx, shx(mx, 32));
        float sum = 0.f;
#pragma unroll
        for (int tk = 0; tk < 16; ++tk)
#pragma unroll
            for (int rr = 0; rr < 4; ++rr) { const float p = __expf((s[tk][rr] - mx) * 0.0625f); s[tk][rr] = p; sum += p; }
        sum += shx(sum, 16); sum += shx(sum, 32);
        inv[blk] = rcpf_(sum);
#pragma unroll
        for (int ks = 0; ks < 8; ++ks) P[blk][ks] = pack_frag(s[2 * ks], s[2 * ks + 1]);
    }
    __syncthreads();
    { u32x4 t_[16];
#pragma unroll
      for (int y = 0; y < 16; ++y) { const int x = c.tid + y * NTHREADS; t_[y] = *(const u32x4*)(kvb + (size_t)(x >> 5) * 2048 + 1024 + (x & 31) * 8); }
#pragma unroll
      for (int y = 0; y < 16; ++y) { const int x = c.tid + y * NTHREADS; *(LAS u32x4*)(KV + (x >> 5) * P256 + (x & 31) * 16) = t_[y]; } }
    __syncthreads();
#pragma unroll
    for (int blk = 0; blk < 2; ++blk) {
        f32x4 o[16];
#pragma unroll
        for (int te = 0; te < 16; ++te) o[te] = zero4();
#pragma unroll
        for (int ks = 0; ks < 8; ++ks) { const int ra = 32 * ks + 4 * g, rb = ra + 16;
#pragma unroll
            for (int t4 = 0; t4 < 4; ++t4) { bf16x8 a4[4]; frag_tr_x4(KV, P256, ra, rb, 64 * t4, lane, a4);
#pragma unroll
                for (int x = 0; x < 4; ++x) o[4 * t4 + x] = MFMA16(a4[x], P[blk][ks], o[4 * t4 + x]); } }
        bf16_t* op = c.mixed() + (size_t)(row0 + 16 * (w + 8 * blk) + i) * D + hd * 256 + 4 * g;
        const float iv = inv[blk];
#pragma unroll
        for (int te = 0; te < 16; ++te) *(unsigned long long*)(op + 16 * te) = (unsigned long long)pk2(o[te][0] * iv, o[te][1] * iv) | ((unsigned long long)pk2(o[te][2] * iv, o[te][3] * iv) << 32);
    }
    __syncthreads();
}
#ifndef MK_PER_PHASE
#define MK_PER_PHASE 0
#endif
#if defined(MK_DUP) || defined(MK_WPHASE)
constexpr int PH_SLOTS = 11;
#else
constexpr int PH_SLOTS = 10;
#endif
constexpr int NP = 2 + DEPTH * PH_SLOTS;
struct Args { const float* in[25]; float* out; unsigned char* ws; int ph_lo, ph_hi; };

__global__ void __launch_bounds__(NTHREADS, 2) mega(Args a) {
    extern __shared__ __attribute__((aligned(16))) unsigned char lds_raw[];
    LAS unsigned char* lds_base = (LAS unsigned char*)lds_raw;
    Ctx c;
    c.out = a.out; c.ws = a.ws;
#if MK_CG_SYNC
    cg::grid_group grid = cg::this_grid();
#else
    if (threadIdx.x < 16) ((LAS unsigned*)(lds_base + LDS_MISC))[threadIdx.x] = 0u;
    __syncthreads();
    const XcdBarrier bar0 = xcd_barrier_post((unsigned*)(a.ws + WS_BAR), (volatile LAS unsigned*)(lds_base + LDS_MISC));
#endif

    for (int p = a.ph_lo; p < a.ph_hi; ++p) {
        { int t_ = threadIdx.x, b_ = blockIdx.x, g_ = gridDim.x;
          asm volatile("" : "+v"(t_)); asm volatile("" : "+s"(b_)); asm volatile("" : "+s"(g_));
          c.tid = t_; c.lane = t_ & 63; c.wave = __builtin_amdgcn_readfirstlane(t_ >> 6); c.bid = b_; c.G = g_; }
        LAS unsigned char* lds; { unsigned lb_ = (unsigned)(size_t)lds_base; asm volatile("" : "+s"(lb_)); lds = (LAS unsigned char*)(size_t)lb_; }
        if (p == 0) {
            convert_part(c, 0, 0, c.bid * NWAVES + c.wave, c.G * NWAVES, lds); convert_part(c, 0, 1, c.bid * NWAVES + c.wave, c.G * NWAVES, lds);
            rows_to_bf16(c, c.in(0), c.hb(), c.rs0(), M);
            rows_to_bf16(c, c.in(1), c.memb(), c.rsm(), MM);
        } else if (p == NP - 1) {
            final_norm(c);
#if MK_OLD_STATES == 3
            if (c.bid == 0) { __syncthreads(); if (c.tid == 0) { float m2 = 0.f; for (int k_ = 0; k_ < c.G; ++k_) m2 = fmaxf(m2, c.wsp<float>(WS_BAR + 15 * 1024)[k_]); c.out[0] += 100.f * fminf(m2, 1.0e4f); } }
#endif
        } else {
            const int l = (p - 1) / PH_SLOTS;
#ifdef MK_DUP
            const int sl_ = (p - 1) % PH_SLOTS, st = sl_ > MK_DUP ? sl_ - 1 : sl_;
#else
            const int st = (p - 1) % PH_SLOTS;
#endif
            if (st == 0) {
                { pg8::Gemm g{c.hb(), c.w_in(), M, NPROJ, D}; pg8::StaticOrder S; S.init(M, NPROJ, c.G, c.bid);
                  EpiScale E{c.proj(), NPROJ, c.rs0(), c.gates(), 13};
                  pg8::gemm_phase<EpiScale, pg8::StaticOrder, true, true>(lds, g, S, E); }
                { pg8::Gemm g{c.memb(), c.wkv(), MM, 2 * D, D}; pg8::StaticOrder S; S.init(MM, 2 * D, c.G, c.bid);
                  EpiScale E{c.memkv(), 2 * D, c.rsm(), nullptr, -1};
                  pg8::gemm_phase<EpiScale, pg8::StaticOrder, true, true>(lds, g, S, E); }
            } else if (st == 1) {
#if MK_OLD_STATES == 1
                if (c.bid < 80) gla_state_item(c, l, c.bid, lds);
                else for (int i = c.bid - 80; i < 768 + 320; i += c.G - 80) { if (i < 768) ml_delta_item(c, l, i, lds); else na_mfma_item(c, l, i - 768, lds); }
#elif MK_OLD_STATES == 3
                if (c.bid < 96) ml_state_item(c, l, c.bid, lds);
                else if (c.bid < 176) gla_state_item(c, l, c.bid - 96, lds);
                else for (int i = c.bid - 176; i < 768 + 320; i += c.G - 176) { if (i < 768) ml_delta_item(c, l, i, lds); else na_mfma_item(c, l, i - 768, lds); }
#elif MK_OLD_STATES == 2
                if (c.bid < 96) ml_state_item(c, l, c.bid, lds);
                else for (int i = c.bid - 96; i < 640 + 320; i += c.G - 96) { if (i < 640) gla_delta_item(c, l, i, lds); else na_mfma_item(c, l, i - 640, lds); }
#else
                for (int i = c.bid; i < 1728; i += c.G) {
                    if (i < 768) ml_delta_item(c, l, i, lds); else if (i < 1408) gla_delta_item(c, l, i - 768, lds); else na_mfma_item(c, l, i - 1408, lds); }
#endif
#ifndef MK_WPHASE
                if (l > 0) convert_part(c, l, 1, c.bid * NWAVES + c.wave, c.G * NWAVES, lds);
                if (l + 1 < DEPTH) convert_part(c, l + 1, 0, c.bid * NWAVES + c.wave, c.G * NWAVES, lds);
#endif
            } else if (st == 2) {
#if MK_OLD_STATES == 1
                ml_scan(c, c.bid * NTHREADS + c.tid, c.G * NTHREADS);
#elif MK_OLD_STATES == 3
                ml_scan(c, c.bid * NTHREADS + c.tid, c.G * NTHREADS);
#elif MK_OLD_STATES == 2
                gla_scan(c, c.bid * NTHREADS + c.tid, c.G * NTHREADS);
#else
                ml_scan(c, c.bid * NTHREADS + c.tid, c.G * NTHREADS); gla_scan(c, c.bid * NTHREADS + c.tid, c.G * NTHREADS);
#endif
            } else if (st == 3) {
#if MK_OLD_STATES == 3
                if (l == MK_PROBE_L) { float mx = 0.f; const bf16_t* A_ = c.wsp<bf16_t>(WS_MLC); const bf16_t* B_ = c.wsp<bf16_t>(WS_MLC2);
                    for (size_t x = (size_t)c.bid * NTHREADS + c.tid; x < (size_t)96 * 16 * 5120; x += (size_t)c.G * NTHREADS) {
                        const int row_ = (int)((x % 5120) / 64), chk_ = (int)((x / 5120) % 16), dir_ = (int)((x / (5120 * 16)) & 1); (void)row_; (void)chk_; (void)dir_;
                        if (!(MK_PROBE_SEL)) continue;
                        const float a_ = bf2f(A_[x]), b_ = bf2f(B_[x]); float d_ = fabsf(a_ - b_); if (!(d_ == d_) || !(b_ == b_)) d_ = 1.0e6f;
                        if (MK_PROBE_REL) d_ = d_ / (fabsf(a_) + 1e-3f); mx = fmaxf(mx, d_); }
#pragma unroll
                    for (int o_ = 1; o_ < 64; o_ <<= 1) mx = fmaxf(mx, __shfl_xor(mx, o_));
                    LAS float* red_ = (LAS float*)lds; if (c.lane == 0) red_[c.wave] = mx; __syncthreads();
                    if (c.tid == 0) { float m2 = 0.f; for (int k_ = 0; k_ < 8; ++k_) m2 = fmaxf(m2, red_[k_]); c.wsp<float>(WS_BAR + 15 * 1024)[c.bid] = m2; }
                    __syncthreads(); }
#endif
                for (int i = c.bid; i < NB * 6 * 16 + NB * 5 * 16; i += c.G) { if (i < NB * 6 * 16) ml_out_item(c, l, i, lds); else gla_out_item(c, l, i - NB * 6 * 16, lds); }
            } else if (st == 4) {
                pg8::Gemm g{c.mixed(), c.w_out(), M, D, D}; pg8::StaticOrder S; S.init(M, D, c.G, c.bid);
                EpiResid E{l == 0 ? c.in(0) : c.out, c.out, c.hb(), c.rs1()};
                pg8::gemm_phase<EpiResid, pg8::StaticOrder, true, true>(lds, g, S, E);
            } else if (st == 5) {
                pg8::Gemm g{c.hb(), c.wq(), M, D, D}; pg8::StaticOrder S; S.init(M, D, c.G, c.bid);
                EpiScale E{c.q(), D, c.rs1(), nullptr, -1};
                pg8::gemm_phase<EpiScale, pg8::StaticOrder, true, true>(lds, g, S, E);
            } else if (st == 6) {
                for (int i = c.bid; i < NB * 4 * 8; i += c.G) xattn_mfma_item(c, i, lds);
            } else if (st == 7) {
                pg8::Gemm g{c.mixed(), c.wo(), M, D, D}; pg8::StaticOrder S; S.init(M, D, c.G, c.bid);
                EpiResid E{c.out, c.out, c.hb(), c.rs2()};
                pg8::gemm_phase<EpiResid, pg8::StaticOrder, true, true>(lds, g, S, E);
            } else if (st == 8) {
                pg8::Gemm g{c.hb(), c.w_up(), M, NUP, D}; pg8::StaticOrder S; S.init(M, NUP, c.G, c.bid);
                EpiFfn E{c.act(), c.rs2(), c.in(21) + (size_t)l * 3 * DFF, c.in(22) + (size_t)l * DFF, c.wsp<float>(WS_BND), (LAS float*)(lds + 131072)};
                pg8::gemm_phase<EpiFfn, pg8::StaticOrder, true, true>(lds, g, S, E);
            } else if (st == 9) {
                pg8::Gemm g{c.act(), c.w_dn(), M, D, DFF}; pg8::StaticOrder S; S.init(M, D, c.G, c.bid);
                { pg8::Unit u0; if (S.next(0, u0)) ffn_fixup(c.wsp<float>(WS_BND), c.in(21) + (size_t)l * 3 * DFF, c.in(22) + (size_t)l * DFF, c.act(), u0.pm, c.tid); }
                EpiResid E{c.out, c.out, c.hb(), c.rs0()};
                pg8::gemm_phase<EpiResid, pg8::StaticOrder, true, true>(lds, g, S, E);
#ifdef MK_WPHASE
            } else if (st == 10) { if (l + 1 < DEPTH) { convert_part(c, l + 1, 0, c.bid * NWAVES + c.wave, c.G * NWAVES, lds); convert_part(c, l + 1, 1, c.bid * NWAVES + c.wave, c.G * NWAVES, lds); }
#endif
            }
        }
#if MK_CG_SYNC
        if (p + 1 < a.ph_hi) grid.sync();
#else
        if (p + 1 < a.ph_hi) { XcdBarrier bar = bar0; { unsigned long long bp_ = (unsigned long long)bar.bar; unsigned lo_ = (unsigned)bp_, hi_ = (unsigned)(bp_ >> 32); asm volatile("" : "+s"(lo_), "+s"(hi_));
                bar.bar = (unsigned*)(((unsigned long long)hi_ << 32) | lo_); }
            xcd_barrier(bar); }
#endif
    }
}
}

extern "C" void kernel_launch(void* const* d_in, const int* in_sizes, int n_in, void* d_out, int out_size, void* d_ws, size_t ws_size, hipStream_t stream) {
    static int grid = 0;
    if (grid == 0) {
        if (n_in != 25 || out_size != mk::M * mk::D || ws_size < mk::WS_END) { fprintf(stderr, "kernel_launch: unexpected shapes / workspace (n_in %d out %d ws %zu need %zu)\n", n_in, out_size, ws_size, (size_t)mk::WS_END); grid = -1; return; }
        int dev = 0, cus = 0, per_cu = 0;
        (void)hipGetDevice(&dev); (void)hipDeviceGetAttribute(&cus, hipDeviceAttributeMultiprocessorCount, dev);
        if (hipFuncSetAttribute((const void*)mk::mega, hipFuncAttributeMaxDynamicSharedMemorySize, mk::LDS_BYTES) != hipSuccess) { fprintf(stderr, "kernel_launch: hipFuncSetAttribute failed\n"); grid = -1; return; }
        (void)hipOccupancyMaxActiveBlocksPerMultiprocessor(&per_cu, (const void*)mk::mega, mk::NTHREADS, mk::LDS_BYTES);
        if (per_cu < 1) { fprintf(stderr, "kernel_launch: occupancy query says %d blocks per CU\n", per_cu); grid = -1; return; }
        grid = cus;
        if (grid < 192) { fprintf(stderr, "kernel_launch: needs >= 192 CUs\n"); grid = -1; return; }
    }
    if (grid < 0) return;
    mk::Args a{};
    for (int i = 0; i < 25; ++i) a.in[i] = (const float*)d_in[i];
    a.out = (float*)d_out; a.ws = (unsigned char*)d_ws;
#if MK_PER_PHASE
    for (int p = 0; p < mk::NP; ++p) { a.ph_lo = p; a.ph_hi = p + 1; hipLaunchKernelGGL(mk::mega, dim3(grid), dim3(mk::NTHREADS), mk::LDS_BYTES, stream, a); }
#else
    a.ph_lo = 0; a.ph_hi = mk::NP;
#if MK_CG_SYNC
    void* args[] = {&a};
    hipError_t e = hipLaunchCooperativeKernel((const void*)mk::mega, dim3(grid), dim3(mk::NTHREADS), args, mk::LDS_BYTES, stream);
    if (e != hipSuccess) fprintf(stderr, "cooperative launch failed: %s (grid %d)\n", hipGetErrorString(e), grid);
#else
    if (hipMemsetAsync((char*)d_ws + mk::WS_BAR, 0, mk::WS_BAR_BYTES, stream) != hipSuccess) { fprintf(stderr, "kernel_launch: memset of the barrier words failed\n"); return; }
    hipLaunchKernelGGL(mk::mega, dim3(grid), dim3(mk::NTHREADS), mk::LDS_BYTES, stream, a);
#endif
#endif
}
```

```cpp
#include <hip/hip_runtime.h>
#include <hip/hip_cooperative_groups.h>
#include <cstdio>
#include <cstdint>
namespace cg = cooperative_groups;
#define MK_PER_PHASE 0
#define MK_CG_SYNC 0
#define MK_LIB_SHFL 0
namespace pg8 {
#define PG8_LAS __attribute__((address_space(3)))
typedef unsigned short bf16_t;
typedef short bf16x8 __attribute__((ext_vector_type(8)));
typedef float f32x4 __attribute__((ext_vector_type(4)));
typedef unsigned u32x4 __attribute__((ext_vector_type(4)));
constexpr int BM = 256, BK = 64, HALF = 128, HTB = HALF * BK * 2  , STAGE_BYTES = 8 * HTB, NXCD = 8, WGM = 8;

__host__ __device__ __forceinline__ int lds_byte(int r, int c) { const int st = (r >> 4) * 2 + (c >> 5), rr = r & 15, cc = c & 31, ob = rr * 64 + cc * 2; return st * 1024 + (ob ^ (((ob >> 9) & 1) << 5)); }
__host__ __device__ __forceinline__ void stage_rc(int b, int& R, int& C) { const int st = b / 1024, sb = b % 1024, swz = sb ^ (((sb >> 9) & 1) << 5); R = (st >> 1) * 16 + swz / 64; C = (st & 1) * 32 + (swz % 64) / 2; }
__host__ __device__ __forceinline__ int perm32(int rho) { const int n = rho >> 4, i = rho & 15; return 8 * (i >> 2) + 4 * n + (i & 3); }

struct Unit { int pm, pn, sel; };
struct Gemm { const bf16_t* A; const bf16_t* Bt; int M, N, K; const bf16_t* A2; const bf16_t* Bt2; };

struct StaticOrder {
    int nM, nN, nwg, G, c;
    __host__ __device__ void init(int M, int N, int G_, int c_) { nM = M / BM; nN = N / BM; nwg = nM * nN; G = G_; c = c_; }
    __host__ __device__ bool next(int i, Unit& u) const {
        const long L = (long)i * G + c; if (L >= nwg) return false;
        int wgid = (int)L; { const int q = nwg / NXCD, r = nwg % NXCD, xcd = wgid % NXCD, off = wgid / NXCD; wgid = (xcd < r ? xcd * (q + 1) : r * (q + 1) + (xcd - r) * q) + off; }
        const int nig = WGM * nN, gid = wgid / nig, fm = gid * WGM, gsz = (nM - fm) < WGM ? (nM - fm) : WGM;
        u.pm = fm + ((wgid % nig) % gsz); u.pn = (wgid % nig) / gsz; u.sel = 0; return true;
    }
    __device__ __forceinline__ void a_ready(const Unit&) const {}
    __device__ __forceinline__ void done(const Unit&) const {}
};

template <class Epi, class Sched, bool ALIGN_EPI = false, bool SP2 = false>
__device__ __forceinline__ void gemm_phase(PG8_LAS unsigned char* lds, const Gemm g, const Sched& S, const Epi& E) {
    int tid_l = threadIdx.x; asm volatile("" : "+v"(tid_l));
    const int tid = tid_l, wid = __builtin_amdgcn_readfirstlane(tid >> 6), lane = tid & 63, wr = wid >> 2, wc = wid & 3, fr = lane & 15, fq = lane >> 4;
    const int K = g.K, nt = K / BK;
    unsigned voffA[2], voffB[2];
#pragma unroll
    for (int i = 0; i < 2; ++i) { int R, C; stage_rc(tid * 16 + i * 8192, R, C); const int Rb = Epi::PERM ? ((R & ~31) + perm32(R & 31)) : R;
        voffA[i] = (unsigned)(R * K + C) * 2u; voffB[i] = (unsigned)(Rb * K + C) * 2u; }
    const size_t kstep = (size_t)(BK * 2);
    const size_t hstep = (size_t)HALF * K * 2;
    const size_t tstep = 2 * hstep;
    const unsigned ldsw = (unsigned)wid * 1024u;
    const int aoff = lds_byte(wr * 64 + fr, fq * 8), boff = lds_byte(wc * 32 + fr, fq * 8);
#define PG8_SA(b, h) (((b) * 2 + (h)) * HTB)
#define PG8_SB(b, h) ((4 + (b) * 2 + (h)) * HTB)
#define PG8_STAGE(bufoff, gbase, voff) do { _Pragma("unroll") for (int _i = 0; _i < 2; ++_i) \
        __builtin_amdgcn_global_load_lds((const unsigned*)((const char*)(gbase) + (voff)[_i]), (PG8_LAS unsigned*)(lds + (bufoff) + ldsw + _i * 8192), 16, 0, 0); } while (0)
#define PG8_LDA(dst, b, h) do { _Pragma("unroll") for (int m = 0; m < 4; ++m) _Pragma("unroll") for (int k = 0; k < 2; ++k) dst[m][k] = *(const PG8_LAS bf16x8*)(lds + PG8_SA(b, h) + aoff + m * 2048 + k * 1024); } while (0)
#define PG8_LDB(dst, b, h) do { _Pragma("unroll") for (int n = 0; n < 2; ++n) _Pragma("unroll") for (int k = 0; k < 2; ++k) dst[n][k] = *(const PG8_LAS bf16x8*)(lds + PG8_SB(b, h) + boff + n * 2048 + k * 1024); } while (0)
#define PG8_MMA(ai, bj, At, Bt) do { __builtin_amdgcn_s_setprio(1); _Pragma("unroll") for (int m = 0; m < 4; ++m) _Pragma("unroll") for (int n = 0; n < 2; ++n) _Pragma("unroll") for (int k = 0; k < 2; ++k) \
        acc[ai][bj][m][n] = __builtin_amdgcn_mfma_f32_16x16x32_bf16(Bt[n][k], At[m][k], acc[ai][bj][m][n], 0, 0, 0); __builtin_amdgcn_s_setprio(0); } while (0)
#define PG8_WAIT_V(n) asm volatile("s_waitcnt vmcnt(" #n ")" ::: "memory")
#define PG8_WAIT_L(n) asm volatile("s_waitcnt lgkmcnt(" #n ")" ::: "memory")
#define PG8_BAR __builtin_amdgcn_s_barrier()
#define PG8_SCHED __builtin_amdgcn_sched_barrier(0)
    Unit cur, nxt; int ui = 0;
    if (!S.next(0, cur)) return;
    f32x4 acc[2][2][4][2];
#pragma unroll
    for (int a = 0; a < 2; ++a)
#pragma unroll
        for (int b = 0; b < 2; ++b)
#pragma unroll
            for (int m = 0; m < 4; ++m)
#pragma unroll
                for (int n = 0; n < 2; ++n) acc[a][b][m][n] = (f32x4){0.f, 0.f, 0.f, 0.f};
    bf16x8 At[4][2], B0[2][2], B1[2][2];
    const char* cA = (const char*)(cur.sel ? g.A2 : g.A) + (size_t)cur.pm * tstep; const char* cB = (const char*)(cur.sel ? g.Bt2 : g.Bt) + (size_t)cur.pn * tstep;
    S.a_ready(cur);
    if constexpr (SP2) {
        PG8_STAGE(PG8_SB(0, 0), cB, voffB); PG8_STAGE(PG8_SB(0, 1), cB + hstep, voffB); PG8_STAGE(PG8_SA(0, 0), cA, voffA); PG8_STAGE(PG8_SA(0, 1), cA + hstep, voffA);
        if (wr == 1) PG8_BAR;
        PG8_WAIT_V(2); PG8_BAR;
        PG8_STAGE(PG8_SB(1, 0), cB + kstep, voffB); PG8_STAGE(PG8_SA(1, 0), cA + kstep, voffA); PG8_STAGE(PG8_SB(1, 1), cB + hstep + kstep, voffB);
        PG8_WAIT_V(6); PG8_BAR;
    } else {
        PG8_STAGE(PG8_SB(0, 0), cB, voffB); PG8_STAGE(PG8_SA(0, 0), cA, voffA); PG8_STAGE(PG8_SB(0, 1), cB + hstep, voffB); PG8_STAGE(PG8_SA(0, 1), cA + hstep, voffA);
        if (wr == 1) PG8_BAR;
        PG8_WAIT_V(4); PG8_BAR;
        PG8_STAGE(PG8_SB(1, 0), cB + kstep, voffB); PG8_STAGE(PG8_SA(1, 0), cA + kstep, voffA); PG8_STAGE(PG8_SB(1, 1), cB + hstep + kstep, voffB);
        PG8_WAIT_V(6); PG8_BAR;
    }
    for (;;) {
        const bool has_next = S.next(ui + 1, nxt);
        const char* nA = has_next ? (const char*)(nxt.sel ? g.A2 : g.A) + (size_t)nxt.pm * tstep : cA; const char* nB = has_next ? (const char*)(nxt.sel ? g.Bt2 : g.Bt) + (size_t)nxt.pn * tstep : cB;
        for (int t = 0; t < nt; t += 2) {
            const bool last = (t == nt - 2);
            const char* a1 = cA + (size_t)(t + 1) * kstep;
            const char* a2 = last ? nA : cA + (size_t)(t + 2) * kstep; const char* b2 = last ? nB : cB + (size_t)(t + 2) * kstep;
            const char* a3 = a2 + kstep; const char* b3 = b2 + kstep;
            if (last && has_next) S.a_ready(nxt);
            if constexpr (SP2) {
            PG8_LDB(B0, 0, 0); PG8_LDB(B1, 0, 1); PG8_SCHED; PG8_LDA(At, 0, 0); PG8_STAGE(PG8_SA(1, 1), a1 + hstep, voffA);
            PG8_WAIT_V(8); PG8_WAIT_L(0); PG8_BAR; PG8_MMA(0, 0, At, B0); PG8_MMA(0, 1, At, B1); PG8_BAR; PG8_SCHED;
            PG8_LDA(At, 0, 1); PG8_STAGE(PG8_SB(0, 0), b2, voffB); PG8_STAGE(PG8_SB(0, 1), b2 + hstep, voffB); PG8_STAGE(PG8_SA(0, 0), a2, voffA);
            PG8_WAIT_V(8); PG8_WAIT_L(0); PG8_BAR; PG8_MMA(1, 0, At, B0); PG8_MMA(1, 1, At, B1); PG8_BAR; PG8_SCHED;
            PG8_LDB(B0, 1, 0); PG8_LDB(B1, 1, 1); PG8_SCHED; PG8_LDA(At, 1, 0); PG8_STAGE(PG8_SA(0, 1), a2 + hstep, voffA);
            PG8_WAIT_V(8); PG8_WAIT_L(0); PG8_BAR; PG8_MMA(0, 0, At, B0); PG8_MMA(0, 1, At, B1); PG8_BAR; PG8_SCHED;
            PG8_LDA(At, 1, 1); PG8_STAGE(PG8_SB(1, 0), b3, voffB); PG8_STAGE(PG8_SB(1, 1), b3 + hstep, voffB); PG8_STAGE(PG8_SA(1, 0), a3, voffA);
            PG8_WAIT_V(8); PG8_WAIT_L(0); PG8_BAR; PG8_MMA(1, 0, At, B0); PG8_MMA(1, 1, At, B1); PG8_BAR; PG8_SCHED;
            } else {
            PG8_LDB(B0, 0, 0); PG8_SCHED; PG8_LDA(At, 0, 0); PG8_STAGE(PG8_SA(1, 1), a1 + hstep, voffA);
            PG8_WAIT_L(8); PG8_BAR; PG8_WAIT_L(0); PG8_MMA(0, 0, At, B0); PG8_BAR; PG8_SCHED;
            PG8_LDB(B1, 0, 1); PG8_STAGE(PG8_SB(0, 0), b2, voffB);
            PG8_BAR; PG8_WAIT_L(0); PG8_MMA(0, 1, At, B1); PG8_BAR;
            PG8_LDA(At, 0, 1); PG8_STAGE(PG8_SA(0, 0), a2, voffA);
            PG8_BAR; PG8_WAIT_L(0); PG8_MMA(1, 0, At, B0); PG8_BAR; PG8_SCHED;
            PG8_STAGE(PG8_SB(0, 1), b2 + hstep, voffB);
            PG8_WAIT_V(6); PG8_BAR; PG8_MMA(1, 1, At, B1); PG8_BAR;
            PG8_LDB(B0, 1, 0); PG8_SCHED; PG8_LDA(At, 1, 0); PG8_STAGE(PG8_SA(0, 1), a2 + hstep, voffA);
            PG8_WAIT_L(8); PG8_BAR; PG8_WAIT_L(0); PG8_MMA(0, 0, At, B0); PG8_BAR; PG8_SCHED;
            PG8_LDB(B1, 1, 1); PG8_STAGE(PG8_SB(1, 0), b3, voffB);
            PG8_BAR; PG8_WAIT_L(0); PG8_MMA(0, 1, At, B1); PG8_BAR;
            PG8_LDA(At, 1, 1); PG8_STAGE(PG8_SA(1, 0), a3, voffA);
            PG8_BAR; PG8_WAIT_L(0); PG8_MMA(1, 0, At, B0); PG8_BAR; PG8_SCHED;
            PG8_STAGE(PG8_SB(1, 1), b3 + hstep, voffB);
            PG8_WAIT_V(6); PG8_BAR; PG8_MMA(1, 1, At, B1); PG8_BAR;
            }
        }
        if constexpr (ALIGN_EPI) { if (wr == 0) PG8_BAR; }
        if constexpr (!Epi::AFTER_DRAIN) { E(acc, cur, wr, wc, fr, fq); S.done(cur); }
        if (!has_next) break;
#pragma unroll
        for (int a = 0; a < 2; ++a)
#pragma unroll
            for (int b = 0; b < 2; ++b)
#pragma unroll
                for (int m = 0; m < 4; ++m)
#pragma unroll
                    for (int n = 0; n < 2; ++n) acc[a][b][m][n] = (f32x4){0.f, 0.f, 0.f, 0.f};
        cur = nxt; cA = nA; cB = nB; ++ui;
        if constexpr (ALIGN_EPI) { if (wr == 1) PG8_BAR; }
    }
    PG8_WAIT_V(0);
    if constexpr (!ALIGN_EPI) { if (wr == 0) PG8_BAR; }
    PG8_BAR;
    if constexpr (Epi::AFTER_DRAIN) { E.fused(acc, cur, wr, wc, fr, fq, lds, wid, lane); S.done(cur); }
#undef PG8_SA
#undef PG8_SB
#undef PG8_STAGE
#undef PG8_LDA
#undef PG8_LDB
#undef PG8_MMA
#undef PG8_WAIT_V
#undef PG8_WAIT_L
#undef PG8_BAR
#undef PG8_SCHED
}
}
namespace mk {
using pg8::bf16_t; using pg8::f32x4; using pg8::u32x4; using pg8::bf16x8;
#define LAS __attribute__((address_space(3)))
constexpr int NB = 8, T = 2048, M = NB * T, D = 1024, DEPTH = 4, NMEM = 256, MM = NB * NMEM;
constexpr int NPROJ = 3584, IN_COLS = 3512, DFF = 2816, NUP = 2 * DFF;
constexpr float EPS = 1e-6f;
constexpr int P_MLQ = 0, P_MLK = 384, P_MLV = 768, P_MLO = 1152, P_NAQ = 1536, P_NAK = 1856, P_NAV = 2176, P_GQ = 2496, P_GK = 2656, P_GV = 2816, P_GG = 3136, P_MLG = 3456, P_GA = 3480;
constexpr int NTHREADS = 512, NWAVES = 8;
constexpr int LDS_BYTES = 160 * 1024, LDS_MISC = LDS_BYTES - 64;
constexpr size_t MiB = (size_t)1 << 20;
constexpr size_t WS_RS0 = 0, WS_RS1 = 1 * MiB, WS_RS2 = 2 * MiB, WS_RSM = 3 * MiB;
constexpr size_t WS_BAR = 3 * MiB + 512 * 1024, WS_BAR_BYTES = 16 * 1024;
constexpr size_t WS_GATES = 4 * MiB;
constexpr size_t WS_MEMB = 8 * MiB;
constexpr size_t WS_MEMKV = 12 * MiB;
constexpr size_t WS_WIN = 20 * MiB, WS_WOUT = 27 * MiB, WS_WQ = 29 * MiB, WS_WO = 31 * MiB, WS_WUP = 33 * MiB, WS_WDN = 44 * MiB, WS_WKV = 50 * MiB;
constexpr size_t WS_HB = 54 * MiB;
constexpr size_t WS_BIG = 86 * MiB;
constexpr size_t WS_BND = WS_BIG + 170 * MiB;
constexpr size_t WS_HSML = WS_BIG + 112 * MiB, WS_HSGL = WS_HSML + 24 * MiB;
constexpr size_t WS_ACT = 262 * MiB;
constexpr size_t WS_MIXED = WS_ACT, WS_Q = WS_ACT + 32 * MiB;
constexpr size_t WS_END = 350 * MiB;

__device__ __forceinline__ float bf2f(unsigned v) { return __uint_as_float(v << 16); }
__device__ __forceinline__ unsigned f2bf(float f) { const unsigned u = __float_as_uint(f); return (u + 0x7fffu + ((u >> 16) & 1u)) >> 16; }
__device__ __forceinline__ unsigned cvt_pk_bf16(float lo, float hi) { unsigned r; asm volatile("v_cvt_pk_bf16_f32 %0, %1, %2" : "=v"(r) : "v"(lo), "v"(hi)); return r; }
__device__ __forceinline__ unsigned pk2(float lo, float hi) { return cvt_pk_bf16(lo, hi); }
__device__ __forceinline__ void unpack8(const u32x4 w, float (&o)[8]) {
    o[0] = bf2f(w.x & 0xffffu); o[1] = bf2f(w.x >> 16); o[2] = bf2f(w.y & 0xffffu); o[3] = bf2f(w.y >> 16);
    o[4] = bf2f(w.z & 0xffffu); o[5] = bf2f(w.z >> 16); o[6] = bf2f(w.w & 0xffffu); o[7] = bf2f(w.w >> 16);
}
__device__ __forceinline__ int lane_() { int l = (int)__lane_id(); asm volatile("" : "+v"(l)); return l; }
#if MK_LIB_SHFL
__device__ __forceinline__ float shl(float v, int src) { return __shfl(v, src); }
__device__ __forceinline__ float shx(float v, int o) { return __shfl_xor(v, o); }
__device__ __forceinline__ float shup(float v, int o) { return __shfl_up(v, o); }
#else
__device__ __forceinline__ float shl(float v, int src) { return __builtin_bit_cast(float, __builtin_amdgcn_ds_bpermute(src << 2, __builtin_bit_cast(int, v))); }
__device__ __forceinline__ float shx(float v, int o) { return shl(v, lane_() ^ o); }
__device__ __forceinline__ float shup(float v, int o) { return shl(v, lane_() - o); }
#endif
__device__ __forceinline__ float wave_sum(float v) {
#pragma unroll
    for (int o = 1; o < 64; o <<= 1) v += shx(v, o);
    return v;
}
__device__ __forceinline__ f32x4 zero4() { return (f32x4){0.f, 0.f, 0.f, 0.f}; }
__device__ __forceinline__ float rcpf_(float x) { return __builtin_amdgcn_rcpf(x); }
__device__ __forceinline__ float rsqf_(float x) { return __builtin_amdgcn_rsqf(x); }
__device__ __forceinline__ float sigmoidf_(float x) { return rcpf_(1.f + __expf(-x)); }

typedef const float* cfptr;
struct Ctx {
    float* out; unsigned char* ws;
    int G, bid, tid, lane, wave;
    __device__ __forceinline__ const float* in(int i) const {
        asm volatile("" : "+s"(i));
        const __attribute__((address_space(4))) cfptr* tbl = (const __attribute__((address_space(4))) cfptr*)__builtin_amdgcn_kernarg_segment_ptr();
        return tbl[i];
    }
    template <class Tp> __device__ __forceinline__ Tp* wsp(size_t off) const { unsigned o = (unsigned)off; asm volatile("" : "+s"(o)); return (Tp*)(ws + o); }
    __device__ __forceinline__ float* rs0() const { return wsp<float>(WS_RS0); }
    __device__ __forceinline__ float* rs1() const { return wsp<float>(WS_RS1); }
    __device__ __forceinline__ float* rs2() const { return wsp<float>(WS_RS2); }
    __device__ __forceinline__ float* rsm() const { return wsp<float>(WS_RSM); }
    __device__ __forceinline__ float* gates() const { return wsp<float>(WS_GATES); }
    __device__ __forceinline__ float* hsml() const { return wsp<float>(WS_HSML); }
    __device__ __forceinline__ float* hsgl() const { return wsp<float>(WS_HSGL); }
    __device__ __forceinline__ bf16_t* memb() const { return wsp<bf16_t>(WS_MEMB); }
    __device__ __forceinline__ bf16_t* memkv() const { return wsp<bf16_t>(WS_MEMKV); }
    __device__ __forceinline__ bf16_t* w_in() const { return wsp<bf16_t>(WS_WIN); }
    __device__ __forceinline__ bf16_t* w_out() const { return wsp<bf16_t>(WS_WOUT); }
    __device__ __forceinline__ bf16_t* wq() const { return wsp<bf16_t>(WS_WQ); }
    __device__ __forceinline__ bf16_t* wo() const { return wsp<bf16_t>(WS_WO); }
    __device__ __forceinline__ bf16_t* w_up() const { return wsp<bf16_t>(WS_WUP); }
    __device__ __forceinline__ bf16_t* w_dn() const { return wsp<bf16_t>(WS_WDN); }
    __device__ __forceinline__ bf16_t* wkv() const { return wsp<bf16_t>(WS_WKV); }
    __device__ __forceinline__ bf16_t* hb() const { return wsp<bf16_t>(WS_HB); }
    __device__ __forceinline__ bf16_t* proj() const { return wsp<bf16_t>(WS_BIG); }
    __device__ __forceinline__ bf16_t* u() const { return wsp<bf16_t>(WS_BIG); }
    __device__ __forceinline__ bf16_t* act() const { return wsp<bf16_t>(WS_ACT); }
    __device__ __forceinline__ bf16_t* mixed() const { return wsp<bf16_t>(WS_MIXED); }
    __device__ __forceinline__ bf16_t* q() const { return wsp<bf16_t>(WS_Q); }
};

#define LAUNDER_CTX(c0, c) Ctx c = (c0); { int t_ = c.tid; asm volatile("" : "+v"(t_)); c.tid = t_; c.lane = t_ & 63; c.wave = __builtin_amdgcn_readfirstlane(t_ >> 6); }

struct EpiScale {
    static constexpr bool PERM = true, AFTER_DRAIN = false;
    bf16_t* O; int ldc; const float* rowss; float* gates; int gate_pn;
    bf16_t* O2; int ldc2; const float* rowss2;
    LAS float* RS;
    __device__ __forceinline__ void operator()(const f32x4 (&acc)[2][2][4][2], const pg8::Unit& u, int wr, int wc, int fr, int fq) const {
        const int row0 = u.pm * 256 + wr * 64 + fr, col0 = u.pn * 256 + wc * 32 + 8 * fq;
        const bool gt = (u.pn == gate_pn) && (wc < 2) && !u.sel;
        bf16_t* const O = u.sel ? O2 : this->O; const int ldc = u.sel ? ldc2 : this->ldc; const float* const rowss = u.sel ? rowss2 : this->rowss;
        { const int tid = (wr * 4 + wc) * 64 + fq * 16 + fr;
          if (tid < 256) { const f32x4* rp = (const f32x4*)(rowss + (size_t)(u.pm * 256 + tid) * 16); const f32x4 p0 = rp[0], p1 = rp[1], p2 = rp[2], p3 = rp[3];
              const float ssum = (((p0[0] + p0[1]) + (p0[2] + p0[3])) + ((p1[0] + p1[1]) + (p1[2] + p1[3]))) + (((p2[0] + p2[1]) + (p2[2] + p2[3])) + ((p3[0] + p3[1]) + (p3[2] + p3[3])));
              RS[tid] = rsqf_(ssum * (1.0f / D) + EPS); }
          asm volatile("s_waitcnt lgkmcnt(0)" ::: "memory"); __builtin_amdgcn_s_barrier(); asm volatile("" ::: "memory"); }
#pragma unroll
        for (int ai = 0; ai < 2; ++ai)
#pragma unroll
            for (int m = 0; m < 4; ++m) {
                const int row = row0 + ai * 128 + m * 16;
                const float rs = RS[wr * 64 + fr + ai * 128 + m * 16];
                bf16_t* rowp = O + (size_t)row * ldc + col0;
#pragma unroll
                for (int bj = 0; bj < 2; ++bj) {
                    const f32x4 v0 = acc[ai][bj][m][0] * rs, v1 = acc[ai][bj][m][1] * rs;
                    u32x4 w; w.x = cvt_pk_bf16(v0[0], v0[1]); w.y = cvt_pk_bf16(v0[2], v0[3]); w.z = cvt_pk_bf16(v1[0], v1[1]); w.w = cvt_pk_bf16(v1[2], v1[3]);
                    *(u32x4*)(rowp + bj * 128) = w;
                    if (bj == 1 && gt) { float* gp = gates + (size_t)row * 64 + wc * 32 + 8 * fq; *(f32x4*)gp = v0; *(f32x4*)(gp + 4) = v1; }
                }
            }
    }
};
struct EpiResid {
    static constexpr bool PERM = true, AFTER_DRAIN = false;
    const float* base; float* out; bf16_t* hb; float* rowss_out;
    __device__ __forceinline__ void operator()(const f32x4 (&acc)[2][2][4][2], const pg8::Unit& u, int wr, int wc, int fr, int fq) const {
        const int row0 = u.pm * 256 + wr * 64 + fr, col0 = u.pn * 256 + wc * 32 + 8 * fq;
#pragma unroll
        for (int ai = 0; ai < 2; ++ai)
#pragma unroll
            for (int m = 0; m < 4; ++m) {
                const int row = row0 + ai * 128 + m * 16; const size_t off = (size_t)row * D + col0; float ss = 0.f;
#pragma unroll
                for (int bj = 0; bj < 2; ++bj) {
                    const f32x4 v0 = acc[ai][bj][m][0] + *(const f32x4*)(base + off + bj * 128), v1 = acc[ai][bj][m][1] + *(const f32x4*)(base + off + bj * 128 + 4);
                    *(f32x4*)(out + off + bj * 128) = v0; *(f32x4*)(out + off + bj * 128 + 4) = v1;
                    u32x4 w; w.x = cvt_pk_bf16(v0[0], v0[1]); w.y = cvt_pk_bf16(v0[2], v0[3]); w.z = cvt_pk_bf16(v1[0], v1[1]); w.w = cvt_pk_bf16(v1[2], v1[3]);
                    *(u32x4*)(hb + off + bj * 128) = w;
                    ss += (v0[0] * v0[0] + v0[1] * v0[1]) + (v0[2] * v0[2] + v0[3] * v0[3]) + (v1[0] * v1[0] + v1[1] * v1[1]) + (v1[2] * v1[2] + v1[3] * v1[3]);
                }
                ss += shx(ss, 16); ss += shx(ss, 32);
                if (fq == 0) rowss_out[(size_t)row * 16 + u.pn * 4 + wc] = ss;
                if (m == 3) asm volatile("" ::: "memory");
            }
    }
};

__device__ __forceinline__ float gelu_tanh_(float y) { const float uu = 0.7978845608028654f * (y + 0.044715f * y * y * y); return y * rcpf_(1.f + __expf(-2.f * uu)); }
struct EpiFfn {
    static constexpr bool PERM = true, AFTER_DRAIN = false;
    bf16_t* act; const float* rowss; const float* cw; const float* cb; float* bnd; LAS float* X;
    __device__ __forceinline__ void operator()(const f32x4 (&acc)[2][2][4][2], const pg8::Unit& u, int wr, int wc, int fr_in, int fq_in) const {
        int fr = fr_in, fq = fq_in; asm volatile("" : "+v"(fr), "+v"(fq));
        const int lane = fq * 16 + fr, colw = 32 * wc + 8 * fq, ch0 = 128 * u.pn + colw, rowl = wr * 64 + fr, tid = (wr * 4 + wc) * 64 + lane;
        const int lprev = (lane & 48) | ((lane - 1) & 15), lnext = (lane & 48) | ((lane + 1) & 15);
        LAS float* RS = X + 1024; LAS float* WT = X + 1280;
        if (tid < 256) { const f32x4* rp = (const f32x4*)(rowss + (size_t)(u.pm * 256 + tid) * 16); const f32x4 p0 = rp[0], p1 = rp[1], p2 = rp[2], p3 = rp[3];
            const float ssum = (((p0[0] + p0[1]) + (p0[2] + p0[3])) + ((p1[0] + p1[1]) + (p1[2] + p1[3]))) + (((p2[0] + p2[1]) + (p2[2] + p2[3])) + ((p3[0] + p3[1]) + (p3[2] + p3[3])));
            RS[tid] = rsqf_(ssum * (1.0f / D) + EPS); }
        else { const int t2 = tid - 256, ch = 128 * u.pn + (t2 & 127);
            WT[(t2 >> 7) * 256 + (t2 & 127)] = (t2 >> 7) ? cw[2 * DFF + ch] : cw[ch]; WT[(t2 >> 7) * 256 + 128 + (t2 & 127)] = (t2 >> 7) ? cb[ch] : cw[DFF + ch]; }
        asm volatile("s_waitcnt lgkmcnt(0)" ::: "memory"); __builtin_amdgcn_s_barrier(); asm volatile("" ::: "memory");
#pragma unroll
        for (int ai = 0; ai < 2; ++ai) { const int blk = 2 * ai + wr; const bool last = (fr == 15);
            const float s_ = RS[rowl + ai * 128 + (last ? 48 : 0)];
            f32x4 v0, v1;
#pragma unroll
            for (int j = 0; j < 4; ++j) { v0[j] = (last ? acc[ai][0][3][0][j] : acc[ai][0][0][0][j]) * s_; v1[j] = (last ? acc[ai][0][3][1][j] : acc[ai][0][0][1][j]) * s_; }
            if (fr == 0 || fr == 15) { LAS float* xp = X + (blk * 2 + (last ? 1 : 0)) * 128 + colw; *(LAS f32x4*)xp = v0; *(LAS f32x4*)(xp + 4) = v1; } }
        asm volatile("s_waitcnt lgkmcnt(0)" ::: "memory"); __builtin_amdgcn_s_barrier(); asm volatile("" ::: "memory");
#pragma unroll
        for (int ai = 0; ai < 2; ++ai) { const int blk = 2 * ai + wr;
            float rs[4];
#pragma unroll
            for (int m = 0; m < 4; ++m) rs[m] = RS[rowl + ai * 128 + m * 16];
            unsigned pk[4][4];
#pragma unroll
            for (int n = 0; n < 2; ++n) {
                const int cl = colw + 4 * n;
                const f32x4 w0 = *(const LAS f32x4*)(WT + cl), w1 = *(const LAS f32x4*)(WT + 128 + cl), w2 = *(const LAS f32x4*)(WT + 256 + cl), bb = *(const LAS f32x4*)(WT + 384 + cl);
                const f32x4 ep = *(const LAS f32x4*)(X + ((blk > 0 ? blk - 1 : 0) * 2 + 1) * 128 + cl) * (blk > 0 ? 1.f : 0.f);
                const f32x4 en = *(const LAS f32x4*)(X + ((blk < 3 ? blk + 1 : 3) * 2 + 0) * 128 + cl) * (blk < 3 ? 1.f : 0.f);
#pragma unroll
                for (int jp = 0; jp < 2; ++jp) {
                    float o[4][2];
#pragma unroll
                    for (int jj = 0; jj < 2; ++jj) { const int j = 2 * jp + jj;
                        float x[4], R[4], L[4];
#pragma unroll
                        for (int m = 0; m < 4; ++m) { x[m] = acc[ai][0][m][n][j] * rs[m]; R[m] = shl(x[m], lprev); L[m] = shl(x[m], lnext); }
#pragma unroll
                        for (int m = 0; m < 4; ++m) { const float pv = (fr == 0) ? (m > 0 ? R[m > 0 ? m - 1 : 0] : ep[j]) : R[m], nx = (fr == 15) ? (m < 3 ? L[m < 3 ? m + 1 : 3] : en[j]) : L[m];
                            const float y = w0[j] * pv + w1[j] * x[m] + w2[j] * nx + bb[j];
                            o[m][jj] = gelu_tanh_(y) * (acc[ai][1][m][n][j] * rs[m]); } }
#pragma unroll
                    for (int m = 0; m < 4; ++m) pk[m][2 * n + jp] = cvt_pk_bf16(o[m][0], o[m][1]);
                }
            }
#pragma unroll
            for (int m = 0; m < 4; ++m) { const size_t row = (size_t)u.pm * 256 + rowl + ai * 128 + m * 16;
                u32x4 wv; wv.x = pk[m][0]; wv.y = pk[m][1]; wv.z = pk[m][2]; wv.w = pk[m][3]; *(u32x4*)(act + row * DFF + ch0) = wv; }
        }
        { const bool hi = (wr == 1); const float s_ = RS[rowl + (hi ? 128 + 48 : 0)];
          f32x4 a0, a1, g0, g1;
#pragma unroll
          for (int j = 0; j < 4; ++j) { a0[j] = (hi ? acc[1][0][3][0][j] : acc[0][0][0][0][j]) * s_; a1[j] = (hi ? acc[1][0][3][1][j] : acc[0][0][0][1][j]) * s_;
                                        g0[j] = (hi ? acc[1][1][3][0][j] : acc[0][1][0][0][j]) * s_; g1[j] = (hi ? acc[1][1][3][1][j] : acc[0][1][0][1][j]) * s_; }
          float* bp = bnd + (size_t)u.pm * 6 * DFF + ch0;
          const bool doa = hi ? (fr >= 14) : (fr < 2), dog = hi ? (fr == 15) : (fr == 0);
          const int slot = hi ? fr - 12 : fr;
          if (doa) { *(f32x4*)(bp + slot * DFF) = a0; *(f32x4*)(bp + slot * DFF + 4) = a1; }
          if (dog) { *(f32x4*)(bp + (hi ? 5 : 4) * DFF) = g0; *(f32x4*)(bp + (hi ? 5 : 4) * DFF + 4) = g1; } }
    }
};
__device__ __forceinline__ void ffn_fixup(const float* bnd, const float* cw, const float* cb, bf16_t* act, int pm, int tid) {
    for (int idx = tid; idx < 2 * (DFF / 4); idx += NTHREADS) { const int which = idx / (DFF / 4), c4 = (idx % (DFF / 4)) * 4;
        if (which == 0 ? (pm % 8 == 0) : (pm % 8 == 7)) continue;
        const float* b0 = bnd + (size_t)pm * 6 * DFF + c4;
        const f32x4 ap = which == 0 ? *(const f32x4*)(b0 - 6 * DFF + 3 * DFF) : *(const f32x4*)(b0 + 2 * DFF);
        const f32x4 a0 = which == 0 ? *(const f32x4*)(b0) : *(const f32x4*)(b0 + 3 * DFF);
        const f32x4 an = which == 0 ? *(const f32x4*)(b0 + DFF) : *(const f32x4*)(b0 + 6 * DFF);
        const f32x4 gg = which == 0 ? *(const f32x4*)(b0 + 4 * DFF) : *(const f32x4*)(b0 + 5 * DFF);
        const f32x4 v0 = *(const f32x4*)(cw + c4), v1 = *(const f32x4*)(cw + DFF + c4), v2 = *(const f32x4*)(cw + 2 * DFF + c4), vb = *(const f32x4*)(cb + c4);
        float o[4];
#pragma unroll
        for (int j = 0; j < 4; ++j) o[j] = gelu_tanh_(v0[j] * ap[j] + v1[j] * a0[j] + v2[j] * an[j] + vb[j]) * gg[j];
        *(unsigned long long*)(act + ((size_t)pm * 256 + (which ? 255 : 0)) * DFF + c4) = (unsigned long long)cvt_pk_bf16(o[0], o[1]) | ((unsigned long long)cvt_pk_bf16(o[2], o[3]) << 32); }
    asm volatile("s_waitcnt vmcnt(0)" ::: "memory"); __syncthreads();
}

struct DualOrder {
    pg8::StaticOrder s1, s2; int n1;
    __device__ void init(int M1, int N1, int M2, int N2, int G, int c) { s1.init(M1, N1, G, c); s2.init(M2, N2, G, c); n1 = s1.nwg; }
    __device__ bool next(int i, pg8::Unit& u) const {
        const long L = (long)i * s1.G + s1.c;
        if (L < n1) return s1.next(i, u);
        const int L2 = (int)(L - n1); if (L2 >= s2.nwg) return false;
        pg8::StaticOrder t = s2; t.c = L2 % s2.G; const bool ok = t.next(L2 / s2.G, u); u.sel = 1; return ok;
    }
    __device__ __forceinline__ void a_ready(const pg8::Unit&) const {}
    __device__ __forceinline__ void done(const pg8::Unit&) const {}
};

template <class Map>
__device__ __forceinline__ void cvt_item(const float* W, int K, int N, const float* gain, bf16_t* WT, LAS float* scr, int item, int lane, Map map) {
    const int nblk = (N + 31) / 32, kb = item / nblk, nb = item % nblk, k0 = 64 * kb, n0 = 32 * nb;
    const int rr = lane >> 3, cc = (lane & 7) * 4; const bool inside = (n0 + cc) < N;
    f32x4 t_[8];
#pragma unroll
    for (int y = 0; y < 8; ++y) t_[y] = inside ? *(const f32x4*)(W + (size_t)(k0 + 8 * y + rr) * N + n0 + cc) : (f32x4){0.f, 0.f, 0.f, 0.f};
#pragma unroll
    for (int y = 0; y < 8; ++y) { const int kk = 8 * y + rr; const float gsc = gain ? gain[k0 + kk] : 1.0f; LAS float* sp = scr + kk * 33 + cc;
        sp[0] = t_[y][0] * gsc; sp[1] = t_[y][1] * gsc; sp[2] = t_[y][2] * gsc; sp[3] = t_[y][3] * gsc; }
    asm volatile("s_waitcnt lgkmcnt(0)" ::: "memory");
    const int c = lane & 7;
#pragma unroll
    for (int j = 0; j < 4; ++j) { const int n = (lane >> 3) + 8 * j; const LAS float* s = scr + (8 * c) * 33 + n;
        u32x4 o; o.x = pk2(s[0 * 33], s[1 * 33]); o.y = pk2(s[2 * 33], s[3 * 33]); o.z = pk2(s[4 * 33], s[5 * 33]); o.w = pk2(s[6 * 33], s[7 * 33]);
        if (n0 + n < N) *(u32x4*)(WT + (size_t)map(n0 + n) * K + k0 + 8 * c) = o; }
    asm volatile("s_waitcnt lgkmcnt(0)" ::: "memory");
}
struct MapId { int off; __device__ __forceinline__ int operator()(int n) const { return n + off; } };
struct MapUp { __device__ __forceinline__ int operator()(int n) const { return n < DFF ? (n >> 7) * 256 + (n & 127) : ((n - DFF) >> 7) * 256 + 128 + ((n - DFF) & 127); } };
struct MapIn { __device__ __forceinline__ int operator()(int n) const { return n < 1536 ? n : (n < 1560 ? n + (P_MLG - 1536) : (n < 3480 ? n - 24 : n)); } };

__device__ __forceinline__ void convert_part(const Ctx& c, int l, int part, int gw, int NGW, LAS unsigned char* lds) {
    LAS float* scr = (LAS float*)(lds + c.wave * 16384);
    constexpr int I_IN = 16 * 110, I_SQ = 16 * 32, I_UP = 16 * 176, I_DN = 44 * 32;
    if (part == 0) {
        for (int it = gw; it < I_IN + 2 * I_SQ; it += NGW) {
            int r = it;
            if (r < I_IN) { cvt_item(c.in(3) + (size_t)l * D * IN_COLS, D, IN_COLS, c.in(2) + l * D, c.w_in(), scr, r, c.lane, MapIn{}); continue; } r -= I_IN;
            if (r < I_SQ) { cvt_item(c.in(16) + (size_t)l * D * D, D, D, c.in(14) + l * D, c.wkv(), scr, r, c.lane, MapId{0}); continue; } r -= I_SQ;
            cvt_item(c.in(17) + (size_t)l * D * D, D, D, c.in(14) + l * D, c.wkv(), scr, r, c.lane, MapId{D});
        }
        for (int i = gw * 64 + c.lane; i < (NPROJ - IN_COLS) * D / 8; i += NGW * 64) *(u32x4*)(c.w_in() + (size_t)IN_COLS * D + (size_t)i * 8) = (u32x4){0u, 0u, 0u, 0u};
    } else {
        for (int it = gw; it < 3 * I_SQ + I_UP + I_DN; it += NGW) {
            int r = it;
            if (r < I_SQ) { cvt_item(c.in(12) + (size_t)l * D * D, D, D, nullptr, c.w_out(), scr, r, c.lane, MapId{0}); continue; } r -= I_SQ;
            if (r < I_SQ) { cvt_item(c.in(15) + (size_t)l * D * D, D, D, c.in(13) + l * D, c.wq(), scr, r, c.lane, MapId{0}); continue; } r -= I_SQ;
            if (r < I_SQ) { cvt_item(c.in(18) + (size_t)l * D * D, D, D, nullptr, c.wo(), scr, r, c.lane, MapId{0}); continue; } r -= I_SQ;
            if (r < I_UP) { cvt_item(c.in(20) + (size_t)l * D * NUP, D, NUP, c.in(19) + l * D, c.w_up(), scr, r, c.lane, MapUp{}); continue; } r -= I_UP;
            cvt_item(c.in(23) + (size_t)l * DFF * D, DFF, D, nullptr, c.w_dn(), scr, r, c.lane, MapId{0});
        }
    }
}
__device__ __forceinline__ void rows_to_bf16(const Ctx& c, const float* X, bf16_t* Y, float* rss, int rows) {
    const int gw = c.bid * NWAVES + c.wave, NGW = c.G * NWAVES;
    for (int m = gw; m < rows; m += NGW) {
        const f32x4* xr = (const f32x4*)(X + (size_t)m * D) + c.lane; float s = 0.f;
        unsigned long long* o8 = (unsigned long long*)(Y + (size_t)m * D) + c.lane;
#pragma unroll
        for (int j = 0; j < 4; ++j) { const f32x4 v = xr[64 * j]; s += (v[0] * v[0] + v[1] * v[1]) + (v[2] * v[2] + v[3] * v[3]);
            o8[64 * j] = (unsigned long long)pk2(v[0], v[1]) | ((unsigned long long)pk2(v[2], v[3]) << 32); }
        s = wave_sum(s); if (c.lane < 16) rss[(size_t)m * 16 + c.lane] = (c.lane == 0) ? s : 0.f;
    }
}
__device__ __forceinline__ void final_norm(const Ctx& c) {
    const int gw = c.bid * NWAVES + c.wave, NGW = c.G * NWAVES; const float* g = c.in(24);
    for (int m = gw; m < M; m += NGW) {
        f32x4* xr = (f32x4*)(c.out + (size_t)m * D) + c.lane; f32x4 v[4]; float s = 0.f;
#pragma unroll
        for (int j = 0; j < 4; ++j) { v[j] = xr[64 * j]; s += (v[j][0] * v[j][0] + v[j][1] * v[j][1]) + (v[j][2] * v[j][2] + v[j][3] * v[j][3]); }
        const float r = 1.0f / sqrtf(wave_sum(s) * (1.0f / D) + EPS);
#pragma unroll
        for (int j = 0; j < 4; ++j) xr[64 * j] = v[j] * r * ((const f32x4*)g)[c.lane + 64 * j];
    }
}
typedef __attribute__((address_space(1))) unsigned gu32;
#define XB_TMO      128
#define XB_XCNT(j)  (256  + 64 * (j))
#define XB_XSUB(j)  (1280 + 64 * (j))
#define XB_XGEN(j)  (2304 + 64 * (j))
#define XB_TOP      3328
#define XB_TOPGEN   3392
#define XCD_BAR_WORDS 3456
#define XB_SPIN_CAP (1u << 18)

__device__ __forceinline__ unsigned xb_ld(unsigned* p)              { return __hip_atomic_load(p, __ATOMIC_RELAXED, __HIP_MEMORY_SCOPE_AGENT); }
__device__ __forceinline__ unsigned xb_add(unsigned* p, unsigned v) { return __hip_atomic_fetch_add(p, v, __ATOMIC_RELAXED, __HIP_MEMORY_SCOPE_AGENT); }
__device__ __forceinline__ unsigned xb_xcc_id() { return (unsigned)__builtin_amdgcn_s_getreg((3 << 11) | 20) & 0xFu; }
#define XB_SPIN(cond, bar) do { unsigned _sp = 0; while (cond) { __builtin_amdgcn_s_sleep(1); \
    if ((++_sp & 255u) == 0u) { if (xb_ld(&(bar)[XB_TMO])) break; if (_sp > XB_SPIN_CAP) { atomicAdd(&(bar)[XB_TMO], 1u); break; } } } } while (0)

struct XcdBarrier {
    unsigned* bar; unsigned x;
    volatile LAS unsigned* st;
};

__device__ __forceinline__ XcdBarrier xcd_barrier_post(unsigned* bar, volatile LAS unsigned* st) {
    XcdBarrier b; b.bar = bar; b.x = xb_xcc_id(); b.st = st;
    if (threadIdx.x == 0) (void)xb_add(&bar[XB_XCNT(b.x)], 1u);
    return b;
}
__device__ __forceinline__ void xcd_barrier_complete(unsigned* bar, unsigned x, unsigned& nloc, unsigned& nx) {
    const unsigned G = gridDim.x * gridDim.y * gridDim.z;
    unsigned sum, cnt, mine, sp = 0u;
    for (;;) {
        sum = 0u; cnt = 0u; mine = 0u;
#pragma unroll 1
        for (unsigned j = 0; j < 16; ++j) {
            const unsigned c = xb_ld(&bar[XB_XCNT(j)]); sum += c; cnt += (c > 0u) ? 1u : 0u; mine = (j == x) ? c : mine; }
        if (sum == G) break;
        __builtin_amdgcn_s_sleep(1);
        if ((++sp & 255u) == 0u) { if (xb_ld(&bar[XB_TMO])) break; if (sp > XB_SPIN_CAP) { atomicAdd(&bar[XB_TMO], 1u); break; } }
    }
    nloc = mine > 0u ? mine : 1u; nx = cnt > 0u ? cnt : 1u;
}

__device__ __forceinline__ void xcd_barrier(const XcdBarrier& b) {
    asm volatile("s_waitcnt vmcnt(0)" ::: "memory");
    __syncthreads();
    if (threadIdx.x == 0) {
        unsigned* bar = b.bar;
        __builtin_amdgcn_s_waitcnt(0);
        unsigned nloc = b.st[0], nx = b.st[1];
        if (nloc == 0u) { xcd_barrier_complete(bar, b.x, nloc, nx); b.st[0] = nloc; b.st[1] = nx; }
        const unsigned old = xb_add(&bar[XB_XSUB(b.x)], 1u);
        const unsigned gen = old / nloc;
        if (old + 1u == (gen + 1u) * nloc) {
            __builtin_amdgcn_fence(__ATOMIC_RELEASE, "agent");
            asm volatile("s_waitcnt vmcnt(0)" ::: "memory");
            const unsigned og = xb_add(&bar[XB_TOP], 1u);
            const unsigned tg = og / nx;
            if (og + 1u == (tg + 1u) * nx) xb_add(&bar[XB_TOPGEN], 1u);
            else XB_SPIN(xb_ld(&bar[XB_TOPGEN]) == tg, bar);
            __builtin_amdgcn_fence(__ATOMIC_ACQUIRE, "agent");
            xb_add(&bar[XB_XGEN(b.x)], 1u);
            asm volatile("s_waitcnt vmcnt(0)" ::: "memory");
        } else {
            XB_SPIN(xb_ld(&bar[XB_XGEN(b.x)]) == gen, bar);
            __builtin_amdgcn_fence(__ATOMIC_ACQUIRE, "agent");
            asm volatile("s_waitcnt vmcnt(0)" ::: "memory");
        }
    }
    __syncthreads();
}
__device__ __forceinline__ void ml_load_row(const bf16_t* projb, int t, int coff, float (&dst)[2][8]) {
    if (t < 0 || t >= T) {
#pragma unroll
        for (int j = 0; j < 8; ++j) { dst[0][j] = 0.f; dst[1][j] = 0.f; }
    } else {
        const u32x4 a = *(const u32x4*)(projb + (size_t)t * NPROJ + P_MLQ + coff), b = *(const u32x4*)(projb + (size_t)t * NPROJ + P_MLK + coff);
        unpack8(a, dst[0]); unpack8(b, dst[1]);
    }
}
__device__ __forceinline__ void ml_item(const Ctx& c0, int l, int item, LAS unsigned char* lds) {
    LAUNDER_CTX(c0, c);
    const int b = item / 6, h = item % 6, e = c.tid & 63, dg = c.tid >> 6;
    LAS float* rnum = (LAS float*)lds;
    LAS float* rden = (LAS float*)lds + 1024;
    const bf16_t* projb = c.proj() + (size_t)b * T * NPROJ;
    const float* gatesb = c.gates() + (size_t)b * T * 64;
    float* hs = c.hsml() + (size_t)b * T * 384 + h * 64;
    const float* cwp = c.in(4) + (size_t)l * 3 * 768; const float* cbp = c.in(5) + (size_t)l * 768;
    const float* gb = c.in(6) + l * 24; const float* ng = c.in(7) + l * 384;
    const int coff = h * 64 + dg * 8;
    float cw[2][8][4];
#pragma unroll
    for (int qk = 0; qk < 2; ++qk)
#pragma unroll
        for (int j = 0; j < 8; ++j) { const int ch = qk * 384 + coff + j; cw[qk][j][0] = cwp[ch]; cw[qk][j][1] = cwp[768 + ch]; cw[qk][j][2] = cwp[1536 + ch]; cw[qk][j][3] = cbp[ch]; }
    for (int dir = 0; dir < 2; ++dir) {
        float C[8], n[8];
#pragma unroll
        for (int j = 0; j < 8; ++j) { C[j] = 0.f; n[j] = 0.f; }
        const float bi = gb[(2 * dir) * 6 + h], bff = gb[(2 * dir + 1) * 6 + h];
        float lo[2][8], mid[2][8], hi[2][8];
        const int t0 = dir ? T - 1 : 0;
        ml_load_row(projb, t0 - 1, coff, lo); ml_load_row(projb, t0, coff, mid); ml_load_row(projb, t0 + 1, coff, hi);
        for (int s = 0; s < T; ++s) {
            const int t = dir ? T - 1 - s : s;
            const float ip = gatesb[(size_t)t * 64 + (2 * dir) * 6 + h] + bi, fp = gatesb[(size_t)t * 64 + (2 * dir + 1) * 6 + h] + bff;
            const float f = sigmoidf_(fp), ig = __expf(ip);
            const float v = bf2f(projb[(size_t)t * NPROJ + P_MLV + h * 64 + e]);
            float pn = 0.f, pd = 0.f;
#pragma unroll
            for (int j = 0; j < 8; ++j) {
                float yq = lo[0][j] * cw[0][j][0] + mid[0][j] * cw[0][j][1] + hi[0][j] * cw[0][j][2] + cw[0][j][3];
                float yk = lo[1][j] * cw[1][j][0] + mid[1][j] * cw[1][j][1] + hi[1][j] * cw[1][j][2] + cw[1][j][3];
                const float qd = yq * sigmoidf_(yq), kd = yk * sigmoidf_(yk) * 0.125f;
                C[j] = f * C[j] + ig * kd * v; n[j] = f * n[j] + ig * kd; pn += C[j] * qd; pd += n[j] * qd;
            }
            const int p = s & 1;
            rnum[(p * 8 + dg) * 64 + e] = pn; if (e == 0) rden[p * 8 + dg] = pd;
            __syncthreads();
            if (dg == 0) {
                float num = 0.f, den = 0.f;
#pragma unroll
                for (int g = 0; g < 8; ++g) { num += rnum[(p * 8 + g) * 64 + e]; den += rden[p * 8 + g]; }
                const float hv = num / fmaxf(fabsf(den), 1.f);
                if (dir == 0) hs[(size_t)t * 384 + e] = hv;
                else { const float tot = hs[(size_t)t * 384 + e] + hv; const float ss = wave_sum(tot * tot);
                    const float r = 1.0f / sqrtf(ss * (1.0f / 64) + EPS); const float og = bf2f(projb[(size_t)t * NPROJ + P_MLO + h * 64 + e]);
                    c.mixed()[((size_t)b * T + t) * D + h * 64 + e] = (bf16_t)f2bf(tot * r * ng[h * 64 + e] * sigmoidf_(og)); }
            }
            if (dir == 0) {
#pragma unroll
                for (int j = 0; j < 8; ++j) { lo[0][j] = mid[0][j]; lo[1][j] = mid[1][j]; mid[0][j] = hi[0][j]; mid[1][j] = hi[1][j]; }
                ml_load_row(projb, t + 2, coff, hi);
            } else {
#pragma unroll
                for (int j = 0; j < 8; ++j) { hi[0][j] = mid[0][j]; hi[1][j] = mid[1][j]; mid[0][j] = lo[0][j]; mid[1][j] = lo[1][j]; }
                ml_load_row(projb, t - 2, coff, lo);
            }
        }
        __syncthreads();
    }
}
__device__ __forceinline__ void gla_item(const Ctx& c0, int l, int item, LAS unsigned char* lds) {
    LAUNDER_CTX(c0, c);
    const int b = item / 5, h = item % 5, e = c.tid & 63, kg = c.tid >> 6;
    LAS float* rnum = (LAS float*)lds;
    const bf16_t* projb = c.proj() + (size_t)b * T * NPROJ;
    const float* gatesb = c.gates() + (size_t)b * T * 64;
    float* gs = c.hsgl() + (size_t)b * T * 320 + h * 64;
    const float* ng = c.in(11) + l * 320;
    const int doff = h * 32 + kg * 4;
    for (int dir = 0; dir < 2; ++dir) {
        const float* w2 = c.in(9) + ((size_t)l * 2 + dir) * 16 * 160; const float* ab = c.in(10) + ((size_t)l * 2 + dir) * 160;
        float w2r[16][4], abv[4], S[4];
#pragma unroll
        for (int j = 0; j < 4; ++j) { abv[j] = ab[doff + j]; S[j] = 0.f;
#pragma unroll
            for (int r = 0; r < 16; ++r) w2r[r][j] = w2[r * 160 + doff + j]; }
        for (int s = 0; s < T; ++s) {
            const int t = dir ? T - 1 - s : s;
            const float* gp = gatesb + (size_t)t * 64 + 24 + dir * 16;
            float ga[16];
#pragma unroll
            for (int r4 = 0; r4 < 4; ++r4) { const f32x4 x = *(const f32x4*)(gp + 4 * r4); ga[4 * r4] = x[0]; ga[4 * r4 + 1] = x[1]; ga[4 * r4 + 2] = x[2]; ga[4 * r4 + 3] = x[3]; }
            const unsigned long long qw = *(const unsigned long long*)(projb + (size_t)t * NPROJ + P_GQ + doff), kw = *(const unsigned long long*)(projb + (size_t)t * NPROJ + P_GK + doff);
            const float v = bf2f(projb[(size_t)t * NPROJ + P_GV + h * 64 + e]);
            float pn = 0.f;
#pragma unroll
            for (int j = 0; j < 4; ++j) {
                float z = abv[j];
#pragma unroll
                for (int r = 0; r < 16; ++r) z += ga[r] * w2r[r][j];
                const float la = (fminf(z, 0.f) - log1pf(__expf(-fabsf(z)))) * (1.0f / 16.0f);
                const float a = __expf(la);
                const float qd = bf2f((unsigned)(qw >> (16 * j)) & 0xffffu), kd = bf2f((unsigned)(kw >> (16 * j)) & 0xffffu);
                S[j] = a * S[j] + kd * v; pn += S[j] * qd;
            }
            const int p = s & 1;
            rnum[(p * 8 + kg) * 64 + e] = pn * 0.17677669529663687f;
            __syncthreads();
            if (kg == 0) {
                float o = 0.f;
#pragma unroll
                for (int g = 0; g < 8; ++g) o += rnum[(p * 8 + g) * 64 + e];
                if (dir == 0) gs[(size_t)t * 320 + e] = o;
                else { const float tot = gs[(size_t)t * 320 + e] + o; const float ss = wave_sum(tot * tot);
                    const float r = 1.0f / sqrtf(ss * (1.0f / 64) + EPS); const float gg = bf2f(projb[(size_t)t * NPROJ + P_GG + h * 64 + e]);
                    c.mixed()[((size_t)b * T + t) * D + 704 + h * 64 + e] = (bf16_t)f2bf(tot * r * ng[h * 64 + e] * gg * sigmoidf_(gg)); }
            }
        }
        __syncthreads();
    }
}
__device__ __forceinline__ void na_item(const Ctx& c0, int l, int item, LAS unsigned char* lds) {
    LAUNDER_CTX(c0, c);
    const int b = item / 160, h = (item % 160) / 32, r = item % 32;
    const int q = c.tid >> 3, s = c.tid & 7;
    LAS float* sc = (LAS float*)lds;
    const bf16_t* projb = c.proj() + (size_t)b * T * NPROJ;
    const float* rpb = c.in(8) + ((size_t)l * 5 + h) * 15 * 31;
    const int rs = min(max(r - 4, 0), 24), cs = min(max(q - 8, 0), 48);
    float qv[64];
    { const bf16_t* qp = projb + (size_t)(r * 64 + q) * NPROJ + P_NAQ + h * 64;
#pragma unroll
      for (int i = 0; i < 8; ++i) { float t8[8]; unpack8(*(const u32x4*)(qp + 8 * i), t8);
#pragma unroll
          for (int j = 0; j < 8; ++j) qv[8 * i + j] = t8[j]; } }
    const int tr = rs + s;
    for (int kk = 0; kk < 16; ++kk) { const int tc = cs + kk;
        const bf16_t* kp = projb + (size_t)(tr * 64 + tc) * NPROJ + P_NAK + h * 64; float d = 0.f;
#pragma unroll
        for (int i = 0; i < 8; ++i) { float t8[8]; unpack8(*(const u32x4*)(kp + 8 * i), t8);
#pragma unroll
            for (int j = 0; j < 8; ++j) d += qv[8 * i + j] * t8[j]; }
        const int dr = tr - r + 7, dc = min(max(tc - q, -15), 15) + 15;
        sc[q * 129 + s * 16 + kk] = d * 0.125f + rpb[dr * 31 + dc]; }
    __syncthreads();
    float mx = -3.0e38f; for (int k = 0; k < 128; ++k) mx = fmaxf(mx, sc[q * 129 + k]);
    float sum = 0.f; for (int k = 0; k < 128; ++k) sum += __expf(sc[q * 129 + k] - mx);
    __syncthreads();
    const float inv = 1.0f / sum;
    for (int kk = 0; kk < 16; ++kk) sc[q * 129 + s * 16 + kk] = __expf(sc[q * 129 + s * 16 + kk] - mx) * inv;
    __syncthreads();
    float o[8];
#pragma unroll
    for (int j = 0; j < 8; ++j) o[j] = 0.f;
    for (int key = 0; key < 128; ++key) { const int trr = rs + (key >> 4), tcc = cs + (key & 15);
        float t8[8]; unpack8(*(const u32x4*)(projb + (size_t)(trr * 64 + tcc) * NPROJ + P_NAV + h * 64 + s * 8), t8); const float p = sc[q * 129 + key];
#pragma unroll
        for (int j = 0; j < 8; ++j) o[j] += p * t8[j]; }
    u32x4 w; w.x = pk2(o[0], o[1]); w.y = pk2(o[2], o[3]); w.z = pk2(o[4], o[5]); w.w = pk2(o[6], o[7]);
    *(u32x4*)(c.mixed() + ((size_t)b * T + r * 64 + q) * D + 384 + h * 64 + s * 8) = w;
    __syncthreads();
}
__device__ __forceinline__ void xattn_item(const Ctx& c0, int item, LAS unsigned char* lds) {
    LAUNDER_CTX(c0, c);
    const int b = item / 256, hd = (item / 64) % 4, qt = item % 64; const int row0 = b * T + qt * 32;
    LAS float* qs = (LAS float*)lds;
    LAS float* ps = (LAS float*)lds + 8192;
    const int qi = c.tid >> 4, sub = c.tid & 15;
    { const bf16_t* qp = c.q() + (size_t)(row0 + qi) * D + hd * 256 + sub * 16; float t8[8];
      unpack8(*(const u32x4*)qp, t8);
#pragma unroll
      for (int j = 0; j < 8; ++j) qs[qi * 256 + sub * 16 + j] = t8[j];
      unpack8(*(const u32x4*)(qp + 8), t8);
#pragma unroll
      for (int j = 0; j < 8; ++j) qs[qi * 256 + sub * 16 + 8 + j] = t8[j]; }
    __syncthreads();
    const bf16_t* kvb = c.memkv() + (size_t)b * NMEM * 2048 + hd * 256;
    float acc[16];
#pragma unroll
    for (int j = 0; j < 16; ++j) acc[j] = 0.f;
    for (int dc = 0; dc < 32; ++dc) {
        float qr[8];
#pragma unroll
        for (int i = 0; i < 8; ++i) qr[i] = qs[qi * 256 + dc * 8 + i];
#pragma unroll
        for (int j = 0; j < 16; ++j) { float t8[8]; unpack8(*(const u32x4*)(kvb + (size_t)(sub + 16 * j) * 2048 + dc * 8), t8);
#pragma unroll
            for (int i = 0; i < 8; ++i) acc[j] += qr[i] * t8[i]; }
    }
    float mx = -3.0e38f;
#pragma unroll
    for (int j = 0; j < 16; ++j) { acc[j] *= 0.0625f; mx = fmaxf(mx, acc[j]); }
#pragma unroll
    for (int o = 1; o < 16; o <<= 1) mx = fmaxf(mx, __shfl_xor(mx, o));
    float sum = 0.f;
#pragma unroll
    for (int j = 0; j < 16; ++j) { acc[j] = __expf(acc[j] - mx); sum += acc[j]; }
#pragma unroll
    for (int o = 1; o < 16; o <<= 1) sum += __shfl_xor(sum, o);
    const float inv = 1.0f / sum;
#pragma unroll
    for (int j = 0; j < 16; ++j) ps[qi * 256 + sub + 16 * j] = acc[j] * inv;
    __syncthreads();
    float o[16];
#pragma unroll
    for (int j = 0; j < 16; ++j) o[j] = 0.f;
    for (int key = 0; key < 256; ++key) { const float p = ps[qi * 256 + key]; const bf16_t* vp = kvb + (size_t)key * 2048 + 1024 + sub * 16; float t8[8];
        unpack8(*(const u32x4*)vp, t8);
#pragma unroll
        for (int j = 0; j < 8; ++j) o[j] += p * t8[j];
        unpack8(*(const u32x4*)(vp + 8), t8);
#pragma unroll
        for (int j = 0; j < 8; ++j) o[8 + j] += p * t8[j]; }
    bf16_t* op = c.mixed() + (size_t)(row0 + qi) * D + hd * 256 + sub * 16;
    u32x4 w; w.x = pk2(o[0], o[1]); w.y = pk2(o[2], o[3]); w.z = pk2(o[4], o[5]); w.w = pk2(o[6], o[7]); *(u32x4*)op = w;
    w.x = pk2(o[8], o[9]); w.y = pk2(o[10], o[11]); w.z = pk2(o[12], o[13]); w.w = pk2(o[14], o[15]); *(u32x4*)(op + 8) = w;
    __syncthreads();
}
__device__ __forceinline__ void act_pass(const Ctx& c, int l) {
    const float* cw = c.in(21) + (size_t)l * 3 * DFF; const float* cb = c.in(22) + (size_t)l * DFF;
    constexpr int CH = DFF / 8;
    for (int idx = c.bid * NTHREADS + c.tid; idx < M * CH; idx += c.G * NTHREADS) {
        const int row = idx / CH, c8 = (idx % CH) * 8, t = row % T;
        const bf16_t* up = c.u() + (size_t)row * NUP + c8;
        float a0[8], am[8], ap[8], g[8];
        unpack8(*(const u32x4*)up, a0); unpack8(*(const u32x4*)(up + DFF), g);
        if (t > 0) unpack8(*(const u32x4*)(up - NUP), am); else {
#pragma unroll
            for (int j = 0; j < 8; ++j) am[j] = 0.f; }
        if (t < T - 1) unpack8(*(const u32x4*)(up + NUP), ap); else {
#pragma unroll
            for (int j = 0; j < 8; ++j) ap[j] = 0.f; }
        float o[8];
#pragma unroll
        for (int j = 0; j < 8; ++j) { const float a = am[j] * cw[c8 + j] + a0[j] * cw[DFF + c8 + j] + ap[j] * cw[2 * DFF + c8 + j] + cb[c8 + j];
            const float uu = 0.7978845608028654f * (a + 0.044715f * a * a * a);
            o[j] = a * rcpf_(1.f + __expf(-2.f * uu)) * g[j]; }
        u32x4 w; w.x = pk2(o[0], o[1]); w.y = pk2(o[2], o[3]); w.z = pk2(o[4], o[5]); w.w = pk2(o[6], o[7]);
        *(u32x4*)(c.act() + (size_t)row * DFF + c8) = w;
    }
}
typedef short s16x4 __attribute__((ext_vector_type(4)));
#define MFMA16(a, b, c) __builtin_amdgcn_mfma_f32_16x16x32_bf16((a), (b), (c), 0, 0, 0)
__device__ __forceinline__ bf16x8 frag_nt(LAS const unsigned char* tile, int pitch, int row, int kbyte) {
    return *(const LAS bf16x8*)(tile + row * pitch + kbyte);
}
__device__ __forceinline__ bf16x8 frag_tr(LAS const unsigned char* tile, int pitch, int r0, int r1, int n0, int lane) {
    const int q4 = (lane & 15) >> 2, p4 = lane & 3;
    const unsigned a0 = (unsigned)(size_t)tile + (unsigned)((r0 + q4) * pitch + (n0 + 4 * p4) * 2), a1 = (unsigned)(size_t)tile + (unsigned)((r1 + q4) * pitch + (n0 + 4 * p4) * 2);
    s16x4 x, y;
    asm volatile("ds_read_b64_tr_b16 %0, %2\n\tds_read_b64_tr_b16 %1, %3\n\ts_waitcnt lgkmcnt(0)" : "=&v"(x), "=&v"(y) : "v"(a0), "v"(a1) : "memory");
    return (bf16x8){x[0], x[1], x[2], x[3], y[0], y[1], y[2], y[3]};
}
__device__ __forceinline__ void frag_tr_x4(LAS const unsigned char* tile, int pitch, int r0, int r1, int n0, int lane, bf16x8 (&out)[4]) {
    const int q4 = (lane & 15) >> 2, p4 = lane & 3;
    const unsigned a0 = (unsigned)(size_t)tile + (unsigned)((r0 + q4) * pitch + (n0 + 4 * p4) * 2), a1 = (unsigned)(size_t)tile + (unsigned)((r1 + q4) * pitch + (n0 + 4 * p4) * 2);
    s16x4 x0, y0, x1, y1, x2, y2, x3, y3;
    asm volatile("ds_read_b64_tr_b16 %0, %8\n\tds_read_b64_tr_b16 %1, %9\n\tds_read_b64_tr_b16 %2, %8 offset:32\n\tds_read_b64_tr_b16 %3, %9 offset:32\n\t"
                 "ds_read_b64_tr_b16 %4, %8 offset:64\n\tds_read_b64_tr_b16 %5, %9 offset:64\n\tds_read_b64_tr_b16 %6, %8 offset:96\n\tds_read_b64_tr_b16 %7, %9 offset:96\n\ts_waitcnt lgkmcnt(0)"
                 : "=&v"(x0), "=&v"(y0), "=&v"(x1), "=&v"(y1), "=&v"(x2), "=&v"(y2), "=&v"(x3), "=&v"(y3) : "v"(a0), "v"(a1) : "memory");
    out[0] = (bf16x8){x0[0], x0[1], x0[2], x0[3], y0[0], y0[1], y0[2], y0[3]}; out[1] = (bf16x8){x1[0], x1[1], x1[2], x1[3], y1[0], y1[1], y1[2], y1[3]};
    out[2] = (bf16x8){x2[0], x2[1], x2[2], x2[3], y2[0], y2[1], y2[2], y2[3]}; out[3] = (bf16x8){x3[0], x3[1], x3[2], x3[3], y3[0], y3[1], y3[2], y3[3]};
}
__device__ __forceinline__ bf16x8 pack_frag(const f32x4 lo, const f32x4 hi) {
    u32x4 w; w.x = cvt_pk_bf16(lo[0], lo[1]); w.y = cvt_pk_bf16(lo[2], lo[3]); w.z = cvt_pk_bf16(hi[0], hi[1]); w.w = cvt_pk_bf16(hi[2], hi[3]);
    return __builtin_bit_cast(bf16x8, w);
}
__device__ __forceinline__ float logsigmoidf_(float x) { return fminf(x, 0.f) - __logf(1.f + __expf(-fabsf(x))); }
__device__ __forceinline__ float wave_incl_scan(float v, int lane) {
#pragma unroll
    for (int o = 1; o < 64; o <<= 1) { const float t = shup(v, o); if (lane >= o) v += t; }
    return v;
}
constexpr int P64 = 144;

constexpr size_t WS_KC = WS_Q;
constexpr size_t WS_GT = WS_ACT + 64 * MiB;
constexpr size_t WS_MLC = WS_HSML, WS_GLC = WS_MLC + 15 * MiB, WS_MLD = WS_GLC + 10 * MiB, WS_GLD = WS_MLD + 15 * MiB, WS_MLG = WS_GLD + 10 * MiB, WS_GLB = WS_MLG + 64 * 1024;
__device__ __forceinline__ bf16_t* mlc_ptr(const Ctx& c, int b, int h, int dir, int ch) { return c.wsp<bf16_t>(WS_MLC) + (size_t)((((b * 6 + h) * 2 + dir) * 16) + ch) * 80 * 64; }

template <bool ROWW>
__device__ __forceinline__ void ml_stage_conv(const Ctx& c, const bf16_t* projb, int t0, int pcol, const float* cwp, const float* cbp, int cch, float scale, const LAS float* roww, LAS unsigned char* tile,
                                              const LAS float* roww2 = nullptr, LAS unsigned char* tile2 = nullptr, bf16_t* gcopy = nullptr) {
    const int j = c.tid >> 2, cb = (c.tid & 3) * 16, t = t0 + j;
    float lo[16], mid[16], hi[16];
    { const bf16_t* p = projb + (size_t)t * NPROJ + pcol + cb; float t8[8];
      unpack8(*(const u32x4*)p, t8);
#pragma unroll
      for (int x = 0; x < 8; ++x) mid[x] = t8[x];
      unpack8(*(const u32x4*)(p + 8), t8);
#pragma unroll
      for (int x = 0; x < 8; ++x) mid[8 + x] = t8[x];
      if (t > 0) { unpack8(*(const u32x4*)(p - NPROJ), t8);
#pragma unroll
          for (int x = 0; x < 8; ++x) lo[x] = t8[x];
          unpack8(*(const u32x4*)(p - NPROJ + 8), t8);
#pragma unroll
          for (int x = 0; x < 8; ++x) lo[8 + x] = t8[x]; }
      else {
#pragma unroll
          for (int x = 0; x < 16; ++x) lo[x] = 0.f; }
      if (t < T - 1) { unpack8(*(const u32x4*)(p + NPROJ), t8);
#pragma unroll
          for (int x = 0; x < 8; ++x) hi[x] = t8[x];
          unpack8(*(const u32x4*)(p + NPROJ + 8), t8);
#pragma unroll
          for (int x = 0; x < 8; ++x) hi[8 + x] = t8[x]; }
      else {
#pragma unroll
          for (int x = 0; x < 16; ++x) hi[x] = 0.f; } }
    float o[16];
#pragma unroll
    for (int x = 0; x < 16; ++x) { const int ch = cch + cb + x;
        const float y = lo[x] * cwp[ch] + mid[x] * cwp[768 + ch] + hi[x] * cwp[1536 + ch] + cbp[ch];
        o[x] = y * sigmoidf_(y) * scale; }
    u32x4 w0, w1;
    if (gcopy) { w0.x = pk2(o[0], o[1]); w0.y = pk2(o[2], o[3]); w0.z = pk2(o[4], o[5]); w0.w = pk2(o[6], o[7]);
        w1.x = pk2(o[8], o[9]); w1.y = pk2(o[10], o[11]); w1.z = pk2(o[12], o[13]); w1.w = pk2(o[14], o[15]);
        *(u32x4*)(gcopy + j * 64 + cb) = w0; *(u32x4*)(gcopy + j * 64 + cb + 8) = w1; }
    { const float rw = ROWW ? roww[j] : 1.0f;
      w0.x = pk2(o[0] * rw, o[1] * rw); w0.y = pk2(o[2] * rw, o[3] * rw); w0.z = pk2(o[4] * rw, o[5] * rw); w0.w = pk2(o[6] * rw, o[7] * rw);
      w1.x = pk2(o[8] * rw, o[9] * rw); w1.y = pk2(o[10] * rw, o[11] * rw); w1.z = pk2(o[12] * rw, o[13] * rw); w1.w = pk2(o[14] * rw, o[15] * rw);
      *(LAS u32x4*)(tile + j * P64 + cb * 2) = w0; *(LAS u32x4*)(tile + j * P64 + cb * 2 + 16) = w1; }
    if (tile2) { const float rw = roww2[j];
      w0.x = pk2(o[0] * rw, o[1] * rw); w0.y = pk2(o[2] * rw, o[3] * rw); w0.z = pk2(o[4] * rw, o[5] * rw); w0.w = pk2(o[6] * rw, o[7] * rw);
      w1.x = pk2(o[8] * rw, o[9] * rw); w1.y = pk2(o[10] * rw, o[11] * rw); w1.z = pk2(o[12] * rw, o[13] * rw); w1.w = pk2(o[14] * rw, o[15] * rw);
      *(LAS u32x4*)(tile2 + j * P64 + cb * 2) = w0; *(LAS u32x4*)(tile2 + j * P64 + cb * 2 + 16) = w1; }
}
__device__ __forceinline__ void ml_stage_plain(const Ctx& c, const bf16_t* projb, int t0, int pcol, LAS unsigned char* tile) {
    const int j = c.tid >> 2, cb = (c.tid & 3) * 16; const bf16_t* p = projb + (size_t)(t0 + j) * NPROJ + pcol + cb;
    *(LAS u32x4*)(tile + j * P64 + cb * 2) = *(const u32x4*)p; *(LAS u32x4*)(tile + j * P64 + cb * 2 + 16) = *(const u32x4*)(p + 8);
}
__device__ __forceinline__ float ml_gate_scan(const float* gatesb, int t0, int dir, int h, float bi, float bf_, LAS float* bcum, LAS float* ii, int lane) {
    const float* g0 = gatesb + (size_t)(t0 + 2 * lane) * 64; const float* g1 = g0 + 64;
    const float i0 = g0[(2 * dir) * 6 + h] + bi, i1 = g1[(2 * dir) * 6 + h] + bi;
    const float f0 = logsigmoidf_(g0[(2 * dir + 1) * 6 + h] + bf_), f1 = logsigmoidf_(g1[(2 * dir + 1) * 6 + h] + bf_);
    const float inc = wave_incl_scan(f0 + f1, lane), tot = shl(inc, 63);
    float b0, b1;
    if (dir == 0) { b0 = inc - f1; b1 = inc; } else { b1 = tot - inc + f1; b0 = b1 + f0; }
    bcum[2 * lane] = b0; bcum[2 * lane + 1] = b1; ii[2 * lane] = i0; ii[2 * lane + 1] = i1;
    return tot;
}

__device__ __forceinline__ bf16_t* mld_ptr(const Ctx& c, int b, int h, int dir, int ch) { return c.wsp<bf16_t>(WS_MLD) + (size_t)((((b * 6 + h) * 2 + dir) * 16) + ch) * 80 * 64; }
constexpr int P80 = 176;

__device__ __forceinline__ void ml_delta_item(const Ctx& c0, int l, int item, LAS unsigned char* lds) {
    LAUNDER_CTX(c0, c);
    const int b = item / 96, h = (item % 96) / 16, ch = item % 16, t0 = ch * 128;
    const int lane = c.lane, w = c.wave, i = lane & 15, g = lane >> 4;
    LAS unsigned char* Kf = lds; LAS unsigned char* Kb = lds + 128 * P64; LAS unsigned char* Vx = lds + 2 * 128 * P64;
    LAS float* bF = (LAS float*)(Vx + 128 * P80); LAS float* iF = bF + 128; LAS float* bB = bF + 256; LAS float* iB = bF + 384; LAS float* wf = bF + 512; LAS float* wb = bF + 640;
    const bf16_t* projb = c.proj() + (size_t)b * T * NPROJ; const float* gatesb = c.gates() + (size_t)b * T * 64;
    const float* cwp = c.in(4) + (size_t)l * 3 * 768; const float* cbp = c.in(5) + (size_t)l * 768; const float* gb = c.in(6) + l * 24;
    if (w < 2) { const int dir = w; LAS float* bc = dir ? bB : bF; LAS float* ii = dir ? iB : iF; LAS float* ww = dir ? wb : wf;
        const float tot = ml_gate_scan(gatesb, t0, dir, h, gb[(2 * dir) * 6 + h], gb[(2 * dir + 1) * 6 + h], bc, ii, lane);
        ww[2 * lane] = __expf(tot - bc[2 * lane] + ii[2 * lane]); ww[2 * lane + 1] = __expf(tot - bc[2 * lane + 1] + ii[2 * lane + 1]);
        if (lane == 0) c.wsp<float>(WS_MLG)[(((b * 6 + h) * 2 + dir) * 16) + ch] = tot; }
    __syncthreads();
    ml_stage_conv<true>(c, projb, t0, P_MLK + h * 64, cwp, cbp, 384 + h * 64, 0.125f, wf, Kf, wb, Kb, c.wsp<bf16_t>(WS_KC) + (size_t)item * 128 * 64);
    { const int j = c.tid >> 2, cb = (c.tid & 3) * 16; const bf16_t* p = projb + (size_t)(t0 + j) * NPROJ + P_MLV + h * 64 + cb;
      *(LAS u32x4*)(Vx + j * P80 + cb * 2) = *(const u32x4*)p; *(LAS u32x4*)(Vx + j * P80 + cb * 2 + 16) = *(const u32x4*)(p + 8);
      if ((c.tid & 3) == 0) { unsigned one = 0x3f80u, zero = 0u; asm volatile("" : "+v"(one), "+v"(zero));
          *(LAS u32x4*)(Vx + j * P80 + 128) = (u32x4){one, zero, zero, zero}; *(LAS u32x4*)(Vx + j * P80 + 144) = (u32x4){zero, zero, zero, zero}; } }
    __syncthreads();
    const int dir = w >> 2, td = w & 3; LAS unsigned char* Kw = dir ? Kb : Kf;
    f32x4 acc[5];
#pragma unroll
    for (int x = 0; x < 5; ++x) acc[x] = zero4();
#pragma unroll
    for (int s = 0; s < 4; ++s) { const int r0 = 32 * s + 8 * g, r1 = r0 + 4;
        const bf16x8 a = frag_tr(Kw, P64, r0, r1, 16 * td, lane);
        bf16x8 b4[4];
#pragma unroll
        for (int x = 0; x < 4; ++x) b4[x] = frag_tr(Vx, P80, r0, r1, 16 * x, lane);
        const bf16x8 b5 = frag_tr(Vx, P80, r0, r1, 64, lane);
#pragma unroll
        for (int x = 0; x < 4; ++x) acc[x] = MFMA16(a, b4[x], acc[x]);
        acc[4] = MFMA16(a, b5, acc[4]); }
    bf16_t* dst = mld_ptr(c, b, h, dir, ch);
#pragma unroll
    for (int x = 0; x < 5; ++x) { const int e = 16 * x + i, d = 16 * td + 4 * g;
        *(unsigned long long*)(dst + e * 64 + d) = (unsigned long long)cvt_pk_bf16(acc[x][0], acc[x][1]) | ((unsigned long long)cvt_pk_bf16(acc[x][2], acc[x][3]) << 32); }
    __syncthreads();
}
__device__ __forceinline__ void ml_scan(const Ctx& c, int gt, int ngt) {
    for (int t = gt; t < 96 * 1280; t += ngt) { const int bhd = t / 1280, off = (t % 1280) * 4, dir = bhd & 1;
        const bf16_t* dsrc = c.wsp<bf16_t>(WS_MLD) + (size_t)bhd * 16 * 5120 + off;
#if MK_OLD_STATES == 3
        bf16_t* cdst = c.wsp<bf16_t>(WS_MLC2) + (size_t)bhd * 16 * 5120 + off;
#else
        bf16_t* cdst = c.wsp<bf16_t>(WS_MLC) + (size_t)bhd * 16 * 5120 + off;
#endif
        const float* gs = c.wsp<float>(WS_MLG) + bhd * 16;
        float C0 = 0.f, C1 = 0.f, C2 = 0.f, C3 = 0.f;
#pragma unroll
        for (int cc = 0; cc < 16; ++cc) { const int ch = dir ? 15 - cc : cc;
            *(unsigned long long*)(cdst + (size_t)ch * 5120) = (unsigned long long)pk2(C0, C1) | ((unsigned long long)pk2(C2, C3) << 32);
            if (cc == 15) break;
            const unsigned long long dw = *(const unsigned long long*)(dsrc + (size_t)ch * 5120); const float eg = __expf(gs[ch]);
            C0 = eg * C0 + bf2f((unsigned)dw & 0xffffu); C1 = eg * C1 + bf2f((unsigned)(dw >> 16) & 0xffffu); C2 = eg * C2 + bf2f((unsigned)(dw >> 32) & 0xffffu); C3 = eg * C3 + bf2f((unsigned)(dw >> 48)); }
    }
}

__device__ __forceinline__ void ml_out_item(const Ctx& c0, int l, int item, LAS unsigned char* lds) {
    LAUNDER_CTX(c0, c);
    const int b = item / 96, h = (item % 96) / 16, ch = item % 16, t0 = ch * 128;
    const int lane = c.lane, w = c.wave, i = lane & 15, g = lane >> 4;
    LAS unsigned char* Qt = lds; LAS unsigned char* Kt = lds + 128 * P64; LAS unsigned char* Vt = lds + 2 * 128 * P64;
    LAS unsigned char* Cf = lds + 3 * 128 * P64; LAS unsigned char* Cb = Cf + 80 * P64;
    LAS float* bF = (LAS float*)(Cb + 80 * P64); LAS float* iF = bF + 128; LAS float* bB = bF + 256; LAS float* iB = bF + 384;
    const bf16_t* projb = c.proj() + (size_t)b * T * NPROJ; const float* gatesb = c.gates() + (size_t)b * T * 64;
    const float* cwp = c.in(4) + (size_t)l * 3 * 768; const float* cbp = c.in(5) + (size_t)l * 768; const float* gb = c.in(6) + l * 24;
    if (w == 0) (void)ml_gate_scan(gatesb, t0, 0, h, gb[0 * 6 + h], gb[1 * 6 + h], bF, iF, lane);
    if (w == 1) (void)ml_gate_scan(gatesb, t0, 1, h, gb[2 * 6 + h], gb[3 * 6 + h], bB, iB, lane);
    ml_stage_conv<false>(c, projb, t0, P_MLQ + h * 64, cwp, cbp, h * 64, 1.0f, nullptr, Qt);
    { const bf16_t* kc = c.wsp<bf16_t>(WS_KC) + (size_t)item * 128 * 64; const int j = c.tid >> 2, cb = (c.tid & 3) * 16;
      *(LAS u32x4*)(Kt + j * P64 + cb * 2) = *(const u32x4*)(kc + j * 64 + cb); *(LAS u32x4*)(Kt + j * P64 + cb * 2 + 16) = *(const u32x4*)(kc + j * 64 + cb + 8); }
    ml_stage_plain(c, projb, t0, P_MLV + h * 64, Vt);
    { const bf16_t* sf = mlc_ptr(c, b, h, 0, ch); const bf16_t* sb = mlc_ptr(c, b, h, 1, ch);
      for (int x = c.tid; x < 80 * 8; x += NTHREADS) { const int r = x >> 3, k8 = x & 7;
          *(LAS u32x4*)(Cf + r * P64 + k8 * 16) = *(const u32x4*)(sf + r * 64 + k8 * 8); *(LAS u32x4*)(Cb + r * P64 + k8 * 16) = *(const u32x4*)(sb + r * 64 + k8 * 8); } }
    __syncthreads();
    const int ti = w, qi = 16 * ti + i;
    const bf16x8 q0 = frag_nt(Qt, P64, qi, 16 * g), q1 = frag_nt(Qt, P64, qi, 64 + 16 * g);
    const float bFq = bF[qi], bBq = bB[qi];
    f32x4 of[4], ob[4];
#pragma unroll
    for (int x = 0; x < 4; ++x) { of[x] = zero4(); ob[x] = zero4(); }
    float denf = 0.f, denb = 0.f;
#pragma unroll
    for (int s4 = 0; s4 < 4; ++s4) {
        const bool dof = (2 * s4 <= ti), dob = (2 * s4 + 1 >= ti);
        f32x4 pf[2], pb[2];
#pragma unroll
        for (int x = 0; x < 2; ++x) { const int tj = 2 * s4 + x;
            f32x4 s = zero4();
            s = MFMA16(frag_nt(Kt, P64, 16 * tj + i, 16 * g), q0, s); s = MFMA16(frag_nt(Kt, P64, 16 * tj + i, 64 + 16 * g), q1, s);
#pragma unroll
            for (int r = 0; r < 4; ++r) { const int j = 16 * tj + 4 * g + r;
                const float wf = (j <= qi) ? __expf(bFq - bF[j] + iF[j]) : 0.f, wb = (j >= qi) ? __expf(bBq - bB[j] + iB[j]) : 0.f;
                pf[x][r] = s[r] * wf; pb[x][r] = s[r] * wb; denf += pf[x][r]; denb += pb[x][r]; } }
        const int r0 = 32 * s4 + 4 * g, r1 = r0 + 16;
        bf16x8 v4[4]; frag_tr_x4(Vt, P64, r0, r1, 0, lane, v4);
        if (dof) { const bf16x8 p = pack_frag(pf[0], pf[1]);
#pragma unroll
            for (int te = 0; te < 4; ++te) of[te] = MFMA16(v4[te], p, of[te]); }
        if (dob) { const bf16x8 p = pack_frag(pb[0], pb[1]);
#pragma unroll
            for (int te = 0; te < 4; ++te) ob[te] = MFMA16(v4[te], p, ob[te]); }
    }
    denf += shx(denf, 16); denf += shx(denf, 32); denb += shx(denb, 16); denb += shx(denb, 32);
    { const float ef = __expf(bFq), eb = __expf(bBq);
#pragma unroll
      for (int te = 0; te < 5; ++te) {
          f32x4 tf = zero4(), tb = zero4();
          tf = MFMA16(frag_nt(Cf, P64, 16 * te + i, 16 * g), q0, tf); tf = MFMA16(frag_nt(Cf, P64, 16 * te + i, 64 + 16 * g), q1, tf);
          tb = MFMA16(frag_nt(Cb, P64, 16 * te + i, 16 * g), q0, tb); tb = MFMA16(frag_nt(Cb, P64, 16 * te + i, 64 + 16 * g), q1, tb);
          if (te < 4) { of[te] = of[te] + tf * ef; ob[te] = ob[te] + tb * eb; }
          else { denf += ef * shl(tf[0], i); denb += eb * shl(tb[0], i); } } }
    const float rf = rcpf_(fmaxf(fabsf(denf), 1.f)), rb = rcpf_(fmaxf(fabsf(denb), 1.f));
    float ss = 0.f;
#pragma unroll
    for (int te = 0; te < 4; ++te) { of[te] = of[te] * rf + ob[te] * rb; ss += (of[te][0] * of[te][0] + of[te][1] * of[te][1]) + (of[te][2] * of[te][2] + of[te][3] * of[te][3]); }
    ss += shx(ss, 16); ss += shx(ss, 32);
    const float rn = rsqf_(ss * (1.0f / 64) + EPS);
    const float* ng = c.in(7) + l * 384 + h * 64;
    const size_t row = (size_t)b * T + t0 + qi;
#pragma unroll
    for (int te = 0; te < 4; ++te) { const int e = 16 * te + 4 * g;
        const unsigned long long ow = *(const unsigned long long*)(projb + (size_t)(t0 + qi) * NPROJ + P_MLO + h * 64 + e);
        float o4[4];
#pragma unroll
        for (int r = 0; r < 4; ++r) { const float og = bf2f((unsigned)(ow >> (16 * r)) & 0xffffu); o4[r] = of[te][r] * rn * ng[e + r] * sigmoidf_(og); }
        *(unsigned long long*)(c.mixed() + row * D + h * 64 + e) = (unsigned long long)pk2(o4[0], o4[1]) | ((unsigned long long)pk2(o4[2], o4[3]) << 32); }
    __syncthreads();
}

constexpr int P32 = 80;
constexpr int LAP = 33;
__device__ __forceinline__ bf16_t* glc_ptr(const Ctx& c, int b, int h, int dir, int ch) { return c.wsp<bf16_t>(WS_GLC) + (size_t)((((b * 5 + h) * 2 + dir) * 32) + ch) * 64 * 32; }
__device__ __forceinline__ void gla_loga(const Ctx& c, const float* gatesb, int t0, int nrows, int dir, const LAS float* w2s  , const LAS float* abs_  , LAS float* la  ) {
    for (int x = c.tid; x < nrows * 8; x += NTHREADS) { const int j = x >> 3, d4 = (x & 7) * 4;
        const float* gp = gatesb + (size_t)(t0 + j) * 64 + 24 + dir * 16; float ga[16];
#pragma unroll
        for (int r4 = 0; r4 < 4; ++r4) { const f32x4 v = *(const f32x4*)(gp + 4 * r4); ga[4 * r4] = v[0]; ga[4 * r4 + 1] = v[1]; ga[4 * r4 + 2] = v[2]; ga[4 * r4 + 3] = v[3]; }
#pragma unroll
        for (int y = 0; y < 4; ++y) { float z = abs_[d4 + y];
#pragma unroll
            for (int r = 0; r < 16; ++r) z += ga[r] * w2s[r * 32 + d4 + y];
            la[j * LAP + d4 + y] = logsigmoidf_(z) * (1.0f / 16.0f); } }
}
__device__ __forceinline__ void gla_scan64(LAS float* la  , int dir, int d, int lane, LAS float* tot) {
    const float v = la[lane * LAP + d]; const float inc = wave_incl_scan(v, lane), t = shl(inc, 63);
    la[lane * LAP + d] = dir ? (t - inc + v) : inc;
    if (tot && lane == 0) tot[d] = t;
}

__device__ __forceinline__ bf16_t* gld_ptr(const Ctx& c, int b, int h, int dir, int ch) { return c.wsp<bf16_t>(WS_GLD) + (size_t)((((b * 5 + h) * 2 + dir) * 32) + ch) * 64 * 32; }
__device__ __forceinline__ void gla_delta_item(const Ctx& c0, int l, int item, LAS unsigned char* lds) {
    LAUNDER_CTX(c0, c);
    const int b = item / 80, h = (item % 80) / 16, cp = item % 16, t0 = cp * 128;
    const int lane = c.lane, w = c.wave, i = lane & 15, g = lane >> 4;
    LAS unsigned char* Kf = lds; LAS unsigned char* Kb = Kf + 128 * P32;
    LAS unsigned char* Vt = Kb + 128 * P32;
    LAS float* laf = (LAS float*)(Vt + 128 * P64); LAS float* lab = laf + 128 * LAP;
    LAS float* w2s = lab + 128 * LAP; LAS float* abs_ = w2s + 1024; LAS float* btot = abs_ + 64;
    const bf16_t* projb = c.proj() + (size_t)b * T * NPROJ; const float* gatesb = c.gates() + (size_t)b * T * 64;
    { const float* w2 = c.in(9) + (size_t)l * 2 * 16 * 160; const float* ab = c.in(10) + (size_t)l * 2 * 160;
      for (int x = c.tid; x < 1024; x += NTHREADS) w2s[x] = w2[(x >> 5) * 160 + h * 32 + (x & 31)];
      if (c.tid < 64) abs_[c.tid] = ab[(c.tid >> 5) * 160 + h * 32 + (c.tid & 31)]; }
    __syncthreads();
    gla_loga(c, gatesb, t0, 128, 0, w2s, abs_, laf);
    gla_loga(c, gatesb, t0, 128, 1, w2s + 512, abs_ + 32, lab);
    __syncthreads();
#pragma unroll 4
    for (int y = 0; y < 16; ++y) { const int sidx = w * 16 + y, dir = sidx >> 6, sub = (sidx >> 5) & 1, d = sidx & 31;
        gla_scan64((dir ? lab : laf) + sub * 64 * LAP, dir, d, lane, btot + (dir * 2 + sub) * 32); }
    __syncthreads();
    { const int j = c.tid >> 2, d8 = (c.tid & 3) * 8;
      float q8[8], k8[8];
      unpack8(*(const u32x4*)(projb + (size_t)(t0 + j) * NPROJ + P_GQ + h * 32 + d8), q8); unpack8(*(const u32x4*)(projb + (size_t)(t0 + j) * NPROJ + P_GK + h * 32 + d8), k8);
      float oqf[8], okf[8], oqb[8], okb[8];
#pragma unroll
      for (int y = 0; y < 8; ++y) { const float bf_ = laf[j * LAP + d8 + y], bb_ = lab[j * LAP + d8 + y];
          oqf[y] = q8[y] * 0.17677669529663687f * __expf(bf_); okf[y] = k8[y] * __expf(-bf_); oqb[y] = q8[y] * 0.17677669529663687f * __expf(bb_); okb[y] = k8[y] * __expf(-bb_); }
      bf16_t* gt = c.wsp<bf16_t>(WS_GT) + (size_t)item * 4 * 128 * 32 + j * 32 + d8;
      u32x4 x;
      x.x = pk2(oqf[0], oqf[1]); x.y = pk2(oqf[2], oqf[3]); x.z = pk2(oqf[4], oqf[5]); x.w = pk2(oqf[6], oqf[7]); *(u32x4*)(gt) = x;
      x.x = pk2(okf[0], okf[1]); x.y = pk2(okf[2], okf[3]); x.z = pk2(okf[4], okf[5]); x.w = pk2(okf[6], okf[7]); *(u32x4*)(gt + 128 * 32) = x; *(LAS u32x4*)(Kf + j * P32 + d8 * 2) = x;
      x.x = pk2(oqb[0], oqb[1]); x.y = pk2(oqb[2], oqb[3]); x.z = pk2(oqb[4], oqb[5]); x.w = pk2(oqb[6], oqb[7]); *(u32x4*)(gt + 2 * 128 * 32) = x;
      x.x = pk2(okb[0], okb[1]); x.y = pk2(okb[2], okb[3]); x.z = pk2(okb[4], okb[5]); x.w = pk2(okb[6], okb[7]); *(u32x4*)(gt + 3 * 128 * 32) = x; *(LAS u32x4*)(Kb + j * P32 + d8 * 2) = x; }
    ml_stage_plain(c, projb, t0, P_GV + h * 64, Vt);
    if (c.tid < 128) { const int dir = c.tid >> 6, sub = (c.tid >> 5) & 1, d = c.tid & 31;
        c.wsp<float>(WS_GLB)[(size_t)((((b * 5 + h) * 2 + dir) * 32) + 2 * cp + sub) * 32 + d] = __expf(btot[(dir * 2 + sub) * 32 + d]); }
    __syncthreads();
    const int dir = w >> 2, sub = (w >> 1) & 1, td = w & 1, R = 64 * sub; LAS unsigned char* Kt = dir ? Kb : Kf;
    f32x4 acc[4];
#pragma unroll
    for (int x = 0; x < 4; ++x) acc[x] = zero4();
#pragma unroll
    for (int s = 0; s < 2; ++s) { const int r0 = R + 32 * s + 8 * g, r1 = r0 + 4;
        const bf16x8 a = frag_tr(Kt, P32, r0, r1, 16 * td, lane); bf16x8 b4[4]; frag_tr_x4(Vt, P64, r0, r1, 0, lane, b4);
#pragma unroll
        for (int x = 0; x < 4; ++x) acc[x] = MFMA16(a, b4[x], acc[x]); }
    float eb[4];
#pragma unroll
    for (int r = 0; r < 4; ++r) eb[r] = __expf(btot[(dir * 2 + sub) * 32 + 16 * td + 4 * g + r]);
    bf16_t* dst = gld_ptr(c, b, h, dir, 2 * cp + sub);
#pragma unroll
    for (int x = 0; x < 4; ++x) { const int e = 16 * x + i, d = 16 * td + 4 * g;
        *(unsigned long long*)(dst + e * 32 + d) = (unsigned long long)cvt_pk_bf16(acc[x][0] * eb[0], acc[x][1] * eb[1]) | ((unsigned long long)cvt_pk_bf16(acc[x][2] * eb[2], acc[x][3] * eb[3]) << 32); }
    __syncthreads();
}
__device__ __forceinline__ void gla_scan(const Ctx& c, int gt, int ngt) {
    for (int t = gt; t < 80 * 512; t += ngt) { const int bhd = t / 512, off = (t % 512) * 4, dir = bhd & 1, d = off & 31;
        const bf16_t* dsrc = c.wsp<bf16_t>(WS_GLD) + (size_t)bhd * 32 * 2048 + off; bf16_t* sdst = c.wsp<bf16_t>(WS_GLC) + (size_t)bhd * 32 * 2048 + off;
        const float* eb = c.wsp<float>(WS_GLB) + (size_t)bhd * 32 * 32 + d;
        float S0 = 0.f, S1 = 0.f, S2 = 0.f, S3 = 0.f;
#pragma unroll 8
        for (int cc = 0; cc < 32; ++cc) { const int ch = dir ? 31 - cc : cc;
            *(unsigned long long*)(sdst + (size_t)ch * 2048) = (unsigned long long)pk2(S0, S1) | ((unsigned long long)pk2(S2, S3) << 32);
            if (cc == 31) break;
            const unsigned long long dw = *(const unsigned long long*)(dsrc + (size_t)ch * 2048); const f32x4 e4 = *(const f32x4*)(eb + ch * 32);
            S0 = e4[0] * S0 + bf2f((unsigned)dw & 0xffffu); S1 = e4[1] * S1 + bf2f((unsigned)(dw >> 16) & 0xffffu); S2 = e4[2] * S2 + bf2f((unsigned)(dw >> 32) & 0xffffu); S3 = e4[3] * S3 + bf2f((unsigned)(dw >> 48)); }
    }
}

__device__ __forceinline__ void gla_out_item(const Ctx& c0, int l, int item, LAS unsigned char* lds) {
    LAUNDER_CTX(c0, c);
    const int b = item / 80, h = (item % 80) / 16, cp = item % 16, t0 = cp * 128;
    const int lane = c.lane, w = c.wave, i = lane & 15, g = lane >> 4;
    LAS unsigned char* Qf = lds; LAS unsigned char* Kf = Qf + 128 * P32; LAS unsigned char* Qb = Kf + 128 * P32; LAS unsigned char* Kb = Qb + 128 * P32;
    LAS unsigned char* Vt = Kb + 128 * P32;
    LAS unsigned char* Sf = Vt + 128 * P64;
    LAS unsigned char* Sb = Sf + 2 * 64 * P32;
    const bf16_t* projb = c.proj() + (size_t)b * T * NPROJ;
    { const bf16_t* gt = c.wsp<bf16_t>(WS_GT) + (size_t)item * 4 * 128 * 32; const int j = c.tid >> 2, d8 = (c.tid & 3) * 8;
      const u32x4 t0_ = *(const u32x4*)(gt + j * 32 + d8), t1_ = *(const u32x4*)(gt + 128 * 32 + j * 32 + d8), t2_ = *(const u32x4*)(gt + 2 * 128 * 32 + j * 32 + d8), t3_ = *(const u32x4*)(gt + 3 * 128 * 32 + j * 32 + d8);
      *(LAS u32x4*)(Qf + j * P32 + d8 * 2) = t0_; *(LAS u32x4*)(Kf + j * P32 + d8 * 2) = t1_; *(LAS u32x4*)(Qb + j * P32 + d8 * 2) = t2_; *(LAS u32x4*)(Kb + j * P32 + d8 * 2) = t3_; }
    ml_stage_plain(c, projb, t0, P_GV + h * 64, Vt);
    for (int x = c.tid; x < 2 * 2 * 64 * 4; x += NTHREADS) { const int dir = x >> 9, sub = (x >> 8) & 1, r = (x >> 2) & 63, k4 = x & 3;
        const bf16_t* s = glc_ptr(c, b, h, dir, 2 * cp + sub); *(LAS u32x4*)((dir ? Sb : Sf) + (sub * 64 + r) * P32 + k4 * 16) = *(const u32x4*)(s + r * 32 + k4 * 8); }
    __syncthreads();
    const int sub = w >> 2, ti = w & 3, R = 64 * sub, qi = 16 * ti + i;
    const bf16x8 qf = frag_nt(Qf, P32, R + qi, 16 * g), qb = frag_nt(Qb, P32, R + qi, 16 * g);
    f32x4 o[4];
#pragma unroll
    for (int te = 0; te < 4; ++te) o[te] = zero4();
#pragma unroll
    for (int s2 = 0; s2 < 2; ++s2) {
        f32x4 p[2];
#pragma unroll
        for (int x = 0; x < 2; ++x) { const int tj = 2 * s2 + x; const f32x4 z = zero4();
            const f32x4 sf = MFMA16(frag_nt(Kf, P32, R + 16 * tj + i, 16 * g), qf, z), sb = MFMA16(frag_nt(Kb, P32, R + 16 * tj + i, 16 * g), qb, z);
#pragma unroll
            for (int r = 0; r < 4; ++r) { const int j = 16 * tj + 4 * g + r; p[x][r] = ((j <= qi) ? sf[r] : 0.f) + ((j >= qi) ? sb[r] : 0.f); } }
        const bf16x8 pp = pack_frag(p[0], p[1]); const int r0 = R + 32 * s2 + 4 * g, r1 = r0 + 16;
        bf16x8 v4[4]; frag_tr_x4(Vt, P64, r0, r1, 0, lane, v4);
#pragma unroll
        for (int te = 0; te < 4; ++te) o[te] = MFMA16(v4[te], pp, o[te]);
    }
#pragma unroll
    for (int te = 0; te < 4; ++te) { o[te] = MFMA16(frag_nt(Sf, P32, R + 16 * te + i, 16 * g), qf, o[te]); o[te] = MFMA16(frag_nt(Sb, P32, R + 16 * te + i, 16 * g), qb, o[te]); }
    float ss = 0.f;
#pragma unroll
    for (int te = 0; te < 4; ++te) ss += (o[te][0] * o[te][0] + o[te][1] * o[te][1]) + (o[te][2] * o[te][2] + o[te][3] * o[te][3]);
    ss += shx(ss, 16); ss += shx(ss, 32);
    const float rn = rsqf_(ss * (1.0f / 64) + EPS);
    const float* ng = c.in(11) + l * 320 + h * 64;
    const int tq = t0 + R + qi;
#pragma unroll
    for (int te = 0; te < 4; ++te) { const int e = 16 * te + 4 * g;
        const unsigned long long gw = *(const unsigned long long*)(projb + (size_t)tq * NPROJ + P_GG + h * 64 + e); float o4[4];
#pragma unroll
        for (int r = 0; r < 4; ++r) { const float gg = bf2f((unsigned)(gw >> (16 * r)) & 0xffffu); o4[r] = o[te][r] * rn * ng[e + r] * gg * sigmoidf_(gg); }
        *(unsigned long long*)(c.mixed() + ((size_t)b * T + tq) * D + 704 + h * 64 + e) = (unsigned long long)pk2(o4[0], o4[1]) | ((unsigned long long)pk2(o4[2], o4[3]) << 32); }
    __syncthreads();
}

__device__ __forceinline__ int clampi(int v, int lo, int hi) { return min(max(v, lo), hi); }
__device__ __forceinline__ void na_mfma_item(const Ctx& c0, int l, int item, LAS unsigned char* lds) {
    LAUNDER_CTX(c0, c);
    const int b = item / 40, h = (item % 40) / 8, r0 = (item % 8) * 4;
    const int lane = c.lane, w = c.wave, i = lane & 15, g = lane >> 4;
    LAS unsigned char* Vb = lds;
    LAS float* rp = (LAS float*)(lds + 704 * P64);
    const bf16_t* projb = c.proj() + (size_t)b * T * NPROJ;
    const int base = clampi(r0 - 4, 0, 24), nrow = clampi(r0 - 1, 0, 24) + 8 - base;
    { u32x4 t_[11];
#pragma unroll
      for (int y = 0; y < 11; ++y) { const int x = c.tid + y * NTHREADS; if (y < nrow) t_[y] = *(const u32x4*)(projb + (size_t)(base * 64 + (x >> 3)) * NPROJ + P_NAV + h * 64 + (x & 7) * 8); }
#pragma unroll
      for (int y = 0; y < 11; ++y) { const int x = c.tid + y * NTHREADS; if (y < nrow) *(LAS u32x4*)(Vb + (x >> 3) * P64 + (x & 7) * 16) = t_[y]; } }
    { const float* rpb = c.in(8) + ((size_t)l * 5 + h) * 15 * 31; if (c.tid < 465) rp[c.tid] = rpb[c.tid]; }
    __syncthreads();
#pragma unroll 1
    for (int qq = 0; qq < 2; ++qq) {
        const int qb = 2 * w + qq, r = r0 + (qb >> 2), jq = qb & 3;
        const int rs = clampi(r - 4, 0, 24), kc0 = clampi(16 * jq - 8, 0, 32), cq = 16 * jq + i, cs = clampi(cq - 8, 0, 48);
        const bf16_t* qp = projb + (size_t)(r * 64 + cq) * NPROJ + P_NAQ + h * 64;
        const bf16x8 q0 = *(const bf16x8*)(qp + 8 * g), q1 = *(const bf16x8*)(qp + 32 + 8 * g);
        f32x4 s[16];
#pragma unroll
        for (int kt = 0; kt < 16; ++kt) { const int kr = kt >> 1, ct = kt & 1;
            const bf16_t* kp = projb + (size_t)((rs + kr) * 64 + kc0 + 16 * ct + i) * NPROJ + P_NAK + h * 64;
            const bf16x8 a0 = *(const bf16x8*)(kp + 8 * g), a1 = *(const bf16x8*)(kp + 32 + 8 * g);
            f32x4 z = zero4(); z = MFMA16(a0, q0, z); s[kt] = MFMA16(a1, q1, z); }
        float mx = -3.0e38f;
#pragma unroll
        for (int kt = 0; kt < 16; ++kt) { const int kr = kt >> 1, ct = kt & 1; const LAS float* rrow = rp + (rs + kr - r + 7) * 31;
#pragma unroll
            for (int rr = 0; rr < 4; ++rr) { const int tc = kc0 + 16 * ct + 4 * g + rr; const bool valid = (tc >= cs) && (tc < cs + 16);
                const float v = s[kt][rr] * 0.125f + rrow[clampi(tc - cq, -15, 15) + 15];
                s[kt][rr] = valid ? v : -3.0e38f; mx = fmaxf(mx, s[kt][rr]); } }
        mx = fmaxf(mx, shx(mx, 16)); mx = fmaxf(mx, shx(mx, 32));
        float sum = 0.f;
#pragma unroll
        for (int kt = 0; kt < 16; ++kt)
#pragma unroll
            for (int rr = 0; rr < 4; ++rr) { const float p = (s[kt][rr] > -1.0e38f) ? __expf(s[kt][rr] - mx) : 0.f; s[kt][rr] = p; sum += p; }
        sum += shx(sum, 16); sum += shx(sum, 32);
        f32x4 o[4];
#pragma unroll
        for (int te = 0; te < 4; ++te) o[te] = zero4();
#pragma unroll
        for (int kr = 0; kr < 8; ++kr) { const bf16x8 pp = pack_frag(s[2 * kr], s[2 * kr + 1]); const int ra = (rs + kr - base) * 64 + kc0 + 4 * g, rb = ra + 16;
            bf16x8 v4[4]; frag_tr_x4(Vb, P64, ra, rb, 0, lane, v4);
#pragma unroll
            for (int te = 0; te < 4; ++te) o[te] = MFMA16(v4[te], pp, o[te]); }
        const float inv = rcpf_(sum);
        bf16_t* op = c.mixed() + ((size_t)b * T + r * 64 + cq) * D + 384 + h * 64;
#pragma unroll
        for (int te = 0; te < 4; ++te) *(unsigned long long*)(op + 16 * te + 4 * g) = (unsigned long long)pk2(o[te][0] * inv, o[te][1] * inv) | ((unsigned long long)pk2(o[te][2] * inv, o[te][3] * inv) << 32);
    }
    __syncthreads();
}

constexpr int P256 = 528;
__device__ __forceinline__ void xattn_mfma_item(const Ctx& c0, int item, LAS unsigned char* lds) {
    LAUNDER_CTX(c0, c);
    const int b = item / 32, hd = (item / 8) % 4, qc = item % 8; const int row0 = b * T + qc * 256;
    const int lane = c.lane, w = c.wave, i = lane & 15, g = lane >> 4;
    LAS unsigned char* KV = lds;
    const bf16_t* kvb = c.memkv() + (size_t)b * NMEM * 2048 + hd * 256;
    { u32x4 t_[16];
#pragma unroll
      for (int y = 0; y < 16; ++y) { const int x = c.tid + y * NTHREADS; t_[y] = *(const u32x4*)(kvb + (size_t)(x >> 5) * 2048 + (x & 31) * 8); }
#pragma unroll
      for (int y = 0; y < 16; ++y) { const int x = c.tid + y * NTHREADS; *(LAS u32x4*)(KV + (x >> 5) * P256 + (x & 31) * 16) = t_[y]; } }
    __syncthreads();
    bf16x8 P[2][8]; float inv[2];
#pragma unroll
    for (int blk = 0; blk < 2; ++blk) {
        const bf16_t* qp = c.q() + (size_t)(row0 + 16 * (w + 8 * blk) + i) * D + hd * 256 + 8 * g;
        bf16x8 qf[8];
#pragma unroll
        for (int s8 = 0; s8 < 8; ++s8) qf[s8] = *(const bf16x8*)(qp + 32 * s8);
        f32x4 s[16];
#pragma unroll
        for (int tk = 0; tk < 16; ++tk) { f32x4 z = zero4();
#pragma unroll
            for (int s8 = 0; s8 < 8; ++s8) z = MFMA16(frag_nt(KV, P256, 16 * tk + i, (32 * s8 + 8 * g) * 2), qf[s8], z);
            s[tk] = z; }
        float mx = -3.0e38f;
#pragma unroll
        for (int tk = 0; tk < 16; ++tk) mx = fmaxf(fmaxf(mx, fmaxf(s[tk][0], s[tk][1])), fmaxf(s[tk][2], s[tk][3]));
        mx = fmaxf(mx, shx(mx, 16)); mx = fmaxf(mx, shx(mx, 32));
        float sum = 0.f;
#pragma unroll
        for (int tk = 0; tk < 16; ++tk)
#pragma unroll
            for (int rr = 0; rr < 4; ++rr) { const float p = __expf((s[tk][rr] - mx) * 0.0625f); s[tk][rr] = p; sum += p; }
        sum += shx(sum, 16); sum += shx(sum, 32);
        inv[blk] = rcpf_(sum);
#pragma unroll
        for (int ks = 0; ks < 8; ++ks) P[blk][ks] = pack_frag(s[2 * ks], s[2 * ks + 1]);
    }
    __syncthreads();
    { u32x4 t_[16];
#pragma unroll
      for (int y = 0; y < 16; ++y) { const int x = c.tid + y * NTHREADS; t_[y] = *(const u32x4*)(kvb + (size_t)(x >> 5) * 2048 + 1024 + (x & 31) * 8); }
#pragma unroll
      for (int y = 0; y < 16; ++y) { const int x = c.tid + y * NTHREADS; *(LAS u32x4*)(KV + (x >> 5) * P256 + (x & 31) * 16) = t_[y]; } }
    __syncthreads();
#pragma unroll
    for (int t4 = 0; t4 < 4; ++t4) {
        f32x4 o0[4], o1[4];
#pragma unroll
        for (int x = 0; x < 4; ++x) { o0[x] = zero4(); o1[x] = zero4(); }
#pragma unroll
        for (int ks = 0; ks < 8; ++ks) { const int ra = 32 * ks + 4 * g, rb = ra + 16;
            bf16x8 a4[4]; frag_tr_x4(KV, P256, ra, rb, 64 * t4, lane, a4);
#pragma unroll
            for (int x = 0; x < 4; ++x) { o0[x] = MFMA16(a4[x], P[0][ks], o0[x]); o1[x] = MFMA16(a4[x], P[1][ks], o1[x]); } }
        bf16_t* op0 = c.mixed() + (size_t)(row0 + 16 * w + i) * D + hd * 256 + 64 * t4 + 4 * g;
        bf16_t* op1 = op0 + (size_t)128 * D;
        const float iv0 = inv[0], iv1 = inv[1];
#pragma unroll
        for (int x = 0; x < 4; ++x) {
            *(unsigned long long*)(op0 + 16 * x) = (unsigned long long)pk2(o0[x][0] * iv0, o0[x][1] * iv0) | ((unsigned long long)pk2(o0[x][2] * iv0, o0[x][3] * iv0) << 32);
            *(unsigned long long*)(op1 + 16 * x) = (unsigned long long)pk2(o1[x][0] * iv1, o1[x][1] * iv1) | ((unsigned long long)pk2(o1[x][2] * iv1, o1[x][3] * iv1) << 32); }
    }
    __syncthreads();
}
#ifndef MK_PER_PHASE
#define MK_PER_PHASE 0
#endif
#if defined(MK_DUP) || defined(MK_WPHASE)
constexpr int PH_SLOTS = 11;
#else
constexpr int PH_SLOTS = 10;
#endif
constexpr int NP = 2 + DEPTH * PH_SLOTS;
struct Args { const float* in[25]; float* out; unsigned char* ws; int ph_lo, ph_hi; };

__global__ void __launch_bounds__(NTHREADS, 2) mega(Args a) {
    extern __shared__ __attribute__((aligned(16))) unsigned char lds_raw[];
    LAS unsigned char* lds_base = (LAS unsigned char*)lds_raw;
    Ctx c;
    c.out = a.out; c.ws = a.ws;
#if MK_CG_SYNC
    cg::grid_group grid = cg::this_grid();
#else
    if (threadIdx.x < 16) ((LAS unsigned*)(lds_base + LDS_MISC))[threadIdx.x] = 0u;
    __syncthreads();
    const XcdBarrier bar0 = xcd_barrier_post((unsigned*)(a.ws + WS_BAR), (volatile LAS unsigned*)(lds_base + LDS_MISC));
#endif

    for (int p = a.ph_lo; p < a.ph_hi; ++p) {
        { int t_ = threadIdx.x, b_ = blockIdx.x, g_ = gridDim.x;
          asm volatile("" : "+v"(t_)); asm volatile("" : "+s"(b_)); asm volatile("" : "+s"(g_));
          c.tid = t_; c.lane = t_ & 63; c.wave = __builtin_amdgcn_readfirstlane(t_ >> 6); c.bid = b_; c.G = g_; }
        LAS unsigned char* lds; { unsigned lb_ = (unsigned)(size_t)lds_base; asm volatile("" : "+s"(lb_)); lds = (LAS unsigned char*)(size_t)lb_; }
        if (p == 0) {
            convert_part(c, 0, 0, c.bid * NWAVES + c.wave, c.G * NWAVES, lds); convert_part(c, 0, 1, c.bid * NWAVES + c.wave, c.G * NWAVES, lds);
            rows_to_bf16(c, c.in(0), c.hb(), c.rs0(), M);
            rows_to_bf16(c, c.in(1), c.memb(), c.rsm(), MM);
        } else if (p == NP - 1) {
            final_norm(c);
#if MK_OLD_STATES == 3
            if (c.bid == 0) { __syncthreads(); if (c.tid == 0) { float m2 = 0.f; for (int k_ = 0; k_ < c.G; ++k_) m2 = fmaxf(m2, c.wsp<float>(WS_BAR + 15 * 1024)[k_]); c.out[0] += 100.f * fminf(m2, 1.0e4f); } }
#endif
        } else {
            const int l = (p - 1) / PH_SLOTS;
#ifdef MK_DUP
            const int sl_ = (p - 1) % PH_SLOTS, st = sl_ > MK_DUP ? sl_ - 1 : sl_;
#else
            const int st = (p - 1) % PH_SLOTS;
#endif
            if (st == 0) {
                { pg8::Gemm g{c.hb(), c.w_in(), M, NPROJ, D, c.memb(), c.wkv()}; DualOrder S; S.init(M, NPROJ, MM, 2 * D, c.G, c.bid);
                  EpiScale E{c.proj(), NPROJ, c.rs0(), c.gates(), 13, c.memkv(), 2 * D, c.rsm(), (LAS float*)(lds + 131072)};
                  pg8::gemm_phase<EpiScale, DualOrder, true, true>(lds, g, S, E); }
            } else if (st == 1) {
#if MK_OLD_STATES == 1
                if (c.bid < 80) gla_state_item(c, l, c.bid, lds);
                else for (int i = c.bid - 80; i < 768 + 320; i += c.G - 80) { if (i < 768) ml_delta_item(c, l, i, lds); else na_mfma_item(c, l, i - 768, lds); }
#elif MK_OLD_STATES == 3
                if (c.bid < 96) ml_state_item(c, l, c.bid, lds);
                else if (c.bid < 176) gla_state_item(c, l, c.bid - 96, lds);
                else for (int i = c.bid - 176; i < 768 + 320; i += c.G - 176) { if (i < 768) ml_delta_item(c, l, i, lds); else na_mfma_item(c, l, i - 768, lds); }
#elif MK_OLD_STATES == 2
                if (c.bid < 96) ml_state_item(c, l, c.bid, lds);
                else for (int i = c.bid - 96; i < 640 + 320; i += c.G - 96) { if (i < 640) gla_delta_item(c, l, i, lds); else na_mfma_item(c, l, i - 640, lds); }
#else
                for (int i = c.bid; i < 1728; i += c.G) {
                    if (i < 768) ml_delta_item(c, l, i, lds); else if (i < 1408) gla_delta_item(c, l, i - 768, lds); else na_mfma_item(c, l, i - 1408, lds); }
#endif
#ifndef MK_WPHASE
                if (l > 0) convert_part(c, l, 1, c.bid * NWAVES + c.wave, c.G * NWAVES, lds);
                if (l + 1 < DEPTH) convert_part(c, l + 1, 0, c.bid * NWAVES + c.wave, c.G * NWAVES, lds);
#endif
            } else if (st == 2) {
#if MK_OLD_STATES == 1
                ml_scan(c, c.bid * NTHREADS + c.tid, c.G * NTHREADS);
#elif MK_OLD_STATES == 3
                ml_scan(c, c.bid * NTHREADS + c.tid, c.G * NTHREADS);
#elif MK_OLD_STATES == 2
                gla_scan(c, c.bid * NTHREADS + c.tid, c.G * NTHREADS);
#else
                ml_scan(c, c.bid * NTHREADS + c.tid, c.G * NTHREADS); gla_scan(c, c.bid * NTHREADS + c.tid, c.G * NTHREADS);
#endif
            } else if (st == 3) {
#if MK_OLD_STATES == 3
                if (l == MK_PROBE_L) { float mx = 0.f; const bf16_t* A_ = c.wsp<bf16_t>(WS_MLC); const bf16_t* B_ = c.wsp<bf16_t>(WS_MLC2);
                    for (size_t x = (size_t)c.bid * NTHREADS + c.tid; x < (size_t)96 * 16 * 5120; x += (size_t)c.G * NTHREADS) {
                        const int row_ = (int)((x % 5120) / 64), chk_ = (int)((x / 5120) % 16), dir_ = (int)((x / (5120 * 16)) & 1); (void)row_; (void)chk_; (void)dir_;
                        if (!(MK_PROBE_SEL)) continue;
                        const float a_ = bf2f(A_[x]), b_ = bf2f(B_[x]); float d_ = fabsf(a_ - b_); if (!(d_ == d_) || !(b_ == b_)) d_ = 1.0e6f;
                        if (MK_PROBE_REL) d_ = d_ / (fabsf(a_) + 1e-3f); mx = fmaxf(mx, d_); }
#pragma unroll
                    for (int o_ = 1; o_ < 64; o_ <<= 1) mx = fmaxf(mx, __shfl_xor(mx, o_));
                    LAS float* red_ = (LAS float*)lds; if (c.lane == 0) red_[c.wave] = mx; __syncthreads();
                    if (c.tid == 0) { float m2 = 0.f; for (int k_ = 0; k_ < 8; ++k_) m2 = fmaxf(m2, red_[k_]); c.wsp<float>(WS_BAR + 15 * 1024)[c.bid] = m2; }
                    __syncthreads(); }
#endif
                for (int i = c.bid; i < NB * 6 * 16 + NB * 5 * 16; i += c.G) { if (i < NB * 6 * 16) ml_out_item(c, l, i, lds); else gla_out_item(c, l, i - NB * 6 * 16, lds); }
            } else if (st == 4) {
                pg8::Gemm g{c.mixed(), c.w_out(), M, D, D}; pg8::StaticOrder S; S.init(M, D, c.G, c.bid);
                EpiResid E{l == 0 ? c.in(0) : c.out, c.out, c.hb(), c.rs1()};
                pg8::gemm_phase<EpiResid, pg8::StaticOrder, true, true>(lds, g, S, E);
            } else if (st == 5) {
                pg8::Gemm g{c.hb(), c.wq(), M, D, D}; pg8::StaticOrder S; S.init(M, D, c.G, c.bid);
                EpiScale E{c.q(), D, c.rs1(), nullptr, -1, nullptr, 0, nullptr, (LAS float*)(lds + 131072)};
                pg8::gemm_phase<EpiScale, pg8::StaticOrder, true, true>(lds, g, S, E);
            } else if (st == 6) {
                for (int i = c.bid; i < NB * 4 * 8; i += c.G) xattn_mfma_item(c, i, lds);
            } else if (st == 7) {
                pg8::Gemm g{c.mixed(), c.wo(), M, D, D}; pg8::StaticOrder S; S.init(M, D, c.G, c.bid);
                EpiResid E{c.out, c.out, c.hb(), c.rs2()};
                pg8::gemm_phase<EpiResid, pg8::StaticOrder, true, true>(lds, g, S, E);
            } else if (st == 8) {
                pg8::Gemm g{c.hb(), c.w_up(), M, NUP, D}; pg8::StaticOrder S; S.init(M, NUP, c.G, c.bid);
                EpiFfn E{c.act(), c.rs2(), c.in(21) + (size_t)l * 3 * DFF, c.in(22) + (size_t)l * DFF, c.wsp<float>(WS_BND), (LAS float*)(lds + 131072)};
                pg8::gemm_phase<EpiFfn, pg8::StaticOrder, true, true>(lds, g, S, E);
            } else if (st == 9) {
                pg8::Gemm g{c.act(), c.w_dn(), M, D, DFF}; pg8::StaticOrder S; S.init(M, D, c.G, c.bid);
                { pg8::Unit u0; if (S.next(0, u0)) ffn_fixup(c.wsp<float>(WS_BND), c.in(21) + (size_t)l * 3 * DFF, c.in(22) + (size_t)l * DFF, c.act(), u0.pm, c.tid); }
                EpiResid E{c.out, c.out, c.hb(), c.rs0()};
                pg8::gemm_phase<EpiResid, pg8::StaticOrder, true, true>(lds, g, S, E);
#ifdef MK_WPHASE
            } else if (st == 10) { if (l + 1 < DEPTH) { convert_part(c, l + 1, 0, c.bid * NWAVES + c.wave, c.G * NWAVES, lds); convert_part(c, l + 1, 1, c.bid * NWAVES + c.wave, c.G * NWAVES, lds); }
#endif
            }
        }
#if MK_CG_SYNC
        if (p + 1 < a.ph_hi) grid.sync();
#else
        if (p + 1 < a.ph_hi) { XcdBarrier bar = bar0; { unsigned long long bp_ = (unsigned long long)bar.bar; unsigned lo_ = (unsigned)bp_, hi_ = (unsigned)(bp_ >> 32); asm volatile("" : "+s"(lo_), "+s"(hi_));
                bar.bar = (unsigned*)(((unsigned long long)hi_ << 32) | lo_); }
            xcd_barrier(bar); }
#endif
    }
}
}

extern "C" void kernel_launch(void* const* d_in, const int* in_sizes, int n_in, void* d_out, int out_size, void* d_ws, size_t ws_size, hipStream_t stream) {
    static int grid = 0;
    if (grid == 0) {
        if (n_in != 25 || out_size != mk::M * mk::D || ws_size < mk::WS_END) { fprintf(stderr, "kernel_launch: unexpected shapes / workspace (n_in %d out %d ws %zu need %zu)\n", n_in, out_size, ws_size, (size_t)mk::WS_END); grid = -1; return; }
        int dev = 0, cus = 0, per_cu = 0;
        (void)hipGetDevice(&dev); (void)hipDeviceGetAttribute(&cus, hipDeviceAttributeMultiprocessorCount, dev);
        if (hipFuncSetAttribute((const void*)mk::mega, hipFuncAttributeMaxDynamicSharedMemorySize, mk::LDS_BYTES) != hipSuccess) { fprintf(stderr, "kernel_launch: hipFuncSetAttribute failed\n"); grid = -1; return; }
        (void)hipOccupancyMaxActiveBlocksPerMultiprocessor(&per_cu, (const void*)mk::mega, mk::NTHREADS, mk::LDS_BYTES);
        if (per_cu < 1) { fprintf(stderr, "kernel_launch: occupancy query says %d blocks per CU\n", per_cu); grid = -1; return; }
        grid = cus;
        if (grid < 192) { fprintf(stderr, "kernel_launch: needs >= 192 CUs\n"); grid = -1; return; }
    }
    if (grid < 0) return;
    mk::Args a{};
    for (int i = 0; i < 25; ++i) a.in[i] = (const float*)d_in[i];
    a.out = (float*)d_out; a.ws = (unsigned char*)d_ws;
#if MK_PER_PHASE
    for (int p = 0; p < mk::NP; ++p) { a.ph_lo = p; a.ph_hi = p + 1; hipLaunchKernelGGL(mk::mega, dim3(grid), dim3(mk::NTHREADS), mk::LDS_BYTES, stream, a); }
#else
    a.ph_lo = 0; a.ph_hi = mk::NP;
#if MK_CG_SYNC
    void* args[] = {&a};
    hipError_t e = hipLaunchCooperativeKernel((const void*)mk::mega, dim3(grid), dim3(mk::NTHREADS), args, mk::LDS_BYTES, stream);
    if (e != hipSuccess) fprintf(stderr, "cooperative launch failed: %s (grid %d)\n", hipGetErrorString(e), grid);
#else
    if (hipMemsetAsync((char*)d_ws + mk::WS_BAR, 0, mk::WS_BAR_BYTES, stream) != hipSuccess) { fprintf(stderr, "kernel_launch: memset of the barrier words failed\n"); return; }
    hipLaunchKernelGGL(mk::mega, dim3(grid), dim3(mk::NTHREADS), mk::LDS_BYTES, stream, a);
#endif
#endif
}
```
